# Optimizing an MI355X kernel written in HIP

```python
import jax
import jax.numpy as jnp
from jax import lax
import numpy as np

D_MODEL = 1024
BATCH = 4
SEQ = 8192
DEPTH = 2

GRID_W = 64
CTX_LEN = 256
HEAD_DIM = 64
NA_HEADS = 6
NA_WIN_R = 8
NA_WIN_C = 16
RET_HEADS = 6
RET_CHUNK = 128
POOL_WINDOWS = (2, 4, 8, 16)
POOL_GROUP = 64
NA_WIDTH = NA_HEADS * HEAD_DIM
RET_WIDTH = RET_HEADS * HEAD_DIM
POOL_WIDTH = POOL_GROUP * len(POOL_WINDOWS)
D_MIX = NA_WIDTH + RET_WIDTH + POOL_WIDTH
O_NA_Q = 0
O_NA_K = O_NA_Q + NA_WIDTH
O_NA_V = O_NA_K + NA_WIDTH
O_RET_Q = O_NA_V + NA_WIDTH
O_RET_K = O_RET_Q + RET_WIDTH
O_RET_V = O_RET_K + RET_WIDTH
O_RET_G = O_RET_V + RET_WIDTH
O_POOL = O_RET_G + RET_WIDTH
D_PROJ = O_POOL + POOL_WIDTH
ROPE_BASE = 10000.0
ROPE_PAIRS = HEAD_DIM // 4
PEER_HEADS = 8
PEER_NKEYS = 128
PEER_KEY_DIM = 128
PEER_TOPK = 16
PEER_BLOCK = 128
N_EXPERTS = PEER_NKEYS * PEER_NKEYS
NORM_EPS = 1e-6
NEG_INF = -1e30

kernel_name = 'hybrid_na_retention_pool_peer_dit'


def rms_norm(x, w):
    xf = x.astype(jnp.float32)
    y = xf * lax.rsqrt(jnp.mean(xf * xf, axis=-1, keepdims=True) + NORM_EPS)
    return (y * w.astype(jnp.float32)).astype(x.dtype)


def modulate(h, shift, scale):
    return h * (1 + scale) + shift


def split_heads(t):
    B, T, _ = t.shape
    return t.reshape(B, T, -1, HEAD_DIM).transpose(0, 2, 1, 3)


def merge_heads(t):
    B, H, T, d = t.shape
    return t.transpose(0, 2, 1, 3).reshape(B, T, H * d)


def rope_2d_tables(S):
    t = jnp.arange(S)
    row = (t // GRID_W).astype(jnp.float32)
    col = (t % GRID_W).astype(jnp.float32)
    inv = ROPE_BASE ** (-jnp.arange(ROPE_PAIRS, dtype=jnp.float32) / ROPE_PAIRS)
    ang = jnp.concatenate([row[:, None] * inv, col[:, None] * inv], axis=-1)
    return jnp.cos(ang), jnp.sin(ang)


def _rotate(xh, cos, sin):
    x1, x2 = xh[..., :ROPE_PAIRS], xh[..., ROPE_PAIRS:]
    return jnp.concatenate([x1 * cos - x2 * sin, x1 * sin + x2 * cos], axis=-1)


def apply_rope_2d(x, cos, sin):
    cos = cos.astype(x.dtype)
    sin = sin.astype(x.dtype)
    half = 2 * ROPE_PAIRS
    return jnp.concatenate([
        _rotate(x[..., :half], cos[:, :ROPE_PAIRS], sin[:, :ROPE_PAIRS]),
        _rotate(x[..., half:], cos[:, ROPE_PAIRS:], sin[:, ROPE_PAIRS:])], axis=-1)


def neighbourhood_attention(q, k, v, k_ctx, v_ctx, rpb):
    B, H, S, d = q.shape
    rows = S // GRID_W
    wr = min(NA_WIN_R, rows)
    qg = q.reshape(B, H, rows, GRID_W, d)
    kg = k.reshape(B, H, rows, GRID_W, d)
    vg = v.reshape(B, H, rows, GRID_W, d)
    r = jnp.arange(rows)
    r_start = jnp.clip(r - wr // 2, 0, rows - wr)
    ridx = r_start[:, None] + jnp.arange(wr)[None, :]
    k_blk = kg[:, :, ridx]
    v_blk = vg[:, :, ridx]
    cidx = jnp.arange(GRID_W)
    c_start = jnp.clip(cidx - NA_WIN_C // 2, 0, GRID_W - NA_WIN_C)
    col_ok = (cidx[None, :] >= c_start[:, None]) & (cidx[None, :] < c_start[:, None] + NA_WIN_C)
    roff = ridx - r[:, None] + (NA_WIN_R - 1)
    coff = jnp.clip(cidx[None, :] - cidx[:, None] + (NA_WIN_C - 1), 0, 2 * NA_WIN_C - 2)
    bias = rpb[:, roff[:, None, :, None], coff[None, :, None, :]].astype(jnp.float32)
    scale = HEAD_DIM ** -0.5
    s_win = jnp.einsum('bhrqd,bhrjkd->bhrqjk', qg, k_blk).astype(jnp.float32) * scale + bias
    s_win = jnp.where(col_ok[:, None, :], s_win, NEG_INF)
    s_ctx = jnp.einsum('bhrqd,bhcd->bhrqc', qg, k_ctx).astype(jnp.float32) * scale
    n_win = wr * GRID_W
    s = jnp.concatenate([s_win.reshape(B, H, rows, GRID_W, n_win), s_ctx], axis=-1)
    p = jax.nn.softmax(s, axis=-1).astype(v.dtype)
    p_win = p[..., :n_win].reshape(B, H, rows, GRID_W, wr, GRID_W)
    p_ctx = p[..., n_win:]
    out = (jnp.einsum('bhrqjk,bhrjkd->bhrqd', p_win, v_blk)
           + jnp.einsum('bhrqc,bhcd->bhrqd', p_ctx, v_ctx))
    return out.reshape(B, H, S, d)


def context_attention(q, k, v):
    s = jnp.einsum('bhqd,bhkd->bhqk', q, k).astype(jnp.float32) * HEAD_DIM ** -0.5
    p = jax.nn.softmax(s, axis=-1).astype(v.dtype)
    return jnp.einsum('bhqk,bhkd->bhqd', p, v)


def retention_scan(q, k, v, log_gamma, state0):
    B, H, T, d = q.shape
    nc = T // RET_CHUNK

    def chunks(t):
        return t.astype(jnp.float32).reshape(B, H, nc, RET_CHUNK, d).transpose(2, 0, 1, 3, 4)

    pos = jnp.arange(RET_CHUNK, dtype=jnp.float32)
    diff = pos[:, None] - pos[None, :]
    decay = jnp.where(diff[None] >= 0,
                      jnp.exp(jnp.maximum(diff, 0.0)[None] * log_gamma[:, None, None]), 0.0)
    xi = jnp.exp((pos + 1.0)[None, :] * log_gamma[:, None])[..., None]
    zeta = jnp.exp((RET_CHUNK - 1.0 - pos)[None, :] * log_gamma[:, None])[..., None]
    chunk_decay = jnp.exp(RET_CHUNK * log_gamma)[:, None, None]

    def step(R, qkv):
        qc, kc, vc = qkv
        inner = jnp.einsum('bhnm,bhmd->bhnd', jnp.einsum('bhnd,bhmd->bhnm', qc, kc) * decay, vc)
        cross = jnp.einsum('bhnd,bhde->bhne', qc * xi, R)
        R = chunk_decay * R + jnp.einsum('bhmd,bhme->bhde', kc * zeta, vc)
        return R, inner + cross

    _, y = lax.scan(step, state0, (chunks(q), chunks(k), chunks(v)))
    return y.transpose(1, 2, 0, 3, 4).reshape(B, H, T, d)


def retention_bidir(q, k, v, lg_fwd, lg_bwd, state_fwd, state_bwd):
    y_f = retention_scan(q, k, v, lg_fwd, state_fwd)
    y_b = retention_scan(jnp.flip(q, 2), jnp.flip(k, 2), jnp.flip(v, 2), lg_bwd, state_bwd)
    return y_f + jnp.flip(y_b, 2)


def context_states(k, v, lg_fwd, lg_bwd):
    C = k.shape[2]
    m = jnp.arange(C, dtype=jnp.float32)
    w_f = jnp.exp((C - 1.0 - m)[None, :] * lg_fwd[:, None])
    w_b = jnp.exp(m[None, :] * lg_bwd[:, None])
    kf = k.astype(jnp.float32)
    vf = v.astype(jnp.float32)
    R_f = jnp.einsum('bhmd,hm,bhme->bhde', kf, w_f, vf)
    R_b = jnp.einsum('bhmd,hm,bhme->bhde', kf, w_b, vf)
    return R_f, R_b


def retention_output(y, gate, gn_w):
    mu = jnp.mean(y, axis=-1, keepdims=True)
    var = jnp.mean(jnp.square(y - mu), axis=-1, keepdims=True)
    yn = merge_heads((y - mu) * lax.rsqrt(var + NORM_EPS)) * gn_w.astype(jnp.float32)
    return (yn * jax.nn.silu(gate.astype(jnp.float32))).astype(gate.dtype)


def multiscale_pool(p, w_pool, scale):
    B, T, _ = p.shape
    t = jnp.arange(T)
    pf = p.astype(jnp.float32)
    outs = []
    for g, w in enumerate(POOL_WINDOWS):
        xg = pf[..., g * POOL_GROUP:(g + 1) * POOL_GROUP]
        cs = jnp.concatenate([jnp.zeros((B, 1, POOL_GROUP), jnp.float32), jnp.cumsum(xg, axis=1)], axis=1)
        lo = jnp.clip(t - w // 2, 0, T)
        hi = jnp.clip(t + w // 2, 0, T)
        mean = (cs[:, hi] - cs[:, lo]) / (hi - lo).astype(jnp.float32)[:, None]
        outs.append((mean - xg).astype(p.dtype) @ w_pool[g])
    return jnp.concatenate(outs, axis=-1) * scale


def peer_ffn(h, wq, keys, u, v):
    B, T, D = h.shape
    xb = h.reshape(-1, PEER_BLOCK, D)

    def block(xt):
        q = (xt @ wq).reshape(PEER_BLOCK, PEER_HEADS, 2, PEER_KEY_DIM)
        s_a = jnp.einsum('thd,hkd->thk', q[:, :, 0], keys[0]).astype(jnp.float32)
        s_b = jnp.einsum('thd,hkd->thk', q[:, :, 1], keys[1]).astype(jnp.float32)
        va, ia = lax.top_k(s_a, PEER_TOPK)
        vb, ib = lax.top_k(s_b, PEER_TOPK)
        cand = (va[..., :, None] + vb[..., None, :]).reshape(PEER_BLOCK, PEER_HEADS, PEER_TOPK * PEER_TOPK)
        sc, ci = lax.top_k(cand, PEER_TOPK)
        idx = (jnp.take_along_axis(ia, ci // PEER_TOPK, axis=-1) * PEER_NKEYS
               + jnp.take_along_axis(ib, ci % PEER_TOPK, axis=-1))
        gate = jax.nn.softmax(sc, axis=-1).astype(xt.dtype)
        act = jax.nn.gelu(jnp.einsum('td,thkd->thk', xt, u[idx]), approximate=False)
        return jnp.einsum('thk,thkd->td', gate * act, v[idx])

    return lax.map(block, xb).reshape(B, T, D)


def setup_inputs(seed: int = 0) -> dict:
    key = jax.random.key(seed)
    ks = jax.random.split(key, 21)
    f32 = jnp.float32

    def nrm(k, shape, scale):
        return jax.random.normal(k, shape, f32) * scale

    base_logit = jnp.log(2.0 ** (5.0 + jnp.arange(RET_HEADS, dtype=f32)) - 1.0)
    return {
        'x': nrm(ks[0], (BATCH, SEQ, D_MODEL), 1.0),
        'c': nrm(ks[1], (BATCH, D_MODEL), 1.0),
        'ctx': nrm(ks[2], (BATCH, CTX_LEN, D_MODEL), 1.0),
        'c_ctx': nrm(ks[3], (D_MODEL,), 1.0),
        'norm1_w': 1.0 + nrm(ks[4], (DEPTH, D_MODEL), 0.02),
        'norm2_w': 1.0 + nrm(ks[5], (DEPTH, D_MODEL), 0.02),
        'w_ada': nrm(ks[6], (DEPTH, D_MODEL, 6 * D_MODEL), 0.5 * D_MODEL ** -0.5),
        'b_ada': nrm(ks[7], (DEPTH, 6 * D_MODEL), 0.01),
        'w_in': nrm(ks[8], (DEPTH, D_MODEL, D_PROJ), D_MODEL ** -0.5),
        'w_out': nrm(ks[9], (DEPTH, D_MIX, D_MODEL), D_MIX ** -0.5),
        'na_rpb': nrm(ks[10], (DEPTH, NA_HEADS, 2 * NA_WIN_R - 1, 2 * NA_WIN_C - 1), 0.02),
        'ret_decay_fwd': base_logit + nrm(ks[11], (DEPTH, RET_HEADS), 0.01),
        'ret_decay_bwd': base_logit + nrm(ks[12], (DEPTH, RET_HEADS), 0.01),
        'ret_gn_w': 1.0 + nrm(ks[13], (DEPTH, RET_WIDTH), 0.02),
        'pool_w': nrm(ks[14], (DEPTH, len(POOL_WINDOWS), POOL_GROUP, POOL_GROUP), POOL_GROUP ** -0.5),
        'pool_scale': 1.0 + nrm(ks[15], (DEPTH, POOL_WIDTH), 0.02),
        'peer_wq': nrm(ks[16], (DEPTH, D_MODEL, PEER_HEADS * 2 * PEER_KEY_DIM), D_MODEL ** -0.5),
        'peer_keys': nrm(ks[17], (DEPTH, 2, PEER_HEADS, PEER_NKEYS, PEER_KEY_DIM), PEER_KEY_DIM ** -0.5),
        'peer_u': nrm(ks[18], (DEPTH, N_EXPERTS, D_MODEL), D_MODEL ** -0.5),
        'peer_v': nrm(ks[19], (DEPTH, N_EXPERTS, D_MODEL), 0.5),
        'final_norm_w': 1.0 + nrm(ks[20], (D_MODEL,), 0.02),
    }


def reference(x, c, ctx, c_ctx, norm1_w, norm2_w, w_ada, b_ada, w_in, w_out, na_rpb,
              ret_decay_fwd, ret_decay_bwd, ret_gn_w, pool_w, pool_scale,
              peer_wq, peer_keys, peer_u, peer_v, final_norm_w):
    B, S, _ = x.shape
    cos, sin = rope_2d_tables(S)
    c_act = jax.nn.silu(c)
    cc_act = jax.nn.silu(c_ctx)
    for l in range(DEPTH):
        last = l == DEPTH - 1
        wi = w_in[l]
        mod_x = (c_act @ w_ada[l] + b_ada[l])[:, None, :]
        mod_c = cc_act @ w_ada[l] + b_ada[l]
        sh1, sc1, g1, sh2, sc2, g2 = jnp.split(mod_x, 6, axis=-1)
        csh1, csc1, cg1, csh2, csc2, cg2 = jnp.split(mod_c, 6, axis=-1)
        lg_f = jax.nn.log_sigmoid(ret_decay_fwd[l].astype(jnp.float32))
        lg_b = jax.nn.log_sigmoid(ret_decay_bwd[l].astype(jnp.float32))

        hc = modulate(rms_norm(ctx, norm1_w[l]), csh1, csc1)
        if last:
            kv_na_c = hc @ wi[:, O_NA_K:O_RET_Q]
            kv_ret_c = hc @ wi[:, O_RET_K:O_RET_G]
        else:
            pc = hc @ wi
            kv_na_c = pc[..., O_NA_K:O_RET_Q]
            kv_ret_c = pc[..., O_RET_K:O_RET_G]
        kc_na = split_heads(kv_na_c[..., :NA_WIDTH])
        vc_na = split_heads(kv_na_c[..., NA_WIDTH:])
        kc_ret = split_heads(kv_ret_c[..., :RET_WIDTH]) * HEAD_DIM ** -0.5
        vc_ret = split_heads(kv_ret_c[..., RET_WIDTH:])
        R_f, R_b = context_states(kc_ret, vc_ret, lg_f, lg_b)

        hx = modulate(rms_norm(x, norm1_w[l]), sh1, sc1)
        px = hx @ wi
        q_na = split_heads(px[..., O_NA_Q:O_NA_K])
        k_na = split_heads(px[..., O_NA_K:O_NA_V])
        v_na = split_heads(px[..., O_NA_V:O_RET_Q])
        q_ret = apply_rope_2d(split_heads(px[..., O_RET_Q:O_RET_K]), cos, sin)
        k_ret = apply_rope_2d(split_heads(px[..., O_RET_K:O_RET_V]), cos, sin) * HEAD_DIM ** -0.5
        v_ret = split_heads(px[..., O_RET_V:O_RET_G])
        na_out = neighbourhood_attention(q_na, k_na, v_na, kc_na, vc_na, na_rpb[l])
        ret_out = retention_output(retention_bidir(q_ret, k_ret, v_ret, lg_f, lg_b, R_f, R_b),
                                   px[..., O_RET_G:O_POOL], ret_gn_w[l])
        pool_out = multiscale_pool(px[..., O_POOL:], pool_w[l], pool_scale[l])
        mix = jnp.concatenate([merge_heads(na_out), ret_out, pool_out], axis=-1) @ w_out[l]
        x = x + g1 * mix
        x = x + g2 * peer_ffn(modulate(rms_norm(x, norm2_w[l]), sh2, sc2),
                              peer_wq[l], peer_keys[l], peer_u[l], peer_v[l])

        if not last:
            zero_state = jnp.zeros((B, RET_HEADS, HEAD_DIM, HEAD_DIM), jnp.float32)
            na_c = context_attention(split_heads(pc[..., O_NA_Q:O_NA_K]), kc_na, vc_na)
            ret_c = retention_output(
                retention_bidir(split_heads(pc[..., O_RET_Q:O_RET_K]), kc_ret, vc_ret,
                                lg_f, lg_b, zero_state, zero_state),
                pc[..., O_RET_G:O_POOL], ret_gn_w[l])
            pool_c = multiscale_pool(pc[..., O_POOL:], pool_w[l], pool_scale[l])
            mix_c = jnp.concatenate([merge_heads(na_c), ret_c, pool_c], axis=-1) @ w_out[l]
            ctx = ctx + cg1 * mix_c
            ctx = ctx + cg2 * peer_ffn(modulate(rms_norm(ctx, norm2_w[l]), csh2, csc2),
                                       peer_wq[l], peer_keys[l], peer_u[l], peer_v[l])
    return rms_norm(x, final_norm_w)
```

```cpp
#include <hip/hip_runtime.h>
#include <cstdio>
#include <cstdint>

namespace {
constexpr int D = 1024, NB = 4, S = 8192, DEPTH = 2, GW = 64, CTX = 256, HD = 64;
constexpr int NAH = 6, RH = 6, NAW = 384, RW = 384, PW = 256;
constexpr int M_LAT = NB * S, M_CTX = NB * CTX, M_ALL = M_LAT + M_CTX;
constexpr int O_NA_Q = 0, O_NA_K = 384, O_NA_V = 768, O_RET_Q = 1152, O_RET_K = 1536, O_RET_V = 1920, O_RET_G = 2304, O_POOL = 2688;
constexpr int DPROJ = 2944, DPROJ_PAD = 3072;
constexpr int PH = 8, PNK = 128, PKD = 128, PTOP = 16, NEXP = 16384, DQ = 2048;
constexpr float EPS = 1e-6f;
constexpr int NCH = S / 128 + 2;

typedef unsigned short bf16;
typedef short bf16x8 __attribute__((ext_vector_type(8)));
typedef float f32x4 __attribute__((ext_vector_type(4)));

__device__ __forceinline__ float bf2f(bf16 v) { return __uint_as_float(((unsigned)v) << 16); }
__device__ __forceinline__ bf16 f2bf(float f) { unsigned u = __float_as_uint(f); return (bf16)((u + 0x7fffu + ((u >> 16) & 1u)) >> 16); }
__device__ __forceinline__ float silu(float x) { return x / (1.f + __expf(-x)); }
__device__ __forceinline__ float wave_sum(float v) {
#pragma unroll
    for (int o = 1; o < 64; o <<= 1) v += __shfl_xor(v, o);
    return v;
}

constexpr size_t MiB = 1u << 20;
constexpr size_t WS_CTL = 0;
constexpr size_t WS_MOD = 1 * MiB;
constexpr size_t WS_ROPE = WS_MOD + 512 * 1024;
constexpr size_t WS_WI = 4 * MiB;
constexpr size_t WS_WO = 16 * MiB;
constexpr size_t WS_WQ = 20 * MiB;
constexpr size_t WS_KEYS = 28 * MiB;
constexpr size_t WS_XCTX = 29 * MiB;
constexpr size_t WS_U = 34 * MiB;
constexpr size_t WS_V = 98 * MiB;
constexpr size_t WS_ACT = 162 * MiB;
constexpr size_t WS_PX = 228 * MiB;
constexpr size_t WS_ST = 418 * MiB;
constexpr size_t WS_TOPV = 360 * MiB;
constexpr size_t WS_TOPI = 468 * MiB;
constexpr size_t WS_END = 501 * MiB;
constexpr size_t WS_IDX = WS_ST, WS_GATE = WS_ST + 17 * MiB;

__global__ void __launch_bounds__(256) k_mods(const float* c, const float* c_ctx, const float* w_ada, const float* b_ada, float* mod) {
    __shared__ float act[5][D];
    for (int i = threadIdx.x; i < 5 * D; i += 256) { int r = i / D, k = i % D; float v = r < 4 ? c[r * D + k] : c_ctx[k]; act[r][k] = silu(v); }
    __syncthreads();
    int gid = blockIdx.x * 256 + threadIdx.x;
    if (gid >= DEPTH * 6 * D) return;
    int l = gid / (6 * D), j = gid % (6 * D);
    const float* w = w_ada + (size_t)l * D * 6 * D + j;
    float a0 = 0, a1 = 0, a2 = 0, a3 = 0, a4 = 0;
    for (int k = 0; k < D; ++k) { float wv = w[(size_t)k * 6 * D]; a0 += act[0][k] * wv; a1 += act[1][k] * wv; a2 += act[2][k] * wv; a3 += act[3][k] * wv; a4 += act[4][k] * wv; }
    float bb = b_ada[l * 6 * D + j];
    float* o = mod + (size_t)l * 5 * 6 * D + j;
    o[0 * 6 * D] = a0 + bb; o[1 * 6 * D] = a1 + bb; o[2 * 6 * D] = a2 + bb; o[3 * 6 * D] = a3 + bb; o[4 * 6 * D] = a4 + bb;
}
__global__ void __launch_bounds__(256) k_rope(float* cosT, float* sinT) {
    int gid = blockIdx.x * 256 + threadIdx.x; if (gid >= S * 32) return;
    int t = gid / 32, j = gid % 32; int jj = j & 15;
    float inv = powf(10000.f, -(float)jj / 16.f);
    float pos = j < 16 ? (float)(t / GW) : (float)(t % GW);
    float ang = pos * inv;
    cosT[gid] = cosf(ang); sinT[gid] = sinf(ang);
}
__global__ void __launch_bounds__(256) k_transpose(const float* W, int K, int N, int Npad, bf16* Wt) {
    __shared__ float tile[32][33];
    int n0 = blockIdx.x * 32, k0 = blockIdx.y * 32;
    int tx = threadIdx.x & 31, ty = threadIdx.x >> 5;
    for (int i = ty; i < 32; i += 8) { int k = k0 + i, n = n0 + tx; tile[i][tx] = (n < N) ? W[(size_t)k * N + n] : 0.f; }
    __syncthreads();
    for (int i = ty; i < 32; i += 8) { int n = n0 + i, k = k0 + tx; if (n < Npad) Wt[(size_t)n * K + k] = f2bf(tile[tx][i]); }
}
__global__ void __launch_bounds__(256) k_wo_eff(const float* w_out, const float* pool_w, const float* pool_scale, bf16* Wo_t) {
    int gid = blockIdx.x * 256 + threadIdx.x; if (gid >= D * D) return;
    int n = gid / D, k = gid % D;
    float v;
    if (k < 768) v = w_out[(size_t)k * D + n];
    else { int g = (k - 768) / 64, i = (k - 768) % 64; v = 0.f;
        for (int j = 0; j < 64; ++j) v += pool_w[(g * 64 + i) * 64 + j] * pool_scale[g * 64 + j] * w_out[(size_t)(768 + g * 64 + j) * D + n]; }
    Wo_t[(size_t)n * D + k] = f2bf(v);
}
__global__ void __launch_bounds__(256) k_cvt(const float* src, bf16* dst, size_t n4) {
    size_t i = (size_t)blockIdx.x * 256 + threadIdx.x; size_t stride = (size_t)gridDim.x * 256;
    for (; i < n4; i += stride) { f32x4 v = ((const f32x4*)src)[i]; ushort4 o; o.x = f2bf(v.x); o.y = f2bf(v.y); o.z = f2bf(v.z); o.w = f2bf(v.w); ((ushort4*)dst)[i] = o; }
}

__global__ void __launch_bounds__(256) k_norm(const float* xlat, const float* xctx, const float* nw, const float* modl, int off_sh, int off_sc, bf16* act, int nrows) {
    int row = blockIdx.x * 4 + (threadIdx.x >> 6); if (row >= nrows) return;
    int lane = threadIdx.x & 63;
    const float* src = row < M_LAT ? xlat + (size_t)row * D : xctx + (size_t)(row - M_LAT) * D;
    int mi = row < M_LAT ? row / S : 4;
    const float* sh = modl + (size_t)mi * 6 * D + off_sh; const float* sc = modl + (size_t)mi * 6 * D + off_sc;
    f32x4 v[4]; float ss = 0.f;
#pragma unroll
    for (int j = 0; j < 4; ++j) { v[j] = ((const f32x4*)src)[lane + 64 * j]; ss += v[j].x * v[j].x + v[j].y * v[j].y + v[j].z * v[j].z + v[j].w * v[j].w; }
    ss = wave_sum(ss);
    float rs = rsqrtf(ss * (1.f / D) + EPS);
#pragma unroll
    for (int j = 0; j < 4; ++j) { int k = (lane + 64 * j) * 4;
        f32x4 w = *(const f32x4*)(nw + k), a = *(const f32x4*)(sc + k), b = *(const f32x4*)(sh + k);
        ushort4 o; o.x = f2bf(v[j].x * rs * w.x * (1.f + a.x) + b.x); o.y = f2bf(v[j].y * rs * w.y * (1.f + a.y) + b.y);
        o.z = f2bf(v[j].z * rs * w.z * (1.f + a.z) + b.z); o.w = f2bf(v[j].w * rs * w.w * (1.f + a.w) + b.w);
        *(ushort4*)(act + (size_t)row * D + k) = o; }
}

template <int EPI>
__global__ void __launch_bounds__(256) k_gemm(const bf16* A, const bf16* Bt, int K, bf16* Cb, int ldc, int ncols,
                                              const float* xin_lat, const float* xin_ctx, float* xout_lat, float* xout_ctx, const float* modl, int off_g) {
    __shared__ bf16 sA[64][40];
    __shared__ bf16 sB[64][40];
    int m0 = blockIdx.y * 64, n0 = blockIdx.x * 64;
    int tid = threadIdx.x, w = tid >> 6, lane = tid & 63, fr = lane & 15, fq = lane >> 4;
    int lr = tid >> 2, lc = (tid & 3) * 8;
    f32x4 acc[4];
#pragma unroll
    for (int j = 0; j < 4; ++j) acc[j] = (f32x4){0.f, 0.f, 0.f, 0.f};
    for (int k0 = 0; k0 < K; k0 += 32) {
        *(bf16x8*)&sA[lr][lc] = *(const bf16x8*)(A + (size_t)(m0 + lr) * K + k0 + lc);
        *(bf16x8*)&sB[lr][lc] = *(const bf16x8*)(Bt + (size_t)(n0 + lr) * K + k0 + lc);
        __syncthreads();
        bf16x8 a = *(const bf16x8*)&sA[w * 16 + fr][fq * 8];
#pragma unroll
        for (int j = 0; j < 4; ++j) { bf16x8 b = *(const bf16x8*)&sB[j * 16 + fr][fq * 8]; acc[j] = __builtin_amdgcn_mfma_f32_16x16x32_bf16(a, b, acc[j], 0, 0, 0); }
        __syncthreads();
    }
#pragma unroll
    for (int j = 0; j < 4; ++j)
#pragma unroll
        for (int i = 0; i < 4; ++i) {
            int row = m0 + w * 16 + fq * 4 + i, col = n0 + j * 16 + fr;
            if (EPI == 0) { if (col < ncols) Cb[(size_t)row * ldc + col] = f2bf(acc[j][i]); }
            else { int mi = row < M_LAT ? row / S : 4; float g = modl[(size_t)mi * 6 * D + off_g + col];
                if (row < M_LAT) xout_lat[(size_t)row * D + col] = xin_lat[(size_t)row * D + col] + g * acc[j][i];
                else { size_t o = (size_t)(row - M_LAT) * D + col; xout_ctx[o] = xin_ctx[o] + g * acc[j][i]; } }
        }
}

__global__ void __launch_bounds__(64) k_na(const bf16* px, const float* rpb  , bf16* act, int nrows) {
    int gid = blockIdx.x * 64 + threadIdx.x; if (gid >= nrows * NAH) return;
    int row = gid / NAH, h = gid % NAH;
    float q[64], o[64];
    const bf16* qp = px + (size_t)row * DPROJ + O_NA_Q + h * 64;
#pragma unroll
    for (int d = 0; d < 64; ++d) { q[d] = bf2f(qp[d]) * 0.125f; o[d] = 0.f; }
    float mx = -1e30f, den = 0.f;
    int b, nwin = 0, rr = 0, cq = 0, r_start = 0, c_start = 0;
    if (row < M_LAT) { b = row / S; int t = row % S; rr = t / GW; cq = t % GW; r_start = min(max(rr - 4, 0), 128 - 8); c_start = min(max(cq - 8, 0), GW - 16); nwin = 128; }
    else b = (row - M_LAT) / CTX;
    for (int i = 0; i < nwin + CTX; ++i) {
        int krow; float bias = 0.f;
        if (i < nwin) { int j = i / 16, kc = c_start + (i % 16); int kr = r_start + j; krow = b * S + kr * GW + kc;
            bias = rpb[(h * 15 + (kr - rr + 7)) * 31 + (kc - cq + 15)]; }
        else krow = M_LAT + b * CTX + (i - nwin);
        const bf16* kp = px + (size_t)krow * DPROJ + O_NA_K + h * 64;
        float s = 0.f;
#pragma unroll
        for (int d = 0; d < 64; ++d) s += q[d] * bf2f(kp[d]);
        s += bias;
        float nm = fmaxf(mx, s), corr = __expf(mx - nm), p = __expf(s - nm);
        den = den * corr + p; mx = nm;
        const bf16* vp = px + (size_t)krow * DPROJ + O_NA_V + h * 64;
#pragma unroll
        for (int d = 0; d < 64; ++d) o[d] = o[d] * corr + p * bf2f(vp[d]);
    }
    float inv = 1.f / den;
    bf16* op = act + (size_t)row * D + h * 64;
#pragma unroll
    for (int d = 0; d < 64; ++d) op[d] = f2bf(o[d] * inv);
}

__global__ void __launch_bounds__(256) k_pool(const bf16* px, bf16* act, int nrows) {
    int row = blockIdx.x; int ch = threadIdx.x;
    int g = ch / 64, w = 2 << g;
    int t, T, base;
    if (row < M_LAT) { t = row % S; T = S; base = row - t; } else { t = (row - M_LAT) % CTX; T = CTX; base = row - t; }
    int lo = max(t - w / 2, 0), hi = min(t + w / 2, T);
    float s = 0.f;
    for (int tt = lo; tt < hi; ++tt) s += bf2f(px[(size_t)(base + tt) * DPROJ + O_POOL + ch]);
    float x = bf2f(px[(size_t)row * DPROJ + O_POOL + ch]);
    act[(size_t)row * D + 768 + ch] = f2bf(s / (float)(hi - lo) - x);
}

__device__ __forceinline__ float rope_elem(const bf16* p, int d, const float* cs, const float* sn, bool rope) {
    float x = bf2f(p[d]);
    if (!rope) return x;
    int half = d >> 5, dd = d & 31, j = dd & 15;
    float c = cs[half * 16 + j], s = sn[half * 16 + j];
    if (dd < 16) { float x2 = bf2f(p[d + 16]); return x * c - x2 * s; }
    else { float x1 = bf2f(p[d - 16]); return x1 * s + x * c; }
}
__device__ __forceinline__ int chunk_row0(int b, int ci) { return ci < 64 ? b * S + ci * 128 : M_LAT + b * CTX + (ci - 64) * 128; }
__global__ void __launch_bounds__(256) k_ret_state(const bf16* px, const float* cosT, const float* sinT, const float* dec_f, const float* dec_b, float* ST) {
    __shared__ float sk[128][64];
    __shared__ float sv[128][64];
    int ci = blockIdx.x % NCH, h = (blockIdx.x / NCH) % RH, b = blockIdx.x / (NCH * RH);
    int row0 = chunk_row0(b, ci); bool rope = ci < 64;
    for (int i = threadIdx.x; i < 128 * 64; i += 256) { int m = i / 64, d = i % 64; int row = row0 + m;
        int t = rope ? (ci * 128 + m) : 0;
        sk[m][d] = rope_elem(px + (size_t)row * DPROJ + O_RET_K + h * 64, d, cosT + t * 32, sinT + t * 32, rope) * 0.125f;
        sv[m][d] = bf2f(px[(size_t)row * DPROJ + O_RET_V + h * 64 + d]); }
    __syncthreads();
    float lgf = -log1pf(expf(-dec_f[h])), lgb = -log1pf(expf(-dec_b[h]));
    for (int i = threadIdx.x; i < 4096; i += 256) { int d = i / 64, e = i % 64;
        float af = 0.f, ab = 0.f;
        for (int m = 0; m < 128; ++m) { float kv = sk[m][d] * sv[m][e]; af += expf((127.f - m) * lgf) * kv; ab += expf((float)m * lgb) * kv; }
        size_t basef = ((((size_t)(b * RH + h) * 2 + 0) * NCH + ci) * 4096) + i, baseb = ((((size_t)(b * RH + h) * 2 + 1) * NCH + ci) * 4096) + i;
        ST[basef] = af; ST[baseb] = ab; }
}
__global__ void __launch_bounds__(256) k_ret_scan(const float* dec_f, const float* dec_b, float* ST) {
    int gid = blockIdx.x * 256 + threadIdx.x; if (gid >= NB * RH * 4096) return;
    int e = gid % 4096, bh = gid / 4096, h = bh % RH;
    float lgf = -log1pf(expf(-dec_f[h])), lgb = -log1pf(expf(-dec_b[h]));
    float gf = expf(128.f * lgf), gb = expf(128.f * lgb);
    float* F = ST + ((size_t)bh * 2 + 0) * NCH * 4096 + e; float* Bk = ST + ((size_t)bh * 2 + 1) * NCH * 4096 + e;
    float kf0 = F[(size_t)64 * 4096], kf1 = F[(size_t)65 * 4096], kb0 = Bk[(size_t)64 * 4096], kb1 = Bk[(size_t)65 * 4096];
    F[(size_t)64 * 4096] = 0.f; F[(size_t)65 * 4096] = kf0; Bk[(size_t)65 * 4096] = 0.f; Bk[(size_t)64 * 4096] = kb1;
    float R = gf * kf0 + kf1;
    for (int c = 0; c < 64; ++c) { float t = F[(size_t)c * 4096]; F[(size_t)c * 4096] = R; R = gf * R + t; }
    R = kb0 + gb * kb1;
    for (int c = 63; c >= 0; --c) { float t = Bk[(size_t)c * 4096]; Bk[(size_t)c * 4096] = R; R = gb * R + t; }
}
__global__ void __launch_bounds__(128) k_ret_out(const bf16* px, const float* cosT, const float* sinT, const float* dec_f, const float* dec_b, const float* ST, const float* gn_w, bf16* act, int nci) {
    __shared__ float sk[128][64];
    __shared__ float sv[128][64];
    int ci = blockIdx.x % nci, h = (blockIdx.x / nci) % RH, b = blockIdx.x / (nci * RH);
    int row0 = chunk_row0(b, ci); bool rope = ci < 64;
    for (int i = threadIdx.x; i < 128 * 64; i += 128) { int m = i / 64, d = i % 64; int row = row0 + m;
        int t = rope ? (ci * 128 + m) : 0;
        sk[m][d] = rope_elem(px + (size_t)row * DPROJ + O_RET_K + h * 64, d, cosT + t * 32, sinT + t * 32, rope) * 0.125f;
        sv[m][d] = bf2f(px[(size_t)row * DPROJ + O_RET_V + h * 64 + d]); }
    __syncthreads();
    int n = threadIdx.x, row = row0 + n; int t = rope ? (ci * 128 + n) : 0;
    float lgf = -log1pf(expf(-dec_f[h])), lgb = -log1pf(expf(-dec_b[h]));
    float q[64], y[64];
#pragma unroll
    for (int d = 0; d < 64; ++d) { q[d] = rope_elem(px + (size_t)row * DPROJ + O_RET_Q + h * 64, d, cosT + t * 32, sinT + t * 32, rope); y[d] = 0.f; }
    for (int m = 0; m < 128; ++m) {
        float s = 0.f;
#pragma unroll
        for (int d = 0; d < 64; ++d) s += q[d] * sk[m][d];
        float dm = m < n ? expf((float)(n - m) * lgf) : (m > n ? expf((float)(m - n) * lgb) : 2.f);
        s *= dm;
#pragma unroll
        for (int e = 0; e < 64; ++e) y[e] += s * sv[m][e];
    }
    const float* Sf = ST + (((size_t)(b * RH + h) * 2 + 0) * NCH + ci) * 4096; const float* Sb = ST + (((size_t)(b * RH + h) * 2 + 1) * NCH + ci) * 4096;
    float xf = expf((float)(n + 1) * lgf), xb = expf((float)(128 - n) * lgb);
#pragma unroll
    for (int d = 0; d < 64; ++d) { float qf = q[d] * xf, qb = q[d] * xb;
#pragma unroll
        for (int e = 0; e < 64; ++e) y[e] += qf * Sf[d * 64 + e] + qb * Sb[d * 64 + e]; }
    float mu = 0.f;
#pragma unroll
    for (int e = 0; e < 64; ++e) mu += y[e];
    mu *= (1.f / 64.f); float var = 0.f;
#pragma unroll
    for (int e = 0; e < 64; ++e) { float dd = y[e] - mu; var += dd * dd; }
    float rs = rsqrtf(var * (1.f / 64.f) + EPS);
    const bf16* gp = px + (size_t)row * DPROJ + O_RET_G + h * 64; bf16* op = act + (size_t)row * D + NAW + h * 64;
#pragma unroll
    for (int e = 0; e < 64; ++e) { float g = bf2f(gp[e]); op[e] = f2bf((y[e] - mu) * rs * gn_w[h * 64 + e] * silu(g)); }
}

__global__ void __launch_bounds__(256) k_topk1(const bf16* Q, const bf16* keysl  , float* topv, int* topi, int nrows) {
    __shared__ bf16 sk[128][128 + 8];
    int side = blockIdx.y & 1, h = blockIdx.y >> 1;
    const bf16* kp = keysl + ((size_t)(side * PH + h) * PNK) * PKD;
    for (int i = threadIdx.x; i < 128 * 128; i += 256) sk[i / 128][i % 128] = kp[i];
    __syncthreads();
    int row = blockIdx.x * 256 + threadIdx.x; if (row >= nrows) return;
    float q[128];
    const bf16* qp = Q + (size_t)row * DQ + h * 256 + side * 128;
#pragma unroll
    for (int d = 0; d < 128; ++d) q[d] = bf2f(qp[d]);
    float tv[16]; int ti[16];
#pragma unroll
    for (int j = 0; j < 16; ++j) { tv[j] = -3e38f; ti[j] = 0; }
    for (int kk = 0; kk < 128; ++kk) {
        float s = 0.f;
#pragma unroll
        for (int d = 0; d < 128; ++d) s += q[d] * bf2f(sk[kk][d]);
        int si = kk;
#pragma unroll
        for (int j = 0; j < 16; ++j) { if (s > tv[j]) { float tvv = tv[j]; int tii = ti[j]; tv[j] = s; ti[j] = si; s = tvv; si = tii; } }
    }
    size_t o = (((size_t)row * PH + h) * 2 + side) * 16;
#pragma unroll
    for (int j = 0; j < 16; ++j) { topv[o + j] = tv[j]; topi[o + j] = ti[j]; }
}
__global__ void __launch_bounds__(256) k_topk2(const float* topv, const int* topi, int* idx, float* gate, int nrows) {
    int gid = blockIdx.x * 256 + threadIdx.x; if (gid >= nrows * PH) return;
    size_t o = (size_t)gid * 32;
    float vb[16];
#pragma unroll
    for (int j = 0; j < 16; ++j) vb[j] = topv[o + 16 + j];
    float tv[16]; int ti[16];
#pragma unroll
    for (int j = 0; j < 16; ++j) { tv[j] = -3e38f; ti[j] = 0; }
#pragma unroll 1
    for (int i = 0; i < 16; ++i) { const float vai = topv[o + i];
#pragma unroll
        for (int jb = 0; jb < 16; ++jb) { float s = vai + vb[jb]; int si = i * 16 + jb;
#pragma unroll
            for (int j = 0; j < 16; ++j) { if (s > tv[j]) { float tvv = tv[j]; int tii = ti[j]; tv[j] = s; ti[j] = si; s = tvv; si = tii; } } } }
    float mx = tv[0], den = 0.f, p[16];
#pragma unroll
    for (int j = 0; j < 16; ++j) { p[j] = __expf(tv[j] - mx); den += p[j]; }
    float inv = 1.f / den;
    size_t oo = (size_t)gid * 16;
#pragma unroll
    for (int j = 0; j < 16; ++j) { int ia = topi[o + (ti[j] >> 4)], ib = topi[o + 16 + (ti[j] & 15)]; idx[oo + j] = ia * PNK + ib; gate[oo + j] = p[j] * inv; }
}

template <bool FINAL>
__global__ void __launch_bounds__(256) k_peer(const bf16* act, const int* idx, const float* gate, const bf16* U, const bf16* V, const float* modl, int off_g,
                                              float* xlat, float* xctx, const float* fw, int nrows) {
    int row = blockIdx.x * 4 + (threadIdx.x >> 6); if (row >= nrows) return;
    int lane = threadIdx.x & 63;
    float hx[16];
    { bf16x8 a = *(const bf16x8*)(act + (size_t)row * D + lane * 8), b = *(const bf16x8*)(act + (size_t)row * D + 512 + lane * 8);
#pragma unroll
      for (int j = 0; j < 8; ++j) { hx[j] = bf2f((bf16)a[j]); hx[8 + j] = bf2f((bf16)b[j]); } }
    int myi0 = idx[(size_t)row * 128 + lane], myi1 = idx[(size_t)row * 128 + 64 + lane];
    float myg0 = gate[(size_t)row * 128 + lane], myg1 = gate[(size_t)row * 128 + 64 + lane];
    float out[16];
#pragma unroll
    for (int j = 0; j < 16; ++j) out[j] = 0.f;
    for (int i = 0; i < 128; ++i) {
        int e = __shfl(i < 64 ? myi0 : myi1, i & 63); float g = __shfl(i < 64 ? myg0 : myg1, i & 63);
        const bf16* up = U + (size_t)e * D;
        bf16x8 a = *(const bf16x8*)(up + lane * 8), b = *(const bf16x8*)(up + 512 + lane * 8);
        float s = 0.f;
#pragma unroll
        for (int j = 0; j < 8; ++j) s += hx[j] * bf2f((bf16)a[j]) + hx[8 + j] * bf2f((bf16)b[j]);
        s = wave_sum(s);
        float w = g * 0.5f * s * (1.f + erff(s * 0.70710678f));
        const bf16* vp = V + (size_t)e * D;
        bf16x8 c = *(const bf16x8*)(vp + lane * 8), d = *(const bf16x8*)(vp + 512 + lane * 8);
#pragma unroll
        for (int j = 0; j < 8; ++j) { out[j] += w * bf2f((bf16)c[j]); out[8 + j] += w * bf2f((bf16)d[j]); }
    }
    int mi = row < M_LAT ? row / S : 4;
    float* xr = row < M_LAT ? xlat + (size_t)row * D : xctx + (size_t)(row - M_LAT) * D;
    const float* g2 = modl + (size_t)mi * 6 * D + off_g;
    float xn[16]; float ss = 0.f;
#pragma unroll
    for (int hlf = 0; hlf < 2; ++hlf)
#pragma unroll
        for (int j = 0; j < 8; ++j) { int k = hlf * 512 + lane * 8 + j; float v = xr[k] + g2[k] * out[hlf * 8 + j]; xn[hlf * 8 + j] = v; ss += v * v; }
    if (FINAL) { ss = wave_sum(ss); float rs = rsqrtf(ss * (1.f / D) + EPS);
#pragma unroll
        for (int hlf = 0; hlf < 2; ++hlf)
#pragma unroll
            for (int j = 0; j < 8; ++j) { int k = hlf * 512 + lane * 8 + j; xr[k] = xn[hlf * 8 + j] * rs * fw[k]; } }
    else {
#pragma unroll
        for (int hlf = 0; hlf < 2; ++hlf)
#pragma unroll
            for (int j = 0; j < 8; ++j) { int k = hlf * 512 + lane * 8 + j; xr[k] = xn[hlf * 8 + j]; } }
}
}

extern "C" void kernel_launch(void* const* d_in, const int* in_sizes, int n_in, void* d_out, int out_size, void* d_ws, size_t ws_size, hipStream_t stream) {
    if (n_in != 21 || out_size != M_LAT * D || ws_size < WS_END) { fprintf(stderr, "kernel_launch: unexpected sizes n_in %d out %d ws %zu (need %zu)\n", n_in, out_size, ws_size, (size_t)WS_END); return; }
    const float* x = (const float*)d_in[0]; const float* c = (const float*)d_in[1]; const float* ctx = (const float*)d_in[2]; const float* c_ctx = (const float*)d_in[3];
    const float* norm1_w = (const float*)d_in[4]; const float* norm2_w = (const float*)d_in[5]; const float* w_ada = (const float*)d_in[6]; const float* b_ada = (const float*)d_in[7];
    const float* w_in = (const float*)d_in[8]; const float* w_out = (const float*)d_in[9]; const float* na_rpb = (const float*)d_in[10];
    const float* dec_f = (const float*)d_in[11]; const float* dec_b = (const float*)d_in[12]; const float* gn_w = (const float*)d_in[13];
    const float* pool_w = (const float*)d_in[14]; const float* pool_scale = (const float*)d_in[15]; const float* peer_wq = (const float*)d_in[16];
    const float* peer_keys = (const float*)d_in[17]; const float* peer_u = (const float*)d_in[18]; const float* peer_v = (const float*)d_in[19]; const float* final_w = (const float*)d_in[20];
    char* ws = (char*)d_ws; float* out = (float*)d_out;
    float* MOD = (float*)(ws + WS_MOD); float* cosT = (float*)(ws + WS_ROPE); float* sinT = cosT + S * 32;
    bf16* WI = (bf16*)(ws + WS_WI); bf16* WO = (bf16*)(ws + WS_WO); bf16* WQ = (bf16*)(ws + WS_WQ); bf16* KEYS = (bf16*)(ws + WS_KEYS);
    float* XCTX = (float*)(ws + WS_XCTX); bf16* U = (bf16*)(ws + WS_U); bf16* V = (bf16*)(ws + WS_V); bf16* ACT = (bf16*)(ws + WS_ACT);
    bf16* PX = (bf16*)(ws + WS_PX); bf16* Q = PX; float* ST = (float*)(ws + WS_ST); int* IDX = (int*)(ws + WS_IDX); float* GATE = (float*)(ws + WS_GATE);
    float* TOPV = (float*)(ws + WS_TOPV); int* TOPI = (int*)(ws + WS_TOPI);

    k_mods<<<(DEPTH * 6 * D + 255) / 256, 256, 0, stream>>>(c, c_ctx, w_ada, b_ada, MOD);
    k_rope<<<S * 32 / 256, 256, 0, stream>>>(cosT, sinT);
    for (int l = 0; l < DEPTH; ++l) {
        k_transpose<<<dim3(DPROJ_PAD / 32, D / 32), 256, 0, stream>>>(w_in + (size_t)l * D * DPROJ, D, DPROJ, DPROJ_PAD, WI + (size_t)l * DPROJ_PAD * D);
        k_transpose<<<dim3(DQ / 32, D / 32), 256, 0, stream>>>(peer_wq + (size_t)l * D * DQ, D, DQ, DQ, WQ + (size_t)l * DQ * D);
        k_wo_eff<<<D * D / 256, 256, 0, stream>>>(w_out + (size_t)l * D * D, pool_w + (size_t)l * 4 * 64 * 64, pool_scale + (size_t)l * PW, WO + (size_t)l * D * D);
    }
    k_cvt<<<1024, 256, 0, stream>>>(peer_keys, KEYS, (size_t)DEPTH * 2 * PH * PNK * PKD / 4);
    k_cvt<<<4096, 256, 0, stream>>>(peer_u, U, (size_t)DEPTH * NEXP * D / 4);
    k_cvt<<<4096, 256, 0, stream>>>(peer_v, V, (size_t)DEPTH * NEXP * D / 4);

    for (int l = 0; l < DEPTH; ++l) {
        const bool last = (l == DEPTH - 1);
        const float* xl = (l == 0) ? x : out; const float* xc = (l == 0) ? ctx : XCTX;
        const float* modl = MOD + (size_t)l * 5 * 6 * D;
        const int mrows = last ? M_LAT : M_ALL;
        k_norm<<<M_ALL / 4, 256, 0, stream>>>(xl, xc, norm1_w + l * D, modl, 0, D, ACT, M_ALL);
        k_gemm<0><<<dim3(DPROJ_PAD / 64, M_ALL / 64), 256, 0, stream>>>(ACT, WI + (size_t)l * DPROJ_PAD * D, D, PX, DPROJ, DPROJ, nullptr, nullptr, nullptr, nullptr, nullptr, 0);
        k_na<<<(mrows * NAH + 63) / 64, 64, 0, stream>>>(PX, na_rpb + (size_t)l * NAH * 15 * 31, ACT, mrows);
        k_pool<<<mrows, 256, 0, stream>>>(PX, ACT, mrows);
        k_ret_state<<<NB * RH * NCH, 256, 0, stream>>>(PX, cosT, sinT, dec_f + l * RH, dec_b + l * RH, ST);
        k_ret_scan<<<NB * RH * 4096 / 256, 256, 0, stream>>>(dec_f + l * RH, dec_b + l * RH, ST);
        { int nci = last ? 64 : NCH; k_ret_out<<<NB * RH * nci, 128, 0, stream>>>(PX, cosT, sinT, dec_f + l * RH, dec_b + l * RH, ST, gn_w + l * RW, ACT, nci); }
        k_gemm<1><<<dim3(D / 64, mrows / 64), 256, 0, stream>>>(ACT, WO + (size_t)l * D * D, D, nullptr, 0, 0, xl, xc, out, XCTX, modl, 2 * D);
        k_norm<<<mrows / 4, 256, 0, stream>>>(out, XCTX, norm2_w + l * D, modl, 3 * D, 4 * D, ACT, mrows);
        k_gemm<0><<<dim3(DQ / 64, mrows / 64), 256, 0, stream>>>(ACT, WQ + (size_t)l * DQ * D, D, Q, DQ, DQ, nullptr, nullptr, nullptr, nullptr, nullptr, 0);
        k_topk1<<<dim3(mrows / 256, PH * 2), 256, 0, stream>>>(Q, KEYS + (size_t)l * 2 * PH * PNK * PKD, TOPV, TOPI, mrows);
        k_topk2<<<(mrows * PH + 255) / 256, 256, 0, stream>>>(TOPV, TOPI, IDX, GATE, mrows);
        if (last) k_peer<true><<<mrows / 4, 256, 0, stream>>>(ACT, IDX, GATE, U + (size_t)l * NEXP * D, V + (size_t)l * NEXP * D, modl, 5 * D, out, XCTX, final_w, mrows);
        else k_peer<false><<<mrows / 4, 256, 0, stream>>>(ACT, IDX, GATE, U + (size_t)l * NEXP * D, V + (size_t)l * NEXP * D, modl, 5 * D, out, XCTX, final_w, mrows);
    }
}
```

```cpp
#include <hip/hip_runtime.h>
#include <cstdio>
#include <cstdint>

#ifndef DUP_MASK
#define DUP_MASK 0
#endif
#ifndef USE_PG8
#define USE_PG8 1
#endif
#ifndef NA_NAIVE
#define NA_NAIVE 0
#endif
#ifndef TK_NAIVE
#define TK_NAIVE 0
#endif
#ifndef RET_NAIVE
#define RET_NAIVE 0
#endif
#ifndef TK32
#define TK32 1
#endif
#ifndef PEER_BF16
#define PEER_BF16 0
#endif
#define DUP(bit) for (int _r = 0; _r < ((((unsigned)DUP_MASK >> (bit)) & 1u) ? 2 : 1); ++_r)

__device__ __forceinline__ int otid() { int t = threadIdx.x; asm volatile("" : "+v"(t)); return t; }

namespace pg8 {

#define PG8_LAS __attribute__((address_space(3)))
typedef unsigned short bf16_t;
typedef short bf16x8 __attribute__((ext_vector_type(8)));
typedef float f32x4 __attribute__((ext_vector_type(4)));
typedef unsigned u32x4 __attribute__((ext_vector_type(4)));
constexpr int BM = 256, BK = 64, HALF = 128, HTB = HALF * BK * 2  , STAGE_BYTES = 8 * HTB, NXCD = 8, WGM = 8;

__host__ __device__ __forceinline__ int lds_byte(int r, int c) { const int st = (r >> 4) * 2 + (c >> 5), rr = r & 15, cc = c & 31, ob = rr * 64 + cc * 2; return st * 1024 + (ob ^ (((ob >> 9) & 1) << 5)); }
__host__ __device__ __forceinline__ void stage_rc(int b, int& R, int& C) { const int st = b / 1024, sb = b % 1024, swz = sb ^ (((sb >> 9) & 1) << 5); R = (st >> 1) * 16 + swz / 64; C = (st & 1) * 32 + (swz % 64) / 2; }
__host__ __device__ __forceinline__ int perm32(int rho) { const int n = rho >> 4, i = rho & 15; return 8 * (i >> 2) + 4 * n + (i & 3); }

struct Unit { int pm, pn; };
struct Gemm { const bf16_t* A; const bf16_t* Bt; int M, N, K; };

struct StaticOrder {
    int nM, nN, nwg, G, c;
    __host__ __device__ __forceinline__ void init(int M, int N, int G_, int c_) { nM = M / BM; nN = N / BM; nwg = nM * nN; G = G_; c = c_; }
    __host__ __device__ __forceinline__ bool next(int i, Unit& u) const {
        const long L = (long)i * G + c; if (L >= nwg) return false;
        int wgid = (int)L; { const int q = nwg / NXCD, r = nwg % NXCD, xcd = wgid % NXCD, off = wgid / NXCD; wgid = (xcd < r ? xcd * (q + 1) : r * (q + 1) + (xcd - r) * q) + off; }
        const int nig = WGM * nN, gid = wgid / nig, fm = gid * WGM, gsz = (nM - fm) < WGM ? (nM - fm) : WGM;
        u.pm = fm + ((wgid % nig) % gsz); u.pn = (wgid % nig) / gsz; return true;
    }
    __device__ __forceinline__ void a_ready(const Unit&) const {}
    __device__ __forceinline__ void done(const Unit&) const {}
};
struct OneUnit { Unit u; __device__ __forceinline__ bool next(int i, Unit& o) const { if (i != 0) return false; o = u; return true; }
    __device__ __forceinline__ void a_ready(const Unit&) const {} __device__ __forceinline__ void done(const Unit&) const {} };

typedef unsigned u32x2 __attribute__((ext_vector_type(2)));
__device__ __forceinline__ unsigned cvt_pk_bf16(float lo, float hi) { unsigned r; asm volatile("v_cvt_pk_bf16_f32 %0, %1, %2" : "=v"(r) : "v"(lo), "v"(hi)); return r; }
template <class Epi, class Sched, bool STAMP = false>
__device__ __forceinline__ void gemm_phase(PG8_LAS unsigned char* lds, const Gemm g, const Sched& S, const Epi& E, unsigned long long* stamps) {
    const int tid = otid(), wid = __builtin_amdgcn_readfirstlane(tid >> 6), lane = tid & 63, wr = wid >> 2, wc = wid & 3, fr = lane & 15, fq = lane >> 4;
    const int K = g.K, nt = K / BK;
    int ts_lo = 0, ts_hi = 0, nts = 0; const unsigned long long rt_entry = STAMP ? (unsigned long long)wall_clock64() : 0ull;
#define PG8_STAMP() do { if (STAMP && wid == 0 && nts < 64) { const unsigned long long _c = (unsigned long long)clock64(); \
        ts_lo = (lane == nts) ? (int)(unsigned)_c : ts_lo; ts_hi = (lane == nts) ? (int)(unsigned)(_c >> 32) : ts_hi; ++nts; } } while (0)
    PG8_STAMP();
    unsigned voffA[2], voffB[2];
#pragma unroll
    for (int i = 0; i < 2; ++i) { int R, C; stage_rc(tid * 16 + i * 8192, R, C); const int Rb = Epi::PERM ? ((R & ~31) + perm32(R & 31)) : R;
        voffA[i] = (unsigned)(R * K + C) * 2u; voffB[i] = (unsigned)(Rb * K + C) * 2u; }
    const size_t kstep = (size_t)(BK * 2);
    const size_t hstep = (size_t)HALF * K * 2;
    const size_t tstep = 2 * hstep;
    const unsigned ldsw = (unsigned)wid * 1024u;
    const int aoff = lds_byte(wr * 64 + fr, fq * 8), boff = lds_byte(wc * 32 + fr, fq * 8);
#define PG8_SA(b, h) (((b) * 2 + (h)) * HTB)
#define PG8_SB(b, h) ((4 + (b) * 2 + (h)) * HTB)
#define PG8_STAGE(bufoff, gbase, voff) do { _Pragma("unroll") for (int _i = 0; _i < 2; ++_i) \
        __builtin_amdgcn_global_load_lds((const unsigned*)((const char*)(gbase) + (voff)[_i]), (PG8_LAS unsigned*)(lds + (bufoff) + ldsw + _i * 8192), 16, 0, 0); } while (0)
#define PG8_LDA(dst, b, h) do { _Pragma("unroll") for (int m = 0; m < 4; ++m) _Pragma("unroll") for (int k = 0; k < 2; ++k) dst[m][k] = *(const PG8_LAS bf16x8*)(lds + PG8_SA(b, h) + aoff + m * 2048 + k * 1024); } while (0)
#define PG8_LDB(dst, b, h) do { _Pragma("unroll") for (int n = 0; n < 2; ++n) _Pragma("unroll") for (int k = 0; k < 2; ++k) dst[n][k] = *(const PG8_LAS bf16x8*)(lds + PG8_SB(b, h) + boff + n * 2048 + k * 1024); } while (0)
#define PG8_MMA(ai, bj, At, Bt) do { __builtin_amdgcn_s_setprio(1); _Pragma("unroll") for (int m = 0; m < 4; ++m) _Pragma("unroll") for (int n = 0; n < 2; ++n) _Pragma("unroll") for (int k = 0; k < 2; ++k) \
        acc[ai][bj][m][n] = __builtin_amdgcn_mfma_f32_16x16x32_bf16(Bt[n][k], At[m][k], acc[ai][bj][m][n], 0, 0, 0); __builtin_amdgcn_s_setprio(0); } while (0)
#define PG8_WAIT_V(n) asm volatile("s_waitcnt vmcnt(" #n ")" ::: "memory")
#define PG8_WAIT_L(n) asm volatile("s_waitcnt lgkmcnt(" #n ")" ::: "memory")
#define PG8_BAR __builtin_amdgcn_s_barrier()
#define PG8_SCHED __builtin_amdgcn_sched_barrier(0)
    Unit cur, nxt; int ui = 0;
    if (!S.next(0, cur)) return;
    f32x4 acc[2][2][4][2];
#pragma unroll
    for (int a = 0; a < 2; ++a)
#pragma unroll
        for (int b = 0; b < 2; ++b)
#pragma unroll
            for (int m = 0; m < 4; ++m)
#pragma unroll
                for (int n = 0; n < 2; ++n) acc[a][b][m][n] = (f32x4){0.f, 0.f, 0.f, 0.f};
    bf16x8 At[4][2], B0[2][2], B1[2][2];
    const char* cA = (const char*)g.A + (size_t)cur.pm * tstep; const char* cB = (const char*)g.Bt + (size_t)cur.pn * tstep;
    S.a_ready(cur);
    PG8_STAGE(PG8_SB(0, 0), cB, voffB); PG8_STAGE(PG8_SA(0, 0), cA, voffA); PG8_STAGE(PG8_SB(0, 1), cB + hstep, voffB); PG8_STAGE(PG8_SA(0, 1), cA + hstep, voffA);
    if (wr == 1) PG8_BAR;
    PG8_WAIT_V(4); PG8_BAR;
    PG8_STAGE(PG8_SB(1, 0), cB + kstep, voffB); PG8_STAGE(PG8_SA(1, 0), cA + kstep, voffA); PG8_STAGE(PG8_SB(1, 1), cB + hstep + kstep, voffB);
    PG8_WAIT_V(6); PG8_BAR;
    PG8_STAMP();
    for (;;) {
        const bool has_next = S.next(ui + 1, nxt);
        const char* nA = has_next ? (const char*)g.A + (size_t)nxt.pm * tstep : cA; const char* nB = has_next ? (const char*)g.Bt + (size_t)nxt.pn * tstep : cB;
        for (int t = 0; t < nt; t += 2) {
            const bool last = (t == nt - 2);
            const char* a1 = cA + (size_t)(t + 1) * kstep;
            const char* a2 = last ? nA : cA + (size_t)(t + 2) * kstep; const char* b2 = last ? nB : cB + (size_t)(t + 2) * kstep;
            const char* a3 = a2 + kstep; const char* b3 = b2 + kstep;
            if (last && has_next) S.a_ready(nxt);
            PG8_LDB(B0, 0, 0); PG8_SCHED; PG8_LDA(At, 0, 0); PG8_STAGE(PG8_SA(1, 1), a1 + hstep, voffA);
            PG8_WAIT_L(8); PG8_BAR; PG8_WAIT_L(0); PG8_MMA(0, 0, At, B0); PG8_BAR; PG8_SCHED;
            PG8_LDB(B1, 0, 1); PG8_STAGE(PG8_SB(0, 0), b2, voffB);
            PG8_BAR; PG8_WAIT_L(0); PG8_MMA(0, 1, At, B1); PG8_BAR;
            PG8_LDA(At, 0, 1); PG8_STAGE(PG8_SA(0, 0), a2, voffA);
            PG8_BAR; PG8_WAIT_L(0); PG8_MMA(1, 0, At, B0); PG8_BAR; PG8_SCHED;
            PG8_STAGE(PG8_SB(0, 1), b2 + hstep, voffB);
            PG8_WAIT_V(6); PG8_BAR; PG8_MMA(1, 1, At, B1); PG8_BAR;
            PG8_LDB(B0, 1, 0); PG8_SCHED; PG8_LDA(At, 1, 0); PG8_STAGE(PG8_SA(0, 1), a2 + hstep, voffA);
            PG8_WAIT_L(8); PG8_BAR; PG8_WAIT_L(0); PG8_MMA(0, 0, At, B0); PG8_BAR; PG8_SCHED;
            PG8_LDB(B1, 1, 1); PG8_STAGE(PG8_SB(1, 0), b3, voffB);
            PG8_BAR; PG8_WAIT_L(0); PG8_MMA(0, 1, At, B1); PG8_BAR;
            PG8_LDA(At, 1, 1); PG8_STAGE(PG8_SA(1, 0), a3, voffA);
            PG8_BAR; PG8_WAIT_L(0); PG8_MMA(1, 0, At, B0); PG8_BAR; PG8_SCHED;
            PG8_STAGE(PG8_SB(1, 1), b3 + hstep, voffB);
            PG8_WAIT_V(6); PG8_BAR; PG8_MMA(1, 1, At, B1); PG8_BAR;
        }
        PG8_STAMP();
        if constexpr (!Epi::AFTER_DRAIN) { E(acc, cur, wr, wc, fr, fq); S.done(cur); }
        PG8_STAMP();
        if (!has_next) break;
#pragma unroll
        for (int a = 0; a < 2; ++a)
#pragma unroll
            for (int b = 0; b < 2; ++b)
#pragma unroll
                for (int m = 0; m < 4; ++m)
#pragma unroll
                    for (int n = 0; n < 2; ++n) acc[a][b][m][n] = (f32x4){0.f, 0.f, 0.f, 0.f};
        cur = nxt; cA = nA; cB = nB; ++ui;
    }
    PG8_WAIT_V(0);
    if (wr == 0) PG8_BAR;
    PG8_BAR;
    if constexpr (Epi::AFTER_DRAIN) { E.fused(acc, cur, wr, wc, fr, fq, lds, wid, lane); S.done(cur); }
    PG8_STAMP();
    if (STAMP && wid == 0) { stamps[lane] = lane < nts ? (((unsigned long long)(unsigned)ts_hi << 32) | (unsigned)ts_lo) : 0ull;
        if (lane == 62) stamps[62] = rt_entry; if (lane == 63) stamps[63] = (unsigned long long)wall_clock64(); }
#undef PG8_STAMP
#undef PG8_SA
#undef PG8_SB
#undef PG8_STAGE
#undef PG8_LDA
#undef PG8_LDB
#undef PG8_MMA
#undef PG8_WAIT_V
#undef PG8_WAIT_L
#undef PG8_BAR
#undef PG8_SCHED
}

typedef int i32x4 __attribute__((ext_vector_type(4)));
template <class Epi, class Sched, bool STAMP = false>
__device__ __forceinline__ void gemm_phase_i8(PG8_LAS unsigned char* lds, const Gemm g, const Sched& S, const Epi& E, unsigned long long* stamps) {
    const int tid = otid(), wid = __builtin_amdgcn_readfirstlane(tid >> 6), lane = tid & 63, wr = wid >> 2, wc = wid & 3, fr = lane & 15, fq = lane >> 4;
    const int K = g.K, nt = K / BK;
    int ts_lo = 0, ts_hi = 0, nts = 0; const unsigned long long rt_entry = STAMP ? (unsigned long long)wall_clock64() : 0ull;
#define PG8_STAMP() do { if (STAMP && wid == 0 && nts < 64) { const unsigned long long _c = (unsigned long long)clock64(); \
        ts_lo = (lane == nts) ? (int)(unsigned)_c : ts_lo; ts_hi = (lane == nts) ? (int)(unsigned)(_c >> 32) : ts_hi; ++nts; } } while (0)
    PG8_STAMP();
    unsigned voffA[2], voffB[2];
#pragma unroll
    for (int i = 0; i < 2; ++i) { int R, C; stage_rc(tid * 16 + i * 8192, R, C); const int Rb = Epi::PERM ? ((R & ~31) + perm32(R & 31)) : R;
        voffA[i] = (unsigned)(R * K + C) * 2u; voffB[i] = (unsigned)(Rb * K + C) * 2u; }
    const size_t kstep = (size_t)(BK * 2);
    const size_t hstep = (size_t)HALF * K * 2;
    const size_t tstep = 2 * hstep;
    const unsigned ldsw = (unsigned)wid * 1024u;
    const int aoff = lds_byte(wr * 64 + fr, fq * 8), boff = lds_byte(wc * 32 + fr, fq * 8);
#define PG8_SA(b, h) (((b) * 2 + (h)) * HTB)
#define PG8_SB(b, h) ((4 + (b) * 2 + (h)) * HTB)
#define PG8_STAGE(bufoff, gbase, voff) do { _Pragma("unroll") for (int _i = 0; _i < 2; ++_i) \
        __builtin_amdgcn_global_load_lds((const unsigned*)((const char*)(gbase) + (voff)[_i]), (PG8_LAS unsigned*)(lds + (bufoff) + ldsw + _i * 8192), 16, 0, 0); } while (0)
#define PG8_LDA(dst, b, h) do { _Pragma("unroll") for (int m = 0; m < 4; ++m) _Pragma("unroll") for (int k = 0; k < 2; ++k) dst[m][k] = *(const PG8_LAS i32x4*)(lds + PG8_SA(b, h) + aoff + m * 2048 + k * 1024); } while (0)
#define PG8_LDB(dst, b, h) do { _Pragma("unroll") for (int n = 0; n < 2; ++n) _Pragma("unroll") for (int k = 0; k < 2; ++k) dst[n][k] = *(const PG8_LAS i32x4*)(lds + PG8_SB(b, h) + boff + n * 2048 + k * 1024); } while (0)
#define PG8_MMA(ai, bj, At, Bt) do { __builtin_amdgcn_s_setprio(1); _Pragma("unroll") for (int m = 0; m < 4; ++m) _Pragma("unroll") for (int n = 0; n < 2; ++n) _Pragma("unroll") for (int k = 0; k < 2; ++k) \
        acc[ai][bj][m][n] = __builtin_amdgcn_mfma_i32_16x16x64_i8(Bt[n][k], At[m][k], acc[ai][bj][m][n], 0, 0, 0); __builtin_amdgcn_s_setprio(0); } while (0)
#define PG8_WAIT_V(n) asm volatile("s_waitcnt vmcnt(" #n ")" ::: "memory")
#define PG8_WAIT_L(n) asm volatile("s_waitcnt lgkmcnt(" #n ")" ::: "memory")
#define PG8_BAR __builtin_amdgcn_s_barrier()
#define PG8_SCHED __builtin_amdgcn_sched_barrier(0)
    Unit cur, nxt; int ui = 0;
    if (!S.next(0, cur)) return;
    i32x4 acc[2][2][4][2];
#pragma unroll
    for (int a = 0; a < 2; ++a)
#pragma unroll
        for (int b = 0; b < 2; ++b)
#pragma unroll
            for (int m = 0; m < 4; ++m)
#pragma unroll
                for (int n = 0; n < 2; ++n) acc[a][b][m][n] = (i32x4){0, 0, 0, 0};
    i32x4 At[4][2], B0[2][2], B1[2][2];
    const char* cA = (const char*)g.A + (size_t)cur.pm * tstep; const char* cB = (const char*)g.Bt + (size_t)cur.pn * tstep;
    S.a_ready(cur);
    PG8_STAGE(PG8_SB(0, 0), cB, voffB); PG8_STAGE(PG8_SA(0, 0), cA, voffA); PG8_STAGE(PG8_SB(0, 1), cB + hstep, voffB); PG8_STAGE(PG8_SA(0, 1), cA + hstep, voffA);
    if (wr == 1) PG8_BAR;
    PG8_WAIT_V(4); PG8_BAR;
    PG8_STAGE(PG8_SB(1, 0), cB + kstep, voffB); PG8_STAGE(PG8_SA(1, 0), cA + kstep, voffA); PG8_STAGE(PG8_SB(1, 1), cB + hstep + kstep, voffB);
    PG8_WAIT_V(6); PG8_BAR;
    PG8_STAMP();
    for (;;) {
        const bool has_next = S.next(ui + 1, nxt);
        const char* nA = has_next ? (const char*)g.A + (size_t)nxt.pm * tstep : cA; const char* nB = has_next ? (const char*)g.Bt + (size_t)nxt.pn * tstep : cB;
        for (int t = 0; t < nt; t += 2) {
            const bool last = (t == nt - 2);
            const char* a1 = cA + (size_t)(t + 1) * kstep;
            const char* a2 = last ? nA : cA + (size_t)(t + 2) * kstep; const char* b2 = last ? nB : cB + (size_t)(t + 2) * kstep;
            const char* a3 = a2 + kstep; const char* b3 = b2 + kstep;
            if (last && has_next) S.a_ready(nxt);
            PG8_LDB(B0, 0, 0); PG8_SCHED; PG8_LDA(At, 0, 0); PG8_STAGE(PG8_SA(1, 1), a1 + hstep, voffA);
            PG8_WAIT_L(8); PG8_BAR; PG8_WAIT_L(0); PG8_MMA(0, 0, At, B0); PG8_BAR; PG8_SCHED;
            PG8_LDB(B1, 0, 1); PG8_STAGE(PG8_SB(0, 0), b2, voffB);
            PG8_BAR; PG8_WAIT_L(0); PG8_MMA(0, 1, At, B1); PG8_BAR;
            PG8_LDA(At, 0, 1); PG8_STAGE(PG8_SA(0, 0), a2, voffA);
            PG8_BAR; PG8_WAIT_L(0); PG8_MMA(1, 0, At, B0); PG8_BAR; PG8_SCHED;
            PG8_STAGE(PG8_SB(0, 1), b2 + hstep, voffB);
            PG8_WAIT_V(6); PG8_BAR; PG8_MMA(1, 1, At, B1); PG8_BAR;
            PG8_LDB(B0, 1, 0); PG8_SCHED; PG8_LDA(At, 1, 0); PG8_STAGE(PG8_SA(0, 1), a2 + hstep, voffA);
            PG8_WAIT_L(8); PG8_BAR; PG8_WAIT_L(0); PG8_MMA(0, 0, At, B0); PG8_BAR; PG8_SCHED;
            PG8_LDB(B1, 1, 1); PG8_STAGE(PG8_SB(1, 0), b3, voffB);
            PG8_BAR; PG8_WAIT_L(0); PG8_MMA(0, 1, At, B1); PG8_BAR;
            PG8_LDA(At, 1, 1); PG8_STAGE(PG8_SA(1, 0), a3, voffA);
            PG8_BAR; PG8_WAIT_L(0); PG8_MMA(1, 0, At, B0); PG8_BAR; PG8_SCHED;
            PG8_STAGE(PG8_SB(1, 1), b3 + hstep, voffB);
            PG8_WAIT_V(6); PG8_BAR; PG8_MMA(1, 1, At, B1); PG8_BAR;
        }
        PG8_STAMP();
        if constexpr (!Epi::AFTER_DRAIN) { for (int _e = 0; _e < ((((unsigned)DUP_MASK >> 14) & 1u) ? 2 : 1); ++_e) E(acc, cur, wr, wc, fr, fq); S.done(cur); }
        PG8_STAMP();
        if (!has_next) break;
#pragma unroll
        for (int a = 0; a < 2; ++a)
#pragma unroll
            for (int b = 0; b < 2; ++b)
#pragma unroll
                for (int m = 0; m < 4; ++m)
#pragma unroll
                    for (int n = 0; n < 2; ++n) acc[a][b][m][n] = (i32x4){0, 0, 0, 0};
        cur = nxt; cA = nA; cB = nB; ++ui;
    }
    PG8_WAIT_V(0);
    if (wr == 0) PG8_BAR;
    PG8_BAR;
    if constexpr (Epi::AFTER_DRAIN) { E.fused(acc, cur, wr, wc, fr, fq, lds, wid, lane); S.done(cur); }
    PG8_STAMP();
    if (STAMP && wid == 0) { stamps[lane] = lane < nts ? (((unsigned long long)(unsigned)ts_hi << 32) | (unsigned)ts_lo) : 0ull;
        if (lane == 62) stamps[62] = rt_entry; if (lane == 63) stamps[63] = (unsigned long long)wall_clock64(); }
#undef PG8_STAMP
#undef PG8_SA
#undef PG8_SB
#undef PG8_STAGE
#undef PG8_LDA
#undef PG8_LDB
#undef PG8_MMA
#undef PG8_WAIT_V
#undef PG8_WAIT_L
#undef PG8_BAR
#undef PG8_SCHED
}
}

#define XB_TMO      128
#define XB_XCNT(j)  (256  + 64 * (j))
#define XB_XSUB(j)  (1280 + 64 * (j))
#define XB_XGEN(j)  (2304 + 64 * (j))
#define XB_TOP      3328
#define XB_TOPGEN   3392
#define XCD_BAR_WORDS 3456
#define XB_SPIN_CAP (1u << 18)
#define LAS __attribute__((address_space(3)))

__device__ __forceinline__ unsigned xb_ld(unsigned* p)              { return __hip_atomic_load(p, __ATOMIC_RELAXED, __HIP_MEMORY_SCOPE_AGENT); }
__device__ __forceinline__ unsigned xb_add(unsigned* p, unsigned v) { return __hip_atomic_fetch_add(p, v, __ATOMIC_RELAXED, __HIP_MEMORY_SCOPE_AGENT); }
__device__ __forceinline__ unsigned xb_xcc_id() { return (unsigned)__builtin_amdgcn_s_getreg((3 << 11) | 20) & 0xFu; }
#define XB_SPIN(cond, bar) do { unsigned _sp = 0; while (cond) { __builtin_amdgcn_s_sleep(1); \
    if ((++_sp & 255u) == 0u) { if (xb_ld(&(bar)[XB_TMO])) break; if (_sp > XB_SPIN_CAP) { atomicAdd(&(bar)[XB_TMO], 1u); break; } } } } while (0)

struct XcdBarrier {
    unsigned* bar; unsigned x;
    volatile LAS unsigned* st;
};

__device__ __forceinline__ XcdBarrier xcd_barrier_post(unsigned* bar, volatile LAS unsigned* st) {
    XcdBarrier b; b.bar = bar; b.x = xb_xcc_id(); b.st = st;
    if (threadIdx.x == 0) (void)xb_add(&bar[XB_XCNT(b.x)], 1u);
    return b;
}
__device__ __forceinline__ void xcd_barrier_complete(unsigned* bar, unsigned x, unsigned& nloc, unsigned& nx) {
    const unsigned G = gridDim.x * gridDim.y * gridDim.z;
    unsigned sum, cnt, mine, sp = 0u;
    for (;;) {
        sum = 0u; cnt = 0u; mine = 0u;
#pragma unroll
        for (unsigned j = 0; j < 16; ++j) { const unsigned c = xb_ld(&bar[XB_XCNT(j)]); sum += c; cnt += (c > 0u) ? 1u : 0u; mine = (j == x) ? c : mine; }
        if (sum == G) break;
        __builtin_amdgcn_s_sleep(1);
        if ((++sp & 255u) == 0u) { if (xb_ld(&bar[XB_TMO])) break; if (sp > XB_SPIN_CAP) { atomicAdd(&bar[XB_TMO], 1u); break; } }
    }
    nloc = mine > 0u ? mine : 1u; nx = cnt > 0u ? cnt : 1u;
}

__device__ __forceinline__ void xcd_barrier(const XcdBarrier& b) {
    asm volatile("s_waitcnt vmcnt(0)" ::: "memory");
    __syncthreads();
    if (threadIdx.x == 0) {
        unsigned* bar = b.bar;
        __builtin_amdgcn_s_waitcnt(0);
        unsigned nloc = b.st[0], nx = b.st[1];
        if (nloc == 0u) { xcd_barrier_complete(bar, b.x, nloc, nx); b.st[0] = nloc; b.st[1] = nx; }
        const unsigned old = xb_add(&bar[XB_XSUB(b.x)], 1u);
        const unsigned gen = old / nloc;
        if (old + 1u == (gen + 1u) * nloc) {
            __builtin_amdgcn_fence(__ATOMIC_RELEASE, "agent");
            asm volatile("s_waitcnt vmcnt(0)" ::: "memory");
            const unsigned og = xb_add(&bar[XB_TOP], 1u);
            const unsigned tg = og / nx;
            if (og + 1u == (tg + 1u) * nx) xb_add(&bar[XB_TOPGEN], 1u);
            else XB_SPIN(xb_ld(&bar[XB_TOPGEN]) == tg, bar);
            __builtin_amdgcn_fence(__ATOMIC_ACQUIRE, "agent");
            xb_add(&bar[XB_XGEN(b.x)], 1u);
            asm volatile("s_waitcnt vmcnt(0)" ::: "memory");
        } else {
            XB_SPIN(xb_ld(&bar[XB_XGEN(b.x)]) == gen, bar);
            __builtin_amdgcn_fence(__ATOMIC_ACQUIRE, "agent");
            asm volatile("s_waitcnt vmcnt(0)" ::: "memory");
        }
    }
    __syncthreads();
}


namespace {
constexpr int D = 1024, NB = 4, S = 8192, DEPTH = 2, GW = 64, CTX = 256, HD = 64;
constexpr int NAH = 6, RH = 6, NAW = 384, RW = 384, PW = 256;
constexpr int M_LAT = NB * S, M_CTX = NB * CTX, M_ALL = M_LAT + M_CTX;
constexpr int O_NA_Q = 0, O_NA_K = 384, O_NA_V = 768, O_RET_Q = 1152, O_RET_K = 1536, O_RET_V = 1920, O_RET_G = 2304, O_POOL = 2688;
constexpr int DPROJ = 2944, DPROJ_PAD = 3072;
constexpr int PH = 8, PNK = 128, PKD = 128, PTOP = 16, NEXP = 16384, DQ = 2048;
constexpr float EPS = 1e-6f;
constexpr int NCH = S / 128 + 2;
constexpr int NT = 512;
constexpr int LDS_BYTES = 163840;

typedef unsigned short bf16;
typedef short bf16x8 __attribute__((ext_vector_type(8)));
typedef float f32x4 __attribute__((ext_vector_type(4)));
typedef unsigned u32x4 __attribute__((ext_vector_type(4)));

__device__ __forceinline__ float bf2f(bf16 v) { return __uint_as_float(((unsigned)v) << 16); }
__device__ __forceinline__ bf16 f2bf(float f) { unsigned u = __float_as_uint(f); return (bf16)((u + 0x7fffu + ((u >> 16) & 1u)) >> 16); }
__device__ __forceinline__ float silu(float x) { return x / (1.f + __expf(-x)); }
#define SWZ_XOR(v, m) __int_as_float(__builtin_amdgcn_ds_swizzle(__float_as_int(v), ((m) << 10) | 0x1f))
__device__ __forceinline__ float wave_sum(float v) {
    v += SWZ_XOR(v, 1); v += SWZ_XOR(v, 2); v += SWZ_XOR(v, 4); v += SWZ_XOR(v, 8); v += SWZ_XOR(v, 16);
    return __int_as_float(__builtin_amdgcn_readlane(__float_as_int(v), 0)) + __int_as_float(__builtin_amdgcn_readlane(__float_as_int(v), 32));
}
__device__ __forceinline__ float wave_max(float v) {
    v = fmaxf(v, SWZ_XOR(v, 1)); v = fmaxf(v, SWZ_XOR(v, 2)); v = fmaxf(v, SWZ_XOR(v, 4)); v = fmaxf(v, SWZ_XOR(v, 8)); v = fmaxf(v, SWZ_XOR(v, 16));
    return fmaxf(__int_as_float(__builtin_amdgcn_readlane(__float_as_int(v), 0)), __int_as_float(__builtin_amdgcn_readlane(__float_as_int(v), 32)));
}
__device__ __forceinline__ int rl_i(int v, int lane) { return __builtin_amdgcn_readlane(v, lane); }
__device__ __forceinline__ float rl_f(float v, int lane) { return __int_as_float(__builtin_amdgcn_readlane(__float_as_int(v), lane)); }

constexpr size_t MiB = 1u << 20;
constexpr size_t WS_CTL = 0;
constexpr size_t WS_MOD = 1 * MiB;
constexpr size_t WS_ROPE = WS_MOD + 512 * 1024;
constexpr size_t WS_KEYS = 3 * MiB + 512 * 1024;
constexpr size_t WS_SU = 4 * MiB + 512 * 1024, WS_SV = WS_SU + 256 * 1024;
constexpr size_t WS_XS = 5 * MiB;
constexpr size_t WS_SWI = 5 * MiB + 512 * 1024, WS_SWQ = WS_SWI + 65536;
constexpr size_t WS_WO = 6 * MiB;
constexpr size_t WS_WI8 = 10 * MiB, WS_WQ8 = 16 * MiB;
constexpr size_t WS_WI = 20 * MiB;
constexpr size_t WS_WQ = 32 * MiB;
constexpr size_t WS_U = 40 * MiB;
constexpr size_t WS_V = 72 * MiB;
constexpr size_t WS_XQ = 104 * MiB;
constexpr size_t WS_ACT = 137 * MiB;
constexpr size_t WS_PX = 203 * MiB;
constexpr size_t WS_AW = WS_PX + 160 * MiB;
constexpr size_t WS_ST = 393 * MiB;
constexpr size_t WS_XR = 443 * MiB;
constexpr size_t WS_XRC = 507 * MiB;
constexpr size_t WS_END = 509 * MiB;
constexpr size_t WS_IDX = WS_ST, WS_GATE = WS_ST + 17 * MiB;
constexpr size_t WS_TOPV = WS_PX + 133 * MiB, WS_TOPI = WS_ACT;

struct Params { const float* in[21]; float* out; unsigned char* ws; };

__device__ __forceinline__ void ph_mods(const float* c, const float* c_ctx, const float* w_ada, const float* b_ada, float* mod, float* sm  ) { const int tidx = otid();
    const int tid = tidx, ks = tid >> 6, jj = tid & 63;
    float* act = sm; float* red = sm + 5 * D;
    if ((int)blockIdx.x >= DEPTH * 96) return;
    for (int i = tid; i < 5 * D; i += NT) { const float v = i < 4 * D ? c[i] : c_ctx[i - 4 * D]; act[i] = silu(v); }
    __syncthreads();
    for (int vb = blockIdx.x; vb < DEPTH * 96; vb += gridDim.x) {
        const int l = vb / 96, j = (vb % 96) * 64 + jj;
        const float* w = w_ada + (size_t)l * D * 6 * D + (size_t)(ks * 128) * 6 * D + j;
        const float* ap = act + ks * 128;
        float a0 = 0, a1 = 0, a2 = 0, a3 = 0, a4 = 0;
#pragma unroll 32
        for (int k = 0; k < 128; ++k) { const float wv = w[(size_t)k * 6 * D];
            a0 += ap[k] * wv; a1 += ap[D + k] * wv; a2 += ap[2 * D + k] * wv; a3 += ap[3 * D + k] * wv; a4 += ap[4 * D + k] * wv; }
        red[(ks * 5 + 0) * 64 + jj] = a0; red[(ks * 5 + 1) * 64 + jj] = a1; red[(ks * 5 + 2) * 64 + jj] = a2; red[(ks * 5 + 3) * 64 + jj] = a3; red[(ks * 5 + 4) * 64 + jj] = a4;
        __syncthreads();
        if (tid < 320) { const int r = tid >> 6; float s = 0.f;
#pragma unroll
            for (int q = 0; q < 8; ++q) s += red[(q * 5 + r) * 64 + jj];
            mod[((size_t)l * 5 + r) * 6 * D + j] = s + b_ada[l * 6 * D + j]; }
        __syncthreads();
    }
}
__device__ __forceinline__ void ph_rope(float* cosT, float* sinT) { const int tidx = otid();
    for (int gid = blockIdx.x * NT + tidx; gid < S * 32; gid += gridDim.x * NT) {
        const int t = gid / 32, j = gid % 32, jj = j & 15;
        const float inv = powf(10000.f, -(float)jj / 16.f);
        const float pos = j < 16 ? (float)(t / GW) : (float)(t % GW);
        const float ang = pos * inv;
        cosT[gid] = cosf(ang); sinT[gid] = sinf(ang);
    }
}
__device__ __forceinline__ void ph_transpose(const float* W, int K, int N, int Npad, int ldk, bf16* Wt, float* tile  ) { const int tidx = otid();
    const int tid = tidx, nbn = Npad / 64, nvb = nbn * (K / 64);
    for (int vb = blockIdx.x; vb < nvb; vb += gridDim.x) {
        const int n0 = (vb % nbn) * 64, k0 = (vb / nbn) * 64;
        { const int kk = tid >> 4, n4 = (tid & 15) * 4;
#pragma unroll
          for (int i = 0; i < 2; ++i) { const int k = kk + 32 * i; const int n = n0 + n4;
              const f32x4 v = (n < N) ? *(const f32x4*)(W + (size_t)(k0 + k) * N + n) : (f32x4){0.f, 0.f, 0.f, 0.f};
              tile[k * 65 + n4] = v.x; tile[k * 65 + n4 + 1] = v.y; tile[k * 65 + n4 + 2] = v.z; tile[k * 65 + n4 + 3] = v.w; } }
        __syncthreads();
        { const int n = tid >> 3, kc = (tid & 7) * 8;
          u32x4 o; o.x = pg8::cvt_pk_bf16(tile[(kc + 0) * 65 + n], tile[(kc + 1) * 65 + n]); o.y = pg8::cvt_pk_bf16(tile[(kc + 2) * 65 + n], tile[(kc + 3) * 65 + n]);
          o.z = pg8::cvt_pk_bf16(tile[(kc + 4) * 65 + n], tile[(kc + 5) * 65 + n]); o.w = pg8::cvt_pk_bf16(tile[(kc + 6) * 65 + n], tile[(kc + 7) * 65 + n]);
          *(u32x4*)(Wt + (size_t)(n0 + n) * ldk + k0 + kc) = o; }
        __syncthreads();
    }
}
__device__ __forceinline__ void ph_transpose_all(const float* w_in, const float* peer_wq, const float* w_out, bf16* WI, bf16* WQ, bf16* WO, float* tile) { const int tidx = otid();
    constexpr int T_IN = (DPROJ_PAD / 64) * (D / 64), T_Q = (DQ / 64) * (D / 64), T_O = (D / 64) * (768 / 64), T_L = T_IN + T_Q + T_O, T_ALL = DEPTH * T_L;
    const int tid = tidx, G = (int)gridDim.x, c = G - 1 - (int)blockIdx.x;
#define TR_DECODE(vb) const int l_ = (vb) / T_L, r0_ = (vb) % T_L; const int which_ = r0_ < T_IN ? 0 : (r0_ < T_IN + T_Q ? 1 : 2); const int r_ = r0_ - (which_ == 0 ? 0 : (which_ == 1 ? T_IN : T_IN + T_Q)); \
        const int N_ = which_ == 0 ? DPROJ : (which_ == 1 ? DQ : D), nbn_ = which_ == 0 ? DPROJ_PAD / 64 : (which_ == 1 ? DQ / 64 : D / 64); \
        const float* W_ = which_ == 0 ? w_in + (size_t)l_ * D * DPROJ : (which_ == 1 ? peer_wq + (size_t)l_ * D * DQ : w_out + (size_t)l_ * D * D); \
        bf16* Wt_ = which_ == 0 ? WI + (size_t)l_ * DPROJ_PAD * D : (which_ == 1 ? WQ + (size_t)l_ * DQ * D : WO + (size_t)l_ * D * D); \
        const int n0_ = (r_ % nbn_) * 64, k0_ = (r_ / nbn_) * 64;
    for (int vb0 = c; vb0 < T_ALL; vb0 += 4 * G) {
        f32x4 v[4][2];
#pragma unroll
        for (int i = 0; i < 4; ++i) { const int vb = vb0 + i * G;
            if (vb < T_ALL) { TR_DECODE(vb) (void)Wt_; const int kk = tid >> 4, n = n0_ + (tid & 15) * 4;
#pragma unroll
                for (int q = 0; q < 2; ++q) v[i][q] = (n < N_) ? *(const f32x4*)(W_ + (size_t)(k0_ + kk + 32 * q) * N_ + n) : (f32x4){0.f, 0.f, 0.f, 0.f}; } }
#pragma unroll
        for (int i = 0; i < 4; ++i) { const int vb = vb0 + i * G;
            if (vb < T_ALL) { float* tl = tile + i * (64 * 65); const int kk = tid >> 4, n4 = (tid & 15) * 4;
#pragma unroll
                for (int q = 0; q < 2; ++q) { const int k = kk + 32 * q; tl[k * 65 + n4] = v[i][q].x; tl[k * 65 + n4 + 1] = v[i][q].y; tl[k * 65 + n4 + 2] = v[i][q].z; tl[k * 65 + n4 + 3] = v[i][q].w; } } }
        __syncthreads();
#pragma unroll
        for (int i = 0; i < 4; ++i) { const int vb = vb0 + i * G;
            if (vb < T_ALL) { TR_DECODE(vb) (void)W_; (void)N_; const float* tl = tile + i * (64 * 65); const int n = tid >> 3, kc = (tid & 7) * 8;
                u32x4 o; o.x = pg8::cvt_pk_bf16(tl[(kc + 0) * 65 + n], tl[(kc + 1) * 65 + n]); o.y = pg8::cvt_pk_bf16(tl[(kc + 2) * 65 + n], tl[(kc + 3) * 65 + n]);
                o.z = pg8::cvt_pk_bf16(tl[(kc + 4) * 65 + n], tl[(kc + 5) * 65 + n]); o.w = pg8::cvt_pk_bf16(tl[(kc + 6) * 65 + n], tl[(kc + 7) * 65 + n]);
                *(u32x4*)(Wt_ + (size_t)(n0_ + n) * D + k0_ + kc) = o; } }
        __syncthreads();
    }
#undef TR_DECODE
}
__device__ __forceinline__ void ph_wo_pool(const float* w_out_all, const float* pool_w_all, const float* pool_scale_all, bf16* Wo_t_all, float* sm) { const int tidx = otid();
    const int tid = tidx; float* P = sm; float* Ws = sm + 64 * 65;
    for (int vb = (int)gridDim.x - 1 - (int)blockIdx.x; vb < DEPTH * 4 * 16; vb += gridDim.x) {
        const int l = vb >> 6, g = (vb >> 4) & 3, n0 = (vb & 15) * 64;
        const float* w_out = w_out_all + (size_t)l * D * D; const float* pool_w = pool_w_all + (size_t)l * 4 * 64 * 64; const float* pool_scale = pool_scale_all + (size_t)l * PW; bf16* Wo_t = Wo_t_all + (size_t)l * D * D;
        for (int i = tid; i < 4096; i += NT) { const int r = i >> 6, cc = i & 63; P[r * 65 + cc] = pool_w[(g * 64 + r) * 64 + cc] * pool_scale[g * 64 + cc]; Ws[r * 65 + cc] = w_out[(size_t)(768 + g * 64 + r) * D + n0 + cc]; }
        __syncthreads();
        { const int i = tid & 63, nq = tid >> 6;
#pragma unroll 1
          for (int nn = nq * 8; nn < nq * 8 + 8; ++nn) { float s = 0.f;
#pragma unroll 16
              for (int j = 0; j < 64; ++j) s += P[i * 65 + j] * Ws[j * 65 + nn];
              Wo_t[(size_t)(n0 + nn) * D + 768 + g * 64 + i] = f2bf(s); } }
        __syncthreads();
    }
}
__device__ __forceinline__ void ph_cvt(const float* src, bf16* dst, size_t n4) { const int tidx = otid();
    for (size_t i = (size_t)blockIdx.x * NT + tidx; i < n4; i += (size_t)gridDim.x * NT) {
        const f32x4 v = ((const f32x4*)src)[i]; ushort4 o; o.x = f2bf(v.x); o.y = f2bf(v.y); o.z = f2bf(v.z); o.w = f2bf(v.w); ((ushort4*)dst)[i] = o; }
}

template <bool BF> __device__ __forceinline__ f32x4 ld4res(const void* p, size_t idx) {
    if (BF) { const ushort4 v = *(const ushort4*)((const bf16*)p + idx); return (f32x4){bf2f(v.x), bf2f(v.y), bf2f(v.z), bf2f(v.w)}; }
    else return *(const f32x4*)((const float*)p + idx);
}
__device__ __forceinline__ void st4res(bf16* p, size_t idx, f32x4 v) { pg8::u32x2 o; o.x = pg8::cvt_pk_bf16(v.x, v.y); o.y = pg8::cvt_pk_bf16(v.z, v.w); *(pg8::u32x2*)(p + idx) = o; }

template <bool XQOUT, bool INBF>
__device__ __forceinline__ void ph_norm(const void* xlat, const void* xctx, const float* nw, const float* modl, int off_sh, int off_sc, bf16* act  , unsigned char* xq, float* xs, int nrows) { const int tidx = otid();
    const int lane = tidx & 63, wave = tidx >> 6;
    for (int row0 = (blockIdx.x * 8 + wave) * 2; row0 < nrows; row0 += gridDim.x * 16) {
        f32x4 v[2][4];
#pragma unroll
        for (int r = 0; r < 2; ++r) { const int row = row0 + r; const void* src = row < M_LAT ? xlat : xctx; const size_t rb = (size_t)(row < M_LAT ? row : row - M_LAT) * D;
#pragma unroll
            for (int j = 0; j < 4; ++j) v[r][j] = ld4res<INBF>(src, rb + (size_t)(lane + 64 * j) * 4); }
#pragma unroll
        for (int r = 0; r < 2; ++r) { const int row = row0 + r; const int mi = row < M_LAT ? row / S : 4;
            const float* sh = modl + (size_t)mi * 6 * D + off_sh; const float* sc = modl + (size_t)mi * 6 * D + off_sc;
            float ss = 0.f;
#pragma unroll
            for (int j = 0; j < 4; ++j) ss += v[r][j].x * v[r][j].x + v[r][j].y * v[r][j].y + v[r][j].z * v[r][j].z + v[r][j].w * v[r][j].w;
            ss = wave_sum(ss);
            const float rs = rsqrtf(ss * (1.f / D) + EPS);
            f32x4 hv[4]; float am = 0.f;
#pragma unroll
            for (int j = 0; j < 4; ++j) { const int k = (lane + 64 * j) * 4;
                const f32x4 w = *(const f32x4*)(nw + k), a = *(const f32x4*)(sc + k), b = *(const f32x4*)(sh + k);
                hv[j].x = v[r][j].x * rs * w.x * (1.f + a.x) + b.x; hv[j].y = v[r][j].y * rs * w.y * (1.f + a.y) + b.y; hv[j].z = v[r][j].z * rs * w.z * (1.f + a.z) + b.z; hv[j].w = v[r][j].w * rs * w.w * (1.f + a.w) + b.w;
                if (act) { ushort4 o; o.x = f2bf(hv[j].x); o.y = f2bf(hv[j].y); o.z = f2bf(hv[j].z); o.w = f2bf(hv[j].w);
                *(ushort4*)(act + (size_t)row * D + k) = o; }
                am = fmaxf(am, fmaxf(fmaxf(fabsf(hv[j].x), fabsf(hv[j].y)), fmaxf(fabsf(hv[j].z), fabsf(hv[j].w)))); }
            if (XQOUT) { am = wave_max(am); const float sx = am > 0.f ? am * (1.f / 127.f) : 1.f, inv = 1.f / sx;
#pragma unroll
                for (int j = 0; j < 4; ++j) { const int q0 = (int)rintf(hv[j].x * inv), q1 = (int)rintf(hv[j].y * inv), q2 = (int)rintf(hv[j].z * inv), q3 = (int)rintf(hv[j].w * inv);
                    *(unsigned*)(xq + (size_t)row * D + (lane + 64 * j) * 4) = (unsigned)(q0 & 0xff) | ((unsigned)(q1 & 0xff) << 8) | ((unsigned)(q2 & 0xff) << 16) | ((unsigned)(q3 & 0xff) << 24); }
                if (lane == 0) xs[row] = sx; }
        }
    }
}

struct EpiBf16Out {
    static constexpr bool PERM = true, AFTER_DRAIN = false;
    bf16* O; int ldc; int ncols;
    __device__ __forceinline__ void operator()(const pg8::f32x4 (&acc)[2][2][4][2], const pg8::Unit& u, int wr, int wc, int fr, int fq) const {
        const int row0 = u.pm * 256 + wr * 64 + fr, col0 = u.pn * 256 + wc * 32 + 8 * fq;
#pragma unroll
        for (int ai = 0; ai < 2; ++ai)
#pragma unroll
            for (int m = 0; m < 4; ++m) { bf16* rowp = O + (size_t)(row0 + ai * 128 + m * 16) * ldc + col0;
#pragma unroll
                for (int bj = 0; bj < 2; ++bj) { if (col0 + bj * 128 < ncols) { const pg8::f32x4 v0 = acc[ai][bj][m][0], v1 = acc[ai][bj][m][1];
                    u32x4 w; w.x = pg8::cvt_pk_bf16(v0[0], v0[1]); w.y = pg8::cvt_pk_bf16(v0[2], v0[3]); w.z = pg8::cvt_pk_bf16(v1[0], v1[1]); w.w = pg8::cvt_pk_bf16(v1[2], v1[3]);
                    *(u32x4*)(rowp + bj * 128) = w; } } }
    }
};
#ifndef NT_STORE
#define NT_STORE 0
#endif
struct EpiI8Bf16Out {
    static constexpr bool PERM = true, AFTER_DRAIN = false;
    bf16* O; int ldc; int ncols; const float* sa; const float* sb;
    __device__ __forceinline__ void operator()(const pg8::i32x4 (&acc)[2][2][4][2], const pg8::Unit& u, int wr, int wc, int fr, int fq) const {
        const int row0 = u.pm * 256 + wr * 64 + fr, col0 = u.pn * 256 + wc * 32 + 8 * fq;
        f32x4 sbv[2][2];
#pragma unroll
        for (int bj = 0; bj < 2; ++bj) { sbv[bj][0] = *(const f32x4*)(sb + col0 + bj * 128); sbv[bj][1] = *(const f32x4*)(sb + col0 + bj * 128 + 4); }
        float srv[2][4];
#pragma unroll
        for (int ai = 0; ai < 2; ++ai)
#pragma unroll
            for (int m = 0; m < 4; ++m) srv[ai][m] = sa[row0 + ai * 128 + m * 16];
#pragma unroll
        for (int ai = 0; ai < 2; ++ai)
#pragma unroll
            for (int m = 0; m < 4; ++m) { const int row = row0 + ai * 128 + m * 16; const float sr = srv[ai][m]; bf16* rowp = O + (size_t)row * ldc + col0;
#pragma unroll
                for (int bj = 0; bj < 2; ++bj) { if (col0 + bj * 128 < ncols) { const pg8::i32x4 v0 = acc[ai][bj][m][0], v1 = acc[ai][bj][m][1]; const f32x4 s0 = sbv[bj][0] * sr, s1 = sbv[bj][1] * sr;
                    u32x4 w; w.x = pg8::cvt_pk_bf16((float)v0[0] * s0.x, (float)v0[1] * s0.y); w.y = pg8::cvt_pk_bf16((float)v0[2] * s0.z, (float)v0[3] * s0.w);
                    w.z = pg8::cvt_pk_bf16((float)v1[0] * s1.x, (float)v1[1] * s1.y); w.w = pg8::cvt_pk_bf16((float)v1[2] * s1.z, (float)v1[3] * s1.w);
                    if (NT_STORE) __builtin_nontemporal_store(w, (u32x4*)(rowp + bj * 128)); else *(u32x4*)(rowp + bj * 128) = w; } } }
    }
};
struct EpiI8QT {
    static constexpr bool PERM = true, AFTER_DRAIN = false;
    bf16* O; const float* sa; const float* sb;
    __device__ __forceinline__ void operator()(const pg8::i32x4 (&acc)[2][2][4][2], const pg8::Unit& u, int wr, int wc, int fr, int fq) const {
        const int row0 = u.pm * 256 + wr * 64 + fr, col0 = u.pn * 256 + wc * 32 + 8 * fq;
        f32x4 sbv[2][2];
#pragma unroll
        for (int bj = 0; bj < 2; ++bj) { sbv[bj][0] = *(const f32x4*)(sb + col0 + bj * 128); sbv[bj][1] = *(const f32x4*)(sb + col0 + bj * 128 + 4); }
        float srv[2][4];
#pragma unroll
        for (int ai = 0; ai < 2; ++ai)
#pragma unroll
            for (int m = 0; m < 4; ++m) srv[ai][m] = sa[row0 + ai * 128 + m * 16];
        const int sfrag = (2 * wc + (fq >> 1)) * 512 + (fq & 1) * 256;
#pragma unroll
        for (int ai = 0; ai < 2; ++ai)
#pragma unroll
            for (int m = 0; m < 4; ++m) { const int row = row0 + ai * 128 + m * 16; const float sr = srv[ai][m];
#pragma unroll
                for (int bj = 0; bj < 2; ++bj) { const pg8::i32x4 v0 = acc[ai][bj][m][0], v1 = acc[ai][bj][m][1]; const f32x4 s0 = sbv[bj][0] * sr, s1 = sbv[bj][1] * sr;
                    u32x4 w; w.x = pg8::cvt_pk_bf16((float)v0[0] * s0.x, (float)v0[1] * s0.y); w.y = pg8::cvt_pk_bf16((float)v0[2] * s0.z, (float)v0[3] * s0.w);
                    w.z = pg8::cvt_pk_bf16((float)v1[0] * s1.x, (float)v1[1] * s1.y); w.w = pg8::cvt_pk_bf16((float)v1[2] * s1.z, (float)v1[3] * s1.w);
                    *(u32x4*)(O + ((size_t)(((row >> 5) * PH + u.pn) * 2 + bj)) * 4096 + sfrag + (row & 31) * 8) = w; } }
    }
};
template <bool INBF>
struct EpiRes {
    static constexpr bool PERM = false, AFTER_DRAIN = false;
    const void* xin_lat; const void* xin_ctx; bf16* xout_lat; bf16* xout_ctx; const float* modl; int off_g;
    __device__ __forceinline__ void operator()(const pg8::f32x4 (&acc)[2][2][4][2], const pg8::Unit& u, int wr, int wc, int fr, int fq) const {
        const int r0 = u.pm * 256; const bool lat = r0 < M_LAT; const int mi = lat ? r0 / S : 4;
        const void* xin = lat ? xin_lat : xin_ctx; bf16* xout = lat ? xout_lat : xout_ctx;
        const size_t rbase = (size_t)(lat ? r0 : r0 - M_LAT) * D;
        const int col0 = u.pn * 256 + wc * 32 + 4 * fq;
        const float* gp = modl + (size_t)mi * 6 * D + off_g + col0;
        f32x4 gv[2][2];
#pragma unroll
        for (int bj = 0; bj < 2; ++bj)
#pragma unroll
            for (int n = 0; n < 2; ++n) gv[bj][n] = *(const f32x4*)(gp + bj * 128 + n * 16);
#pragma unroll
        for (int ai = 0; ai < 2; ++ai) {
            f32x4 xi[4][2][2];
#pragma unroll
            for (int mm = 0; mm < 4; ++mm) { const size_t off = rbase + (size_t)(ai * 128 + wr * 64 + mm * 16 + fr) * D + col0;
#pragma unroll
                for (int bj = 0; bj < 2; ++bj)
#pragma unroll
                    for (int n = 0; n < 2; ++n) xi[mm][bj][n] = ld4res<INBF>(xin, off + bj * 128 + n * 16); }
#pragma unroll
            for (int mm = 0; mm < 4; ++mm) { const size_t off = rbase + (size_t)(ai * 128 + wr * 64 + mm * 16 + fr) * D + col0;
#pragma unroll
                for (int bj = 0; bj < 2; ++bj)
#pragma unroll
                    for (int n = 0; n < 2; ++n) { const pg8::f32x4 a = acc[ai][bj][mm][n]; const f32x4 gq = gv[bj][n], x4 = xi[mm][bj][n]; f32x4 o;
                        o.x = x4.x + gq.x * a[0]; o.y = x4.y + gq.y * a[1]; o.z = x4.z + gq.z * a[2]; o.w = x4.w + gq.w * a[3];
                        st4res(xout, off + bj * 128 + n * 16, o); } }
            asm volatile("" ::: "memory");
        }
    }
};

template <int EPI>
__device__ __forceinline__ void ph_gemm_simple(const bf16* A, const bf16* Bt, int M, int N, int K, bf16* Cb, int ldc, int ncols,
                                               const float* xin_lat, const float* xin_ctx, float* xout_lat, float* xout_ctx, const float* modl, int off_g, bf16* sm  ) { const int tidx = otid();
    bf16 (*sA)[40] = (bf16 (*)[40])sm; bf16 (*sB)[40] = (bf16 (*)[40])(sm + 128 * 40);
    const int tid = tidx, w = tid >> 6, lane = tid & 63, fr = lane & 15, fq = lane >> 4;
    const int lr = tid >> 2, lc = (tid & 3) * 8;
    const int nbn = N / 64, nvb = (M / 128) * nbn;
    for (int vb = blockIdx.x; vb < nvb; vb += gridDim.x) {
        const int m0 = (vb / nbn) * 128, n0 = (vb % nbn) * 64;
        f32x4 acc[4];
#pragma unroll
        for (int j = 0; j < 4; ++j) acc[j] = (f32x4){0.f, 0.f, 0.f, 0.f};
        for (int k0 = 0; k0 < K; k0 += 32) {
            *(bf16x8*)&sA[lr][lc] = *(const bf16x8*)(A + (size_t)(m0 + lr) * K + k0 + lc);
            if (tid < 256) *(bf16x8*)&sB[lr][lc] = *(const bf16x8*)(Bt + (size_t)(n0 + lr) * K + k0 + lc);
            __syncthreads();
            const bf16x8 a = *(const bf16x8*)&sA[w * 16 + fr][fq * 8];
#pragma unroll
            for (int j = 0; j < 4; ++j) { const bf16x8 b = *(const bf16x8*)&sB[j * 16 + fr][fq * 8]; acc[j] = __builtin_amdgcn_mfma_f32_16x16x32_bf16(a, b, acc[j], 0, 0, 0); }
            __syncthreads();
        }
#pragma unroll
        for (int j = 0; j < 4; ++j)
#pragma unroll
            for (int i = 0; i < 4; ++i) {
                const int row = m0 + w * 16 + fq * 4 + i, col = n0 + j * 16 + fr;
                if (EPI == 0) { if (col < ncols) Cb[(size_t)row * ldc + col] = f2bf(acc[j][i]); }
                else { const int mi = row < M_LAT ? row / S : 4; const float g = modl[(size_t)mi * 6 * D + off_g + col];
                    if (row < M_LAT) xout_lat[(size_t)row * D + col] = xin_lat[(size_t)row * D + col] + g * acc[j][i];
                    else { const size_t o = (size_t)(row - M_LAT) * D + col; xout_ctx[o] = xin_ctx[o] + g * acc[j][i]; } }
            }
    }
}

__device__ __forceinline__ void ph_na(const bf16* px, const float* rpb  , bf16* act, int nrows) { const int tidx = otid();
    for (int gid = blockIdx.x * NT + tidx; gid < nrows * NAH; gid += gridDim.x * NT) {
        const int row = gid / NAH, h = gid % NAH;
        float q[64], o[64];
        const bf16* qp = px + (size_t)row * DPROJ + O_NA_Q + h * 64;
#pragma unroll
        for (int d = 0; d < 64; ++d) { q[d] = bf2f(qp[d]) * 0.125f; o[d] = 0.f; }
        float mx = -1e30f, den = 0.f;
        int b, nwin = 0, rr = 0, cq = 0, r_start = 0, c_start = 0;
        if (row < M_LAT) { b = row / S; const int t = row % S; rr = t / GW; cq = t % GW; r_start = min(max(rr - 4, 0), 128 - 8); c_start = min(max(cq - 8, 0), GW - 16); nwin = 128; }
        else b = (row - M_LAT) / CTX;
        for (int i = 0; i < nwin + CTX; ++i) {
            int krow; float bias = 0.f;
            if (i < nwin) { const int j = i / 16, kc = c_start + (i % 16), kr = r_start + j; krow = b * S + kr * GW + kc;
                bias = rpb[(h * 15 + (kr - rr + 7)) * 31 + (kc - cq + 15)]; }
            else krow = M_LAT + b * CTX + (i - nwin);
            const bf16* kp = px + (size_t)krow * DPROJ + O_NA_K + h * 64;
            float s = 0.f;
#pragma unroll
            for (int d = 0; d < 64; ++d) s += q[d] * bf2f(kp[d]);
            s += bias;
            const float nm = fmaxf(mx, s), corr = __expf(mx - nm), p = __expf(s - nm);
            den = den * corr + p; mx = nm;
            const bf16* vp = px + (size_t)krow * DPROJ + O_NA_V + h * 64;
#pragma unroll
            for (int d = 0; d < 64; ++d) o[d] = o[d] * corr + p * bf2f(vp[d]);
        }
        const float inv = 1.f / den;
        bf16* op = act + (size_t)row * D + h * 64;
#pragma unroll
        for (int d = 0; d < 64; ++d) op[d] = f2bf(o[d] * inv);
    }
}

typedef short s16x4 __attribute__((ext_vector_type(4)));
typedef __attribute__((address_space(3))) const unsigned char* lds_cp;
__device__ __forceinline__ s16x4 vtr(lds_cp p) { return __builtin_bit_cast(s16x4, __builtin_amdgcn_ds_read_tr16_b64_v4i16((__attribute__((address_space(3))) s16x4*)p)); }
__device__ __forceinline__ float xq_max(float x) {
    auto s = __builtin_amdgcn_permlane16_swap(__float_as_uint(x), __float_as_uint(x), false, false);
    x = fmaxf(__uint_as_float(s[0]), __uint_as_float(s[1]));
    auto t = __builtin_amdgcn_permlane32_swap(__float_as_uint(x), __float_as_uint(x), false, false);
    return fmaxf(__uint_as_float(t[0]), __uint_as_float(t[1]));
}
__device__ __forceinline__ float xq_sum(float x) {
    auto s = __builtin_amdgcn_permlane16_swap(__float_as_uint(x), __float_as_uint(x), false, false);
    x = __uint_as_float(s[0]) + __uint_as_float(s[1]);
    auto t = __builtin_amdgcn_permlane32_swap(__float_as_uint(x), __float_as_uint(x), false, false);
    return __uint_as_float(t[0]) + __uint_as_float(t[1]);
}
constexpr int NA_ROWB = 160;
constexpr int NA_KOFF = 0, NA_VOFF = 2 * 64 * NA_ROWB, NA_BOFF = 4 * 64 * NA_ROWB;
__device__ __forceinline__ void ph_na_mfma(const bf16* px, const float* rpb  , bf16* act, int nunits, unsigned char* ldsg) { const int tidx = otid();
    const int lane = tidx & 63, w = __builtin_amdgcn_readfirstlane(tidx >> 6), fr = lane & 15, quad = lane >> 4;
    const lds_cp lds = (lds_cp)ldsg;
    float* sbias = (float*)(ldsg + NA_BOFF);
    constexpr float LOG2E = 1.4426950408889634f;
    const int skey = tidx >> 3, spiece = tidx & 7;
    const int G_ = gridDim.x, vcu = (G_ % 8 == 0) ? ((int)blockIdx.x % 8) * (G_ / 8) + (int)blockIdx.x / 8 : (int)blockIdx.x;
    float bvn = 0.f; bf16x8 qn[2]; u32x4 kreg, vreg;
#define NA_ISSUE(ux) do { int b_, h_, qrow_; if ((ux) < 1536) { b_ = (ux) / 384; h_ = ((ux) / 64) % 6; qrow_ = b_ * S + (2 * ((ux) % 64) + (w >> 2)) * GW + 16 * (w & 3) + fr; } \
        else { const int cu_ = (ux) - 1536; b_ = cu_ / 12; h_ = (cu_ >> 1) % 6; qrow_ = M_LAT + b_ * CTX + (cu_ & 1) * 128 + 16 * w + fr; } \
        bvn = (tidx < 480 && (tidx & 31) < 31) ? rpb[h_ * 465 + (tidx >> 5) * 31 + (tidx & 31)] : 0.f; \
        qn[0] = *(const bf16x8*)(px + (size_t)qrow_ * DPROJ + O_NA_Q + h_ * 64 + 8 * quad); qn[1] = *(const bf16x8*)(px + (size_t)qrow_ * DPROJ + O_NA_Q + h_ * 64 + 32 + 8 * quad); \
        { const size_t r_ = (size_t)(M_LAT + b_ * CTX + skey); kreg = *(const u32x4*)(px + r_ * DPROJ + O_NA_K + h_ * 64 + spiece * 8); vreg = *(const u32x4*)(px + r_ * DPROJ + O_NA_V + h_ * 64 + spiece * 8); } } while (0)
    if (vcu < nunits) NA_ISSUE(vcu);
    for (int u = vcu; u < nunits; u += G_) {
        int b, h, wr0 = 0, nwin = 0, rq = 0, g = 0, rs_q = 0, qrow;
        const bool latent = u < 1536;
        if (latent) { b = u / 384; h = (u / 64) % 6; const int rp = u % 64;
            wr0 = min(max(2 * rp - 4, 0), 120); const int rs1 = min(max(2 * rp - 3, 0), 120); nwin = rs1 + 8 - wr0;
            rq = 2 * rp + (w >> 2); g = w & 3; rs_q = min(max(rq - 4, 0), 120); qrow = b * S + rq * GW + 16 * g + fr; }
        else { const int cu = u - 1536; b = cu / 12; h = (cu >> 1) % 6; qrow = M_LAT + b * CTX + (cu & 1) * 128 + 16 * w + fr; }
        const int nchunks = 4 + nwin;
        const int cq = 16 * g + fr, c_start = min(max(cq - 8, 0), 48);
        __syncthreads();
        if (tidx < 480) sbias[tidx] = (tidx & 31) < 31 ? bvn * LOG2E : -1e30f;
        bf16x8 qf[2]; qf[0] = qn[0]; qf[1] = qn[1];
        *(u32x4*)(ldsg + NA_KOFF + skey * NA_ROWB + spiece * 16) = kreg; *(u32x4*)(ldsg + NA_VOFF + skey * NA_ROWB + spiece * 16) = vreg;
        __syncthreads();
        f32x4 O[4];
#pragma unroll
        for (int dt = 0; dt < 4; ++dt) O[dt] = (f32x4){0.f, 0.f, 0.f, 0.f};
        float m = -1e30f, lsum = 0.f;
        const int cbase = 4 * quad - cq + 15;
        const int vbase = 4 * quad - c_start;
        int boff[2][8];
#pragma unroll
        for (int pair = 0; pair < 2; ++pair)
#pragma unroll
            for (int e = 0; e < 8; ++e) { const int ce = 32 * pair + 16 * (e >> 2) + (e & 3); boff[pair][e] = ((unsigned)(vbase + ce) < 16u) ? 4 * min(max(cbase + ce, 0), 30) : 4 * 31; }
        for (int c = 0; c < nchunks; ++c) {
            const int buf = c & 1;
            if (c + 1 < nchunks) { const int c1 = c + 1; const size_t r = c1 < 4 ? (size_t)(M_LAT + b * CTX + 64 * c1 + skey) : (size_t)(b * S + (wr0 + c1 - 4) * GW + skey);
                kreg = *(const u32x4*)(px + r * DPROJ + O_NA_K + h * 64 + spiece * 8); vreg = *(const u32x4*)(px + r * DPROJ + O_NA_V + h * 64 + spiece * 8); }
            else if (u + G_ < nunits) NA_ISSUE(u + G_);
            const bool isctx = c < 4; const int kr = wr0 + c - 4;
            const bool use = isctx || (kr >= rs_q && kr < rs_q + 8);
            if (use) {
                const lds_cp kb = lds + NA_KOFF + buf * 64 * NA_ROWB, vb = lds + NA_VOFF + buf * 64 * NA_ROWB;
                const char* brow = (const char*)(sbias + (kr - rq + 7) * 32);
#pragma unroll
                for (int pair = 0; pair < 2; ++pair) {
                    if (!isctx && !(pair == 0 ? (g <= 2) : (g >= 1))) continue;
                    f32x4 a0 = (f32x4){0.f, 0.f, 0.f, 0.f}, a1 = a0;
#pragma unroll
                    for (int s = 0; s < 2; ++s) {
                        const bf16x8 k0 = *(const __attribute__((address_space(3))) bf16x8*)(kb + (32 * pair + fr) * NA_ROWB + 64 * s + 16 * quad);
                        const bf16x8 k1 = *(const __attribute__((address_space(3))) bf16x8*)(kb + (32 * pair + 16 + fr) * NA_ROWB + 64 * s + 16 * quad);
                        a0 = __builtin_amdgcn_mfma_f32_16x16x32_bf16(k0, qf[s], a0, 0, 0, 0);
                        a1 = __builtin_amdgcn_mfma_f32_16x16x32_bf16(k1, qf[s], a1, 0, 0, 0);
                    }
                    float sc[8];
                    if (isctx) {
#pragma unroll
                        for (int i = 0; i < 4; ++i) { sc[i] = a0[i] * (0.125f * LOG2E); sc[4 + i] = a1[i] * (0.125f * LOG2E); }
                    } else {
#pragma unroll
                        for (int e = 0; e < 8; ++e) { const float bm = *(const float*)(brow + boff[pair][e]);
                            sc[e] = __builtin_fmaf(e < 4 ? a0[e & 3] : a1[e & 3], 0.125f * LOG2E, bm); }
                    }
                    float mx = __builtin_fmaxf(__builtin_fmaxf(__builtin_fmaxf(sc[0], sc[1]), __builtin_fmaxf(sc[2], sc[3])), __builtin_fmaxf(__builtin_fmaxf(sc[4], sc[5]), __builtin_fmaxf(sc[6], sc[7])));
                    mx = xq_max(mx);
                    if (__any(mx > m + 6.f)) {
                        const float mn = fmaxf(m, mx), corr = __builtin_amdgcn_exp2f(m - mn); m = mn;
                        lsum *= corr;
#pragma unroll
                        for (int dt = 0; dt < 4; ++dt) O[dt] = O[dt] * corr;
                    }
                    float p[8], ps = 0.f;
#pragma unroll
                    for (int e = 0; e < 8; ++e) { p[e] = __builtin_amdgcn_exp2f(sc[e] - m); ps += p[e]; }
                    lsum += ps;
                    u32x4 pk; pk.x = pg8::cvt_pk_bf16(p[0], p[1]); pk.y = pg8::cvt_pk_bf16(p[2], p[3]); pk.z = pg8::cvt_pk_bf16(p[4], p[5]); pk.w = pg8::cvt_pk_bf16(p[6], p[7]);
                    const bf16x8 pb = __builtin_bit_cast(bf16x8, pk);
#pragma unroll
                    for (int dt = 0; dt < 4; ++dt) {
                        const lds_cp va = vb + (32 * pair + 4 * quad + (fr >> 2)) * NA_ROWB + (16 * dt + 4 * (fr & 3)) * 2;
                        const s16x4 v0 = vtr(va), v1 = vtr(va + 16 * NA_ROWB);
                        bf16x8 A; A[0] = v0[0]; A[1] = v0[1]; A[2] = v0[2]; A[3] = v0[3]; A[4] = v1[0]; A[5] = v1[1]; A[6] = v1[2]; A[7] = v1[3];
                        O[dt] = __builtin_amdgcn_mfma_f32_16x16x32_bf16(A, pb, O[dt], 0, 0, 0);
                    }
                }
            }
            if (c + 1 < nchunks) { const int nb = (c + 1) & 1;
                *(u32x4*)(ldsg + NA_KOFF + nb * 64 * NA_ROWB + skey * NA_ROWB + spiece * 16) = kreg; *(u32x4*)(ldsg + NA_VOFF + nb * 64 * NA_ROWB + skey * NA_ROWB + spiece * 16) = vreg; }
            __syncthreads();
        }
        const float inv = 1.f / xq_sum(lsum);
        bf16* op = act + (size_t)qrow * D + h * 64 + 4 * quad;
#pragma unroll
        for (int dt = 0; dt < 4; ++dt) { pg8::u32x2 o; o.x = pg8::cvt_pk_bf16(O[dt][0] * inv, O[dt][1] * inv); o.y = pg8::cvt_pk_bf16(O[dt][2] * inv, O[dt][3] * inv); *(pg8::u32x2*)(op + 16 * dt) = o; }
    }
#undef NA_ISSUE
}
template <int W>
__device__ __forceinline__ void pool_item(const bf16* px, bf16* act, int row, int oc) {
    int t, T, base;
    if (row < M_LAT) { t = row % S; T = S; base = row - t; } else { t = (row - M_LAT) % CTX; T = CTX; base = row - t; }
    const int lo = max(t - W / 2, 0), hi = min(t + W / 2, T);
    bf16x8 tv[W];
#pragma unroll
    for (int i = 0; i < W; ++i) { const int tt = min(lo + i, hi - 1); tv[i] = *(const bf16x8*)(px + (size_t)(base + tt) * DPROJ + O_POOL + oc * 8); }
    const bf16x8 xv = *(const bf16x8*)(px + (size_t)row * DPROJ + O_POOL + oc * 8);
    float s[8];
#pragma unroll
    for (int j = 0; j < 8; ++j) s[j] = 0.f;
#pragma unroll
    for (int i = 0; i < W; ++i) { const float wgt = (lo + i < hi) ? 1.f : 0.f;
#pragma unroll
        for (int j = 0; j < 8; ++j) s[j] += wgt * bf2f((bf16)tv[i][j]); }
    const float inv = 1.f / (float)(hi - lo);
    u32x4 o; o.x = pg8::cvt_pk_bf16(s[0] * inv - bf2f((bf16)xv[0]), s[1] * inv - bf2f((bf16)xv[1])); o.y = pg8::cvt_pk_bf16(s[2] * inv - bf2f((bf16)xv[2]), s[3] * inv - bf2f((bf16)xv[3]));
    o.z = pg8::cvt_pk_bf16(s[4] * inv - bf2f((bf16)xv[4]), s[5] * inv - bf2f((bf16)xv[5])); o.w = pg8::cvt_pk_bf16(s[6] * inv - bf2f((bf16)xv[6]), s[7] * inv - bf2f((bf16)xv[7]));
    *(u32x4*)(act + (size_t)row * D + 768 + oc * 8) = o;
}
__device__ __forceinline__ void ph_pool(const bf16* px, bf16* act, int nrows) { const int tidx = otid();
    const int per = nrows * 8;
    for (int gid = blockIdx.x * NT + tidx; gid < 4 * per; gid += gridDim.x * NT) {
        const int g = gid / per, r = gid - g * per, row = r >> 3, oc = g * 8 + (r & 7);
        if (g == 0) pool_item<2>(px, act, row, oc); else if (g == 1) pool_item<4>(px, act, row, oc); else if (g == 2) pool_item<8>(px, act, row, oc); else pool_item<16>(px, act, row, oc);
    }
}
__device__ __forceinline__ float rope_elem(const bf16* p, int d, const float* cs, const float* sn, bool rope) {
    const float x = bf2f(p[d]);
    if (!rope) return x;
    const int half = d >> 5, dd = d & 31, j = dd & 15;
    const float c = cs[half * 16 + j], s = sn[half * 16 + j];
    if (dd < 16) { const float x2 = bf2f(p[d + 16]); return x * c - x2 * s; }
    else { const float x1 = bf2f(p[d - 16]); return x1 * s + x * c; }
}
__device__ __forceinline__ int chunk_row0(int b, int ci) { return ci < 64 ? b * S + ci * 128 : M_LAT + b * CTX + (ci - 64) * 128; }
__device__ __forceinline__ void load_kv_chunk(const bf16* px, const float* cosT, const float* sinT, int b, int h, int ci, float* sk, float* sv) { const int tidx = otid();
    const int row0 = chunk_row0(b, ci); const bool rope = ci < 64;
    for (int i = tidx; i < 128 * 64; i += NT) { const int m = i / 64, d = i % 64, row = row0 + m; const int t = rope ? (ci * 128 + m) : 0;
        sk[i] = rope_elem(px + (size_t)row * DPROJ + O_RET_K + h * 64, d, cosT + t * 32, sinT + t * 32, rope) * 0.125f;
        sv[i] = bf2f(px[(size_t)row * DPROJ + O_RET_V + h * 64 + d]); }
}
__device__ __forceinline__ void ph_ret_state(const bf16* px, const float* cosT, const float* sinT, const float* dec_f, const float* dec_b, float* ST, float* sm) { const int tidx = otid();
    float* sk = sm; float* sv = sm + 128 * 64;
    for (int vb = blockIdx.x; vb < NB * RH * NCH; vb += gridDim.x) {
        const int ci = vb % NCH, h = (vb / NCH) % RH, b = vb / (NCH * RH);
        load_kv_chunk(px, cosT, sinT, b, h, ci, sk, sv);
        __syncthreads();
        const float lgf = -log1pf(expf(-dec_f[h])), lgb = -log1pf(expf(-dec_b[h]));
        for (int i = tidx; i < 4096; i += NT) { const int d = i / 64, e = i % 64;
            float af = 0.f, ab = 0.f;
            for (int m = 0; m < 128; ++m) { const float kv = sk[m * 64 + d] * sv[m * 64 + e]; af += expf((127.f - m) * lgf) * kv; ab += expf((float)m * lgb) * kv; }
            ST[((((size_t)(b * RH + h) * 2 + 0) * NCH + ci) * 4096) + i] = af; ST[((((size_t)(b * RH + h) * 2 + 1) * NCH + ci) * 4096) + i] = ab; }
        __syncthreads();
    }
}
__device__ __forceinline__ void ph_ret_scan(const float* dec_f, const float* dec_b, float* ST) { const int tidx = otid();
    for (int gid = blockIdx.x * NT + tidx; gid < NB * RH * 2 * 4096; gid += gridDim.x * NT) {
        const int e = gid % 4096, dir = (gid / 4096) & 1, bh = gid / 8192, h = bh % RH;
        const float lg = -log1pf(expf(-(dir ? dec_b[h] : dec_f[h]))), gg = expf(128.f * lg);
        float* P = ST + ((size_t)bh * 2 + dir) * NCH * 4096 + e;
        float t[64];
#pragma unroll
        for (int c = 0; c < 64; ++c) t[c] = P[(size_t)c * 4096];
        const float k0 = P[(size_t)64 * 4096], k1 = P[(size_t)65 * 4096];
        if (dir == 0) { P[(size_t)64 * 4096] = 0.f; P[(size_t)65 * 4096] = k0; float R = gg * k0 + k1;
#pragma unroll
            for (int c = 0; c < 64; ++c) { const float v = t[c]; t[c] = R; R = gg * R + v; } }
        else { P[(size_t)65 * 4096] = 0.f; P[(size_t)64 * 4096] = k1; float R = k0 + gg * k1;
#pragma unroll
            for (int c = 63; c >= 0; --c) { const float v = t[c]; t[c] = R; R = gg * R + v; } }
#pragma unroll
        for (int c = 0; c < 64; ++c) P[(size_t)c * 4096] = t[c];
    }
}
__device__ __forceinline__ void ph_ret_scan_bf(const float* dec_f, const float* dec_b, bf16* ST) { const int tidx = otid();
    for (int gid = blockIdx.x * NT + tidx; gid < NB * RH * 2 * 2048; gid += gridDim.x * NT) {
        const int e2 = gid % 2048, dir = (gid / 2048) & 1, bh = gid / 4096, h = bh % RH;
        const float lg = -log1pf(expf(-(dir ? dec_b[h] : dec_f[h]))), gg = expf(128.f * lg);
        unsigned* P = (unsigned*)(ST + ((size_t)bh * 2 + dir) * NCH * 4096) + e2;
        unsigned t[64];
#pragma unroll
        for (int c = 0; c < 64; ++c) t[c] = P[(size_t)c * 2048];
        const unsigned k0 = P[(size_t)64 * 2048], k1 = P[(size_t)65 * 2048];
        const float k0x = __uint_as_float(k0 << 16), k0y = __uint_as_float(k0 & 0xffff0000u), k1x = __uint_as_float(k1 << 16), k1y = __uint_as_float(k1 & 0xffff0000u);
        if (dir == 0) { P[(size_t)64 * 2048] = 0u; P[(size_t)65 * 2048] = k0; float Rx = gg * k0x + k1x, Ry = gg * k0y + k1y;
#pragma unroll
            for (int c = 0; c < 64; ++c) { const unsigned v = t[c]; t[c] = pg8::cvt_pk_bf16(Rx, Ry); Rx = gg * Rx + __uint_as_float(v << 16); Ry = gg * Ry + __uint_as_float(v & 0xffff0000u); } }
        else { P[(size_t)65 * 2048] = 0u; P[(size_t)64 * 2048] = k1; float Rx = k0x + gg * k1x, Ry = k0y + gg * k1y;
#pragma unroll
            for (int c = 63; c >= 0; --c) { const unsigned v = t[c]; t[c] = pg8::cvt_pk_bf16(Rx, Ry); Rx = gg * Rx + __uint_as_float(v << 16); Ry = gg * Ry + __uint_as_float(v & 0xffff0000u); } }
#pragma unroll
        for (int c = 0; c < 64; ++c) P[(size_t)c * 2048] = t[c];
    }
}
__device__ __forceinline__ void ph_ret_out(const bf16* px, const float* cosT, const float* sinT, const float* dec_f, const float* dec_b, const float* ST, const float* gn_w, bf16* act, int nci, float* sm) { const int tidx = otid();
    float* sk = sm; float* sv = sm + 128 * 64; float* sy = sm + 2 * 128 * 64; float* sq = sy + 128 * 65;
    const int n = tidx & 127, eq = tidx >> 7;
    for (int vb = blockIdx.x; vb < NB * RH * nci; vb += gridDim.x) {
        const int ci = vb % nci, h = (vb / nci) % RH, b = vb / (nci * RH);
        const int row0 = chunk_row0(b, ci); const bool rope = ci < 64;
        load_kv_chunk(px, cosT, sinT, b, h, ci, sk, sv);
        __syncthreads();
        const int row = row0 + n; const int t = rope ? (ci * 128 + n) : 0;
        const float lgf = -log1pf(expf(-dec_f[h])), lgb = -log1pf(expf(-dec_b[h]));
        float q[64], y[16];
#pragma unroll
        for (int d = 0; d < 64; ++d) { q[d] = rope_elem(px + (size_t)row * DPROJ + O_RET_Q + h * 64, d, cosT + t * 32, sinT + t * 32, rope); if (eq == 0) sq[n * 65 + d] = q[d]; }
        __syncthreads();
#pragma unroll
        for (int e = 0; e < 16; ++e) y[e] = 0.f;
        for (int m = 0; m < 128; ++m) {
            float s = 0.f;
#pragma unroll
            for (int d = 0; d < 64; ++d) s += q[d] * sk[m * 64 + d];
            const float dm = m < n ? expf((float)(n - m) * lgf) : (m > n ? expf((float)(m - n) * lgb) : 2.f);
            s *= dm;
#pragma unroll
            for (int e = 0; e < 16; ++e) y[e] += s * sv[m * 64 + eq * 16 + e];
        }
        const float* Sf = ST + (((size_t)(b * RH + h) * 2 + 0) * NCH + ci) * 4096 + eq * 16; const float* Sb = ST + (((size_t)(b * RH + h) * 2 + 1) * NCH + ci) * 4096 + eq * 16;
        const float xf = expf((float)(n + 1) * lgf), xb = expf((float)(128 - n) * lgb);
#pragma unroll 1
        for (int d = 0; d < 64; ++d) { const float qd = sq[n * 65 + d]; const float qf = qd * xf, qb = qd * xb;
#pragma unroll
            for (int e = 0; e < 16; ++e) y[e] += qf * Sf[d * 64 + e] + qb * Sb[d * 64 + e]; }
#pragma unroll
        for (int e = 0; e < 16; ++e) sy[n * 65 + eq * 16 + e] = y[e];
        __syncthreads();
        float mu = 0.f;
        for (int e = 0; e < 64; ++e) mu += sy[n * 65 + e];
        mu *= (1.f / 64.f); float var = 0.f;
        for (int e = 0; e < 64; ++e) { const float dd = sy[n * 65 + e] - mu; var += dd * dd; }
        const float rs = rsqrtf(var * (1.f / 64.f) + EPS);
        const bf16* gp = px + (size_t)row * DPROJ + O_RET_G + h * 64 + eq * 16; bf16* op = act + (size_t)row * D + NAW + h * 64 + eq * 16;
#pragma unroll
        for (int e = 0; e < 16; ++e) { const float g = bf2f(gp[e]); op[e] = f2bf((y[e] - mu) * rs * gn_w[h * 64 + eq * 16 + e] * silu(g)); }
        __syncthreads();
    }
}


__device__ __forceinline__ void rope8(const bf16* hp, int piece, const float* cs, const float* sn, bool rope, float (&o)[8]) {
    const bf16x8 own = *(const bf16x8*)(hp + piece * 8);
    if (!rope) {
#pragma unroll
        for (int j = 0; j < 8; ++j) o[j] = bf2f((bf16)own[j]);
        return; }
    const bf16x8 par = *(const bf16x8*)(hp + (piece ^ 2) * 8);
    const int half = piece >> 2, pp = piece & 3, tb = half * 16 + 8 * (pp & 1);
    const f32x4 c0 = *(const f32x4*)(cs + tb), c1 = *(const f32x4*)(cs + tb + 4), s0 = *(const f32x4*)(sn + tb), s1 = *(const f32x4*)(sn + tb + 4);
    const float c[8] = {c0.x, c0.y, c0.z, c0.w, c1.x, c1.y, c1.z, c1.w}, s[8] = {s0.x, s0.y, s0.z, s0.w, s1.x, s1.y, s1.z, s1.w};
#pragma unroll
    for (int j = 0; j < 8; ++j) { const float a = bf2f((bf16)own[j]), b = bf2f((bf16)par[j]); o[j] = pp < 2 ? a * c[j] - b * s[j] : b * s[j] + a * c[j]; }
}
__device__ __forceinline__ u32x4 pack8(const float (&o)[8], float sc) {
    u32x4 r; r.x = pg8::cvt_pk_bf16(o[0] * sc, o[1] * sc); r.y = pg8::cvt_pk_bf16(o[2] * sc, o[3] * sc); r.z = pg8::cvt_pk_bf16(o[4] * sc, o[5] * sc); r.w = pg8::cvt_pk_bf16(o[6] * sc, o[7] * sc); return r;
}
__device__ __forceinline__ bf16x8 tr2(lds_cp a, int second_off) {
    const s16x4 v0 = vtr(a), v1 = vtr(a + second_off);
    bf16x8 A; A[0] = v0[0]; A[1] = v0[1]; A[2] = v0[2]; A[3] = v0[3]; A[4] = v1[0]; A[5] = v1[1]; A[6] = v1[2]; A[7] = v1[3]; return A;
}
constexpr int RT_P = 160;
__device__ __forceinline__ void rope_inv8(int odd, float (&inv8)[8]) {
#pragma unroll
    for (int k = 0; k < 8; ++k) inv8[k] = __builtin_amdgcn_exp2f(-(float)(8 * odd + k) * (13.287712379549449f / 16.f)) * 0.15915494309189535f;
}
__device__ __forceinline__ void rope8c(const bf16x8 own, const bf16x8 par, int piece, int t, const float (&inv8)[8], bool rope, float (&o)[8]) {
    if (!rope) {
#pragma unroll
        for (int j = 0; j < 8; ++j) o[j] = bf2f((bf16)own[j]);
        return; }
    const int half = piece >> 2, pp = piece & 3;
    const float pos = (float)(half ? (t % GW) : (t / GW));
#pragma unroll
    for (int j = 0; j < 8; ++j) { const float rev = pos * inv8[j], c = __builtin_amdgcn_cosf(rev), s = __builtin_amdgcn_sinf(rev);
        const float a = bf2f((bf16)own[j]), b = bf2f((bf16)par[j]); o[j] = pp < 2 ? a * c - b * s : b * s + a * c; }
}
__device__ __forceinline__ void rope8r(const bf16x8 own, const bf16x8 par, int piece, const float* cs, const float* sn, bool rope, float (&o)[8]) {
    if (!rope) {
#pragma unroll
        for (int j = 0; j < 8; ++j) o[j] = bf2f((bf16)own[j]);
        return; }
    const int half = piece >> 2, pp = piece & 3, tb = half * 16 + 8 * (pp & 1);
    const f32x4 c0 = *(const f32x4*)(cs + tb), c1 = *(const f32x4*)(cs + tb + 4), s0 = *(const f32x4*)(sn + tb), s1 = *(const f32x4*)(sn + tb + 4);
    const float c[8] = {c0.x, c0.y, c0.z, c0.w, c1.x, c1.y, c1.z, c1.w}, s[8] = {s0.x, s0.y, s0.z, s0.w, s1.x, s1.y, s1.z, s1.w};
#pragma unroll
    for (int j = 0; j < 8; ++j) { const float a = bf2f((bf16)own[j]), b = bf2f((bf16)par[j]); o[j] = pp < 2 ? a * c[j] - b * s[j] : b * s[j] + a * c[j]; }
}
__device__ __forceinline__ void ph_ret_state_mfma(const bf16* px, const float* cosT, const float* sinT, const float* dec_f, const float* dec_b, bf16* ST, unsigned char* ldsg) { const int tidx = otid();
    const int lane = tidx & 63, w = __builtin_amdgcn_readfirstlane(tidx >> 6), fr = lane & 15, quad = lane >> 4;
    const lds_cp lds = (lds_cp)ldsg;
    constexpr int KF = 0, KB = 128 * RT_P, VS = 2 * 128 * RT_P;
    constexpr int NU = NB * RH * NCH;
    bf16x8 kown[2], kpar[2]; u32x4 vv[2];
#define R1_ISSUE(vbx) do { const int ci_ = (vbx) % NCH, h_ = ((vbx) / NCH) % RH, b_ = (vbx) / (NCH * RH); const int row0_ = chunk_row0(b_, ci_); \
        _Pragma("unroll") for (int it = 0; it < 2; ++it) { const int item = tidx + NT * it, m = item >> 3, piece = item & 7; const bf16* rp = px + (size_t)(row0_ + m) * DPROJ; \
            kown[it] = *(const bf16x8*)(rp + O_RET_K + h_ * 64 + piece * 8); kpar[it] = *(const bf16x8*)(rp + O_RET_K + h_ * 64 + (piece ^ 2) * 8); vv[it] = *(const u32x4*)(rp + O_RET_V + h_ * 64 + piece * 8); } } while (0)
    float invk[8]; rope_inv8(tidx & 1, invk);
    int vb = blockIdx.x;
    if (vb < NU) R1_ISSUE(vb);
    for (; vb < NU; vb += gridDim.x) {
        const int ci = vb % NCH, h = (vb / NCH) % RH, b = vb / (NCH * RH);
        const bool rope = ci < 64;
        const float lgf = -log1pf(expf(-dec_f[h])), lgb = -log1pf(expf(-dec_b[h]));
        __syncthreads();
#pragma unroll
        for (int it = 0; it < 2; ++it) { const int item = tidx + NT * it, m = item >> 3, piece = item & 7; const int t = rope ? (ci * 128 + m) : 0;
            float o[8]; rope8c(kown[it], kpar[it], piece, t, invk, rope, o);
            *(u32x4*)(ldsg + KF + m * RT_P + piece * 16) = pack8(o, 0.125f * expf((127.f - (float)m) * lgf));
            *(u32x4*)(ldsg + KB + m * RT_P + piece * 16) = pack8(o, 0.125f * expf((float)m * lgb));
            *(u32x4*)(ldsg + VS + m * RT_P + piece * 16) = vv[it]; }
        if (vb + (int)gridDim.x < NU) R1_ISSUE(vb + (int)gridDim.x);
        __syncthreads();
        const int dir = w >> 2, dt = w & 3;
        const lds_cp kb = lds + (dir ? KB : KF);
        bf16x8 A[4];
#pragma unroll
        for (int ks = 0; ks < 4; ++ks) A[ks] = tr2(kb + (32 * ks + 8 * quad + (fr >> 2)) * RT_P + (16 * dt + 4 * (fr & 3)) * 2, 4 * RT_P);
        bf16* outp = ST + ((((size_t)(b * RH + h) * 2 + dir) * NCH + ci) * 4096);
#pragma unroll
        for (int et = 0; et < 4; ++et) {
            f32x4 acc = (f32x4){0.f, 0.f, 0.f, 0.f};
#pragma unroll
            for (int ks = 0; ks < 4; ++ks) { const bf16x8 Bv = tr2(lds + VS + (32 * ks + 8 * quad + (fr >> 2)) * RT_P + (16 * et + 4 * (fr & 3)) * 2, 4 * RT_P);
                acc = __builtin_amdgcn_mfma_f32_16x16x32_bf16(A[ks], Bv, acc, 0, 0, 0); }
#pragma unroll
            for (int i = 0; i < 4; ++i) outp[(16 * dt + 4 * quad + i) * 64 + 16 * et + fr] = f2bf(acc[i]);
        }
    }
#undef R1_ISSUE
}
__device__ __forceinline__ void ph_ret_out_mfma(const bf16* px, const float* cosT, const float* sinT, const float* dec_f, const float* dec_b, const bf16* ST, const float* gn_w, bf16* act, int nci, unsigned char* ldsg) { const int tidx = otid();
    const int lane = tidx & 63, w = __builtin_amdgcn_readfirstlane(tidx >> 6), fr = lane & 15, quad = lane >> 4;
    const lds_cp lds = (lds_cp)ldsg;
    constexpr int KS = 0, VS = 128 * RT_P, SF = 2 * 128 * RT_P, SB = SF + 64 * RT_P;
    constexpr float LOG2E = 1.4426950408889634f;
    const int NU = NB * RH * nci;
    bf16x8 kown[2], kpar[2], qown[2], qpar[2]; u32x4 vv[2]; u32x4 sfu, sbu;
#define R3_ISSUE(vbx) do { const int ci_ = (vbx) % nci, h_ = ((vbx) / nci) % RH, b_ = (vbx) / (nci * RH); const int row0_ = chunk_row0(b_, ci_); \
        _Pragma("unroll") for (int it = 0; it < 2; ++it) { const int item = tidx + NT * it, m = item >> 3, piece = item & 7; const bf16* rp = px + (size_t)(row0_ + m) * DPROJ; \
            kown[it] = *(const bf16x8*)(rp + O_RET_K + h_ * 64 + piece * 8); kpar[it] = *(const bf16x8*)(rp + O_RET_K + h_ * 64 + (piece ^ 2) * 8); vv[it] = *(const u32x4*)(rp + O_RET_V + h_ * 64 + piece * 8); } \
        { const bf16* Sf_ = ST + (((size_t)(b_ * RH + h_) * 2 + 0) * NCH + ci_) * 4096; const bf16* Sb_ = ST + (((size_t)(b_ * RH + h_) * 2 + 1) * NCH + ci_) * 4096; const int d_ = tidx >> 3, e0_ = (tidx & 7) * 8; \
          sfu = *(const u32x4*)(Sf_ + d_ * 64 + e0_); sbu = *(const u32x4*)(Sb_ + d_ * 64 + e0_); } \
        { const bf16* qp = px + (size_t)(row0_ + 16 * w + fr) * DPROJ + O_RET_Q + h_ * 64; \
          _Pragma("unroll") for (int s = 0; s < 2; ++s) { qown[s] = *(const bf16x8*)(qp + (4 * s + quad) * 8); qpar[s] = *(const bf16x8*)(qp + ((4 * s + quad) ^ 2) * 8); } } } while (0)
    float invk[8], invq[8]; rope_inv8(tidx & 1, invk); rope_inv8(quad & 1, invq);
    int vb = blockIdx.x;
    if (vb < NU) R3_ISSUE(vb);
    for (; vb < NU; vb += gridDim.x) {
        const int ci = vb % nci, h = (vb / nci) % RH, b = vb / (nci * RH);
        const int row0 = chunk_row0(b, ci); const bool rope = ci < 64;
        const float lgf2 = -log1pf(expf(-dec_f[h])) * LOG2E, lgb2 = -log1pf(expf(-dec_b[h])) * LOG2E;
        __syncthreads();
#pragma unroll
        for (int it = 0; it < 2; ++it) { const int item = tidx + NT * it, m = item >> 3, piece = item & 7; const int t = rope ? (ci * 128 + m) : 0;
            float o[8]; rope8c(kown[it], kpar[it], piece, t, invk, rope, o);
            *(u32x4*)(ldsg + KS + m * RT_P + piece * 16) = pack8(o, 0.125f);
            *(u32x4*)(ldsg + VS + m * RT_P + piece * 16) = vv[it]; }
        { const int d = tidx >> 3, e0 = (tidx & 7) * 8;
          *(u32x4*)(ldsg + SF + d * RT_P + e0 * 2) = sfu; *(u32x4*)(ldsg + SB + d * RT_P + e0 * 2) = sbu; }
        const int nloc = 16 * w + fr, row = row0 + nloc; const int tq = rope ? (ci * 128 + nloc) : 0;
        bf16x8 qf[2];
#pragma unroll
        for (int s = 0; s < 2; ++s) { float o[8]; rope8c(qown[s], qpar[s], 4 * s + quad, tq, invq, rope, o); qf[s] = __builtin_bit_cast(bf16x8, pack8(o, 1.f)); }
        if (vb + (int)gridDim.x < NU) R3_ISSUE(vb + (int)gridDim.x);
        __syncthreads();
        f32x4 Y[4];
#pragma unroll
        for (int et = 0; et < 4; ++et) Y[et] = (f32x4){0.f, 0.f, 0.f, 0.f};
        float lf[4], lb[4];
#pragma unroll
        for (int i = 0; i < 4; ++i) { const float dl = (float)(fr - 4 * quad - i); lf[i] = __builtin_amdgcn_exp2f(dl * lgf2); lb[i] = __builtin_amdgcn_exp2f(-dl * lgb2); }
#pragma unroll
        for (int mp = 0; mp < 4; ++mp) {
            float p[8];
#pragma unroll
            for (int t2 = 0; t2 < 2; ++t2) { const int mt = 2 * mp + t2;
                f32x4 acc = (f32x4){0.f, 0.f, 0.f, 0.f};
#pragma unroll
                for (int s = 0; s < 2; ++s) { const bf16x8 kf = *(const __attribute__((address_space(3))) bf16x8*)(lds + KS + (16 * mt + fr) * RT_P + 64 * s + 16 * quad);
                    acc = __builtin_amdgcn_mfma_f32_16x16x32_bf16(kf, qf[s], acc, 0, 0, 0); }
                if (mt == w) {
#pragma unroll
                    for (int i = 0; i < 4; ++i) { const int df = fr - 4 * quad - i;
                        const float dm = df > 0 ? lf[i] : (df < 0 ? lb[i] : 2.f);
                        p[4 * t2 + i] = acc[i] * dm; }
                } else {
                    const float tf = mt < w ? __builtin_amdgcn_exp2f((float)(16 * (w - mt)) * lgf2) : __builtin_amdgcn_exp2f((float)(16 * (mt - w)) * lgb2);
#pragma unroll
                    for (int i = 0; i < 4; ++i) p[4 * t2 + i] = acc[i] * ((mt < w ? lf[i] : lb[i]) * tf);
                } }
            u32x4 pk; pk.x = pg8::cvt_pk_bf16(p[0], p[1]); pk.y = pg8::cvt_pk_bf16(p[2], p[3]); pk.z = pg8::cvt_pk_bf16(p[4], p[5]); pk.w = pg8::cvt_pk_bf16(p[6], p[7]);
            const bf16x8 pb = __builtin_bit_cast(bf16x8, pk);
#pragma unroll
            for (int et = 0; et < 4; ++et) { const bf16x8 A = tr2(lds + VS + (32 * mp + 4 * quad + (fr >> 2)) * RT_P + (16 * et + 4 * (fr & 3)) * 2, 16 * RT_P);
                Y[et] = __builtin_amdgcn_mfma_f32_16x16x32_bf16(A, pb, Y[et], 0, 0, 0); }
        }
        const float xf = __builtin_amdgcn_exp2f((float)(nloc + 1) * lgf2), xb = __builtin_amdgcn_exp2f((float)(128 - nloc) * lgb2);
#pragma unroll
        for (int et = 0; et < 4; ++et) {
            f32x4 cf = (f32x4){0.f, 0.f, 0.f, 0.f}, cb = cf;
#pragma unroll
            for (int ks = 0; ks < 2; ++ks) { const int ro = (32 * ks + 8 * quad + (fr >> 2)) * RT_P + (16 * et + 4 * (fr & 3)) * 2;
                cf = __builtin_amdgcn_mfma_f32_16x16x32_bf16(tr2(lds + SF + ro, 4 * RT_P), qf[ks], cf, 0, 0, 0);
                cb = __builtin_amdgcn_mfma_f32_16x16x32_bf16(tr2(lds + SB + ro, 4 * RT_P), qf[ks], cb, 0, 0, 0); }
            Y[et] = Y[et] + cf * xf + cb * xb;
        }
        float s1 = 0.f;
#pragma unroll
        for (int et = 0; et < 4; ++et) s1 += (Y[et][0] + Y[et][1]) + (Y[et][2] + Y[et][3]);
        const float mu = xq_sum(s1) * (1.f / 64.f);
        float s2 = 0.f;
#pragma unroll
        for (int et = 0; et < 4; ++et)
#pragma unroll
            for (int i = 0; i < 4; ++i) { const float dd = Y[et][i] - mu; s2 += dd * dd; }
        const float rs = rsqrtf(xq_sum(s2) * (1.f / 64.f) + EPS);
        const bf16* gp = px + (size_t)row * DPROJ + O_RET_G + h * 64 + 4 * quad; bf16* op = act + (size_t)row * D + NAW + h * 64 + 4 * quad; const float* gw = gn_w + h * 64 + 4 * quad;
#pragma unroll
        for (int et = 0; et < 4; ++et) { const ushort4 gv = *(const ushort4*)(gp + 16 * et); const f32x4 wv = *(const f32x4*)(gw + 16 * et);
            const float o0 = (Y[et][0] - mu) * rs * wv.x * silu(bf2f(gv.x)), o1 = (Y[et][1] - mu) * rs * wv.y * silu(bf2f(gv.y)), o2 = (Y[et][2] - mu) * rs * wv.z * silu(bf2f(gv.z)), o3 = (Y[et][3] - mu) * rs * wv.w * silu(bf2f(gv.w));
            pg8::u32x2 o; o.x = pg8::cvt_pk_bf16(o0, o1); o.y = pg8::cvt_pk_bf16(o2, o3); *(pg8::u32x2*)(op + 16 * et) = o; }
    }
#undef R3_ISSUE
}
__device__ __forceinline__ void ph_topk1(const bf16* Q, const bf16* keysl, float* topv, int* topi, int nrows, bf16* sm) { const int tidx = otid();
    bf16 (*sk)[136] = (bf16 (*)[136])sm;
    const int nrt = nrows / NT;
    for (int vb = blockIdx.x; vb < nrt * 16; vb += gridDim.x) {
        const int hs = vb % 16, side = hs & 1, h = hs >> 1, row = (vb / 16) * NT + tidx;
        const bf16* kp = keysl + ((size_t)(side * PH + h) * PNK) * PKD;
        for (int i = tidx; i < 128 * 128; i += NT) sk[i / 128][i % 128] = kp[i];
        __syncthreads();
        float q[128];
        const bf16* qp = Q + (size_t)row * DQ + h * 256 + side * 128;
#pragma unroll
        for (int d = 0; d < 128; ++d) q[d] = bf2f(qp[d]);
        float tv[16]; int ti[16];
#pragma unroll
        for (int j = 0; j < 16; ++j) { tv[j] = -3e38f; ti[j] = 0; }
        for (int kk = 0; kk < 128; ++kk) {
            float s = 0.f;
#pragma unroll
            for (int d = 0; d < 128; ++d) s += q[d] * bf2f(sk[kk][d]);
            int si = kk;
#pragma unroll
            for (int j = 0; j < 16; ++j) { if (s > tv[j]) { const float tvv = tv[j]; const int tii = ti[j]; tv[j] = s; ti[j] = si; s = tvv; si = tii; } }
        }
        const size_t o = (((size_t)row * PH + h) * 2 + side) * 16;
#pragma unroll
        for (int j = 0; j < 16; ++j) { topv[o + j] = tv[j]; topi[o + j] = ti[j]; }
        __syncthreads();
    }
}
__device__ __forceinline__ void ph_topk2(const float* topv, const int* topi, int* idx, float* gate, int nrows) { const int tidx = otid();
    for (int gid = blockIdx.x * NT + tidx; gid < nrows * PH; gid += gridDim.x * NT) {
        const size_t o = (size_t)gid * 32;
        float vb[16];
#pragma unroll
        for (int j = 0; j < 16; ++j) vb[j] = topv[o + 16 + j];
        float tv[16]; int ti[16];
#pragma unroll
        for (int j = 0; j < 16; ++j) { tv[j] = -3e38f; ti[j] = 0; }
#pragma unroll 1
        for (int i = 0; i < 16; ++i) { const float vai = topv[o + i];
#pragma unroll
            for (int jb = 0; jb < 16; ++jb) { float s = vai + vb[jb]; int si = i * 16 + jb;
#pragma unroll
                for (int j = 0; j < 16; ++j) { if (s > tv[j]) { const float tvv = tv[j]; const int tii = ti[j]; tv[j] = s; ti[j] = si; s = tvv; si = tii; } } } }
        const float mx = tv[0]; float den = 0.f, p[16];
#pragma unroll
        for (int j = 0; j < 16; ++j) { p[j] = __expf(tv[j] - mx); den += p[j]; }
        const float inv = 1.f / den;
        const size_t oo = (size_t)gid * 16;
#pragma unroll
        for (int j = 0; j < 16; ++j) { const int ia = topi[o + (ti[j] >> 4)], ib = topi[o + 16 + (ti[j] & 15)]; idx[oo + j] = ia * PNK + ib; gate[oo + j] = p[j] * inv; }
    }
}


__device__ __forceinline__ void ins16(float (&L)[16], float v) {
#pragma unroll
    for (int j = 15; j >= 1; --j) L[j] = __builtin_amdgcn_fmed3f(L[j - 1], v, L[j]);
    L[0] = fmaxf(L[0], v);
}
__device__ __forceinline__ void bitonic_merge16(float (&L)[16], const float (&A)[16], const float (&B)[16]) {
#pragma unroll
    for (int j = 0; j < 16; ++j) L[j] = fmaxf(A[j], B[15 - j]);
#pragma unroll
    for (int st = 8; st >= 1; st >>= 1)
#pragma unroll
        for (int j = 0; j < 16; ++j) if ((j & st) == 0) { const float hi = fmaxf(L[j], L[j + st]), lo = fminf(L[j], L[j + st]); L[j] = hi; L[j + st] = lo; }
}
__device__ __forceinline__ void top16of32(float (&v)[32]) {
#define CE(i, j) { const float hi_ = fmaxf(v[i], v[j]), lo_ = fminf(v[i], v[j]); v[i] = hi_; v[j] = lo_; }
#define CMAX(i, j) { v[i] = fmaxf(v[i], v[j]); }
#define CMIN(i, j) { v[j] = fminf(v[i], v[j]); }
    CE(0,1) CE(2,3) CE(0,2) CE(1,3) CE(1,2) CE(4,5) CE(6,7) CE(4,6) CE(5,7) CE(5,6) CE(0,4) CE(2,6) CE(2,4) CE(1,5) CE(3,7) CE(3,5) CE(1,2) CE(3,4) CE(5,6) CE(8,9) CE(10,11) CE(8,10) CE(9,11) CE(9,10) CE(12,13) CE(14,15) CE(12,14) CE(13,15) CE(13,14) CE(8,12) CE(10,14) CE(10,12) CE(9,13) CE(11,15) CE(11,13) CE(9,10) CE(11,12) CE(13,14) CE(0,8) CE(4,12) CE(4,8) CE(2,10) CE(6,14) CE(6,10) CE(2,4) CE(6,8) CE(10,12) CE(1,9) CE(5,13) CE(5,9) CE(3,11) CE(7,15) CE(7,11) CE(3,5) CE(7,9) CE(11,13) CE(1,2) CE(3,4) CE(5,6) CE(7,8) CE(9,10) CE(11,12) CE(13,14) CE(16,17) CE(18,19) CE(16,18) CE(17,19) CE(17,18) CE(20,21) CE(22,23) CE(20,22) CE(21,23) CE(21,22) CE(16,20) CE(18,22) CE(18,20) CE(17,21) CE(19,23) CE(19,21) CE(17,18) CE(19,20) CE(21,22) CE(24,25) CE(26,27) CE(24,26) CE(25,27) CE(25,26) CE(28,29) CE(30,31) CE(28,30) CE(29,31) CE(29,30) CE(24,28) CE(26,30) CE(26,28) CE(25,29) CE(27,31) CE(27,29) CE(25,26) CE(27,28) CE(29,30) CE(16,24) CE(20,28) CE(20,24) CE(18,26) CE(22,30) CE(22,26) CE(18,20) CE(22,24) CE(26,28) CE(17,25) CE(21,29) CE(21,25) CE(19,27) CE(23,31) CE(23,27) CE(19,21) CE(23,25) CE(27,29) CE(17,18) CE(19,20) CE(21,22) CE(23,24) CE(25,26) CE(27,28) CE(29,30) CE(0,16) CMAX(8,24) CE(8,16) CE(4,20) CMAX(12,28) CMAX(12,20) CE(4,8) CE(12,16) CE(2,18) CMAX(10,26) CE(10,18) CE(6,22) CMAX(14,30) CMAX(14,22) CE(6,10) CMAX(14,18) CE(2,4) CE(6,8) CE(10,12) CE(14,16) CE(1,17) CMAX(9,25) CE(9,17) CE(5,21) CMAX(13,29) CMAX(13,21) CE(5,9) CE(13,17) CE(3,19) CMAX(11,27) CE(11,19) CE(7,23) CMAX(15,31) CMAX(15,23) CE(7,11) CMAX(15,19) CE(3,5) CE(7,9) CE(11,13) CMAX(15,17) CE(1,2) CE(3,4) CE(5,6) CE(7,8) CE(9,10) CE(11,12) CE(13,14) CMAX(15,16)
#undef CE
#undef CMAX
#undef CMIN
}
constexpr int TK_KROW = 272;
constexpr int TK_LIST = 2 * 128 * TK_KROW;
__device__ __forceinline__ void ph_tk_mfma(const bf16* Q, const bf16* keysl, int* idx, float* gate, int nrows, unsigned char* ldsg) { const int tidx = otid();
    const int lane = tidx & 63, w = __builtin_amdgcn_readfirstlane(tidx >> 6), fr = lane & 15, quad = lane >> 4;
    const lds_cp lds = (lds_cp)ldsg;
    unsigned* lists = (unsigned*)(ldsg + TK_LIST) + (w * 16 + fr) * 32;
    const int nunits = (nrows / 128) * PH;
    int hcur = -1;
    for (int u = blockIdx.x; u < nunits; u += gridDim.x) {
        const int h = u % PH, tile = u / PH;
        __syncthreads();
        if (h != hcur) {
            for (int i = tidx; i < 2 * 128 * 16; i += NT) { const int side = i >> 11, r = (i >> 4) & 127, pc = i & 15;
                *(u32x4*)(ldsg + (side * 128 + r) * TK_KROW + pc * 16) = *(const u32x4*)(keysl + ((size_t)(side * PH + h) * PNK + r) * PKD + pc * 8); }
            hcur = h;
        }
        __syncthreads();
        const int row = tile * 128 + 16 * w + fr;
        float Lb[16];
#pragma unroll
        for (int side = 0; side < 2; ++side) {
            bf16x8 qf[4];
#pragma unroll
            for (int s = 0; s < 4; ++s) qf[s] = *(const bf16x8*)(Q + (size_t)row * DQ + h * 256 + side * 128 + 32 * s + 8 * quad);
            float L[16];
            { float pv[32];
#pragma unroll
              for (int t = 0; t < 8; ++t) {
                f32x4 acc = (f32x4){0.f, 0.f, 0.f, 0.f};
#pragma unroll
                for (int s = 0; s < 4; ++s) { const bf16x8 kf = *(const __attribute__((address_space(3))) bf16x8*)(lds + (side * 128 + 16 * t + fr) * TK_KROW + 64 * s + 16 * quad);
                    acc = __builtin_amdgcn_mfma_f32_16x16x32_bf16(kf, qf[s], acc, 0, 0, 0); }
#pragma unroll
                for (int i = 0; i < 4; ++i) { const unsigned key = 16 * t + 4 * quad + i; pv[4 * t + i] = __uint_as_float((__float_as_uint(acc[i]) & ~0x7fu) | key); }
              }
              top16of32(pv);
#pragma unroll
              for (int j = 0; j < 16; ++j) L[j] = pv[j]; }
            { float A[16], B[16];
#pragma unroll
              for (int j = 0; j < 16; ++j) { auto s = __builtin_amdgcn_permlane16_swap(__float_as_uint(L[j]), __float_as_uint(L[j]), false, false); A[j] = __uint_as_float(s[0]); B[j] = __uint_as_float(s[1]); }
              bitonic_merge16(L, A, B);
#pragma unroll
              for (int j = 0; j < 16; ++j) { auto s = __builtin_amdgcn_permlane32_swap(__float_as_uint(L[j]), __float_as_uint(L[j]), false, false); A[j] = __uint_as_float(s[0]); B[j] = __uint_as_float(s[1]); }
              bitonic_merge16(L, A, B); }
            if (side == 0) {
                if (quad == 0) {
#pragma unroll
                    for (int j = 0; j < 16; ++j) lists[j] = __float_as_uint(L[j]); }
            } else {
#pragma unroll
                for (int j = 0; j < 16; ++j) Lb[j] = L[j];
                if (quad == 0) {
#pragma unroll
                    for (int j = 0; j < 16; ++j) lists[16 + j] = __float_as_uint(L[j]); }
            }
        }

        float C[16];
#pragma unroll
        for (int j = 0; j < 16; ++j) C[j] = -3.0e38f;
#pragma unroll
        for (int r = 0; r < 4; ++r) {
            const float vai = __uint_as_float(lists[4 * r + quad] & ~0x7fu);
            const int irow = 4 * r + quad, len = 16 / (irow + 1);
            constexpr int maxlen[4] = {16, 3, 1, 1};
#pragma unroll
            for (int j = 0; j < maxlen[r]; ++j) { const float s = vai + __uint_as_float(__float_as_uint(Lb[j]) & ~0x7fu);
                const float pkv = __uint_as_float((__float_as_uint(s) & ~0xffu) | (unsigned)(irow * 16 + j));
                ins16(C, j < len ? pkv : -3.0e38f); }
        }
        { float A[16], B[16];
#pragma unroll
          for (int j = 0; j < 16; ++j) { auto s = __builtin_amdgcn_permlane16_swap(__float_as_uint(C[j]), __float_as_uint(C[j]), false, false); A[j] = __uint_as_float(s[0]); B[j] = __uint_as_float(s[1]); }
          bitonic_merge16(C, A, B);
#pragma unroll
          for (int j = 0; j < 16; ++j) { auto s = __builtin_amdgcn_permlane32_swap(__float_as_uint(C[j]), __float_as_uint(C[j]), false, false); A[j] = __uint_as_float(s[0]); B[j] = __uint_as_float(s[1]); }
          bitonic_merge16(C, A, B); }
        const float mx = __uint_as_float(__float_as_uint(C[0]) & ~0xffu);
        float p[16], den = 0.f; int ex[16];
#pragma unroll
        for (int k = 0; k < 16; ++k) { const unsigned cb = __float_as_uint(C[k]); const float sv = __uint_as_float(cb & ~0xffu); p[k] = __expf(sv - mx); den += p[k];
            const unsigned ka = lists[(cb >> 4) & 15] & 0x7fu, kb = lists[16 + (cb & 15)] & 0x7fu; ex[k] = (int)(ka * PNK + kb); }
        const float inv = 1.f / den;
        if (quad == 0) {
            int* ip = idx + (size_t)row * 128 + h * 16; float* gp = gate + (size_t)row * 128 + h * 16;
#pragma unroll
            for (int k = 0; k < 16; k += 4) { *(int4*)(ip + k) = make_int4(ex[k], ex[k + 1], ex[k + 2], ex[k + 3]); *(f32x4*)(gp + k) = (f32x4){p[k] * inv, p[k + 1] * inv, p[k + 2] * inv, p[k + 3] * inv}; }
        }
    }
}
template <int B>
__device__ __forceinline__ void sort16at(float (&v)[64]) {
#define CE(i, j) { const float hi_ = fmaxf(v[B + i], v[B + j]), lo_ = fminf(v[B + i], v[B + j]); v[B + i] = hi_; v[B + j] = lo_; }
    CE(0,1) CE(2,3) CE(0,2) CE(1,3) CE(1,2) CE(4,5) CE(6,7) CE(4,6) CE(5,7) CE(5,6) CE(0,4) CE(2,6) CE(2,4) CE(1,5) CE(3,7) CE(3,5) CE(1,2) CE(3,4) CE(5,6) CE(8,9) CE(10,11) CE(8,10) CE(9,11) CE(9,10) CE(12,13) CE(14,15) CE(12,14) CE(13,15) CE(13,14) CE(8,12) CE(10,14) CE(10,12) CE(9,13) CE(11,15) CE(11,13) CE(9,10) CE(11,12) CE(13,14) CE(0,8) CE(4,12) CE(4,8) CE(2,10) CE(6,14) CE(6,10) CE(2,4) CE(6,8) CE(10,12) CE(1,9) CE(5,13) CE(5,9) CE(3,11) CE(7,15) CE(7,11) CE(3,5) CE(7,9) CE(11,13) CE(1,2) CE(3,4) CE(5,6) CE(7,8) CE(9,10) CE(11,12) CE(13,14)
#undef CE
}
__device__ __forceinline__ void top16of64(float (&v)[64], float (&L)[16]) {
    sort16at<0>(v); sort16at<16>(v); sort16at<32>(v); sort16at<48>(v);
    float A[16], Bv[16], M0[16], M1[16];
#pragma unroll
    for (int j = 0; j < 16; ++j) { A[j] = v[j]; Bv[j] = v[16 + j]; }
    bitonic_merge16(M0, A, Bv);
#pragma unroll
    for (int j = 0; j < 16; ++j) { A[j] = v[32 + j]; Bv[j] = v[48 + j]; }
    bitonic_merge16(M1, A, Bv);
    bitonic_merge16(L, M0, M1);
}
typedef float f32x16 __attribute__((ext_vector_type(16)));
__device__ __forceinline__ void ph_tk32(const bf16* Q, const bf16* keysl, int* idx, float* gate, int nrows, unsigned char* ldsg) { const int tidx = otid();
    const int lane = tidx & 63, w = __builtin_amdgcn_readfirstlane(tidx >> 6), r32 = lane & 31, hh = lane >> 5;
    const lds_cp lds = (lds_cp)ldsg;
    unsigned* lists = (unsigned*)(ldsg + TK_LIST) + (w * 32 + r32) * 32;
    const int nunits = (nrows / 256) * PH;
    int hcur = -1;
    for (int u = blockIdx.x; u < nunits; u += gridDim.x) {
        const int h = u % PH, tile = u / PH;
        __syncthreads();
        if (h != hcur) {
            for (int i = tidx; i < 2 * 128 * 16; i += NT) { const int side = i >> 11, r = (i >> 4) & 127, pc = i & 15;
                *(u32x4*)(ldsg + (side * 128 + r) * TK_KROW + pc * 16) = *(const u32x4*)(keysl + ((size_t)(side * PH + h) * PNK + r) * PKD + pc * 8); }
            hcur = h;
        }
        __syncthreads();
        const int row = tile * 256 + 32 * w + r32;
        float Lb[16];
#pragma unroll
        for (int side = 0; side < 2; ++side) {
            bf16x8 qf[8];
#pragma unroll
            for (int s = 0; s < 8; ++s) qf[s] = *(const bf16x8*)(Q + ((size_t)(((tile * 8 + w) * PH + h) * 2 + side)) * 4096 + s * 512 + hh * 256 + r32 * 8);
            float pv[64];
#pragma unroll
            for (int t = 0; t < 4; ++t) {
                f32x16 acc;
#pragma unroll
                for (int i = 0; i < 16; ++i) acc[i] = 0.f;
#pragma unroll
                for (int s = 0; s < 8; ++s) { const bf16x8 kf = *(const __attribute__((address_space(3))) bf16x8*)(lds + (side * 128 + 32 * t + r32) * TK_KROW + 32 * s + 16 * hh);
                    acc = __builtin_amdgcn_mfma_f32_32x32x16_bf16(kf, qf[s], acc, 0, 0, 0); }
#pragma unroll
                for (int i = 0; i < 16; ++i) { const unsigned key = 32 * t + (i & 3) + 8 * (i >> 2) + 4 * hh; pv[16 * t + i] = __uint_as_float((__float_as_uint(acc[i]) & ~0x7fu) | key); }
            }
            float L[16];
            top16of64(pv, L);
            { float A[16], B[16];
#pragma unroll
              for (int j = 0; j < 16; ++j) { auto s = __builtin_amdgcn_permlane32_swap(__float_as_uint(L[j]), __float_as_uint(L[j]), false, false); A[j] = __uint_as_float(s[0]); B[j] = __uint_as_float(s[1]); }
              bitonic_merge16(L, A, B); }
            if (side == 0) { if (hh == 0) {
#pragma unroll
                    for (int j = 0; j < 16; ++j) lists[j] = __float_as_uint(L[j]); } }
            else {
#pragma unroll
                for (int j = 0; j < 16; ++j) Lb[j] = L[j];
                if (hh == 0) {
#pragma unroll
                    for (int j = 0; j < 16; ++j) lists[16 + j] = __float_as_uint(L[j]); } }
        }
        float C[16];
#pragma unroll
        for (int j = 0; j < 16; ++j) C[j] = -3.0e38f;
#pragma unroll
        for (int r = 0; r < 8; ++r) {
            const float vai = __uint_as_float(lists[2 * r + hh] & ~0x7fu);
            const int irow = 2 * r + hh, len = 16 / (irow + 1);
            constexpr int maxlen[8] = {16, 5, 3, 2, 1, 1, 1, 1};
#pragma unroll
            for (int j = 0; j < maxlen[r]; ++j) { const float s = vai + __uint_as_float(__float_as_uint(Lb[j]) & ~0x7fu);
                const float pkv = __uint_as_float((__float_as_uint(s) & ~0xffu) | (unsigned)(irow * 16 + j));
                ins16(C, j < len ? pkv : -3.0e38f); }
        }
        { float A[16], B[16];
#pragma unroll
          for (int j = 0; j < 16; ++j) { auto s = __builtin_amdgcn_permlane32_swap(__float_as_uint(C[j]), __float_as_uint(C[j]), false, false); A[j] = __uint_as_float(s[0]); B[j] = __uint_as_float(s[1]); }
          bitonic_merge16(C, A, B); }
        const float mx = __uint_as_float(__float_as_uint(C[0]) & ~0xffu);
        float p[16], den = 0.f; int ex[16];
#pragma unroll
        for (int k = 0; k < 16; ++k) { const unsigned cb = __float_as_uint(C[k]); const float sv = __uint_as_float(cb & ~0xffu); p[k] = __expf(sv - mx); den += p[k];
            const unsigned ka = lists[(cb >> 4) & 15] & 0x7fu, kb = lists[16 + (cb & 15)] & 0x7fu; ex[k] = (int)(ka * PNK + kb); }
        const float inv = 1.f / den;
        if (hh == 0) {
            int* ip = idx + (size_t)row * 128 + h * 16; float* gp = gate + (size_t)row * 128 + h * 16;
#pragma unroll
            for (int k = 0; k < 16; k += 4) { *(int4*)(ip + k) = make_int4(ex[k], ex[k + 1], ex[k + 2], ex[k + 3]); *(f32x4*)(gp + k) = (f32x4){p[k] * inv, p[k + 1] * inv, p[k + 2] * inv, p[k + 3] * inv}; }
        }
    }
}
__device__ __forceinline__ float dot16(const float (&hx)[16], const bf16x8 a, const bf16x8 b) {
    float s = 0.f;
#pragma unroll
    for (int j = 0; j < 8; ++j) s += hx[j] * bf2f((bf16)a[j]) + hx[8 + j] * bf2f((bf16)b[j]);
    return s;
}
template <bool FINAL>
__device__ __forceinline__ void ph_peer(const bf16* act, const int* idx, const float* gate, const bf16* U, const bf16* V, const float* modl, int off_g,
                                        float* xlat, float* xctx, const float* fw, int nrows) { const int tidx = otid();
    const int lane = tidx & 63, wave = tidx >> 6;
    for (int row = blockIdx.x * 8 + wave; row < nrows; row += gridDim.x * 8) {
        float hx[16];
        { const bf16x8 a = *(const bf16x8*)(act + (size_t)row * D + lane * 8), b = *(const bf16x8*)(act + (size_t)row * D + 512 + lane * 8);
#pragma unroll
          for (int j = 0; j < 8; ++j) { hx[j] = bf2f((bf16)a[j]); hx[8 + j] = bf2f((bf16)b[j]); } }
        const int myi0 = idx[(size_t)row * 128 + lane], myi1 = idx[(size_t)row * 128 + 64 + lane];
        const float myg0 = gate[(size_t)row * 128 + lane], myg1 = gate[(size_t)row * 128 + 64 + lane];
        float a0 = 0.f, a1 = 0.f;
        for (int base = 0; base < 128; base += 8) {
            bf16x8 ua[8], ub[8];
#pragma unroll
            for (int j = 0; j < 8; ++j) { const int e = rl_i(base < 64 ? myi0 : myi1, (base + j) & 63); const bf16* up = U + (size_t)e * D; ua[j] = *(const bf16x8*)(up + lane * 8); ub[j] = *(const bf16x8*)(up + 512 + lane * 8); }
#pragma unroll
            for (int j = 0; j < 8; ++j) { const float s = wave_sum(dot16(hx, ua[j], ub[j])); if (lane == ((base + j) & 63)) { if (base < 64) a0 = s; else a1 = s; } }
        }
        const float w0 = myg0 * 0.5f * a0 * (1.f + erff(a0 * 0.70710678f)), w1 = myg1 * 0.5f * a1 * (1.f + erff(a1 * 0.70710678f));
        float out[16];
#pragma unroll
        for (int j = 0; j < 16; ++j) out[j] = 0.f;
        for (int base = 0; base < 128; base += 8) {
            bf16x8 va[8], vb[8];
#pragma unroll
            for (int j = 0; j < 8; ++j) { const int e = rl_i(base < 64 ? myi0 : myi1, (base + j) & 63); const bf16* vp = V + (size_t)e * D; va[j] = *(const bf16x8*)(vp + lane * 8); vb[j] = *(const bf16x8*)(vp + 512 + lane * 8); }
#pragma unroll
            for (int j = 0; j < 8; ++j) { const float w = rl_f(base < 64 ? w0 : w1, (base + j) & 63);
#pragma unroll
                for (int q = 0; q < 8; ++q) { out[q] += w * bf2f((bf16)va[j][q]); out[8 + q] += w * bf2f((bf16)vb[j][q]); } }
        }
        const int mi = row < M_LAT ? row / S : 4;
        float* xr = row < M_LAT ? xlat + (size_t)row * D : xctx + (size_t)(row - M_LAT) * D;
        const float* g2 = modl + (size_t)mi * 6 * D + off_g;
        float xn[16]; float ss = 0.f;
#pragma unroll
        for (int hlf = 0; hlf < 2; ++hlf) { const int k = hlf * 512 + lane * 8;
            const f32x4 x0 = *(const f32x4*)(xr + k), x1 = *(const f32x4*)(xr + k + 4), g0 = *(const f32x4*)(g2 + k), g1 = *(const f32x4*)(g2 + k + 4);
            xn[hlf * 8 + 0] = x0.x + g0.x * out[hlf * 8 + 0]; xn[hlf * 8 + 1] = x0.y + g0.y * out[hlf * 8 + 1]; xn[hlf * 8 + 2] = x0.z + g0.z * out[hlf * 8 + 2]; xn[hlf * 8 + 3] = x0.w + g0.w * out[hlf * 8 + 3];
            xn[hlf * 8 + 4] = x1.x + g1.x * out[hlf * 8 + 4]; xn[hlf * 8 + 5] = x1.y + g1.y * out[hlf * 8 + 5]; xn[hlf * 8 + 6] = x1.z + g1.z * out[hlf * 8 + 6]; xn[hlf * 8 + 7] = x1.w + g1.w * out[hlf * 8 + 7]; }
#pragma unroll
        for (int j = 0; j < 16; ++j) ss += xn[j] * xn[j];
        float rs = 1.f;
        if (FINAL) { ss = wave_sum(ss); rs = rsqrtf(ss * (1.f / D) + EPS); }
#pragma unroll
        for (int hlf = 0; hlf < 2; ++hlf) { const int k = hlf * 512 + lane * 8;
            f32x4 o0, o1;
            if (FINAL) { const f32x4 f0 = *(const f32x4*)(fw + k), f1 = *(const f32x4*)(fw + k + 4);
                o0 = (f32x4){xn[hlf * 8 + 0] * rs * f0.x, xn[hlf * 8 + 1] * rs * f0.y, xn[hlf * 8 + 2] * rs * f0.z, xn[hlf * 8 + 3] * rs * f0.w};
                o1 = (f32x4){xn[hlf * 8 + 4] * rs * f1.x, xn[hlf * 8 + 5] * rs * f1.y, xn[hlf * 8 + 6] * rs * f1.z, xn[hlf * 8 + 7] * rs * f1.w}; }
            else { o0 = (f32x4){xn[hlf * 8 + 0], xn[hlf * 8 + 1], xn[hlf * 8 + 2], xn[hlf * 8 + 3]}; o1 = (f32x4){xn[hlf * 8 + 4], xn[hlf * 8 + 5], xn[hlf * 8 + 6], xn[hlf * 8 + 7]}; }
            *(f32x4*)(xr + k) = o0; *(f32x4*)(xr + k + 4) = o1; }
    }
}


__device__ __forceinline__ void ph_quant(const float* src, unsigned char* dst, float* scl, int nrows, int offs  ) { const int tidx = otid();
    const int lane = tidx & 63, wave = tidx >> 6;
    for (int row0 = (blockIdx.x * 8 + wave) * 4; row0 < nrows; row0 += gridDim.x * 8 * 4) {
        f32x4 v[4][4];
#pragma unroll
        for (int r = 0; r < 4; ++r)
#pragma unroll
            for (int j = 0; j < 4; ++j) v[r][j] = *(const f32x4*)(src + (size_t)(row0 + r) * D + lane * 16 + 4 * j);
#pragma unroll
        for (int r = 0; r < 4; ++r) {
            float am = 0.f;
#pragma unroll
            for (int j = 0; j < 4; ++j) am = fmaxf(am, fmaxf(fmaxf(fabsf(v[r][j].x), fabsf(v[r][j].y)), fmaxf(fabsf(v[r][j].z), fabsf(v[r][j].w))));
            am = wave_max(am);
            const float sc = am > 0.f ? am * (1.f / 127.f) : 1.f, inv = 1.f / sc;
            u32x4 o;
#pragma unroll
            for (int j = 0; j < 4; ++j) { const int q0 = (int)rintf(v[r][j].x * inv) + offs, q1 = (int)rintf(v[r][j].y * inv) + offs, q2 = (int)rintf(v[r][j].z * inv) + offs, q3 = (int)rintf(v[r][j].w * inv) + offs;
                o[j] = (unsigned)(q0 & 0xff) | ((unsigned)(q1 & 0xff) << 8) | ((unsigned)(q2 & 0xff) << 16) | ((unsigned)(q3 & 0xff) << 24); }
            *(u32x4*)(dst + (size_t)(row0 + r) * D + lane * 16) = o;
            if (lane == 0) scl[row0 + r] = sc;
        }
    }
}
__device__ __forceinline__ void ph_quant_w(const bf16* src, unsigned char* dst, float* scl, int nrows) { const int tidx = otid();
    const int lane = tidx & 63, wave = tidx >> 6;
    for (int row0 = (blockIdx.x * 8 + wave) * 2; row0 < nrows; row0 += gridDim.x * 16) {
        bf16x8 a[2][2];
#pragma unroll
        for (int r = 0; r < 2; ++r) { a[r][0] = *(const bf16x8*)(src + (size_t)(row0 + r) * D + lane * 16); a[r][1] = *(const bf16x8*)(src + (size_t)(row0 + r) * D + lane * 16 + 8); }
#pragma unroll
        for (int r = 0; r < 2; ++r) { float f[16]; float am = 0.f;
#pragma unroll
            for (int j = 0; j < 8; ++j) { f[j] = bf2f((bf16)a[r][0][j]); f[8 + j] = bf2f((bf16)a[r][1][j]); am = fmaxf(am, fmaxf(fabsf(f[j]), fabsf(f[8 + j]))); }
            am = wave_max(am); const float sc = am > 0.f ? am * (1.f / 127.f) : 1.f, inv = 1.f / sc;
            u32x4 o;
#pragma unroll
            for (int j = 0; j < 4; ++j) { const int q0 = (int)rintf(f[4 * j] * inv), q1 = (int)rintf(f[4 * j + 1] * inv), q2 = (int)rintf(f[4 * j + 2] * inv), q3 = (int)rintf(f[4 * j + 3] * inv);
                o[j] = (unsigned)(q0 & 0xff) | ((unsigned)(q1 & 0xff) << 8) | ((unsigned)(q2 & 0xff) << 16) | ((unsigned)(q3 & 0xff) << 24); }
            *(u32x4*)(dst + (size_t)(row0 + r) * D + lane * 16) = o;
            if (lane == 0) scl[row0 + r] = sc; }
    }
}
__device__ __forceinline__ int xreduce64(int (&p)[64], int lane) {
#pragma unroll
    for (int k = 0; k < 32; ++k) { auto r = __builtin_amdgcn_permlane32_swap((unsigned)p[k], (unsigned)p[k + 32], false, false); p[k] = (int)(r[0] + r[1]); }
#pragma unroll
    for (int k = 0; k < 16; ++k) { auto r = __builtin_amdgcn_permlane16_swap((unsigned)p[k], (unsigned)p[k + 16], false, false); p[k] = (int)(r[0] + r[1]); }
#define XR_STEP(n, M) _Pragma("unroll") for (int k = 0; k < (n) / 2; ++k) { const bool up = (lane & (M)) != 0; const int send = up ? p[k] : p[k + (n) / 2], keep = up ? p[k + (n) / 2] : p[k]; \
        p[k] = keep + __builtin_amdgcn_ds_swizzle(send, ((M) << 10) | 0x1f); }
    XR_STEP(16, 8) XR_STEP(8, 4) XR_STEP(4, 2) XR_STEP(2, 1)
#undef XR_STEP
    return p[0];
}
template <int MODE  >
__device__ __forceinline__ void ph_peer8(bf16* act, const int* idx, const float* gate, const unsigned char* U8, const unsigned char* V8, const float* SU, const float* SV,
                                         const float* modl, int off_g, bf16* xlat, bf16* xctx, float* outf, const float* fw, const float* modn, int nrows) { const int tidx = otid();
    constexpr bool FINAL = (MODE == 2);
    const int lane = tidx & 63, wave = tidx >> 6;
    for (int row = blockIdx.x * 8 + wave; row < nrows; row += gridDim.x * 8) {
        int xq[4]; float sx;
        { const bf16x8 a = *(const bf16x8*)(act + (size_t)row * D + lane * 16), b = *(const bf16x8*)(act + (size_t)row * D + lane * 16 + 8);
          float hx[16]; float am = 0.f;
#pragma unroll
          for (int j = 0; j < 8; ++j) { hx[j] = bf2f((bf16)a[j]); hx[8 + j] = bf2f((bf16)b[j]); am = fmaxf(am, fmaxf(fabsf(hx[j]), fabsf(hx[8 + j]))); }
          am = wave_max(am); sx = am > 0.f ? am * (1.f / 127.f) : 1.f; const float inv = 1.f / sx;
#pragma unroll
          for (int j = 0; j < 4; ++j) { const int q0 = (int)rintf(hx[4 * j] * inv), q1 = (int)rintf(hx[4 * j + 1] * inv), q2 = (int)rintf(hx[4 * j + 2] * inv), q3 = (int)rintf(hx[4 * j + 3] * inv);
              xq[j] = (int)((unsigned)(q0 & 0xff) | ((unsigned)(q1 & 0xff) << 8) | ((unsigned)(q2 & 0xff) << 16) | ((unsigned)(q3 & 0xff) << 24)); } }
        const int myi0 = idx[(size_t)row * 128 + lane], myi1 = idx[(size_t)row * 128 + 64 + lane];
        const float myg0 = gate[(size_t)row * 128 + lane], myg1 = gate[(size_t)row * 128 + 64 + lane];
        const float su0 = SU[myi0], su1 = SU[myi1], sv0 = SV[myi0], sv1 = SV[myi1];
        float wgt[2];
#pragma unroll
        for (int hf = 0; hf < 2; ++hf) {
            int p[64];
#pragma unroll
            for (int base = 0; base < 64; base += 16) {
                u32x4 ub[16];
#pragma unroll
                for (int j = 0; j < 16; ++j) { const int e = rl_i(hf ? myi1 : myi0, base + j); ub[j] = *(const u32x4*)(U8 + (size_t)e * D + lane * 16); }
#pragma unroll
                for (int j = 0; j < 16; ++j) { int s = __builtin_amdgcn_sdot4((int)ub[j].x, xq[0], 0, false); s = __builtin_amdgcn_sdot4((int)ub[j].y, xq[1], s, false);
                    s = __builtin_amdgcn_sdot4((int)ub[j].z, xq[2], s, false); p[base + j] = __builtin_amdgcn_sdot4((int)ub[j].w, xq[3], s, false); }
            }
            const float a = (float)xreduce64(p, lane) * sx * (hf ? su1 : su0);
            wgt[hf] = (hf ? myg1 * sv1 : myg0 * sv0) * 0.5f * a * (1.f + erff(a * 0.70710678f));
        }
        float out[16];
#pragma unroll
        for (int j = 0; j < 16; ++j) out[j] = 0.f;
#pragma unroll 1
        for (int base = 0; base < 128; base += 16) {
            u32x4 vb[16];
#pragma unroll
            for (int j = 0; j < 16; ++j) { const int e = rl_i(base < 64 ? myi0 : myi1, (base + j) & 63); vb[j] = *(const u32x4*)(V8 + (size_t)e * D + lane * 16); }
#pragma unroll
            for (int j = 0; j < 16; ++j) { const float wv = rl_f(base < 64 ? wgt[0] : wgt[1], (base + j) & 63);
#pragma unroll
                for (int q = 0; q < 4; ++q) { const unsigned dw = vb[j][q];
                    out[4 * q + 0] += wv * (float)((int)(dw << 24) >> 24); out[4 * q + 1] += wv * (float)((int)(dw << 16) >> 24); out[4 * q + 2] += wv * (float)((int)(dw << 8) >> 24); out[4 * q + 3] += wv * (float)((int)dw >> 24); } }
        }
        const int mi = row < M_LAT ? row / S : 4;
        bf16* xr = (row < M_LAT ? xlat + (size_t)row * D : xctx + (size_t)(row - M_LAT) * D) + lane * 16;
        const float* g2 = modl + (size_t)mi * 6 * D + off_g + lane * 16;
        float xn[16]; float ss = 0.f;
#pragma unroll
        for (int q = 0; q < 4; ++q) { const f32x4 x0 = ld4res<true>(xr, 4 * q), g0 = *(const f32x4*)(g2 + 4 * q);
            xn[4 * q + 0] = bf2f(f2bf(x0.x + g0.x * out[4 * q + 0])); xn[4 * q + 1] = bf2f(f2bf(x0.y + g0.y * out[4 * q + 1]));
            xn[4 * q + 2] = bf2f(f2bf(x0.z + g0.z * out[4 * q + 2])); xn[4 * q + 3] = bf2f(f2bf(x0.w + g0.w * out[4 * q + 3])); }
#pragma unroll
        for (int j = 0; j < 16; ++j) ss += xn[j] * xn[j];
        float rs = 1.f;
        if (MODE != 0) { ss = wave_sum(ss); rs = rsqrtf(ss * (1.f / D) + EPS); }
#pragma unroll
        for (int q = 0; q < 4; ++q) {
            if (FINAL) { const f32x4 f0 = *(const f32x4*)(fw + lane * 16 + 4 * q); *(f32x4*)(outf + (size_t)row * D + lane * 16 + 4 * q) = (f32x4){xn[4 * q] * rs * f0.x, xn[4 * q + 1] * rs * f0.y, xn[4 * q + 2] * rs * f0.z, xn[4 * q + 3] * rs * f0.w}; }
            else st4res(xr, 4 * q, (f32x4){xn[4 * q], xn[4 * q + 1], xn[4 * q + 2], xn[4 * q + 3]}); }
        if (MODE == 1) {
            const float* sh = modn + (size_t)mi * 6 * D + lane * 16; const float* sc = sh + D; const float* nw = fw + lane * 16;
            u32x4 o0, o1; unsigned pk[8];
#pragma unroll
            for (int q = 0; q < 4; ++q) { const f32x4 w4 = *(const f32x4*)(nw + 4 * q), a4 = *(const f32x4*)(sc + 4 * q), b4 = *(const f32x4*)(sh + 4 * q);
                pk[2 * q] = pg8::cvt_pk_bf16(xn[4 * q] * rs * w4.x * (1.f + a4.x) + b4.x, xn[4 * q + 1] * rs * w4.y * (1.f + a4.y) + b4.y);
                pk[2 * q + 1] = pg8::cvt_pk_bf16(xn[4 * q + 2] * rs * w4.z * (1.f + a4.z) + b4.z, xn[4 * q + 3] * rs * w4.w * (1.f + a4.w) + b4.w); }
            o0 = (u32x4){pk[0], pk[1], pk[2], pk[3]}; o1 = (u32x4){pk[4], pk[5], pk[6], pk[7]};
            *(u32x4*)(act + (size_t)row * D + lane * 16) = o0; *(u32x4*)(act + (size_t)row * D + lane * 16 + 8) = o1;
        }
    }
}

constexpr int PSA_ENT_MAX = 512;
constexpr int PSA_XQ = 0, PSA_ENT = 135168, PSA_ENT_BYTES = 2048, PSA_SX = PSA_ENT + 8 * PSA_ENT_BYTES;
constexpr int PSA_HIST = 152576, PSA_WTOT = PSA_HIST + 8192, PSA_SORT_MAX = 4096;
static_assert(PSA_SX + 132 * 4 <= PSA_HIST && PSA_WTOT + 64 <= LDS_BYTES - 64, "sweep A LDS map");
constexpr int PSB_IDX = 0, PSB_WQ = 33792, PSB_SW = PSB_WQ + 132 * 128, PSB_SS = PSB_SW + 1024;
#ifndef PEER_NSLAB
#define PEER_NSLAB 8
#endif
#ifndef PEER_PSH
static_assert(true, "");
#define PEER_SORTA 1
#define PEER_PSH 11
#endif
__device__ __forceinline__ int reduce32i(int (&p)[32], int lane) {
#pragma unroll
    for (int k = 0; k < 16; ++k) { auto r = __builtin_amdgcn_permlane32_swap((unsigned)p[k], (unsigned)p[k + 16], false, false); p[k] = (int)(r[0] + r[1]); }
#pragma unroll
    for (int k = 0; k < 8; ++k) { auto r = __builtin_amdgcn_permlane16_swap((unsigned)p[k], (unsigned)p[k + 8], false, false); p[k] = (int)(r[0] + r[1]); }
    { const bool up = (lane & 8) != 0;
#pragma unroll
      for (int k = 0; k < 4; ++k) { const int send = up ? p[k] : p[k + 4], keep = up ? p[k + 4] : p[k]; p[k] = keep + __builtin_amdgcn_ds_swizzle(send, (8 << 10) | 0x1f); } }
    { const bool up = (lane & 4) != 0;
#pragma unroll
      for (int k = 0; k < 2; ++k) { const int send = up ? p[k] : p[k + 2], keep = up ? p[k + 2] : p[k]; p[k] = keep + __builtin_amdgcn_ds_swizzle(send, (4 << 10) | 0x1f); } }
    { const bool up = (lane & 2) != 0; const int send = up ? p[0] : p[1], keep = up ? p[1] : p[0]; p[0] = keep + __builtin_amdgcn_ds_swizzle(send, (2 << 10) | 0x1f); }
    p[0] += __builtin_amdgcn_ds_swizzle(p[0], (1 << 10) | 0x1f);
    return p[0];
}
template <int LPS>
__device__ __forceinline__ void reduce16r(int (&p)[16], int lane) {
#pragma unroll
    for (int k = 0; k < 8; ++k) { auto r = __builtin_amdgcn_permlane32_swap((unsigned)p[k], (unsigned)p[k + 8], false, false); p[k] = (int)(r[0] + r[1]); }
#pragma unroll
    for (int k = 0; k < 4; ++k) { auto r = __builtin_amdgcn_permlane16_swap((unsigned)p[k], (unsigned)p[k + 4], false, false); p[k] = (int)(r[0] + r[1]); }
    { const bool up = (lane & 8) != 0;
#pragma unroll
      for (int k = 0; k < 2; ++k) { const int send = up ? p[k] : p[k + 2], keep = up ? p[k + 2] : p[k]; p[k] = keep + __builtin_amdgcn_ds_swizzle(send, (8 << 10) | 0x1f); } }
    if (LPS == 4) { const bool up = (lane & 4) != 0; const int send = up ? p[0] : p[1], keep = up ? p[1] : p[0]; p[0] = keep + __builtin_amdgcn_ds_swizzle(send, (4 << 10) | 0x1f); }
}
template <int MODE  >
__device__ __forceinline__ void ph_peer_sweep(const int* idx, const float* gate, const unsigned char* U8, const unsigned char* V8, const float* SU, const float* SV, const unsigned char* XQ, const float* XS,
                                              float* AW  , const float* modl, int off_g, bf16* xlat, bf16* xctx, float* outf  , const float* nw, const float* modn, unsigned char* xqo, float* xso, int nrows, unsigned char* ldsg) { const int tidx = otid();
    const int lane = tidx & 63, wave = __builtin_amdgcn_readfirstlane(tidx >> 6);
    const int TPW = nrows / (int)gridDim.x, row0 = (int)blockIdx.x * TPW;
    const int J = (TPW - wave + 7) / 8;
    __syncthreads();
    unsigned* ent = (unsigned*)(ldsg + PSA_ENT + wave * PSA_ENT_BYTES); float* sxs = (float*)(ldsg + PSA_SX);
    for (int j = 0; j < J; ++j) { const int tl = wave + 8 * j; *(u32x4*)(ldsg + PSA_XQ + tl * 1024 + lane * 16) = *(const u32x4*)(XQ + (size_t)(row0 + tl) * D + lane * 16); if (lane == 0) sxs[tl] = XS[row0 + tl]; }
    unsigned iab[17];
#pragma unroll
    for (int j = 0; j < 17; ++j) { if (j < J) { const size_t r = (size_t)(row0 + wave + 8 * j) * 128; iab[j] = (unsigned)idx[r + lane] | ((unsigned)idx[r + 64 + lane] << 16); } else iab[j] = 0xffffffffu; }
#if PEER_SORTA
    unsigned* hist = (unsigned*)(ldsg + PSA_HIST); unsigned* srt = (unsigned*)(ldsg + PSA_ENT); unsigned* wtot = (unsigned*)(ldsg + PSA_WTOT);
    ((u32x4*)hist)[tidx] = (u32x4){0u, 0u, 0u, 0u};
    __syncthreads();
#endif
#define IA(j) ((int)(iab[j] & 0xffffu))
#define IB(j) ((int)(iab[j] >> 16))
#pragma unroll 1
    for (int p = 0; p < (NEXP >> PEER_PSH); ++p) {
        const unsigned* lst = ent; int n = 0, cstart = 0, cstride = 32, nov = 0;
#pragma unroll
        for (int j = 0; j < 17; ++j) asm volatile("" : "+v"(iab[j]));
        unsigned lane_o = (unsigned)lane; asm volatile("" : "+v"(lane_o));
#if PEER_SORTA
#pragma unroll
        for (int j = 0; j < 17; ++j) {
            if ((IA(j) >> PEER_PSH) == p) atomicAdd(&hist[IA(j) & 2047], 1u);
            if ((IB(j) >> PEER_PSH) == p) atomicAdd(&hist[IB(j) & 2047], 1u);
        }
        __syncthreads();
        const u32x4 hh4 = ((const u32x4*)hist)[tidx];
        const unsigned hs = hh4.x + hh4.y + hh4.z + hh4.w; unsigned inc = hs;
#pragma unroll
        for (int d = 1; d < 64; d <<= 1) { const unsigned t = (unsigned)__shfl_up((int)inc, d); if (lane >= d) inc += t; }
        if (lane == 63) wtot[wave] = inc;
        __syncthreads();
        unsigned wbase = 0, NS = 0;
#pragma unroll
        for (int w2 = 0; w2 < 8; ++w2) { const unsigned t = wtot[w2]; NS += t; if (w2 < wave) wbase += t; }
        NS = (unsigned)__builtin_amdgcn_readfirstlane((int)NS); wbase = (unsigned)__builtin_amdgcn_readfirstlane((int)wbase);
        { const unsigned ex = wbase + inc - hs; u32x4 o; o.x = ex; o.y = ex + hh4.x; o.z = o.y + hh4.y; o.w = o.z + hh4.z; ((u32x4*)hist)[tidx] = o; }
        __syncthreads();
        if (NS <= (unsigned)PSA_SORT_MAX) {
#pragma unroll
            for (int j = 0; j < 17; ++j) {
                if ((IA(j) >> PEER_PSH) == p) { const unsigned pos = atomicAdd(&hist[IA(j) & 2047], 1u); srt[pos] = (unsigned)IA(j) | (lane_o << 14) | ((unsigned)(wave + 8 * j) << 21); }
                if ((IB(j) >> PEER_PSH) == p) { const unsigned pos = atomicAdd(&hist[IB(j) & 2047], 1u); srt[pos] = (unsigned)IB(j) | ((64u + lane_o) << 14) | ((unsigned)(wave + 8 * j) << 21); }
            }
            __syncthreads();
            ((u32x4*)hist)[tidx] = (u32x4){0u, 0u, 0u, 0u};
            lst = srt; n = (int)NS; cstart = wave * 32; cstride = 256;
        } else {
        ((u32x4*)hist)[tidx] = (u32x4){0u, 0u, 0u, 0u};
#endif
#pragma unroll
        for (int j = 0; j < 17; ++j) {
            const bool in0 = (IA(j) >> PEER_PSH) == p, in1 = (IB(j) >> PEER_PSH) == p;
            const unsigned long long m0 = __ballot(in0), m1 = __ballot(in1);
            const int c0 = __popcll(m0), c1 = __popcll(m1);
            const int r0 = n + (int)__builtin_amdgcn_mbcnt_hi((unsigned)(m0 >> 32), __builtin_amdgcn_mbcnt_lo((unsigned)m0, 0u));
            const int r1 = n + c0 + (int)__builtin_amdgcn_mbcnt_hi((unsigned)(m1 >> 32), __builtin_amdgcn_mbcnt_lo((unsigned)m1, 0u));
            if (in0 && r0 < PSA_ENT_MAX) ent[r0] = (unsigned)IA(j) | (lane_o << 14) | ((unsigned)(wave + 8 * j) << 21);
            if (in1 && r1 < PSA_ENT_MAX) ent[r1] = (unsigned)IB(j) | ((64u + lane_o) << 14) | ((unsigned)(wave + 8 * j) << 21);
            n += c0 + c1;
        }
        nov = n;
        n = min(n, PSA_ENT_MAX);
#if PEER_SORTA
        }
#endif
        {
#pragma unroll 1
            for (int base = cstart; base < n; base += cstride) {
                const unsigned myent = lst[min(base + (lane & 31), n - 1)];
                u32x4 ub[32];
#pragma unroll
                for (int q = 0; q < 32; ++q) { const unsigned ej = (unsigned)rl_i((int)myent, q); ub[q] = *(const u32x4*)(U8 + (size_t)(ej & 0x3fffu) * D + lane * 16); }
                int ps[32];
#pragma unroll
                for (int q = 0; q < 32; ++q) { const int tq = (int)((unsigned)rl_i((int)myent, q) >> 21); const u32x4 xv = *(const u32x4*)(ldsg + PSA_XQ + tq * 1024 + lane * 16);
                    int s = __builtin_amdgcn_sdot4((int)ub[q].x, (int)xv.x, 0, false); s = __builtin_amdgcn_sdot4((int)ub[q].y, (int)xv.y, s, false);
                    s = __builtin_amdgcn_sdot4((int)ub[q].z, (int)xv.z, s, false); ps[q] = __builtin_amdgcn_sdot4((int)ub[q].w, (int)xv.w, s, false); }
                const int tot = reduce32i(ps, lane);
                const int slot = lane >> 1;
                if ((lane & 1) == 0 && base + slot < n) { const unsigned en = lst[base + slot]; const int tl = (int)(en >> 21), pos = (int)((en >> 14) & 127u);
                    AW[(size_t)(row0 + tl) * 128 + pos] = (float)tot * sxs[tl]; }
            }
        }
        if (nov > PSA_ENT_MAX) {
            int cnt = 0;
#pragma unroll 1
            for (int j = 0; j < J; ++j) { const size_t r = (size_t)(row0 + wave + 8 * j) * 128;
#pragma unroll 1
                for (int pos = 0; pos < 128; ++pos) { const int e = idx[r + pos];
                    if ((e >> PEER_PSH) == p) { if (cnt >= PSA_ENT_MAX) { const u32x4 uv = *(const u32x4*)(U8 + (size_t)e * D + lane * 16), xv = *(const u32x4*)(ldsg + PSA_XQ + (wave + 8 * j) * 1024 + lane * 16);
                            int s = __builtin_amdgcn_sdot4((int)uv.x, (int)xv.x, 0, false); s = __builtin_amdgcn_sdot4((int)uv.y, (int)xv.y, s, false); s = __builtin_amdgcn_sdot4((int)uv.z, (int)xv.z, s, false); s = __builtin_amdgcn_sdot4((int)uv.w, (int)xv.w, s, false);
                            const float a = wave_sum((float)s); if (lane == 0) AW[r + pos] = a * sxs[wave + 8 * j]; }
                        ++cnt; } } }
        }
        __syncthreads();
    }
    unsigned short* idxs = (unsigned short*)(ldsg + PSB_IDX); unsigned char* wqb = ldsg + PSB_WQ; float* sws = (float*)(ldsg + PSB_SW); float* ssl = (float*)(ldsg + PSB_SS);
    constexpr int LPS = 64 / PEER_NSLAB, RR = 64 / LPS, NK = 128 / RR, NG = NK / 4;
#pragma unroll
    for (int jb = 0; jb < 18; jb += 3) {
        float aw0[3], aw1[3], g0[3], g1[3], su0[3], su1[3], sv0[3], sv1[3];
#pragma unroll
        for (int q = 0; q < 3; ++q) { const int j = jb + q; if (j < 17 && j < J) { const size_t r = (size_t)(row0 + wave + 8 * j) * 128;
            aw0[q] = AW[r + lane]; aw1[q] = AW[r + 64 + lane]; g0[q] = gate[r + lane]; g1[q] = gate[r + 64 + lane];
            su0[q] = SU[IA(j)]; su1[q] = SU[IB(j)]; sv0[q] = SV[IA(j)]; sv1[q] = SV[IB(j)]; } }
#pragma unroll
        for (int q = 0; q < 3; ++q) { const int j = jb + q; if (j < 17 && j < J) { const int tl = wave + 8 * j;
            const float a0 = aw0[q] * su0[q], a1 = aw1[q] * su1[q];
            const float w0 = g0[q] * sv0[q] * 0.5f * a0 * (1.f + erff(a0 * 0.70710678f)), w1 = g1[q] * sv1[q] * 0.5f * a1 * (1.f + erff(a1 * 0.70710678f));
            const float wm = wave_max(fmaxf(fabsf(w0), fabsf(w1))); const float sw = wm > 0.f ? wm * (1.f / 127.f) : 1.f, inv = 1.f / sw;
            const int q0 = (int)rintf(w0 * inv), q1 = (int)rintf(w1 * inv);
            { const int pos = lane, k = pos / RR, rr = pos % RR; wqb[tl * 128 + ((k >> 2) * RR + rr) * 4 + (k & 3)] = (unsigned char)(q0 & 0xff); }
            { const int pos = 64 + lane, k = pos / RR, rr = pos % RR; wqb[tl * 128 + ((k >> 2) * RR + rr) * 4 + (k & 3)] = (unsigned char)(q1 & 0xff); }
            idxs[tl * 128 + lane] = (unsigned short)IA(j); idxs[tl * 128 + 64 + lane] = (unsigned short)IB(j);
            if (lane == 0) sws[tl] = sw; ssl[tl * 64 + lane] = 0.f; } }
    }
    __syncthreads();
    const int rr = lane / LPS, cc = lane % LPS;
    constexpr int NREPB = ((DUP_MASK >> 10) & 1) ? 2 : 1; constexpr float WSC = 1.f / NREPB;
    constexpr int TB = (NK == 8) ? 4 : 2;
    for (int repB = 0; repB < NREPB; ++repB)
#pragma unroll 1
    for (int s = 0; s < PEER_NSLAB; ++s) {
#pragma unroll 1
        for (int jg = 0; jg < J; jg += TB) {
            u32x4 vb[TB][NK];
#pragma unroll
            for (int q = 0; q < TB; ++q) if (jg + q < J) { const int tl = wave + 8 * (jg + q);
#pragma unroll
                for (int k = 0; k < NK; ++k) { const int e = idxs[tl * 128 + RR * k + rr]; vb[q][k] = *(const u32x4*)(V8 + (size_t)e * D + s * (LPS * 16) + cc * 16); } }
#pragma unroll
            for (int q = 0; q < TB; ++q) if (jg + q < J) { const int tl = wave + 8 * (jg + q), row = row0 + tl;
                int acc[16];
#pragma unroll
                for (int c = 0; c < 16; ++c) acc[c] = 0;
#pragma unroll
                for (int gq = 0; gq < NG; ++gq) { const int wq = *(const int*)(wqb + tl * 128 + (gq * RR + rr) * 4);
#pragma unroll
                    for (int d4 = 0; d4 < 4; ++d4) { const unsigned a = vb[q][4 * gq][d4], b = vb[q][4 * gq + 1][d4], c = vb[q][4 * gq + 2][d4], d = vb[q][4 * gq + 3][d4];
                        const unsigned x0 = __builtin_amdgcn_perm(b, a, 0x05010400u), x1 = __builtin_amdgcn_perm(b, a, 0x07030602u), y0 = __builtin_amdgcn_perm(d, c, 0x05010400u), y1 = __builtin_amdgcn_perm(d, c, 0x07030602u);
                        acc[4 * d4 + 0] = __builtin_amdgcn_sdot4((int)__builtin_amdgcn_perm(y0, x0, 0x05040100u), wq, acc[4 * d4 + 0], false);
                        acc[4 * d4 + 1] = __builtin_amdgcn_sdot4((int)__builtin_amdgcn_perm(y0, x0, 0x07060302u), wq, acc[4 * d4 + 1], false);
                        acc[4 * d4 + 2] = __builtin_amdgcn_sdot4((int)__builtin_amdgcn_perm(y1, x1, 0x05040100u), wq, acc[4 * d4 + 2], false);
                        acc[4 * d4 + 3] = __builtin_amdgcn_sdot4((int)__builtin_amdgcn_perm(y1, x1, 0x07060302u), wq, acc[4 * d4 + 3], false); } }
                reduce16r<LPS>(acc, lane);
                const float sc = sws[tl] * WSC;
                const int mi = row < M_LAT ? row / S : 4;
                bf16* xrow = row < M_LAT ? xlat + (size_t)row * D : xctx + (size_t)(row - M_LAT) * D;
                const float* g2 = modl + (size_t)mi * 6 * D + off_g;
                if (LPS == 4) { const int col = s * 64 + cc * 16 + rr; const bf16 vb = f2bf(bf2f(xrow[col]) + g2[col] * ((float)acc[0] * sc)); xrow[col] = vb; const float v0 = bf2f(vb); if (repB == NREPB - 1) ssl[tl * 64 + lane] += v0 * v0; }
                else { const int col = s * 128 + cc * 16 + 2 * rr; const unsigned xb = *(const unsigned*)(xrow + col); const float2 gg = *(const float2*)(g2 + col);
                    const unsigned ob = pg8::cvt_pk_bf16(__uint_as_float(xb << 16) + gg.x * ((float)acc[0] * sc), __uint_as_float(xb & 0xffff0000u) + gg.y * ((float)acc[1] * sc));
                    *(unsigned*)(xrow + col) = ob; const float v0 = __uint_as_float(ob << 16), v1 = __uint_as_float(ob & 0xffff0000u);
                    if (repB == NREPB - 1) ssl[tl * 64 + lane] += v0 * v0 + v1 * v1; }
            }
        }
        __syncthreads();
    }
    asm volatile("s_waitcnt vmcnt(0)" ::: "memory");
    __builtin_amdgcn_fence(__ATOMIC_ACQUIRE, "agent");
    asm volatile("s_waitcnt vmcnt(0)" ::: "memory");
#pragma unroll 1
    for (int j0 = 0; j0 < J; j0 += 2) {
        f32x4 v[2][4];
#pragma unroll
        for (int t = 0; t < 2; ++t) if (j0 + t < J) { const int row = row0 + wave + 8 * (j0 + t); const bf16* xrow = row < M_LAT ? xlat + (size_t)row * D : xctx + (size_t)(row - M_LAT) * D;
#pragma unroll
            for (int q = 0; q < 4; ++q) v[t][q] = ld4res<true>(xrow, (size_t)(lane + 64 * q) * 4); }
#pragma unroll
        for (int t = 0; t < 2; ++t) if (j0 + t < J) { const int tl = wave + 8 * (j0 + t), row = row0 + tl; const int mi = row < M_LAT ? row / S : 4;
            float* xrow = outf + (size_t)row * D;
            const float rs = rsqrtf(wave_sum(ssl[tl * 64 + lane]) * (1.f / D) + EPS);
            float am = 0.f;
#pragma unroll
            for (int q = 0; q < 4; ++q) { const int k = (lane + 64 * q) * 4; const f32x4 w = *(const f32x4*)(nw + k);
                if (MODE == 2) { f32x4 o; o.x = v[t][q].x * rs * w.x; o.y = v[t][q].y * rs * w.y; o.z = v[t][q].z * rs * w.z; o.w = v[t][q].w * rs * w.w; ((f32x4*)xrow)[lane + 64 * q] = o; }
                else { const f32x4 b = *(const f32x4*)(modn + (size_t)mi * 6 * D + k), a = *(const f32x4*)(modn + (size_t)mi * 6 * D + D + k);
                    v[t][q].x = v[t][q].x * rs * w.x * (1.f + a.x) + b.x; v[t][q].y = v[t][q].y * rs * w.y * (1.f + a.y) + b.y; v[t][q].z = v[t][q].z * rs * w.z * (1.f + a.z) + b.z; v[t][q].w = v[t][q].w * rs * w.w * (1.f + a.w) + b.w;
                    am = fmaxf(am, fmaxf(fmaxf(fabsf(v[t][q].x), fabsf(v[t][q].y)), fmaxf(fabsf(v[t][q].z), fabsf(v[t][q].w)))); } }
            if (MODE == 1) {
                am = wave_max(am); const float sx = am > 0.f ? am * (1.f / 127.f) : 1.f, inv = 1.f / sx;
#pragma unroll
                for (int q = 0; q < 4; ++q) { const int q0 = (int)rintf(v[t][q].x * inv), q1 = (int)rintf(v[t][q].y * inv), q2 = (int)rintf(v[t][q].z * inv), q3 = (int)rintf(v[t][q].w * inv);
                    *(unsigned*)(xqo + (size_t)row * D + (lane + 64 * q) * 4) = (unsigned)(q0 & 0xff) | ((unsigned)(q1 & 0xff) << 8) | ((unsigned)(q2 & 0xff) << 16) | ((unsigned)(q3 & 0xff) << 24); }
                if (lane == 0) xso[row] = sx; }
        }
    }
}
__device__ __forceinline__ void ph_final_norm(float* x, const float* fw, int nrows) { const int tidx = otid();
    const int lane = tidx & 63, wave = tidx >> 6;
    for (int row0 = (blockIdx.x * 8 + wave) * 2; row0 < nrows; row0 += gridDim.x * 16) {
        f32x4 v[2][4];
#pragma unroll
        for (int r = 0; r < 2; ++r)
#pragma unroll
            for (int j = 0; j < 4; ++j) v[r][j] = ((const f32x4*)(x + (size_t)(row0 + r) * D))[lane + 64 * j];
#pragma unroll
        for (int r = 0; r < 2; ++r) { float ss = 0.f;
#pragma unroll
            for (int j = 0; j < 4; ++j) ss += v[r][j].x * v[r][j].x + v[r][j].y * v[r][j].y + v[r][j].z * v[r][j].z + v[r][j].w * v[r][j].w;
            ss = wave_sum(ss); const float rs = rsqrtf(ss * (1.f / D) + EPS);
#pragma unroll
            for (int j = 0; j < 4; ++j) { const f32x4 w = *(const f32x4*)(fw + (lane + 64 * j) * 4); f32x4 o = v[r][j] * rs; o.x *= w.x; o.y *= w.y; o.z *= w.z; o.w *= w.w; ((f32x4*)(x + (size_t)(row0 + r) * D))[lane + 64 * j] = o; } }
    }
}
#define DEFINE_PTRS \
    const float* x = p.in[0]; const float* c = p.in[1]; const float* ctx = p.in[2]; const float* c_ctx = p.in[3]; \
    const float* norm1_w = p.in[4]; const float* norm2_w = p.in[5]; const float* w_ada = p.in[6]; const float* b_ada = p.in[7]; \
    const float* w_in = p.in[8]; const float* w_out = p.in[9]; const float* na_rpb = p.in[10]; \
    const float* dec_f = p.in[11]; const float* dec_b = p.in[12]; const float* gn_w = p.in[13]; \
    const float* pool_w = p.in[14]; const float* pool_scale = p.in[15]; const float* peer_wq = p.in[16]; \
    const float* peer_keys = p.in[17]; const float* peer_u = p.in[18]; const float* peer_v = p.in[19]; const float* final_w = p.in[20]; \
    unsigned char* ws = p.ws; float* out = p.out; \
    float* MOD = (float*)(ws + WS_MOD); float* cosT = (float*)(ws + WS_ROPE); float* sinT = cosT + S * 32; \
    bf16* WI = (bf16*)(ws + WS_WI); bf16* WO = (bf16*)(ws + WS_WO); bf16* WQ = (bf16*)(ws + WS_WQ); bf16* KEYS = (bf16*)(ws + WS_KEYS); \
    bf16* XR = (bf16*)(ws + WS_XR); bf16* XRC = (bf16*)(ws + WS_XRC); bf16* U = (bf16*)(ws + WS_U); bf16* V = (bf16*)(ws + WS_V); bf16* ACT = (bf16*)(ws + WS_ACT); \
    bf16* PX = (bf16*)(ws + WS_PX); bf16* Q = PX; float* ST = (float*)(ws + WS_ST); bf16* STB = (bf16*)(ws + WS_ST); int* IDX = (int*)(ws + WS_IDX); float* GATE = (float*)(ws + WS_GATE); \
    float* TOPV = (float*)(ws + WS_TOPV); int* TOPI = (int*)(ws + WS_TOPI); \
    float* AW = (float*)(ws + WS_AW); (void)AW; \
    unsigned char* WI8 = ws + WS_WI8; unsigned char* WQ8 = ws + WS_WQ8; float* SWI = (float*)(ws + WS_SWI); float* SWQ = (float*)(ws + WS_SWQ); (void)WI8; (void)WQ8; (void)SWI; (void)SWQ; \
    unsigned char* XQ = ws + WS_XQ; float* XS = (float*)(ws + WS_XS); (void)XQ; (void)XS; \
    unsigned char* U8 = ws + WS_U; unsigned char* V8 = ws + WS_V; float* SU = (float*)(ws + WS_SU); float* SV = (float*)(ws + WS_SV); (void)U8; (void)V8; (void)SU; (void)SV; \
    (void)x; (void)c; (void)ctx; (void)c_ctx; (void)norm1_w; (void)norm2_w; (void)w_ada; (void)b_ada; (void)w_in; (void)w_out; (void)na_rpb; (void)dec_f; (void)dec_b; (void)gn_w; \
    (void)pool_w; (void)pool_scale; (void)peer_wq; (void)peer_keys; (void)peer_u; (void)peer_v; (void)final_w; (void)out; (void)MOD; (void)cosT; (void)sinT; (void)WI; (void)WO; (void)WQ; \
    (void)KEYS; (void)XR; (void)XRC; (void)U; (void)V; (void)ACT; (void)PX; (void)Q; (void)ST; (void)IDX; (void)GATE; (void)TOPV; (void)TOPI;
#define GRID_SYNC() xcd_barrier(bar)

template <int l>
__device__ __forceinline__ void layer(const Params& p, unsigned char* lds, const XcdBarrier& bar) {
    DEFINE_PTRS
    constexpr bool last = (l == DEPTH - 1);
    const float* modl = MOD + (size_t)l * 5 * 6 * D;
    constexpr int mrows = last ? M_LAT : M_ALL;
    if (l == 0) { ph_quant_w(WI, WI8, SWI, DEPTH * DPROJ_PAD); ph_quant_w(WQ, WQ8, SWQ, DEPTH * DQ); }
    if (l == 0) { DUP(1) ph_norm<true, false>(x, ctx, norm1_w + l * D, modl, 0, D, nullptr, XQ, XS, M_ALL);
    GRID_SYNC(); }
    else if (gridDim.x != 256) { ph_norm<true, true>(XR, XRC, norm1_w + l * D, modl, 0, D, nullptr, XQ, XS, M_ALL);
    GRID_SYNC(); }
#if USE_PG8
    DUP(2) { pg8::Gemm g{(const pg8::bf16_t*)XQ, (const pg8::bf16_t*)(WI8 + (size_t)l * DPROJ_PAD * D), M_ALL, DPROJ_PAD, D / 2}; pg8::StaticOrder So; So.init(M_ALL, DPROJ_PAD, (int)gridDim.x, (int)blockIdx.x);
      EpiI8Bf16Out E{PX, DPROJ, DPROJ, XS, SWI + l * DPROJ_PAD}; pg8::gemm_phase_i8<EpiI8Bf16Out, pg8::StaticOrder>((PG8_LAS unsigned char*)lds, g, So, E, nullptr); }
#else
    ph_gemm_simple<0>(ACT, WI + (size_t)l * DPROJ_PAD * D, M_ALL, DPROJ_PAD, D, PX, DPROJ, DPROJ, nullptr, nullptr, nullptr, nullptr, nullptr, 0, (bf16*)lds);
#endif
    GRID_SYNC();
#if NA_NAIVE
    ph_na(PX, na_rpb + (size_t)l * NAH * 15 * 31, ACT, mrows);
#else
    DUP(4) { ph_na_mfma(PX, na_rpb + (size_t)l * NAH * 15 * 31, ACT, last ? 1536 : 1584, lds);
    __syncthreads(); }
#endif
    DUP(5) ph_pool(PX, ACT, mrows);
#if RET_NAIVE
    ph_ret_state(PX, cosT, sinT, dec_f + l * RH, dec_b + l * RH, ST, (float*)lds);
#else
    DUP(6) ph_ret_state_mfma(PX, cosT, sinT, dec_f + l * RH, dec_b + l * RH, STB, lds);
#endif
    GRID_SYNC();
#if RET_NAIVE
    ph_ret_scan(dec_f + l * RH, dec_b + l * RH, ST);
#else
    ph_ret_scan_bf(dec_f + l * RH, dec_b + l * RH, STB);
#endif
    GRID_SYNC();
#if RET_NAIVE
    ph_ret_out(PX, cosT, sinT, dec_f + l * RH, dec_b + l * RH, ST, gn_w + l * RW, ACT, last ? 64 : NCH, (float*)lds);
#else
    DUP(7) ph_ret_out_mfma(PX, cosT, sinT, dec_f + l * RH, dec_b + l * RH, STB, gn_w + l * RW, ACT, last ? 64 : NCH, lds);
#endif
    GRID_SYNC();
#if USE_PG8
    DUP(l == 0 ? 11 : 31) { pg8::Gemm g{ACT, WO + (size_t)l * D * D, mrows, D, D}; pg8::StaticOrder So; So.init(mrows, D, (int)gridDim.x, (int)blockIdx.x);
      if (l == 0) { EpiRes<false> E{x, ctx, XR, XRC, modl, 2 * D}; pg8::gemm_phase<EpiRes<false>, pg8::StaticOrder>((PG8_LAS unsigned char*)lds, g, So, E, nullptr); }
      else { EpiRes<true> E{XR, XRC, XR, XRC, modl, 2 * D}; pg8::gemm_phase<EpiRes<true>, pg8::StaticOrder>((PG8_LAS unsigned char*)lds, g, So, E, nullptr); } }
#else
    ph_gemm_simple<1>(ACT, WO + (size_t)l * D * D, mrows, D, D, nullptr, 0, 0, xl, xc, out, XCTX, modl, 2 * D, (bf16*)lds);
#endif
    GRID_SYNC();
    DUP(1) ph_norm<true, true>(XR, XRC, norm2_w + l * D, modl, 3 * D, 4 * D, gridDim.x != 256 ? ACT : nullptr, XQ, XS, mrows);
    GRID_SYNC();
#if USE_PG8
    DUP(3) { pg8::Gemm g{(const pg8::bf16_t*)XQ, (const pg8::bf16_t*)(WQ8 + (size_t)l * DQ * D), mrows, DQ, D / 2}; pg8::StaticOrder So; So.init(mrows, DQ, (int)gridDim.x, (int)blockIdx.x);
#if TK32
      EpiI8QT E{Q, XS, SWQ + l * DQ}; pg8::gemm_phase_i8<EpiI8QT, pg8::StaticOrder>((PG8_LAS unsigned char*)lds, g, So, E, nullptr); }
#else
      EpiI8Bf16Out E{Q, DQ, DQ, XS, SWQ + l * DQ}; pg8::gemm_phase_i8<EpiI8Bf16Out, pg8::StaticOrder>((PG8_LAS unsigned char*)lds, g, So, E, nullptr); }
#endif
#else
    ph_gemm_simple<0>(ACT, WQ + (size_t)l * DQ * D, mrows, DQ, D, Q, DQ, DQ, nullptr, nullptr, nullptr, nullptr, nullptr, 0, (bf16*)lds);
#endif
    GRID_SYNC();
#if 1
#if TK32
    DUP(8) ph_tk32(Q, KEYS + (size_t)l * 2 * PH * PNK * PKD, IDX, GATE, mrows, lds);
#else
    DUP(8) ph_tk_mfma(Q, KEYS + (size_t)l * 2 * PH * PNK * PKD, IDX, GATE, mrows, lds);
#endif
#endif
    GRID_SYNC();
#if PEER_BF16
    ph_peer<last>(ACT, IDX, GATE, U + (size_t)l * NEXP * D, V + (size_t)l * NEXP * D, modl, 5 * D, out, XCTX, final_w, mrows);
#else
    if (gridDim.x == 256) {
        ph_peer_sweep<last ? 2 : 1>(IDX, GATE, U8 + (size_t)l * NEXP * D, V8 + (size_t)l * NEXP * D, SU + l * NEXP, SV + l * NEXP, XQ, XS, AW, modl, 5 * D, XR, XRC, out,
                                    last ? final_w : norm1_w + (l + 1) * D, MOD + (size_t)(l + 1 < DEPTH ? l + 1 : l) * 5 * 6 * D, XQ, XS, mrows, lds);
        if (!last) GRID_SYNC();
    } else {
        ph_peer8<last ? 2 : 0>(ACT, IDX, GATE, U8 + (size_t)l * NEXP * D, V8 + (size_t)l * NEXP * D, SU + l * NEXP, SV + l * NEXP, modl, 5 * D, XR, XRC, out, final_w, nullptr, mrows);
        if (!last) GRID_SYNC();
    }
    return;
#endif
    if (!last) GRID_SYNC();
}

__global__ void __launch_bounds__(NT, 2) mega(Params p) {
    extern __shared__ __attribute__((aligned(16))) unsigned char lds[];
    volatile LAS unsigned* bst = (volatile LAS unsigned*)((LAS unsigned char*)lds + LDS_BYTES - 64);
    if (threadIdx.x < 16) bst[threadIdx.x] = 0u;
    __syncthreads();
    const XcdBarrier bar = xcd_barrier_post((unsigned*)(p.ws + WS_CTL), bst);
    DUP(0) {
        DEFINE_PTRS
        DUP(20) { ph_mods(c, c_ctx, w_ada, b_ada, MOD, (float*)lds);
        __syncthreads();
#if RET_NAIVE
        ph_rope(cosT, sinT);
#endif
        }
        DUP(21)
        { ph_transpose_all(w_in, peer_wq, w_out, WI, WQ, WO, (float*)lds);
          ph_wo_pool(w_out, pool_w, pool_scale, WO, (float*)lds); }
        ph_cvt(peer_keys, KEYS, (size_t)DEPTH * 2 * PH * PNK * PKD / 4);
#if PEER_BF16
        ph_cvt(peer_u, U, (size_t)DEPTH * NEXP * D / 4);
        ph_cvt(peer_v, V, (size_t)DEPTH * NEXP * D / 4);
#else
        DUP(22) { ph_quant(peer_u, U8, SU, DEPTH * NEXP, 0);
        ph_quant(peer_v, V8, SV, DEPTH * NEXP, 0); }
#endif
    }
    GRID_SYNC();
    layer<0>(p, lds, bar);
    layer<1>(p, lds, bar);
}
}

extern "C" void kernel_launch(void* const* d_in, const int* in_sizes, int n_in, void* d_out, int out_size, void* d_ws, size_t ws_size, hipStream_t stream) {
    static int grid = 0;
    if (grid == 0) {
        if (n_in != 21 || out_size != M_LAT * D || ws_size < WS_END) { fprintf(stderr, "kernel_launch: unexpected sizes n_in %d out %d ws %zu (need %zu)\n", n_in, out_size, ws_size, (size_t)WS_END); grid = -1; return; }
        int dev = 0, cus = 0, per_cu = 0;
        if (hipGetDevice(&dev) != hipSuccess || hipDeviceGetAttribute(&cus, hipDeviceAttributeMultiprocessorCount, dev) != hipSuccess) { fprintf(stderr, "kernel_launch: device query failed\n"); grid = -1; return; }
        if (hipFuncSetAttribute((const void*)mega, hipFuncAttributeMaxDynamicSharedMemorySize, LDS_BYTES) != hipSuccess) { fprintf(stderr, "kernel_launch: hipFuncSetAttribute failed\n"); grid = -1; return; }
        if (hipOccupancyMaxActiveBlocksPerMultiprocessor(&per_cu, (const void*)mega, NT, LDS_BYTES) != hipSuccess || per_cu < 1) { fprintf(stderr, "kernel_launch: occupancy query says %d\n", per_cu); grid = -1; (void)hipGetLastError(); return; }
        grid = cus;
    }
    if (grid < 0) return;
    Params p{};
    for (int i = 0; i < 21; ++i) p.in[i] = (const float*)d_in[i];
    p.out = (float*)d_out; p.ws = (unsigned char*)d_ws;
    if (hipMemsetAsync((char*)d_ws + WS_CTL, 0, 65536, stream) != hipSuccess) { fprintf(stderr, "kernel_launch: memset failed\n"); return; }
    hipLaunchKernelGGL(mega, dim3(grid), dim3(NT), LDS_BYTES, stream, p);
    hipError_t e = hipPeekAtLastError();
    if (e != hipSuccess) fprintf(stderr, "kernel_launch: launch failed: %s (grid %d)\n", hipGetErrorString(e), grid);
}
```

```cpp
#include <hip/hip_runtime.h>
#include <cstdio>
#include <cstdint>

#ifndef DUP_MASK
#define DUP_MASK 0
#endif
#ifndef USE_PG8
#define USE_PG8 1
#endif
#ifndef NA_NAIVE
#define NA_NAIVE 0
#endif
#ifndef TK_NAIVE
#define TK_NAIVE 0
#endif
#ifndef RET_NAIVE
#define RET_NAIVE 0
#endif
#ifndef TK32
#define TK32 1
#endif
#ifndef PEER_BF16
#define PEER_BF16 0
#endif
#define DUP(bit) for (int _r = 0; _r < ((((unsigned)DUP_MASK >> (bit)) & 1u) ? 2 : 1); ++_r)

__device__ __forceinline__ int otid() { int t = threadIdx.x; asm volatile("" : "+v"(t)); return t; }

namespace pg8 {

#define PG8_LAS __attribute__((address_space(3)))
typedef unsigned short bf16_t;
typedef short bf16x8 __attribute__((ext_vector_type(8)));
typedef float f32x4 __attribute__((ext_vector_type(4)));
typedef unsigned u32x4 __attribute__((ext_vector_type(4)));
constexpr int BM = 256, BK = 64, HALF = 128, HTB = HALF * BK * 2  , STAGE_BYTES = 8 * HTB, NXCD = 8, WGM = 8;

__host__ __device__ __forceinline__ int lds_byte(int r, int c) { const int st = (r >> 4) * 2 + (c >> 5), rr = r & 15, cc = c & 31, ob = rr * 64 + cc * 2; return st * 1024 + (ob ^ (((ob >> 9) & 1) << 5)); }
__host__ __device__ __forceinline__ void stage_rc(int b, int& R, int& C) { const int st = b / 1024, sb = b % 1024, swz = sb ^ (((sb >> 9) & 1) << 5); R = (st >> 1) * 16 + swz / 64; C = (st & 1) * 32 + (swz % 64) / 2; }
__host__ __device__ __forceinline__ int perm32(int rho) { const int n = rho >> 4, i = rho & 15; return 8 * (i >> 2) + 4 * n + (i & 3); }

struct Unit { int pm, pn; };
struct Gemm { const bf16_t* A; const bf16_t* Bt; int M, N, K; };

struct StaticOrder {
    int nM, nN, nwg, G, c;
    __host__ __device__ __forceinline__ void init(int M, int N, int G_, int c_) { nM = M / BM; nN = N / BM; nwg = nM * nN; G = G_; c = c_; }
    __host__ __device__ __forceinline__ bool next(int i, Unit& u) const {
        const long L = (long)i * G + c; if (L >= nwg) return false;
        int wgid = (int)L; { const int q = nwg / NXCD, r = nwg % NXCD, xcd = wgid % NXCD, off = wgid / NXCD; wgid = (xcd < r ? xcd * (q + 1) : r * (q + 1) + (xcd - r) * q) + off; }
        const int nig = WGM * nN, gid = wgid / nig, fm = gid * WGM, gsz = (nM - fm) < WGM ? (nM - fm) : WGM;
        u.pm = fm + ((wgid % nig) % gsz); u.pn = (wgid % nig) / gsz; return true;
    }
    __device__ __forceinline__ void a_ready(const Unit&) const {}
    __device__ __forceinline__ void done(const Unit&) const {}
};
struct OneUnit { Unit u; __device__ __forceinline__ bool next(int i, Unit& o) const { if (i != 0) return false; o = u; return true; }
    __device__ __forceinline__ void a_ready(const Unit&) const {} __device__ __forceinline__ void done(const Unit&) const {} };

typedef unsigned u32x2 __attribute__((ext_vector_type(2)));
__device__ __forceinline__ unsigned cvt_pk_bf16(float lo, float hi) { unsigned r; asm volatile("v_cvt_pk_bf16_f32 %0, %1, %2" : "=v"(r) : "v"(lo), "v"(hi)); return r; }
template <class Epi, class Sched, bool STAMP = false>
__device__ __forceinline__ void gemm_phase(PG8_LAS unsigned char* lds, const Gemm g, const Sched& S, const Epi& E, unsigned long long* stamps) {
    const int tid = otid(), wid = __builtin_amdgcn_readfirstlane(tid >> 6), lane = tid & 63, wr = wid >> 2, wc = wid & 3, fr = lane & 15, fq = lane >> 4;
    const int K = g.K, nt = K / BK;
    int ts_lo = 0, ts_hi = 0, nts = 0; const unsigned long long rt_entry = STAMP ? (unsigned long long)wall_clock64() : 0ull;
#define PG8_STAMP() do { if (STAMP && wid == 0 && nts < 64) { const unsigned long long _c = (unsigned long long)clock64(); \
        ts_lo = (lane == nts) ? (int)(unsigned)_c : ts_lo; ts_hi = (lane == nts) ? (int)(unsigned)(_c >> 32) : ts_hi; ++nts; } } while (0)
    PG8_STAMP();
    unsigned voffA[2], voffB[2];
#pragma unroll
    for (int i = 0; i < 2; ++i) { int R, C; stage_rc(tid * 16 + i * 8192, R, C); const int Rb = Epi::PERM ? ((R & ~31) + perm32(R & 31)) : R;
        voffA[i] = (unsigned)(R * K + C) * 2u; voffB[i] = (unsigned)(Rb * K + C) * 2u; }
    const size_t kstep = (size_t)(BK * 2);
    const size_t hstep = (size_t)HALF * K * 2;
    const size_t tstep = 2 * hstep;
    const unsigned ldsw = (unsigned)wid * 1024u;
    const int aoff = lds_byte(wr * 64 + fr, fq * 8), boff = lds_byte(wc * 32 + fr, fq * 8);
#define PG8_SA(b, h) (((b) * 2 + (h)) * HTB)
#define PG8_SB(b, h) ((4 + (b) * 2 + (h)) * HTB)
#define PG8_STAGE(bufoff, gbase, voff) do { _Pragma("unroll") for (int _i = 0; _i < 2; ++_i) \
        __builtin_amdgcn_global_load_lds((const unsigned*)((const char*)(gbase) + (voff)[_i]), (PG8_LAS unsigned*)(lds + (bufoff) + ldsw + _i * 8192), 16, 0, 0); } while (0)
#define PG8_LDA(dst, b, h) do { _Pragma("unroll") for (int m = 0; m < 4; ++m) _Pragma("unroll") for (int k = 0; k < 2; ++k) dst[m][k] = *(const PG8_LAS bf16x8*)(lds + PG8_SA(b, h) + aoff + m * 2048 + k * 1024); } while (0)
#define PG8_LDB(dst, b, h) do { _Pragma("unroll") for (int n = 0; n < 2; ++n) _Pragma("unroll") for (int k = 0; k < 2; ++k) dst[n][k] = *(const PG8_LAS bf16x8*)(lds + PG8_SB(b, h) + boff + n * 2048 + k * 1024); } while (0)
#define PG8_MMA(ai, bj, At, Bt) do { __builtin_amdgcn_s_setprio(1); _Pragma("unroll") for (int m = 0; m < 4; ++m) _Pragma("unroll") for (int n = 0; n < 2; ++n) _Pragma("unroll") for (int k = 0; k < 2; ++k) \
        acc[ai][bj][m][n] = __builtin_amdgcn_mfma_f32_16x16x32_bf16(Bt[n][k], At[m][k], acc[ai][bj][m][n], 0, 0, 0); __builtin_amdgcn_s_setprio(0); } while (0)
#define PG8_WAIT_V(n) asm volatile("s_waitcnt vmcnt(" #n ")" ::: "memory")
#define PG8_WAIT_L(n) asm volatile("s_waitcnt lgkmcnt(" #n ")" ::: "memory")
#define PG8_BAR __builtin_amdgcn_s_barrier()
#define PG8_SCHED __builtin_amdgcn_sched_barrier(0)
    Unit cur, nxt; int ui = 0;
    if (!S.next(0, cur)) return;
    f32x4 acc[2][2][4][2];
#pragma unroll
    for (int a = 0; a < 2; ++a)
#pragma unroll
        for (int b = 0; b < 2; ++b)
#pragma unroll
            for (int m = 0; m < 4; ++m)
#pragma unroll
                for (int n = 0; n < 2; ++n) acc[a][b][m][n] = (f32x4){0.f, 0.f, 0.f, 0.f};
    bf16x8 At[4][2], B0[2][2], B1[2][2];
    const char* cA = (const char*)g.A + (size_t)cur.pm * tstep; const char* cB = (const char*)g.Bt + (size_t)cur.pn * tstep;
    S.a_ready(cur);
    PG8_STAGE(PG8_SB(0, 0), cB, voffB); PG8_STAGE(PG8_SA(0, 0), cA, voffA); PG8_STAGE(PG8_SB(0, 1), cB + hstep, voffB); PG8_STAGE(PG8_SA(0, 1), cA + hstep, voffA);
    if (wr == 1) PG8_BAR;
    PG8_WAIT_V(4); PG8_BAR;
    PG8_STAGE(PG8_SB(1, 0), cB + kstep, voffB); PG8_STAGE(PG8_SA(1, 0), cA + kstep, voffA); PG8_STAGE(PG8_SB(1, 1), cB + hstep + kstep, voffB);
    PG8_WAIT_V(6); PG8_BAR;
    PG8_STAMP();
    for (;;) {
        const bool has_next = S.next(ui + 1, nxt);
        const char* nA = has_next ? (const char*)g.A + (size_t)nxt.pm * tstep : cA; const char* nB = has_next ? (const char*)g.Bt + (size_t)nxt.pn * tstep : cB;
        for (int t = 0; t < nt; t += 2) {
            const bool last = (t == nt - 2);
            const char* a1 = cA + (size_t)(t + 1) * kstep;
            const char* a2 = last ? nA : cA + (size_t)(t + 2) * kstep; const char* b2 = last ? nB : cB + (size_t)(t + 2) * kstep;
            const char* a3 = a2 + kstep; const char* b3 = b2 + kstep;
            if (last && has_next) S.a_ready(nxt);
            PG8_LDB(B0, 0, 0); PG8_SCHED; PG8_LDA(At, 0, 0); PG8_STAGE(PG8_SA(1, 1), a1 + hstep, voffA);
            PG8_WAIT_L(8); PG8_BAR; PG8_WAIT_L(0); PG8_MMA(0, 0, At, B0); PG8_BAR; PG8_SCHED;
            PG8_LDB(B1, 0, 1); PG8_STAGE(PG8_SB(0, 0), b2, voffB);
            PG8_BAR; PG8_WAIT_L(0); PG8_MMA(0, 1, At, B1); PG8_BAR;
            PG8_LDA(At, 0, 1); PG8_STAGE(PG8_SA(0, 0), a2, voffA);
            PG8_BAR; PG8_WAIT_L(0); PG8_MMA(1, 0, At, B0); PG8_BAR; PG8_SCHED;
            PG8_STAGE(PG8_SB(0, 1), b2 + hstep, voffB);
            PG8_WAIT_V(6); PG8_BAR; PG8_MMA(1, 1, At, B1); PG8_BAR;
            PG8_LDB(B0, 1, 0); PG8_SCHED; PG8_LDA(At, 1, 0); PG8_STAGE(PG8_SA(0, 1), a2 + hstep, voffA);
            PG8_WAIT_L(8); PG8_BAR; PG8_WAIT_L(0); PG8_MMA(0, 0, At, B0); PG8_BAR; PG8_SCHED;
            PG8_LDB(B1, 1, 1); PG8_STAGE(PG8_SB(1, 0), b3, voffB);
            PG8_BAR; PG8_WAIT_L(0); PG8_MMA(0, 1, At, B1); PG8_BAR;
            PG8_LDA(At, 1, 1); PG8_STAGE(PG8_SA(1, 0), a3, voffA);
            PG8_BAR; PG8_WAIT_L(0); PG8_MMA(1, 0, At, B0); PG8_BAR; PG8_SCHED;
            PG8_STAGE(PG8_SB(1, 1), b3 + hstep, voffB);
            PG8_WAIT_V(6); PG8_BAR; PG8_MMA(1, 1, At, B1); PG8_BAR;
        }
        PG8_STAMP();
        if constexpr (!Epi::AFTER_DRAIN) { E(acc, cur, wr, wc, fr, fq); S.done(cur); }
        PG8_STAMP();
        if (!has_next) break;
#pragma unroll
        for (int a = 0; a < 2; ++a)
#pragma unroll
            for (int b = 0; b < 2; ++b)
#pragma unroll
                for (int m = 0; m < 4; ++m)
#pragma unroll
                    for (int n = 0; n < 2; ++n) acc[a][b][m][n] = (f32x4){0.f, 0.f, 0.f, 0.f};
        cur = nxt; cA = nA; cB = nB; ++ui;
    }
    PG8_WAIT_V(0);
    if (wr == 0) PG8_BAR;
    PG8_BAR;
    if constexpr (Epi::AFTER_DRAIN) { E.fused(acc, cur, wr, wc, fr, fq, lds, wid, lane); S.done(cur); }
    PG8_STAMP();
    if (STAMP && wid == 0) { stamps[lane] = lane < nts ? (((unsigned long long)(unsigned)ts_hi << 32) | (unsigned)ts_lo) : 0ull;
        if (lane == 62) stamps[62] = rt_entry; if (lane == 63) stamps[63] = (unsigned long long)wall_clock64(); }
#undef PG8_STAMP
#undef PG8_SA
#undef PG8_SB
#undef PG8_STAGE
#undef PG8_LDA
#undef PG8_LDB
#undef PG8_MMA
#undef PG8_WAIT_V
#undef PG8_WAIT_L
#undef PG8_BAR
#undef PG8_SCHED
}

typedef int i32x4 __attribute__((ext_vector_type(4)));
template <class Epi, class Sched, bool STAMP = false>
__device__ __forceinline__ void gemm_phase_i8(PG8_LAS unsigned char* lds, const Gemm g, const Sched& S, const Epi& E, unsigned long long* stamps) {
    const int tid = otid(), wid = __builtin_amdgcn_readfirstlane(tid >> 6), lane = tid & 63, wr = wid >> 2, wc = wid & 3, fr = lane & 15, fq = lane >> 4;
    const int K = g.K, nt = K / BK;
    int ts_lo = 0, ts_hi = 0, nts = 0; const unsigned long long rt_entry = STAMP ? (unsigned long long)wall_clock64() : 0ull;
#define PG8_STAMP() do { if (STAMP && wid == 0 && nts < 64) { const unsigned long long _c = (unsigned long long)clock64(); \
        ts_lo = (lane == nts) ? (int)(unsigned)_c : ts_lo; ts_hi = (lane == nts) ? (int)(unsigned)(_c >> 32) : ts_hi; ++nts; } } while (0)
    PG8_STAMP();
    unsigned voffA[2], voffB[2];
#pragma unroll
    for (int i = 0; i < 2; ++i) { int R, C; stage_rc(tid * 16 + i * 8192, R, C); const int Rb = Epi::PERM ? ((R & ~31) + perm32(R & 31)) : R;
        voffA[i] = (unsigned)(R * K + C) * 2u; voffB[i] = (unsigned)(Rb * K + C) * 2u; }
    const size_t kstep = (size_t)(BK * 2);
    const size_t hstep = (size_t)HALF * K * 2;
    const size_t tstep = 2 * hstep;
    const unsigned ldsw = (unsigned)wid * 1024u;
    const int aoff = lds_byte(wr * 64 + fr, fq * 8), boff = lds_byte(wc * 32 + fr, fq * 8);
#define PG8_SA(b, h) (((b) * 2 + (h)) * HTB)
#define PG8_SB(b, h) ((4 + (b) * 2 + (h)) * HTB)
#define PG8_STAGE(bufoff, gbase, voff) do { _Pragma("unroll") for (int _i = 0; _i < 2; ++_i) \
        __builtin_amdgcn_global_load_lds((const unsigned*)((const char*)(gbase) + (voff)[_i]), (PG8_LAS unsigned*)(lds + (bufoff) + ldsw + _i * 8192), 16, 0, 0); } while (0)
#define PG8_LDA(dst, b, h) do { _Pragma("unroll") for (int m = 0; m < 4; ++m) _Pragma("unroll") for (int k = 0; k < 2; ++k) dst[m][k] = *(const PG8_LAS i32x4*)(lds + PG8_SA(b, h) + aoff + m * 2048 + k * 1024); } while (0)
#define PG8_LDB(dst, b, h) do { _Pragma("unroll") for (int n = 0; n < 2; ++n) _Pragma("unroll") for (int k = 0; k < 2; ++k) dst[n][k] = *(const PG8_LAS i32x4*)(lds + PG8_SB(b, h) + boff + n * 2048 + k * 1024); } while (0)
#define PG8_MMA(ai, bj, At, Bt) do { __builtin_amdgcn_s_setprio(1); _Pragma("unroll") for (int m = 0; m < 4; ++m) _Pragma("unroll") for (int n = 0; n < 2; ++n) _Pragma("unroll") for (int k = 0; k < 2; ++k) \
        acc[ai][bj][m][n] = __builtin_amdgcn_mfma_i32_16x16x64_i8(Bt[n][k], At[m][k], acc[ai][bj][m][n], 0, 0, 0); __builtin_amdgcn_s_setprio(0); } while (0)
#define PG8_WAIT_V(n) asm volatile("s_waitcnt vmcnt(" #n ")" ::: "memory")
#define PG8_WAIT_L(n) asm volatile("s_waitcnt lgkmcnt(" #n ")" ::: "memory")
#define PG8_BAR __builtin_amdgcn_s_barrier()
#define PG8_SCHED __builtin_amdgcn_sched_barrier(0)
    Unit cur, nxt; int ui = 0;
    if (!S.next(0, cur)) return;
    i32x4 acc[2][2][4][2];
#pragma unroll
    for (int a = 0; a < 2; ++a)
#pragma unroll
        for (int b = 0; b < 2; ++b)
#pragma unroll
            for (int m = 0; m < 4; ++m)
#pragma unroll
                for (int n = 0; n < 2; ++n) acc[a][b][m][n] = (i32x4){0, 0, 0, 0};
    i32x4 At[4][2], B0[2][2], B1[2][2];
    const char* cA = (const char*)g.A + (size_t)cur.pm * tstep; const char* cB = (const char*)g.Bt + (size_t)cur.pn * tstep;
    S.a_ready(cur);
    PG8_STAGE(PG8_SB(0, 0), cB, voffB); PG8_STAGE(PG8_SA(0, 0), cA, voffA); PG8_STAGE(PG8_SB(0, 1), cB + hstep, voffB); PG8_STAGE(PG8_SA(0, 1), cA + hstep, voffA);
    if (wr == 1) PG8_BAR;
    PG8_WAIT_V(4); PG8_BAR;
    PG8_STAGE(PG8_SB(1, 0), cB + kstep, voffB); PG8_STAGE(PG8_SA(1, 0), cA + kstep, voffA); PG8_STAGE(PG8_SB(1, 1), cB + hstep + kstep, voffB);
    PG8_WAIT_V(6); PG8_BAR;
    PG8_STAMP();
    for (;;) {
        const bool has_next = S.next(ui + 1, nxt);
        const char* nA = has_next ? (const char*)g.A + (size_t)nxt.pm * tstep : cA; const char* nB = has_next ? (const char*)g.Bt + (size_t)nxt.pn * tstep : cB;
        for (int t = 0; t < nt; t += 2) {
            const bool last = (t == nt - 2);
            const char* a1 = cA + (size_t)(t + 1) * kstep;
            const char* a2 = last ? nA : cA + (size_t)(t + 2) * kstep; const char* b2 = last ? nB : cB + (size_t)(t + 2) * kstep;
            const char* a3 = a2 + kstep; const char* b3 = b2 + kstep;
            if (last && has_next) S.a_ready(nxt);
            PG8_LDB(B0, 0, 0); PG8_SCHED; PG8_LDA(At, 0, 0); PG8_STAGE(PG8_SA(1, 1), a1 + hstep, voffA);
            PG8_WAIT_L(8); PG8_BAR; PG8_WAIT_L(0); PG8_MMA(0, 0, At, B0); PG8_BAR; PG8_SCHED;
            PG8_LDB(B1, 0, 1); PG8_STAGE(PG8_SB(0, 0), b2, voffB);
            PG8_BAR; PG8_WAIT_L(0); PG8_MMA(0, 1, At, B1); PG8_BAR;
            PG8_LDA(At, 0, 1); PG8_STAGE(PG8_SA(0, 0), a2, voffA);
            PG8_BAR; PG8_WAIT_L(0); PG8_MMA(1, 0, At, B0); PG8_BAR; PG8_SCHED;
            PG8_STAGE(PG8_SB(0, 1), b2 + hstep, voffB);
            PG8_WAIT_V(6); PG8_BAR; PG8_MMA(1, 1, At, B1); PG8_BAR;
            PG8_LDB(B0, 1, 0); PG8_SCHED; PG8_LDA(At, 1, 0); PG8_STAGE(PG8_SA(0, 1), a2 + hstep, voffA);
            PG8_WAIT_L(8); PG8_BAR; PG8_WAIT_L(0); PG8_MMA(0, 0, At, B0); PG8_BAR; PG8_SCHED;
            PG8_LDB(B1, 1, 1); PG8_STAGE(PG8_SB(1, 0), b3, voffB);
            PG8_BAR; PG8_WAIT_L(0); PG8_MMA(0, 1, At, B1); PG8_BAR;
            PG8_LDA(At, 1, 1); PG8_STAGE(PG8_SA(1, 0), a3, voffA);
            PG8_BAR; PG8_WAIT_L(0); PG8_MMA(1, 0, At, B0); PG8_BAR; PG8_SCHED;
            PG8_STAGE(PG8_SB(1, 1), b3 + hstep, voffB);
            PG8_WAIT_V(6); PG8_BAR; PG8_MMA(1, 1, At, B1); PG8_BAR;
        }
        PG8_STAMP();
        if constexpr (!Epi::AFTER_DRAIN) { for (int _e = 0; _e < ((((unsigned)DUP_MASK >> 14) & 1u) ? 2 : 1); ++_e) E(acc, cur, wr, wc, fr, fq); S.done(cur); }
        PG8_STAMP();
        if (!has_next) break;
#pragma unroll
        for (int a = 0; a < 2; ++a)
#pragma unroll
            for (int b = 0; b < 2; ++b)
#pragma unroll
                for (int m = 0; m < 4; ++m)
#pragma unroll
                    for (int n = 0; n < 2; ++n) acc[a][b][m][n] = (i32x4){0, 0, 0, 0};
        cur = nxt; cA = nA; cB = nB; ++ui;
    }
    PG8_WAIT_V(0);
    if (wr == 0) PG8_BAR;
    PG8_BAR;
    if constexpr (Epi::AFTER_DRAIN) { E.fused(acc, cur, wr, wc, fr, fq, lds, wid, lane); S.done(cur); }
    PG8_STAMP();
    if (STAMP && wid == 0) { stamps[lane] = lane < nts ? (((unsigned long long)(unsigned)ts_hi << 32) | (unsigned)ts_lo) : 0ull;
        if (lane == 62) stamps[62] = rt_entry; if (lane == 63) stamps[63] = (unsigned long long)wall_clock64(); }
#undef PG8_STAMP
#undef PG8_SA
#undef PG8_SB
#undef PG8_STAGE
#undef PG8_LDA
#undef PG8_LDB
#undef PG8_MMA
#undef PG8_WAIT_V
#undef PG8_WAIT_L
#undef PG8_BAR
#undef PG8_SCHED
}
}

#define XB_TMO      128
#define XB_XCNT(j)  (256  + 64 * (j))
#define XB_XSUB(j)  (1280 + 64 * (j))
#define XB_XGEN(j)  (2304 + 64 * (j))
#define XB_TOP      3328
#define XB_TOPGEN   3392
#define XCD_BAR_WORDS 3456
#define XB_SPIN_CAP (1u << 18)
#define LAS __attribute__((address_space(3)))

__device__ __forceinline__ unsigned xb_ld(unsigned* p)              { return __hip_atomic_load(p, __ATOMIC_RELAXED, __HIP_MEMORY_SCOPE_AGENT); }
__device__ __forceinline__ unsigned xb_add(unsigned* p, unsigned v) { return __hip_atomic_fetch_add(p, v, __ATOMIC_RELAXED, __HIP_MEMORY_SCOPE_AGENT); }
__device__ __forceinline__ unsigned xb_xcc_id() { return (unsigned)__builtin_amdgcn_s_getreg((3 << 11) | 20) & 0xFu; }
#define XB_SPIN(cond, bar) do { unsigned _sp = 0; while (cond) { __builtin_amdgcn_s_sleep(1); \
    if ((++_sp & 255u) == 0u) { if (xb_ld(&(bar)[XB_TMO])) break; if (_sp > XB_SPIN_CAP) { atomicAdd(&(bar)[XB_TMO], 1u); break; } } } } while (0)

struct XcdBarrier {
    unsigned* bar; unsigned x;
    volatile LAS unsigned* st;
};

__device__ __forceinline__ XcdBarrier xcd_barrier_post(unsigned* bar, volatile LAS unsigned* st) {
    XcdBarrier b; b.bar = bar; b.x = xb_xcc_id(); b.st = st;
    if (threadIdx.x == 0) (void)xb_add(&bar[XB_XCNT(b.x)], 1u);
    return b;
}
__device__ __forceinline__ void xcd_barrier_complete(unsigned* bar, unsigned x, unsigned& nloc, unsigned& nx) {
    const unsigned G = gridDim.x * gridDim.y * gridDim.z;
    unsigned sum, cnt, mine, sp = 0u;
    for (;;) {
        sum = 0u; cnt = 0u; mine = 0u;
#pragma unroll
        for (unsigned j = 0; j < 16; ++j) { const unsigned c = xb_ld(&bar[XB_XCNT(j)]); sum += c; cnt += (c > 0u) ? 1u : 0u; mine = (j == x) ? c : mine; }
        if (sum == G) break;
        __builtin_amdgcn_s_sleep(1);
        if ((++sp & 255u) == 0u) { if (xb_ld(&bar[XB_TMO])) break; if (sp > XB_SPIN_CAP) { atomicAdd(&bar[XB_TMO], 1u); break; } }
    }
    nloc = mine > 0u ? mine : 1u; nx = cnt > 0u ? cnt : 1u;
}

__device__ __forceinline__ void xcd_barrier(const XcdBarrier& b) {
    asm volatile("s_waitcnt vmcnt(0)" ::: "memory");
    __syncthreads();
    if (threadIdx.x == 0) {
        unsigned* bar = b.bar;
        __builtin_amdgcn_s_waitcnt(0);
        unsigned nloc = b.st[0], nx = b.st[1];
        if (nloc == 0u) { xcd_barrier_complete(bar, b.x, nloc, nx); b.st[0] = nloc; b.st[1] = nx; }
        const unsigned old = xb_add(&bar[XB_XSUB(b.x)], 1u);
        const unsigned gen = old / nloc;
        if (old + 1u == (gen + 1u) * nloc) {
            __builtin_amdgcn_fence(__ATOMIC_RELEASE, "agent");
            asm volatile("s_waitcnt vmcnt(0)" ::: "memory");
            const unsigned og = xb_add(&bar[XB_TOP], 1u);
            const unsigned tg = og / nx;
            if (og + 1u == (tg + 1u) * nx) xb_add(&bar[XB_TOPGEN], 1u);
            else XB_SPIN(xb_ld(&bar[XB_TOPGEN]) == tg, bar);
            __builtin_amdgcn_fence(__ATOMIC_ACQUIRE, "agent");
            xb_add(&bar[XB_XGEN(b.x)], 1u);
            asm volatile("s_waitcnt vmcnt(0)" ::: "memory");
        } else {
            XB_SPIN(xb_ld(&bar[XB_XGEN(b.x)]) == gen, bar);
            __builtin_amdgcn_fence(__ATOMIC_ACQUIRE, "agent");
            asm volatile("s_waitcnt vmcnt(0)" ::: "memory");
        }
    }
    __syncthreads();
}


namespace {
constexpr int D = 1024, NB = 4, S = 8192, DEPTH = 2, GW = 64, CTX = 256, HD = 64;
constexpr int NAH = 6, RH = 6, NAW = 384, RW = 384, PW = 256;
constexpr int M_LAT = NB * S, M_CTX = NB * CTX, M_ALL = M_LAT + M_CTX;
constexpr int O_NA_Q = 0, O_NA_K = 384, O_NA_V = 768, O_RET_Q = 1152, O_RET_K = 1536, O_RET_V = 1920, O_RET_G = 2304, O_POOL = 2688;
constexpr int DPROJ = 2944, DPROJ_PAD = 3072;
constexpr int PH = 8, PNK = 128, PKD = 128, PTOP = 16, NEXP = 16384, DQ = 2048;
constexpr float EPS = 1e-6f;
constexpr int NCH = S / 128 + 2;
constexpr int NT = 512;
constexpr int LDS_BYTES = 163840;

typedef unsigned short bf16;
typedef short bf16x8 __attribute__((ext_vector_type(8)));
typedef float f32x4 __attribute__((ext_vector_type(4)));
typedef unsigned u32x4 __attribute__((ext_vector_type(4)));

__device__ __forceinline__ float bf2f(bf16 v) { return __uint_as_float(((unsigned)v) << 16); }
__device__ __forceinline__ bf16 f2bf(float f) { unsigned u = __float_as_uint(f); return (bf16)((u + 0x7fffu + ((u >> 16) & 1u)) >> 16); }
__device__ __forceinline__ float silu(float x) { return x / (1.f + __expf(-x)); }
#define SWZ_XOR(v, m) __int_as_float(__builtin_amdgcn_ds_swizzle(__float_as_int(v), ((m) << 10) | 0x1f))
__device__ __forceinline__ float wave_sum(float v) {
    v += SWZ_XOR(v, 1); v += SWZ_XOR(v, 2); v += SWZ_XOR(v, 4); v += SWZ_XOR(v, 8); v += SWZ_XOR(v, 16);
    return __int_as_float(__builtin_amdgcn_readlane(__float_as_int(v), 0)) + __int_as_float(__builtin_amdgcn_readlane(__float_as_int(v), 32));
}
__device__ __forceinline__ float wave_max(float v) {
    v = fmaxf(v, SWZ_XOR(v, 1)); v = fmaxf(v, SWZ_XOR(v, 2)); v = fmaxf(v, SWZ_XOR(v, 4)); v = fmaxf(v, SWZ_XOR(v, 8)); v = fmaxf(v, SWZ_XOR(v, 16));
    return fmaxf(__int_as_float(__builtin_amdgcn_readlane(__float_as_int(v), 0)), __int_as_float(__builtin_amdgcn_readlane(__float_as_int(v), 32)));
}
__device__ __forceinline__ int rl_i(int v, int lane) { return __builtin_amdgcn_readlane(v, lane); }
__device__ __forceinline__ float rl_f(float v, int lane) { return __int_as_float(__builtin_amdgcn_readlane(__float_as_int(v), lane)); }

constexpr size_t MiB = 1u << 20;
constexpr size_t WS_CTL = 0;
constexpr size_t WS_MOD = 1 * MiB;
constexpr size_t WS_ROPE = WS_MOD + 512 * 1024;
constexpr size_t WS_KEYS = 3 * MiB + 512 * 1024;
constexpr size_t WS_SU = 4 * MiB + 512 * 1024, WS_SV = WS_SU + 256 * 1024;
constexpr size_t WS_XS = 5 * MiB;
constexpr size_t WS_SWI = 5 * MiB + 512 * 1024, WS_SWQ = WS_SWI + 65536;
constexpr size_t WS_WO = 6 * MiB;
constexpr size_t WS_WI8 = 10 * MiB, WS_WQ8 = 16 * MiB;
constexpr size_t WS_WI = 20 * MiB;
constexpr size_t WS_WQ = 32 * MiB;
constexpr size_t WS_U = 40 * MiB;
constexpr size_t WS_V = 72 * MiB;
constexpr size_t WS_XQ = 104 * MiB;
constexpr size_t WS_ACT = 137 * MiB;
constexpr size_t WS_PX = 203 * MiB;
constexpr size_t WS_AW = WS_PX + 160 * MiB;
constexpr size_t WS_ST = 393 * MiB;
constexpr size_t WS_XR = 443 * MiB;
constexpr size_t WS_XRC = 507 * MiB;
constexpr size_t WS_END = 509 * MiB;
constexpr size_t WS_IDX = WS_ST, WS_GATE = WS_ST + 17 * MiB;
constexpr size_t WS_TOPV = WS_PX + 133 * MiB, WS_TOPI = WS_ACT;

struct Params { const float* in[21]; float* out; unsigned char* ws; };

__device__ __forceinline__ void ph_mods(const float* c, const float* c_ctx, const float* w_ada, const float* b_ada, float* mod, float* sm  ) { const int tidx = otid();
    const int tid = tidx, ks = tid >> 6, jj = tid & 63;
    float* act = sm; float* red = sm + 5 * D;
    if ((int)blockIdx.x >= DEPTH * 96) return;
    for (int i = tid; i < 5 * D; i += NT) { const float v = i < 4 * D ? c[i] : c_ctx[i - 4 * D]; act[i] = silu(v); }
    __syncthreads();
    for (int vb = blockIdx.x; vb < DEPTH * 96; vb += gridDim.x) {
        const int l = vb / 96, j = (vb % 96) * 64 + jj;
        const float* w = w_ada + (size_t)l * D * 6 * D + (size_t)(ks * 128) * 6 * D + j;
        const float* ap = act + ks * 128;
        float a0 = 0, a1 = 0, a2 = 0, a3 = 0, a4 = 0;
#pragma unroll 32
        for (int k = 0; k < 128; ++k) { const float wv = w[(size_t)k * 6 * D];
            a0 += ap[k] * wv; a1 += ap[D + k] * wv; a2 += ap[2 * D + k] * wv; a3 += ap[3 * D + k] * wv; a4 += ap[4 * D + k] * wv; }
        red[(ks * 5 + 0) * 64 + jj] = a0; red[(ks * 5 + 1) * 64 + jj] = a1; red[(ks * 5 + 2) * 64 + jj] = a2; red[(ks * 5 + 3) * 64 + jj] = a3; red[(ks * 5 + 4) * 64 + jj] = a4;
        __syncthreads();
        if (tid < 320) { const int r = tid >> 6; float s = 0.f;
#pragma unroll
            for (int q = 0; q < 8; ++q) s += red[(q * 5 + r) * 64 + jj];
            mod[((size_t)l * 5 + r) * 6 * D + j] = s + b_ada[l * 6 * D + j]; }
        __syncthreads();
    }
}
__device__ __forceinline__ void ph_rope(float* cosT, float* sinT) { const int tidx = otid();
    for (int gid = blockIdx.x * NT + tidx; gid < S * 32; gid += gridDim.x * NT) {
        const int t = gid / 32, j = gid % 32, jj = j & 15;
        const float inv = powf(10000.f, -(float)jj / 16.f);
        const float pos = j < 16 ? (float)(t / GW) : (float)(t % GW);
        const float ang = pos * inv;
        cosT[gid] = cosf(ang); sinT[gid] = sinf(ang);
    }
}
__device__ __forceinline__ void ph_transpose(const float* W, int K, int N, int Npad, int ldk, bf16* Wt, float* tile  ) { const int tidx = otid();
    const int tid = tidx, nbn = Npad / 64, nvb = nbn * (K / 64);
    for (int vb = blockIdx.x; vb < nvb; vb += gridDim.x) {
        const int n0 = (vb % nbn) * 64, k0 = (vb / nbn) * 64;
        { const int kk = tid >> 4, n4 = (tid & 15) * 4;
#pragma unroll
          for (int i = 0; i < 2; ++i) { const int k = kk + 32 * i; const int n = n0 + n4;
              const f32x4 v = (n < N) ? *(const f32x4*)(W + (size_t)(k0 + k) * N + n) : (f32x4){0.f, 0.f, 0.f, 0.f};
              tile[k * 65 + n4] = v.x; tile[k * 65 + n4 + 1] = v.y; tile[k * 65 + n4 + 2] = v.z; tile[k * 65 + n4 + 3] = v.w; } }
        __syncthreads();
        { const int n = tid >> 3, kc = (tid & 7) * 8;
          u32x4 o; o.x = pg8::cvt_pk_bf16(tile[(kc + 0) * 65 + n], tile[(kc + 1) * 65 + n]); o.y = pg8::cvt_pk_bf16(tile[(kc + 2) * 65 + n], tile[(kc + 3) * 65 + n]);
          o.z = pg8::cvt_pk_bf16(tile[(kc + 4) * 65 + n], tile[(kc + 5) * 65 + n]); o.w = pg8::cvt_pk_bf16(tile[(kc + 6) * 65 + n], tile[(kc + 7) * 65 + n]);
          *(u32x4*)(Wt + (size_t)(n0 + n) * ldk + k0 + kc) = o; }
        __syncthreads();
    }
}
__device__ __forceinline__ void ph_transpose_all(const float* w_in, const float* peer_wq, const float* w_out, bf16* WI, bf16* WQ, bf16* WO, float* tile) { const int tidx = otid();
    constexpr int T_IN = (DPROJ_PAD / 64) * (D / 64), T_Q = (DQ / 64) * (D / 64), T_O = (D / 64) * (768 / 64), T_L = T_IN + T_Q + T_O, T_ALL = DEPTH * T_L;
    const int tid = tidx, G = (int)gridDim.x, c = G - 1 - (int)blockIdx.x;
#define TR_DECODE(vb) const int l_ = (vb) / T_L, r0_ = (vb) % T_L; const int which_ = r0_ < T_IN ? 0 : (r0_ < T_IN + T_Q ? 1 : 2); const int r_ = r0_ - (which_ == 0 ? 0 : (which_ == 1 ? T_IN : T_IN + T_Q)); \
        const int N_ = which_ == 0 ? DPROJ : (which_ == 1 ? DQ : D), nbn_ = which_ == 0 ? DPROJ_PAD / 64 : (which_ == 1 ? DQ / 64 : D / 64); \
        const float* W_ = which_ == 0 ? w_in + (size_t)l_ * D * DPROJ : (which_ == 1 ? peer_wq + (size_t)l_ * D * DQ : w_out + (size_t)l_ * D * D); \
        bf16* Wt_ = which_ == 0 ? WI + (size_t)l_ * DPROJ_PAD * D : (which_ == 1 ? WQ + (size_t)l_ * DQ * D : WO + (size_t)l_ * D * D); \
        const int n0_ = (r_ % nbn_) * 64, k0_ = (r_ / nbn_) * 64;
    for (int vb0 = c; vb0 < T_ALL; vb0 += 4 * G) {
        f32x4 v[4][2];
#pragma unroll
        for (int i = 0; i < 4; ++i) { const int vb = vb0 + i * G;
            if (vb < T_ALL) { TR_DECODE(vb) (void)Wt_; const int kk = tid >> 4, n = n0_ + (tid & 15) * 4;
#pragma unroll
                for (int q = 0; q < 2; ++q) v[i][q] = (n < N_) ? *(const f32x4*)(W_ + (size_t)(k0_ + kk + 32 * q) * N_ + n) : (f32x4){0.f, 0.f, 0.f, 0.f}; } }
#pragma unroll
        for (int i = 0; i < 4; ++i) { const int vb = vb0 + i * G;
            if (vb < T_ALL) { float* tl = tile + i * (64 * 65); const int kk = tid >> 4, n4 = (tid & 15) * 4;
#pragma unroll
                for (int q = 0; q < 2; ++q) { const int k = kk + 32 * q; tl[k * 65 + n4] = v[i][q].x; tl[k * 65 + n4 + 1] = v[i][q].y; tl[k * 65 + n4 + 2] = v[i][q].z; tl[k * 65 + n4 + 3] = v[i][q].w; } } }
        __syncthreads();
#pragma unroll
        for (int i = 0; i < 4; ++i) { const int vb = vb0 + i * G;
            if (vb < T_ALL) { TR_DECODE(vb) (void)W_; (void)N_; const float* tl = tile + i * (64 * 65); const int n = tid >> 3, kc = (tid & 7) * 8;
                u32x4 o; o.x = pg8::cvt_pk_bf16(tl[(kc + 0) * 65 + n], tl[(kc + 1) * 65 + n]); o.y = pg8::cvt_pk_bf16(tl[(kc + 2) * 65 + n], tl[(kc + 3) * 65 + n]);
                o.z = pg8::cvt_pk_bf16(tl[(kc + 4) * 65 + n], tl[(kc + 5) * 65 + n]); o.w = pg8::cvt_pk_bf16(tl[(kc + 6) * 65 + n], tl[(kc + 7) * 65 + n]);
                *(u32x4*)(Wt_ + (size_t)(n0_ + n) * D + k0_ + kc) = o; } }
        __syncthreads();
    }
#undef TR_DECODE
}
__device__ __forceinline__ void ph_wo_pool(const float* w_out_all, const float* pool_w_all, const float* pool_scale_all, bf16* Wo_t_all, float* sm) { const int tidx = otid();
    const int tid = tidx; float* P = sm; float* Ws = sm + 64 * 65;
    for (int vb = (int)gridDim.x - 1 - (int)blockIdx.x; vb < DEPTH * 4 * 16; vb += gridDim.x) {
        const int l = vb >> 6, g = (vb >> 4) & 3, n0 = (vb & 15) * 64;
        const float* w_out = w_out_all + (size_t)l * D * D; const float* pool_w = pool_w_all + (size_t)l * 4 * 64 * 64; const float* pool_scale = pool_scale_all + (size_t)l * PW; bf16* Wo_t = Wo_t_all + (size_t)l * D * D;
        for (int i = tid; i < 4096; i += NT) { const int r = i >> 6, cc = i & 63; P[r * 65 + cc] = pool_w[(g * 64 + r) * 64 + cc] * pool_scale[g * 64 + cc]; Ws[r * 65 + cc] = w_out[(size_t)(768 + g * 64 + r) * D + n0 + cc]; }
        __syncthreads();
        { const int i = tid & 63, nq = tid >> 6;
#pragma unroll 1
          for (int nn = nq * 8; nn < nq * 8 + 8; ++nn) { float s = 0.f;
#pragma unroll 16
              for (int j = 0; j < 64; ++j) s += P[i * 65 + j] * Ws[j * 65 + nn];
              Wo_t[(size_t)(n0 + nn) * D + 768 + g * 64 + i] = f2bf(s); } }
        __syncthreads();
    }
}
__device__ __forceinline__ void ph_cvt(const float* src, bf16* dst, size_t n4) { const int tidx = otid();
    for (size_t i = (size_t)blockIdx.x * NT + tidx; i < n4; i += (size_t)gridDim.x * NT) {
        const f32x4 v = ((const f32x4*)src)[i]; ushort4 o; o.x = f2bf(v.x); o.y = f2bf(v.y); o.z = f2bf(v.z); o.w = f2bf(v.w); ((ushort4*)dst)[i] = o; }
}

template <bool BF> __device__ __forceinline__ f32x4 ld4res(const void* p, size_t idx) {
    if (BF) { const ushort4 v = *(const ushort4*)((const bf16*)p + idx); return (f32x4){bf2f(v.x), bf2f(v.y), bf2f(v.z), bf2f(v.w)}; }
    else return *(const f32x4*)((const float*)p + idx);
}
__device__ __forceinline__ void st4res(bf16* p, size_t idx, f32x4 v) { pg8::u32x2 o; o.x = pg8::cvt_pk_bf16(v.x, v.y); o.y = pg8::cvt_pk_bf16(v.z, v.w); *(pg8::u32x2*)(p + idx) = o; }

template <bool XQOUT, bool INBF>
__device__ __forceinline__ void ph_norm(const void* xlat, const void* xctx, const float* nw, const float* modl, int off_sh, int off_sc, bf16* act  , unsigned char* xq, float* xs, int nrows) { const int tidx = otid();
    const int lane = tidx & 63, wave = tidx >> 6;
    for (int row0 = (blockIdx.x * 8 + wave) * 2; row0 < nrows; row0 += gridDim.x * 16) {
        f32x4 v[2][4];
#pragma unroll
        for (int r = 0; r < 2; ++r) { const int row = row0 + r; const void* src = row < M_LAT ? xlat : xctx; const size_t rb = (size_t)(row < M_LAT ? row : row - M_LAT) * D;
#pragma unroll
            for (int j = 0; j < 4; ++j) v[r][j] = ld4res<INBF>(src, rb + (size_t)(lane + 64 * j) * 4); }
#pragma unroll
        for (int r = 0; r < 2; ++r) { const int row = row0 + r; const int mi = row < M_LAT ? row / S : 4;
            const float* sh = modl + (size_t)mi * 6 * D + off_sh; const float* sc = modl + (size_t)mi * 6 * D + off_sc;
            float ss = 0.f;
#pragma unroll
            for (int j = 0; j < 4; ++j) ss += v[r][j].x * v[r][j].x + v[r][j].y * v[r][j].y + v[r][j].z * v[r][j].z + v[r][j].w * v[r][j].w;
            ss = wave_sum(ss);
            const float rs = rsqrtf(ss * (1.f / D) + EPS);
            f32x4 hv[4]; float am = 0.f;
#pragma unroll
            for (int j = 0; j < 4; ++j) { const int k = (lane + 64 * j) * 4;
                const f32x4 w = *(const f32x4*)(nw + k), a = *(const f32x4*)(sc + k), b = *(const f32x4*)(sh + k);
                hv[j].x = v[r][j].x * rs * w.x * (1.f + a.x) + b.x; hv[j].y = v[r][j].y * rs * w.y * (1.f + a.y) + b.y; hv[j].z = v[r][j].z * rs * w.z * (1.f + a.z) + b.z; hv[j].w = v[r][j].w * rs * w.w * (1.f + a.w) + b.w;
                if (act) { ushort4 o; o.x = f2bf(hv[j].x); o.y = f2bf(hv[j].y); o.z = f2bf(hv[j].z); o.w = f2bf(hv[j].w);
                *(ushort4*)(act + (size_t)row * D + k) = o; }
                am = fmaxf(am, fmaxf(fmaxf(fabsf(hv[j].x), fabsf(hv[j].y)), fmaxf(fabsf(hv[j].z), fabsf(hv[j].w)))); }
            if (XQOUT) { am = wave_max(am); const float sx = am > 0.f ? am * (1.f / 127.f) : 1.f, inv = 1.f / sx;
#pragma unroll
                for (int j = 0; j < 4; ++j) { const int q0 = (int)rintf(hv[j].x * inv), q1 = (int)rintf(hv[j].y * inv), q2 = (int)rintf(hv[j].z * inv), q3 = (int)rintf(hv[j].w * inv);
                    *(unsigned*)(xq + (size_t)row * D + (lane + 64 * j) * 4) = (unsigned)(q0 & 0xff) | ((unsigned)(q1 & 0xff) << 8) | ((unsigned)(q2 & 0xff) << 16) | ((unsigned)(q3 & 0xff) << 24); }
                if (lane == 0) xs[row] = sx; }
        }
    }
}

struct EpiBf16Out {
    static constexpr bool PERM = true, AFTER_DRAIN = false;
    bf16* O; int ldc; int ncols;
    __device__ __forceinline__ void operator()(const pg8::f32x4 (&acc)[2][2][4][2], const pg8::Unit& u, int wr, int wc, int fr, int fq) const {
        const int row0 = u.pm * 256 + wr * 64 + fr, col0 = u.pn * 256 + wc * 32 + 8 * fq;
#pragma unroll
        for (int ai = 0; ai < 2; ++ai)
#pragma unroll
            for (int m = 0; m < 4; ++m) { bf16* rowp = O + (size_t)(row0 + ai * 128 + m * 16) * ldc + col0;
#pragma unroll
                for (int bj = 0; bj < 2; ++bj) { if (col0 + bj * 128 < ncols) { const pg8::f32x4 v0 = acc[ai][bj][m][0], v1 = acc[ai][bj][m][1];
                    u32x4 w; w.x = pg8::cvt_pk_bf16(v0[0], v0[1]); w.y = pg8::cvt_pk_bf16(v0[2], v0[3]); w.z = pg8::cvt_pk_bf16(v1[0], v1[1]); w.w = pg8::cvt_pk_bf16(v1[2], v1[3]);
                    *(u32x4*)(rowp + bj * 128) = w; } } }
    }
};
#ifndef NT_STORE
#define NT_STORE 0
#endif
struct EpiI8Bf16Out {
    static constexpr bool PERM = true, AFTER_DRAIN = false;
    bf16* O; int ldc; int ncols; const float* sa; const float* sb;
    __device__ __forceinline__ void operator()(const pg8::i32x4 (&acc)[2][2][4][2], const pg8::Unit& u, int wr, int wc, int fr, int fq) const {
        const int row0 = u.pm * 256 + wr * 64 + fr, col0 = u.pn * 256 + wc * 32 + 8 * fq;
        f32x4 sbv[2][2];
#pragma unroll
        for (int bj = 0; bj < 2; ++bj) { sbv[bj][0] = *(const f32x4*)(sb + col0 + bj * 128); sbv[bj][1] = *(const f32x4*)(sb + col0 + bj * 128 + 4); }
        float srv[2][4];
#pragma unroll
        for (int ai = 0; ai < 2; ++ai)
#pragma unroll
            for (int m = 0; m < 4; ++m) srv[ai][m] = sa[row0 + ai * 128 + m * 16];
#pragma unroll
        for (int ai = 0; ai < 2; ++ai)
#pragma unroll
            for (int m = 0; m < 4; ++m) { const int row = row0 + ai * 128 + m * 16; const float sr = srv[ai][m]; bf16* rowp = O + (size_t)row * ldc + col0;
#pragma unroll
                for (int bj = 0; bj < 2; ++bj) { if (col0 + bj * 128 < ncols) { const pg8::i32x4 v0 = acc[ai][bj][m][0], v1 = acc[ai][bj][m][1]; const f32x4 s0 = sbv[bj][0] * sr, s1 = sbv[bj][1] * sr;
                    u32x4 w; w.x = pg8::cvt_pk_bf16((float)v0[0] * s0.x, (float)v0[1] * s0.y); w.y = pg8::cvt_pk_bf16((float)v0[2] * s0.z, (float)v0[3] * s0.w);
                    w.z = pg8::cvt_pk_bf16((float)v1[0] * s1.x, (float)v1[1] * s1.y); w.w = pg8::cvt_pk_bf16((float)v1[2] * s1.z, (float)v1[3] * s1.w);
                    if (NT_STORE) __builtin_nontemporal_store(w, (u32x4*)(rowp + bj * 128)); else *(u32x4*)(rowp + bj * 128) = w; } } }
    }
};
struct EpiI8QT {
    static constexpr bool PERM = true, AFTER_DRAIN = false;
    bf16* O; const float* sa; const float* sb;
    __device__ __forceinline__ void operator()(const pg8::i32x4 (&acc)[2][2][4][2], const pg8::Unit& u, int wr, int wc, int fr, int fq) const {
        const int row0 = u.pm * 256 + wr * 64 + fr, col0 = u.pn * 256 + wc * 32 + 8 * fq;
        f32x4 sbv[2][2];
#pragma unroll
        for (int bj = 0; bj < 2; ++bj) { sbv[bj][0] = *(const f32x4*)(sb + col0 + bj * 128); sbv[bj][1] = *(const f32x4*)(sb + col0 + bj * 128 + 4); }
        float srv[2][4];
#pragma unroll
        for (int ai = 0; ai < 2; ++ai)
#pragma unroll
            for (int m = 0; m < 4; ++m) srv[ai][m] = sa[row0 + ai * 128 + m * 16];
        const int sfrag = (2 * wc + (fq >> 1)) * 512 + (fq & 1) * 256;
#pragma unroll
        for (int ai = 0; ai < 2; ++ai)
#pragma unroll
            for (int m = 0; m < 4; ++m) { const int row = row0 + ai * 128 + m * 16; const float sr = srv[ai][m];
#pragma unroll
                for (int bj = 0; bj < 2; ++bj) { const pg8::i32x4 v0 = acc[ai][bj][m][0], v1 = acc[ai][bj][m][1]; const f32x4 s0 = sbv[bj][0] * sr, s1 = sbv[bj][1] * sr;
                    u32x4 w; w.x = pg8::cvt_pk_bf16((float)v0[0] * s0.x, (float)v0[1] * s0.y); w.y = pg8::cvt_pk_bf16((float)v0[2] * s0.z, (float)v0[3] * s0.w);
                    w.z = pg8::cvt_pk_bf16((float)v1[0] * s1.x, (float)v1[1] * s1.y); w.w = pg8::cvt_pk_bf16((float)v1[2] * s1.z, (float)v1[3] * s1.w);
                    *(u32x4*)(O + ((size_t)(((row >> 5) * PH + u.pn) * 2 + bj)) * 4096 + sfrag + (row & 31) * 8) = w; } }
    }
};
template <bool INBF>
struct EpiRes {
    static constexpr bool PERM = false, AFTER_DRAIN = false;
    const void* xin_lat; const void* xin_ctx; bf16* xout_lat; bf16* xout_ctx; const float* modl; int off_g;
    __device__ __forceinline__ void operator()(const pg8::f32x4 (&acc)[2][2][4][2], const pg8::Unit& u, int wr, int wc, int fr, int fq) const {
        const int r0 = u.pm * 256; const bool lat = r0 < M_LAT; const int mi = lat ? r0 / S : 4;
        const void* xin = lat ? xin_lat : xin_ctx; bf16* xout = lat ? xout_lat : xout_ctx;
        const size_t rbase = (size_t)(lat ? r0 : r0 - M_LAT) * D;
        const int col0 = u.pn * 256 + wc * 32 + 4 * fq;
        const float* gp = modl + (size_t)mi * 6 * D + off_g + col0;
        f32x4 gv[2][2];
#pragma unroll
        for (int bj = 0; bj < 2; ++bj)
#pragma unroll
            for (int n = 0; n < 2; ++n) gv[bj][n] = *(const f32x4*)(gp + bj * 128 + n * 16);
#pragma unroll
        for (int ai = 0; ai < 2; ++ai) {
            f32x4 xi[4][2][2];
#pragma unroll
            for (int mm = 0; mm < 4; ++mm) { const size_t off = rbase + (size_t)(ai * 128 + wr * 64 + mm * 16 + fr) * D + col0;
#pragma unroll
                for (int bj = 0; bj < 2; ++bj)
#pragma unroll
                    for (int n = 0; n < 2; ++n) xi[mm][bj][n] = ld4res<INBF>(xin, off + bj * 128 + n * 16); }
#pragma unroll
            for (int mm = 0; mm < 4; ++mm) { const size_t off = rbase + (size_t)(ai * 128 + wr * 64 + mm * 16 + fr) * D + col0;
#pragma unroll
                for (int bj = 0; bj < 2; ++bj)
#pragma unroll
                    for (int n = 0; n < 2; ++n) { const pg8::f32x4 a = acc[ai][bj][mm][n]; const f32x4 gq = gv[bj][n], x4 = xi[mm][bj][n]; f32x4 o;
                        o.x = x4.x + gq.x * a[0]; o.y = x4.y + gq.y * a[1]; o.z = x4.z + gq.z * a[2]; o.w = x4.w + gq.w * a[3];
                        st4res(xout, off + bj * 128 + n * 16, o); } }
            asm volatile("" ::: "memory");
        }
    }
};

template <int EPI>
__device__ __forceinline__ void ph_gemm_simple(const bf16* A, const bf16* Bt, int M, int N, int K, bf16* Cb, int ldc, int ncols,
                                               const float* xin_lat, const float* xin_ctx, float* xout_lat, float* xout_ctx, const float* modl, int off_g, bf16* sm  ) { const int tidx = otid();
    bf16 (*sA)[40] = (bf16 (*)[40])sm; bf16 (*sB)[40] = (bf16 (*)[40])(sm + 128 * 40);
    const int tid = tidx, w = tid >> 6, lane = tid & 63, fr = lane & 15, fq = lane >> 4;
    const int lr = tid >> 2, lc = (tid & 3) * 8;
    const int nbn = N / 64, nvb = (M / 128) * nbn;
    for (int vb = blockIdx.x; vb < nvb; vb += gridDim.x) {
        const int m0 = (vb / nbn) * 128, n0 = (vb % nbn) * 64;
        f32x4 acc[4];
#pragma unroll
        for (int j = 0; j < 4; ++j) acc[j] = (f32x4){0.f, 0.f, 0.f, 0.f};
        for (int k0 = 0; k0 < K; k0 += 32) {
            *(bf16x8*)&sA[lr][lc] = *(const bf16x8*)(A + (size_t)(m0 + lr) * K + k0 + lc);
            if (tid < 256) *(bf16x8*)&sB[lr][lc] = *(const bf16x8*)(Bt + (size_t)(n0 + lr) * K + k0 + lc);
            __syncthreads();
            const bf16x8 a = *(const bf16x8*)&sA[w * 16 + fr][fq * 8];
#pragma unroll
            for (int j = 0; j < 4; ++j) { const bf16x8 b = *(const bf16x8*)&sB[j * 16 + fr][fq * 8]; acc[j] = __builtin_amdgcn_mfma_f32_16x16x32_bf16(a, b, acc[j], 0, 0, 0); }
            __syncthreads();
        }
#pragma unroll
        for (int j = 0; j < 4; ++j)
#pragma unroll
            for (int i = 0; i < 4; ++i) {
                const int row = m0 + w * 16 + fq * 4 + i, col = n0 + j * 16 + fr;
                if (EPI == 0) { if (col < ncols) Cb[(size_t)row * ldc + col] = f2bf(acc[j][i]); }
                else { const int mi = row < M_LAT ? row / S : 4; const float g = modl[(size_t)mi * 6 * D + off_g + col];
                    if (row < M_LAT) xout_lat[(size_t)row * D + col] = xin_lat[(size_t)row * D + col] + g * acc[j][i];
                    else { const size_t o = (size_t)(row - M_LAT) * D + col; xout_ctx[o] = xin_ctx[o] + g * acc[j][i]; } }
            }
    }
}

__device__ __forceinline__ void ph_na(const bf16* px, const float* rpb  , bf16* act, int nrows) { const int tidx = otid();
    for (int gid = blockIdx.x * NT + tidx; gid < nrows * NAH; gid += gridDim.x * NT) {
        const int row = gid / NAH, h = gid % NAH;
        float q[64], o[64];
        const bf16* qp = px + (size_t)row * DPROJ + O_NA_Q + h * 64;
#pragma unroll
        for (int d = 0; d < 64; ++d) { q[d] = bf2f(qp[d]) * 0.125f; o[d] = 0.f; }
        float mx = -1e30f, den = 0.f;
        int b, nwin = 0, rr = 0, cq = 0, r_start = 0, c_start = 0;
        if (row < M_LAT) { b = row / S; const int t = row % S; rr = t / GW; cq = t % GW; r_start = min(max(rr - 4, 0), 128 - 8); c_start = min(max(cq - 8, 0), GW - 16); nwin = 128; }
        else b = (row - M_LAT) / CTX;
        for (int i = 0; i < nwin + CTX; ++i) {
            int krow; float bias = 0.f;
            if (i < nwin) { const int j = i / 16, kc = c_start + (i % 16), kr = r_start + j; krow = b * S + kr * GW + kc;
                bias = rpb[(h * 15 + (kr - rr + 7)) * 31 + (kc - cq + 15)]; }
            else krow = M_LAT + b * CTX + (i - nwin);
            const bf16* kp = px + (size_t)krow * DPROJ + O_NA_K + h * 64;
            float s = 0.f;
#pragma unroll
            for (int d = 0; d < 64; ++d) s += q[d] * bf2f(kp[d]);
            s += bias;
            const float nm = fmaxf(mx, s), corr = __expf(mx - nm), p = __expf(s - nm);
            den = den * corr + p; mx = nm;
            const bf16* vp = px + (size_t)krow * DPROJ + O_NA_V + h * 64;
#pragma unroll
            for (int d = 0; d < 64; ++d) o[d] = o[d] * corr + p * bf2f(vp[d]);
        }
        const float inv = 1.f / den;
        bf16* op = act + (size_t)row * D + h * 64;
#pragma unroll
        for (int d = 0; d < 64; ++d) op[d] = f2bf(o[d] * inv);
    }
}

typedef short s16x4 __attribute__((ext_vector_type(4)));
typedef __attribute__((address_space(3))) const unsigned char* lds_cp;
__device__ __forceinline__ s16x4 vtr(lds_cp p) { return __builtin_bit_cast(s16x4, __builtin_amdgcn_ds_read_tr16_b64_v4i16((__attribute__((address_space(3))) s16x4*)p)); }
__device__ __forceinline__ float xq_max(float x) {
    auto s = __builtin_amdgcn_permlane16_swap(__float_as_uint(x), __float_as_uint(x), false, false);
    x = fmaxf(__uint_as_float(s[0]), __uint_as_float(s[1]));
    auto t = __builtin_amdgcn_permlane32_swap(__float_as_uint(x), __float_as_uint(x), false, false);
    return fmaxf(__uint_as_float(t[0]), __uint_as_float(t[1]));
}
__device__ __forceinline__ float xq_sum(float x) {
    auto s = __builtin_amdgcn_permlane16_swap(__float_as_uint(x), __float_as_uint(x), false, false);
    x = __uint_as_float(s[0]) + __uint_as_float(s[1]);
    auto t = __builtin_amdgcn_permlane32_swap(__float_as_uint(x), __float_as_uint(x), false, false);
    return __uint_as_float(t[0]) + __uint_as_float(t[1]);
}
constexpr int NA_ROWB = 160;
constexpr int NA_KOFF = 0, NA_VOFF = 2 * 64 * NA_ROWB, NA_BOFF = 4 * 64 * NA_ROWB;
__device__ __forceinline__ void ph_na_mfma(const bf16* px, const float* rpb  , bf16* act, int nunits, unsigned char* ldsg) { const int tidx = otid();
    const int lane = tidx & 63, w = __builtin_amdgcn_readfirstlane(tidx >> 6), fr = lane & 15, quad = lane >> 4;
    const lds_cp lds = (lds_cp)ldsg;
    float* sbias = (float*)(ldsg + NA_BOFF);
    constexpr float LOG2E = 1.4426950408889634f;
    const int skey = tidx >> 3, spiece = tidx & 7;
    const int G_ = gridDim.x, vcu = (G_ % 8 == 0) ? ((int)blockIdx.x % 8) * (G_ / 8) + (int)blockIdx.x / 8 : (int)blockIdx.x;
    for (int u = vcu; u < nunits; u += G_) {
        int b, h, wr0 = 0, nwin = 0, rq = 0, g = 0, rs_q = 0, qrow;
        const bool latent = u < 1536;
        if (latent) { b = u / 384; h = (u / 64) % 6; const int rp = u % 64;
            wr0 = min(max(2 * rp - 4, 0), 120); const int rs1 = min(max(2 * rp - 3, 0), 120); nwin = rs1 + 8 - wr0;
            rq = 2 * rp + (w >> 2); g = w & 3; rs_q = min(max(rq - 4, 0), 120); qrow = b * S + rq * GW + 16 * g + fr; }
        else { const int cu = u - 1536; b = cu / 12; h = (cu >> 1) % 6; qrow = M_LAT + b * CTX + (cu & 1) * 128 + 16 * w + fr; }
        const int nchunks = 4 + nwin;
        const int cq = 16 * g + fr, c_start = min(max(cq - 8, 0), 48);
        __syncthreads();
        for (int i = tidx; i < 480; i += NT) sbias[i] = (i & 31) < 31 ? rpb[h * 465 + (i >> 5) * 31 + (i & 31)] * LOG2E : -1e30f;
        bf16x8 qf[2];
        qf[0] = *(const bf16x8*)(px + (size_t)qrow * DPROJ + O_NA_Q + h * 64 + 8 * quad);
        qf[1] = *(const bf16x8*)(px + (size_t)qrow * DPROJ + O_NA_Q + h * 64 + 32 + 8 * quad);
        u32x4 kreg, vreg;
        { const size_t r = (size_t)(M_LAT + b * CTX + skey);
          kreg = *(const u32x4*)(px + r * DPROJ + O_NA_K + h * 64 + spiece * 8); vreg = *(const u32x4*)(px + r * DPROJ + O_NA_V + h * 64 + spiece * 8); }
        *(u32x4*)(ldsg + NA_KOFF + skey * NA_ROWB + spiece * 16) = kreg; *(u32x4*)(ldsg + NA_VOFF + skey * NA_ROWB + spiece * 16) = vreg;
        __syncthreads();
        f32x4 O[4];
#pragma unroll
        for (int dt = 0; dt < 4; ++dt) O[dt] = (f32x4){0.f, 0.f, 0.f, 0.f};
        float m = -1e30f, lsum = 0.f;
        const int cbase = 4 * quad - cq + 15;
        const int vbase = 4 * quad - c_start;
        const int c0 = min(max(16 * g - 8, 0), 32);
        int boff[8];
#pragma unroll
        for (int e = 0; e < 8; ++e) { const int ce = c0 + 16 * (e >> 2) + (e & 3); boff[e] = ((unsigned)(vbase + ce) < 16u) ? 4 * min(max(cbase + ce, 0), 30) : 4 * 31; }
        for (int c = 0; c < nchunks; ++c) {
            const int buf = c & 1;
            if (c + 1 < nchunks) { const int c1 = c + 1; const size_t r = c1 < 4 ? (size_t)(M_LAT + b * CTX + 64 * c1 + skey) : (size_t)(b * S + (wr0 + c1 - 4) * GW + skey);
                kreg = *(const u32x4*)(px + r * DPROJ + O_NA_K + h * 64 + spiece * 8); vreg = *(const u32x4*)(px + r * DPROJ + O_NA_V + h * 64 + spiece * 8); }
            const bool isctx = c < 4; const int kr = wr0 + c - 4;
            const bool use = isctx || (kr >= rs_q && kr < rs_q + 8);
            if (use) {
                const lds_cp kb = lds + NA_KOFF + buf * 64 * NA_ROWB, vb = lds + NA_VOFF + buf * 64 * NA_ROWB;
                const char* brow = (const char*)(sbias + (kr - rq + 7) * 32);
#pragma unroll
                for (int pair = 0; pair < 2; ++pair) {
                    if (!isctx && pair == 1) continue;
                    const int kofs = isctx ? 32 * pair : c0;
                    f32x4 a0 = (f32x4){0.f, 0.f, 0.f, 0.f}, a1 = a0;
#pragma unroll
                    for (int s = 0; s < 2; ++s) {
                        const bf16x8 k0 = *(const __attribute__((address_space(3))) bf16x8*)(kb + (kofs + fr) * NA_ROWB + 64 * s + 16 * quad);
                        const bf16x8 k1 = *(const __attribute__((address_space(3))) bf16x8*)(kb + (kofs + 16 + fr) * NA_ROWB + 64 * s + 16 * quad);
                        a0 = __builtin_amdgcn_mfma_f32_16x16x32_bf16(k0, qf[s], a0, 0, 0, 0);
                        a1 = __builtin_amdgcn_mfma_f32_16x16x32_bf16(k1, qf[s], a1, 0, 0, 0);
                    }
                    float sc[8];
                    if (isctx) {
#pragma unroll
                        for (int i = 0; i < 4; ++i) { sc[i] = a0[i] * (0.125f * LOG2E); sc[4 + i] = a1[i] * (0.125f * LOG2E); }
                    } else {
#pragma unroll
                        for (int e = 0; e < 8; ++e) { const float bm = *(const float*)(brow + boff[e]);
                            sc[e] = __builtin_fmaf(e < 4 ? a0[e & 3] : a1[e & 3], 0.125f * LOG2E, bm); }
                    }
                    float mx = __builtin_fmaxf(__builtin_fmaxf(__builtin_fmaxf(sc[0], sc[1]), __builtin_fmaxf(sc[2], sc[3])), __builtin_fmaxf(__builtin_fmaxf(sc[4], sc[5]), __builtin_fmaxf(sc[6], sc[7])));
                    mx = xq_max(mx);
                    if (__any(mx > m + 6.f)) {
                        const float mn = fmaxf(m, mx), corr = __builtin_amdgcn_exp2f(m - mn); m = mn;
                        lsum *= corr;
#pragma unroll
                        for (int dt = 0; dt < 4; ++dt) O[dt] = O[dt] * corr;
                    }
                    float p[8], ps = 0.f;
#pragma unroll
                    for (int e = 0; e < 8; ++e) { p[e] = __builtin_amdgcn_exp2f(sc[e] - m); ps += p[e]; }
                    lsum += ps;
                    u32x4 pk; pk.x = pg8::cvt_pk_bf16(p[0], p[1]); pk.y = pg8::cvt_pk_bf16(p[2], p[3]); pk.z = pg8::cvt_pk_bf16(p[4], p[5]); pk.w = pg8::cvt_pk_bf16(p[6], p[7]);
                    const bf16x8 pb = __builtin_bit_cast(bf16x8, pk);
#pragma unroll
                    for (int dt = 0; dt < 4; ++dt) {
                        const lds_cp va = vb + (kofs + 4 * quad + (fr >> 2)) * NA_ROWB + (16 * dt + 4 * (fr & 3)) * 2;
                        const s16x4 v0 = vtr(va), v1 = vtr(va + 16 * NA_ROWB);
                        bf16x8 A; A[0] = v0[0]; A[1] = v0[1]; A[2] = v0[2]; A[3] = v0[3]; A[4] = v1[0]; A[5] = v1[1]; A[6] = v1[2]; A[7] = v1[3];
                        O[dt] = __builtin_amdgcn_mfma_f32_16x16x32_bf16(A, pb, O[dt], 0, 0, 0);
                    }
                }
            }
            if (c + 1 < nchunks) { const int nb = (c + 1) & 1;
                *(u32x4*)(ldsg + NA_KOFF + nb * 64 * NA_ROWB + skey * NA_ROWB + spiece * 16) = kreg; *(u32x4*)(ldsg + NA_VOFF + nb * 64 * NA_ROWB + skey * NA_ROWB + spiece * 16) = vreg; }
            __syncthreads();
        }
        const float inv = 1.f / xq_sum(lsum);
        bf16* op = act + (size_t)qrow * D + h * 64 + 4 * quad;
#pragma unroll
        for (int dt = 0; dt < 4; ++dt) { pg8::u32x2 o; o.x = pg8::cvt_pk_bf16(O[dt][0] * inv, O[dt][1] * inv); o.y = pg8::cvt_pk_bf16(O[dt][2] * inv, O[dt][3] * inv); *(pg8::u32x2*)(op + 16 * dt) = o; }
    }
}
template <int W>
__device__ __forceinline__ void pool_item(const bf16* px, bf16* act, int row, int oc) {
    int t, T, base;
    if (row < M_LAT) { t = row % S; T = S; base = row - t; } else { t = (row - M_LAT) % CTX; T = CTX; base = row - t; }
    const int lo = max(t - W / 2, 0), hi = min(t + W / 2, T);
    bf16x8 tv[W];
#pragma unroll
    for (int i = 0; i < W; ++i) { const int tt = min(lo + i, hi - 1); tv[i] = *(const bf16x8*)(px + (size_t)(base + tt) * DPROJ + O_POOL + oc * 8); }
    const bf16x8 xv = *(const bf16x8*)(px + (size_t)row * DPROJ + O_POOL + oc * 8);
    float s[8];
#pragma unroll
    for (int j = 0; j < 8; ++j) s[j] = 0.f;
#pragma unroll
    for (int i = 0; i < W; ++i) { const float wgt = (lo + i < hi) ? 1.f : 0.f;
#pragma unroll
        for (int j = 0; j < 8; ++j) s[j] += wgt * bf2f((bf16)tv[i][j]); }
    const float inv = 1.f / (float)(hi - lo);
    u32x4 o; o.x = pg8::cvt_pk_bf16(s[0] * inv - bf2f((bf16)xv[0]), s[1] * inv - bf2f((bf16)xv[1])); o.y = pg8::cvt_pk_bf16(s[2] * inv - bf2f((bf16)xv[2]), s[3] * inv - bf2f((bf16)xv[3]));
    o.z = pg8::cvt_pk_bf16(s[4] * inv - bf2f((bf16)xv[4]), s[5] * inv - bf2f((bf16)xv[5])); o.w = pg8::cvt_pk_bf16(s[6] * inv - bf2f((bf16)xv[6]), s[7] * inv - bf2f((bf16)xv[7]));
    *(u32x4*)(act + (size_t)row * D + 768 + oc * 8) = o;
}
__device__ __forceinline__ void ph_pool(const bf16* px, bf16* act, int nrows) { const int tidx = otid();
    const int per = nrows * 8;
    for (int gid = blockIdx.x * NT + tidx; gid < 4 * per; gid += gridDim.x * NT) {
        const int g = gid / per, r = gid - g * per, row = r >> 3, oc = g * 8 + (r & 7);
        if (g == 0) pool_item<2>(px, act, row, oc); else if (g == 1) pool_item<4>(px, act, row, oc); else if (g == 2) pool_item<8>(px, act, row, oc); else pool_item<16>(px, act, row, oc);
    }
}
__device__ __forceinline__ float rope_elem(const bf16* p, int d, const float* cs, const float* sn, bool rope) {
    const float x = bf2f(p[d]);
    if (!rope) return x;
    const int half = d >> 5, dd = d & 31, j = dd & 15;
    const float c = cs[half * 16 + j], s = sn[half * 16 + j];
    if (dd < 16) { const float x2 = bf2f(p[d + 16]); return x * c - x2 * s; }
    else { const float x1 = bf2f(p[d - 16]); return x1 * s + x * c; }
}
__device__ __forceinline__ int chunk_row0(int b, int ci) { return ci < 64 ? b * S + ci * 128 : M_LAT + b * CTX + (ci - 64) * 128; }
__device__ __forceinline__ void load_kv_chunk(const bf16* px, const float* cosT, const float* sinT, int b, int h, int ci, float* sk, float* sv) { const int tidx = otid();
    const int row0 = chunk_row0(b, ci); const bool rope = ci < 64;
    for (int i = tidx; i < 128 * 64; i += NT) { const int m = i / 64, d = i % 64, row = row0 + m; const int t = rope ? (ci * 128 + m) : 0;
        sk[i] = rope_elem(px + (size_t)row * DPROJ + O_RET_K + h * 64, d, cosT + t * 32, sinT + t * 32, rope) * 0.125f;
        sv[i] = bf2f(px[(size_t)row * DPROJ + O_RET_V + h * 64 + d]); }
}
__device__ __forceinline__ void ph_ret_state(const bf16* px, const float* cosT, const float* sinT, const float* dec_f, const float* dec_b, float* ST, float* sm) { const int tidx = otid();
    float* sk = sm; float* sv = sm + 128 * 64;
    for (int vb = blockIdx.x; vb < NB * RH * NCH; vb += gridDim.x) {
        const int ci = vb % NCH, h = (vb / NCH) % RH, b = vb / (NCH * RH);
        load_kv_chunk(px, cosT, sinT, b, h, ci, sk, sv);
        __syncthreads();
        const float lgf = -log1pf(expf(-dec_f[h])), lgb = -log1pf(expf(-dec_b[h]));
        for (int i = tidx; i < 4096; i += NT) { const int d = i / 64, e = i % 64;
            float af = 0.f, ab = 0.f;
            for (int m = 0; m < 128; ++m) { const float kv = sk[m * 64 + d] * sv[m * 64 + e]; af += expf((127.f - m) * lgf) * kv; ab += expf((float)m * lgb) * kv; }
            ST[((((size_t)(b * RH + h) * 2 + 0) * NCH + ci) * 4096) + i] = af; ST[((((size_t)(b * RH + h) * 2 + 1) * NCH + ci) * 4096) + i] = ab; }
        __syncthreads();
    }
}
__device__ __forceinline__ void ph_ret_scan(const float* dec_f, const float* dec_b, float* ST) { const int tidx = otid();
    for (int gid = blockIdx.x * NT + tidx; gid < NB * RH * 2 * 4096; gid += gridDim.x * NT) {
        const int e = gid % 4096, dir = (gid / 4096) & 1, bh = gid / 8192, h = bh % RH;
        const float lg = -log1pf(expf(-(dir ? dec_b[h] : dec_f[h]))), gg = expf(128.f * lg);
        float* P = ST + ((size_t)bh * 2 + dir) * NCH * 4096 + e;
        float t[64];
#pragma unroll
        for (int c = 0; c < 64; ++c) t[c] = P[(size_t)c * 4096];
        const float k0 = P[(size_t)64 * 4096], k1 = P[(size_t)65 * 4096];
        if (dir == 0) { P[(size_t)64 * 4096] = 0.f; P[(size_t)65 * 4096] = k0; float R = gg * k0 + k1;
#pragma unroll
            for (int c = 0; c < 64; ++c) { const float v = t[c]; t[c] = R; R = gg * R + v; } }
        else { P[(size_t)65 * 4096] = 0.f; P[(size_t)64 * 4096] = k1; float R = k0 + gg * k1;
#pragma unroll
            for (int c = 63; c >= 0; --c) { const float v = t[c]; t[c] = R; R = gg * R + v; } }
#pragma unroll
        for (int c = 0; c < 64; ++c) P[(size_t)c * 4096] = t[c];
    }
}
__device__ __forceinline__ void ph_ret_scan_bf(const float* dec_f, const float* dec_b, bf16* ST) { const int tidx = otid();
    for (int gid = blockIdx.x * NT + tidx; gid < NB * RH * 2 * 2048; gid += gridDim.x * NT) {
        const int e2 = gid % 2048, dir = (gid / 2048) & 1, bh = gid / 4096, h = bh % RH;
        const float lg = -log1pf(expf(-(dir ? dec_b[h] : dec_f[h]))), gg = expf(128.f * lg);
        unsigned* P = (unsigned*)(ST + ((size_t)bh * 2 + dir) * NCH * 4096) + e2;
        unsigned t[64];
#pragma unroll
        for (int c = 0; c < 64; ++c) t[c] = P[(size_t)c * 2048];
        const unsigned k0 = P[(size_t)64 * 2048], k1 = P[(size_t)65 * 2048];
        const float k0x = __uint_as_float(k0 << 16), k0y = __uint_as_float(k0 & 0xffff0000u), k1x = __uint_as_float(k1 << 16), k1y = __uint_as_float(k1 & 0xffff0000u);
        if (dir == 0) { P[(size_t)64 * 2048] = 0u; P[(size_t)65 * 2048] = k0; float Rx = gg * k0x + k1x, Ry = gg * k0y + k1y;
#pragma unroll
            for (int c = 0; c < 64; ++c) { const unsigned v = t[c]; t[c] = pg8::cvt_pk_bf16(Rx, Ry); Rx = gg * Rx + __uint_as_float(v << 16); Ry = gg * Ry + __uint_as_float(v & 0xffff0000u); } }
        else { P[(size_t)65 * 2048] = 0u; P[(size_t)64 * 2048] = k1; float Rx = k0x + gg * k1x, Ry = k0y + gg * k1y;
#pragma unroll
            for (int c = 63; c >= 0; --c) { const unsigned v = t[c]; t[c] = pg8::cvt_pk_bf16(Rx, Ry); Rx = gg * Rx + __uint_as_float(v << 16); Ry = gg * Ry + __uint_as_float(v & 0xffff0000u); } }
#pragma unroll
        for (int c = 0; c < 64; ++c) P[(size_t)c * 2048] = t[c];
    }
}
__device__ __forceinline__ void ph_ret_out(const bf16* px, const float* cosT, const float* sinT, const float* dec_f, const float* dec_b, const float* ST, const float* gn_w, bf16* act, int nci, float* sm) { const int tidx = otid();
    float* sk = sm; float* sv = sm + 128 * 64; float* sy = sm + 2 * 128 * 64; float* sq = sy + 128 * 65;
    const int n = tidx & 127, eq = tidx >> 7;
    for (int vb = blockIdx.x; vb < NB * RH * nci; vb += gridDim.x) {
        const int ci = vb % nci, h = (vb / nci) % RH, b = vb / (nci * RH);
        const int row0 = chunk_row0(b, ci); const bool rope = ci < 64;
        load_kv_chunk(px, cosT, sinT, b, h, ci, sk, sv);
        __syncthreads();
        const int row = row0 + n; const int t = rope ? (ci * 128 + n) : 0;
        const float lgf = -log1pf(expf(-dec_f[h])), lgb = -log1pf(expf(-dec_b[h]));
        float q[64], y[16];
#pragma unroll
        for (int d = 0; d < 64; ++d) { q[d] = rope_elem(px + (size_t)row * DPROJ + O_RET_Q + h * 64, d, cosT + t * 32, sinT + t * 32, rope); if (eq == 0) sq[n * 65 + d] = q[d]; }
        __syncthreads();
#pragma unroll
        for (int e = 0; e < 16; ++e) y[e] = 0.f;
        for (int m = 0; m < 128; ++m) {
            float s = 0.f;
#pragma unroll
            for (int d = 0; d < 64; ++d) s += q[d] * sk[m * 64 + d];
            const float dm = m < n ? expf((float)(n - m) * lgf) : (m > n ? expf((float)(m - n) * lgb) : 2.f);
            s *= dm;
#pragma unroll
            for (int e = 0; e < 16; ++e) y[e] += s * sv[m * 64 + eq * 16 + e];
        }
        const float* Sf = ST + (((size_t)(b * RH + h) * 2 + 0) * NCH + ci) * 4096 + eq * 16; const float* Sb = ST + (((size_t)(b * RH + h) * 2 + 1) * NCH + ci) * 4096 + eq * 16;
        const float xf = expf((float)(n + 1) * lgf), xb = expf((float)(128 - n) * lgb);
#pragma unroll 1
        for (int d = 0; d < 64; ++d) { const float qd = sq[n * 65 + d]; const float qf = qd * xf, qb = qd * xb;
#pragma unroll
            for (int e = 0; e < 16; ++e) y[e] += qf * Sf[d * 64 + e] + qb * Sb[d * 64 + e]; }
#pragma unroll
        for (int e = 0; e < 16; ++e) sy[n * 65 + eq * 16 + e] = y[e];
        __syncthreads();
        float mu = 0.f;
        for (int e = 0; e < 64; ++e) mu += sy[n * 65 + e];
        mu *= (1.f / 64.f); float var = 0.f;
        for (int e = 0; e < 64; ++e) { const float dd = sy[n * 65 + e] - mu; var += dd * dd; }
        const float rs = rsqrtf(var * (1.f / 64.f) + EPS);
        const bf16* gp = px + (size_t)row * DPROJ + O_RET_G + h * 64 + eq * 16; bf16* op = act + (size_t)row * D + NAW + h * 64 + eq * 16;
#pragma unroll
        for (int e = 0; e < 16; ++e) { const float g = bf2f(gp[e]); op[e] = f2bf((y[e] - mu) * rs * gn_w[h * 64 + eq * 16 + e] * silu(g)); }
        __syncthreads();
    }
}


__device__ __forceinline__ void rope8(const bf16* hp, int piece, const float* cs, const float* sn, bool rope, float (&o)[8]) {
    const bf16x8 own = *(const bf16x8*)(hp + piece * 8);
    if (!rope) {
#pragma unroll
        for (int j = 0; j < 8; ++j) o[j] = bf2f((bf16)own[j]);
        return; }
    const bf16x8 par = *(const bf16x8*)(hp + (piece ^ 2) * 8);
    const int half = piece >> 2, pp = piece & 3, tb = half * 16 + 8 * (pp & 1);
    const f32x4 c0 = *(const f32x4*)(cs + tb), c1 = *(const f32x4*)(cs + tb + 4), s0 = *(const f32x4*)(sn + tb), s1 = *(const f32x4*)(sn + tb + 4);
    const float c[8] = {c0.x, c0.y, c0.z, c0.w, c1.x, c1.y, c1.z, c1.w}, s[8] = {s0.x, s0.y, s0.z, s0.w, s1.x, s1.y, s1.z, s1.w};
#pragma unroll
    for (int j = 0; j < 8; ++j) { const float a = bf2f((bf16)own[j]), b = bf2f((bf16)par[j]); o[j] = pp < 2 ? a * c[j] - b * s[j] : b * s[j] + a * c[j]; }
}
__device__ __forceinline__ u32x4 pack8(const float (&o)[8], float sc) {
    u32x4 r; r.x = pg8::cvt_pk_bf16(o[0] * sc, o[1] * sc); r.y = pg8::cvt_pk_bf16(o[2] * sc, o[3] * sc); r.z = pg8::cvt_pk_bf16(o[4] * sc, o[5] * sc); r.w = pg8::cvt_pk_bf16(o[6] * sc, o[7] * sc); return r;
}
__device__ __forceinline__ bf16x8 tr2(lds_cp a, int second_off) {
    const s16x4 v0 = vtr(a), v1 = vtr(a + second_off);
    bf16x8 A; A[0] = v0[0]; A[1] = v0[1]; A[2] = v0[2]; A[3] = v0[3]; A[4] = v1[0]; A[5] = v1[1]; A[6] = v1[2]; A[7] = v1[3]; return A;
}
constexpr int RT_P = 160;
__device__ __forceinline__ void rope_inv8(int odd, float (&inv8)[8]) {
#pragma unroll
    for (int k = 0; k < 8; ++k) inv8[k] = __builtin_amdgcn_exp2f(-(float)(8 * odd + k) * (13.287712379549449f / 16.f)) * 0.15915494309189535f;
}
__device__ __forceinline__ void rope8c(const bf16x8 own, const bf16x8 par, int piece, int t, const float (&inv8)[8], bool rope, float (&o)[8]) {
    if (!rope) {
#pragma unroll
        for (int j = 0; j < 8; ++j) o[j] = bf2f((bf16)own[j]);
        return; }
    const int half = piece >> 2, pp = piece & 3;
    const float pos = (float)(half ? (t % GW) : (t / GW));
#pragma unroll
    for (int j = 0; j < 8; ++j) { const float rev = pos * inv8[j], c = __builtin_amdgcn_cosf(rev), s = __builtin_amdgcn_sinf(rev);
        const float a = bf2f((bf16)own[j]), b = bf2f((bf16)par[j]); o[j] = pp < 2 ? a * c - b * s : b * s + a * c; }
}
__device__ __forceinline__ void rope8r(const bf16x8 own, const bf16x8 par, int piece, const float* cs, const float* sn, bool rope, float (&o)[8]) {
    if (!rope) {
#pragma unroll
        for (int j = 0; j < 8; ++j) o[j] = bf2f((bf16)own[j]);
        return; }
    const int half = piece >> 2, pp = piece & 3, tb = half * 16 + 8 * (pp & 1);
    const f32x4 c0 = *(const f32x4*)(cs + tb), c1 = *(const f32x4*)(cs + tb + 4), s0 = *(const f32x4*)(sn + tb), s1 = *(const f32x4*)(sn + tb + 4);
    const float c[8] = {c0.x, c0.y, c0.z, c0.w, c1.x, c1.y, c1.z, c1.w}, s[8] = {s0.x, s0.y, s0.z, s0.w, s1.x, s1.y, s1.z, s1.w};
#pragma unroll
    for (int j = 0; j < 8; ++j) { const float a = bf2f((bf16)own[j]), b = bf2f((bf16)par[j]); o[j] = pp < 2 ? a * c[j] - b * s[j] : b * s[j] + a * c[j]; }
}
__device__ __forceinline__ void ph_ret_state_mfma(const bf16* px, const float* cosT, const float* sinT, const float* dec_f, const float* dec_b, bf16* ST, unsigned char* ldsg) { const int tidx = otid();
    const int lane = tidx & 63, w = __builtin_amdgcn_readfirstlane(tidx >> 6), fr = lane & 15, quad = lane >> 4;
    const lds_cp lds = (lds_cp)ldsg;
    constexpr int KF = 0, KB = 128 * RT_P, VS = 2 * 128 * RT_P;
    constexpr int NU = NB * RH * NCH;
    bf16x8 kown[2], kpar[2]; u32x4 vv[2];
#define R1_ISSUE(vbx) do { const int ci_ = (vbx) % NCH, h_ = ((vbx) / NCH) % RH, b_ = (vbx) / (NCH * RH); const int row0_ = chunk_row0(b_, ci_); \
        _Pragma("unroll") for (int it = 0; it < 2; ++it) { const int item = tidx + NT * it, m = item >> 3, piece = item & 7; const bf16* rp = px + (size_t)(row0_ + m) * DPROJ; \
            kown[it] = *(const bf16x8*)(rp + O_RET_K + h_ * 64 + piece * 8); kpar[it] = *(const bf16x8*)(rp + O_RET_K + h_ * 64 + (piece ^ 2) * 8); vv[it] = *(const u32x4*)(rp + O_RET_V + h_ * 64 + piece * 8); } } while (0)
    float invk[8]; rope_inv8(tidx & 1, invk);
    int vb = blockIdx.x;
    if (vb < NU) R1_ISSUE(vb);
    for (; vb < NU; vb += gridDim.x) {
        const int ci = vb % NCH, h = (vb / NCH) % RH, b = vb / (NCH * RH);
        const bool rope = ci < 64;
        const float lgf = -log1pf(expf(-dec_f[h])), lgb = -log1pf(expf(-dec_b[h]));
        __syncthreads();
#pragma unroll
        for (int it = 0; it < 2; ++it) { const int item = tidx + NT * it, m = item >> 3, piece = item & 7; const int t = rope ? (ci * 128 + m) : 0;
            float o[8]; rope8c(kown[it], kpar[it], piece, t, invk, rope, o);
            *(u32x4*)(ldsg + KF + m * RT_P + piece * 16) = pack8(o, 0.125f * expf((127.f - (float)m) * lgf));
            *(u32x4*)(ldsg + KB + m * RT_P + piece * 16) = pack8(o, 0.125f * expf((float)m * lgb));
            *(u32x4*)(ldsg + VS + m * RT_P + piece * 16) = vv[it]; }
        if (vb + (int)gridDim.x < NU) R1_ISSUE(vb + (int)gridDim.x);
        __syncthreads();
        const int dir = w >> 2, dt = w & 3;
        const lds_cp kb = lds + (dir ? KB : KF);
        bf16x8 A[4];
#pragma unroll
        for (int ks = 0; ks < 4; ++ks) A[ks] = tr2(kb + (32 * ks + 8 * quad + (fr >> 2)) * RT_P + (16 * dt + 4 * (fr & 3)) * 2, 4 * RT_P);
        bf16* outp = ST + ((((size_t)(b * RH + h) * 2 + dir) * NCH + ci) * 4096);
#pragma unroll
        for (int et = 0; et < 4; ++et) {
            f32x4 acc = (f32x4){0.f, 0.f, 0.f, 0.f};
#pragma unroll
            for (int ks = 0; ks < 4; ++ks) { const bf16x8 Bv = tr2(lds + VS + (32 * ks + 8 * quad + (fr >> 2)) * RT_P + (16 * et + 4 * (fr & 3)) * 2, 4 * RT_P);
                acc = __builtin_amdgcn_mfma_f32_16x16x32_bf16(A[ks], Bv, acc, 0, 0, 0); }
#pragma unroll
            for (int i = 0; i < 4; ++i) outp[(16 * dt + 4 * quad + i) * 64 + 16 * et + fr] = f2bf(acc[i]);
        }
    }
#undef R1_ISSUE
}
__device__ __forceinline__ void ph_ret_out_mfma(const bf16* px, const float* cosT, const float* sinT, const float* dec_f, const float* dec_b, const bf16* ST, const float* gn_w, bf16* act, int nci, unsigned char* ldsg) { const int tidx = otid();
    const int lane = tidx & 63, w = __builtin_amdgcn_readfirstlane(tidx >> 6), fr = lane & 15, quad = lane >> 4;
    const lds_cp lds = (lds_cp)ldsg;
    constexpr int KS = 0, VS = 128 * RT_P, SF = 2 * 128 * RT_P, SB = SF + 64 * RT_P;
    constexpr float LOG2E = 1.4426950408889634f;
    const int NU = NB * RH * nci;
    bf16x8 kown[2], kpar[2], qown[2], qpar[2]; u32x4 vv[2]; u32x4 sfu, sbu;
#define R3_ISSUE(vbx) do { const int ci_ = (vbx) % nci, h_ = ((vbx) / nci) % RH, b_ = (vbx) / (nci * RH); const int row0_ = chunk_row0(b_, ci_); \
        _Pragma("unroll") for (int it = 0; it < 2; ++it) { const int item = tidx + NT * it, m = item >> 3, piece = item & 7; const bf16* rp = px + (size_t)(row0_ + m) * DPROJ; \
            kown[it] = *(const bf16x8*)(rp + O_RET_K + h_ * 64 + piece * 8); kpar[it] = *(const bf16x8*)(rp + O_RET_K + h_ * 64 + (piece ^ 2) * 8); vv[it] = *(const u32x4*)(rp + O_RET_V + h_ * 64 + piece * 8); } \
        { const bf16* Sf_ = ST + (((size_t)(b_ * RH + h_) * 2 + 0) * NCH + ci_) * 4096; const bf16* Sb_ = ST + (((size_t)(b_ * RH + h_) * 2 + 1) * NCH + ci_) * 4096; const int d_ = tidx >> 3, e0_ = (tidx & 7) * 8; \
          sfu = *(const u32x4*)(Sf_ + d_ * 64 + e0_); sbu = *(const u32x4*)(Sb_ + d_ * 64 + e0_); } \
        { const bf16* qp = px + (size_t)(row0_ + 16 * w + fr) * DPROJ + O_RET_Q + h_ * 64; \
          _Pragma("unroll") for (int s = 0; s < 2; ++s) { qown[s] = *(const bf16x8*)(qp + (4 * s + quad) * 8); qpar[s] = *(const bf16x8*)(qp + ((4 * s + quad) ^ 2) * 8); } } } while (0)
    float invk[8], invq[8]; rope_inv8(tidx & 1, invk); rope_inv8(quad & 1, invq);
    int vb = blockIdx.x;
    if (vb < NU) R3_ISSUE(vb);
    for (; vb < NU; vb += gridDim.x) {
        const int ci = vb % nci, h = (vb / nci) % RH, b = vb / (nci * RH);
        const int row0 = chunk_row0(b, ci); const bool rope = ci < 64;
        const float lgf2 = -log1pf(expf(-dec_f[h])) * LOG2E, lgb2 = -log1pf(expf(-dec_b[h])) * LOG2E;
        __syncthreads();
#pragma unroll
        for (int it = 0; it < 2; ++it) { const int item = tidx + NT * it, m = item >> 3, piece = item & 7; const int t = rope ? (ci * 128 + m) : 0;
            float o[8]; rope8c(kown[it], kpar[it], piece, t, invk, rope, o);
            *(u32x4*)(ldsg + KS + m * RT_P + piece * 16) = pack8(o, 0.125f);
            *(u32x4*)(ldsg + VS + m * RT_P + piece * 16) = vv[it]; }
        { const int d = tidx >> 3, e0 = (tidx & 7) * 8;
          *(u32x4*)(ldsg + SF + d * RT_P + e0 * 2) = sfu; *(u32x4*)(ldsg + SB + d * RT_P + e0 * 2) = sbu; }
        const int nloc = 16 * w + fr, row = row0 + nloc; const int tq = rope ? (ci * 128 + nloc) : 0;
        bf16x8 qf[2];
#pragma unroll
        for (int s = 0; s < 2; ++s) { float o[8]; rope8c(qown[s], qpar[s], 4 * s + quad, tq, invq, rope, o); qf[s] = __builtin_bit_cast(bf16x8, pack8(o, 1.f)); }
        if (vb + (int)gridDim.x < NU) R3_ISSUE(vb + (int)gridDim.x);
        __syncthreads();
        f32x4 Y[4];
#pragma unroll
        for (int et = 0; et < 4; ++et) Y[et] = (f32x4){0.f, 0.f, 0.f, 0.f};
        float lf[4], lb[4];
#pragma unroll
        for (int i = 0; i < 4; ++i) { const float dl = (float)(fr - 4 * quad - i); lf[i] = __builtin_amdgcn_exp2f(dl * lgf2); lb[i] = __builtin_amdgcn_exp2f(-dl * lgb2); }
#pragma unroll
        for (int mp = 0; mp < 4; ++mp) {
            float p[8];
#pragma unroll
            for (int t2 = 0; t2 < 2; ++t2) { const int mt = 2 * mp + t2;
                f32x4 acc = (f32x4){0.f, 0.f, 0.f, 0.f};
#pragma unroll
                for (int s = 0; s < 2; ++s) { const bf16x8 kf = *(const __attribute__((address_space(3))) bf16x8*)(lds + KS + (16 * mt + fr) * RT_P + 64 * s + 16 * quad);
                    acc = __builtin_amdgcn_mfma_f32_16x16x32_bf16(kf, qf[s], acc, 0, 0, 0); }
                if (mt == w) {
#pragma unroll
                    for (int i = 0; i < 4; ++i) { const int df = fr - 4 * quad - i;
                        const float dm = df > 0 ? lf[i] : (df < 0 ? lb[i] : 2.f);
                        p[4 * t2 + i] = acc[i] * dm; }
                } else {
                    const float tf = mt < w ? __builtin_amdgcn_exp2f((float)(16 * (w - mt)) * lgf2) : __builtin_amdgcn_exp2f((float)(16 * (mt - w)) * lgb2);
#pragma unroll
                    for (int i = 0; i < 4; ++i) p[4 * t2 + i] = acc[i] * ((mt < w ? lf[i] : lb[i]) * tf);
                } }
            u32x4 pk; pk.x = pg8::cvt_pk_bf16(p[0], p[1]); pk.y = pg8::cvt_pk_bf16(p[2], p[3]); pk.z = pg8::cvt_pk_bf16(p[4], p[5]); pk.w = pg8::cvt_pk_bf16(p[6], p[7]);
            const bf16x8 pb = __builtin_bit_cast(bf16x8, pk);
#pragma unroll
            for (int et = 0; et < 4; ++et) { const bf16x8 A = tr2(lds + VS + (32 * mp + 4 * quad + (fr >> 2)) * RT_P + (16 * et + 4 * (fr & 3)) * 2, 16 * RT_P);
                Y[et] = __builtin_amdgcn_mfma_f32_16x16x32_bf16(A, pb, Y[et], 0, 0, 0); }
        }
        const float xf = __builtin_amdgcn_exp2f((float)(nloc + 1) * lgf2), xb = __builtin_amdgcn_exp2f((float)(128 - nloc) * lgb2);
#pragma unroll
        for (int et = 0; et < 4; ++et) {
            f32x4 cf = (f32x4){0.f, 0.f, 0.f, 0.f}, cb = cf;
#pragma unroll
            for (int ks = 0; ks < 2; ++ks) { const int ro = (32 * ks + 8 * quad + (fr >> 2)) * RT_P + (16 * et + 4 * (fr & 3)) * 2;
                cf = __builtin_amdgcn_mfma_f32_16x16x32_bf16(tr2(lds + SF + ro, 4 * RT_P), qf[ks], cf, 0, 0, 0);
                cb = __builtin_amdgcn_mfma_f32_16x16x32_bf16(tr2(lds + SB + ro, 4 * RT_P), qf[ks], cb, 0, 0, 0); }
            Y[et] = Y[et] + cf * xf + cb * xb;
        }
        float s1 = 0.f;
#pragma unroll
        for (int et = 0; et < 4; ++et) s1 += (Y[et][0] + Y[et][1]) + (Y[et][2] + Y[et][3]);
        const float mu = xq_sum(s1) * (1.f / 64.f);
        float s2 = 0.f;
#pragma unroll
        for (int et = 0; et < 4; ++et)
#pragma unroll
            for (int i = 0; i < 4; ++i) { const float dd = Y[et][i] - mu; s2 += dd * dd; }
        const float rs = rsqrtf(xq_sum(s2) * (1.f / 64.f) + EPS);
        const bf16* gp = px + (size_t)row * DPROJ + O_RET_G + h * 64 + 4 * quad; bf16* op = act + (size_t)row * D + NAW + h * 64 + 4 * quad; const float* gw = gn_w + h * 64 + 4 * quad;
#pragma unroll
        for (int et = 0; et < 4; ++et) { const ushort4 gv = *(const ushort4*)(gp + 16 * et); const f32x4 wv = *(const f32x4*)(gw + 16 * et);
            const float o0 = (Y[et][0] - mu) * rs * wv.x * silu(bf2f(gv.x)), o1 = (Y[et][1] - mu) * rs * wv.y * silu(bf2f(gv.y)), o2 = (Y[et][2] - mu) * rs * wv.z * silu(bf2f(gv.z)), o3 = (Y[et][3] - mu) * rs * wv.w * silu(bf2f(gv.w));
            pg8::u32x2 o; o.x = pg8::cvt_pk_bf16(o0, o1); o.y = pg8::cvt_pk_bf16(o2, o3); *(pg8::u32x2*)(op + 16 * et) = o; }
    }
#undef R3_ISSUE
}
__device__ __forceinline__ void ph_topk1(const bf16* Q, const bf16* keysl, float* topv, int* topi, int nrows, bf16* sm) { const int tidx = otid();
    bf16 (*sk)[136] = (bf16 (*)[136])sm;
    const int nrt = nrows / NT;
    for (int vb = blockIdx.x; vb < nrt * 16; vb += gridDim.x) {
        const int hs = vb % 16, side = hs & 1, h = hs >> 1, row = (vb / 16) * NT + tidx;
        const bf16* kp = keysl + ((size_t)(side * PH + h) * PNK) * PKD;
        for (int i = tidx; i < 128 * 128; i += NT) sk[i / 128][i % 128] = kp[i];
        __syncthreads();
        float q[128];
        const bf16* qp = Q + (size_t)row * DQ + h * 256 + side * 128;
#pragma unroll
        for (int d = 0; d < 128; ++d) q[d] = bf2f(qp[d]);
        float tv[16]; int ti[16];
#pragma unroll
        for (int j = 0; j < 16; ++j) { tv[j] = -3e38f; ti[j] = 0; }
        for (int kk = 0; kk < 128; ++kk) {
            float s = 0.f;
#pragma unroll
            for (int d = 0; d < 128; ++d) s += q[d] * bf2f(sk[kk][d]);
            int si = kk;
#pragma unroll
            for (int j = 0; j < 16; ++j) { if (s > tv[j]) { const float tvv = tv[j]; const int tii = ti[j]; tv[j] = s; ti[j] = si; s = tvv; si = tii; } }
        }
        const size_t o = (((size_t)row * PH + h) * 2 + side) * 16;
#pragma unroll
        for (int j = 0; j < 16; ++j) { topv[o + j] = tv[j]; topi[o + j] = ti[j]; }
        __syncthreads();
    }
}
__device__ __forceinline__ void ph_topk2(const float* topv, const int* topi, int* idx, float* gate, int nrows) { const int tidx = otid();
    for (int gid = blockIdx.x * NT + tidx; gid < nrows * PH; gid += gridDim.x * NT) {
        const size_t o = (size_t)gid * 32;
        float vb[16];
#pragma unroll
        for (int j = 0; j < 16; ++j) vb[j] = topv[o + 16 + j];
        float tv[16]; int ti[16];
#pragma unroll
        for (int j = 0; j < 16; ++j) { tv[j] = -3e38f; ti[j] = 0; }
#pragma unroll 1
        for (int i = 0; i < 16; ++i) { const float vai = topv[o + i];
#pragma unroll
            for (int jb = 0; jb < 16; ++jb) { float s = vai + vb[jb]; int si = i * 16 + jb;
#pragma unroll
                for (int j = 0; j < 16; ++j) { if (s > tv[j]) { const float tvv = tv[j]; const int tii = ti[j]; tv[j] = s; ti[j] = si; s = tvv; si = tii; } } } }
        const float mx = tv[0]; float den = 0.f, p[16];
#pragma unroll
        for (int j = 0; j < 16; ++j) { p[j] = __expf(tv[j] - mx); den += p[j]; }
        const float inv = 1.f / den;
        const size_t oo = (size_t)gid * 16;
#pragma unroll
        for (int j = 0; j < 16; ++j) { const int ia = topi[o + (ti[j] >> 4)], ib = topi[o + 16 + (ti[j] & 15)]; idx[oo + j] = ia * PNK + ib; gate[oo + j] = p[j] * inv; }
    }
}


__device__ __forceinline__ void ins16(float (&L)[16], float v) {
#pragma unroll
    for (int j = 15; j >= 1; --j) L[j] = __builtin_amdgcn_fmed3f(L[j - 1], v, L[j]);
    L[0] = fmaxf(L[0], v);
}
__device__ __forceinline__ void bitonic_merge16(float (&L)[16], const float (&A)[16], const float (&B)[16]) {
#pragma unroll
    for (int j = 0; j < 16; ++j) L[j] = fmaxf(A[j], B[15 - j]);
#pragma unroll
    for (int st = 8; st >= 1; st >>= 1)
#pragma unroll
        for (int j = 0; j < 16; ++j) if ((j & st) == 0) { const float hi = fmaxf(L[j], L[j + st]), lo = fminf(L[j], L[j + st]); L[j] = hi; L[j + st] = lo; }
}
__device__ __forceinline__ void top16of32(float (&v)[32]) {
#define CE(i, j) { const float hi_ = fmaxf(v[i], v[j]), lo_ = fminf(v[i], v[j]); v[i] = hi_; v[j] = lo_; }
#define CMAX(i, j) { v[i] = fmaxf(v[i], v[j]); }
#define CMIN(i, j) { v[j] = fminf(v[i], v[j]); }
    CE(0,1) CE(2,3) CE(0,2) CE(1,3) CE(1,2) CE(4,5) CE(6,7) CE(4,6) CE(5,7) CE(5,6) CE(0,4) CE(2,6) CE(2,4) CE(1,5) CE(3,7) CE(3,5) CE(1,2) CE(3,4) CE(5,6) CE(8,9) CE(10,11) CE(8,10) CE(9,11) CE(9,10) CE(12,13) CE(14,15) CE(12,14) CE(13,15) CE(13,14) CE(8,12) CE(10,14) CE(10,12) CE(9,13) CE(11,15) CE(11,13) CE(9,10) CE(11,12) CE(13,14) CE(0,8) CE(4,12) CE(4,8) CE(2,10) CE(6,14) CE(6,10) CE(2,4) CE(6,8) CE(10,12) CE(1,9) CE(5,13) CE(5,9) CE(3,11) CE(7,15) CE(7,11) CE(3,5) CE(7,9) CE(11,13) CE(1,2) CE(3,4) CE(5,6) CE(7,8) CE(9,10) CE(11,12) CE(13,14) CE(16,17) CE(18,19) CE(16,18) CE(17,19) CE(17,18) CE(20,21) CE(22,23) CE(20,22) CE(21,23) CE(21,22) CE(16,20) CE(18,22) CE(18,20) CE(17,21) CE(19,23) CE(19,21) CE(17,18) CE(19,20) CE(21,22) CE(24,25) CE(26,27) CE(24,26) CE(25,27) CE(25,26) CE(28,29) CE(30,31) CE(28,30) CE(29,31) CE(29,30) CE(24,28) CE(26,30) CE(26,28) CE(25,29) CE(27,31) CE(27,29) CE(25,26) CE(27,28) CE(29,30) CE(16,24) CE(20,28) CE(20,24) CE(18,26) CE(22,30) CE(22,26) CE(18,20) CE(22,24) CE(26,28) CE(17,25) CE(21,29) CE(21,25) CE(19,27) CE(23,31) CE(23,27) CE(19,21) CE(23,25) CE(27,29) CE(17,18) CE(19,20) CE(21,22) CE(23,24) CE(25,26) CE(27,28) CE(29,30) CE(0,16) CMAX(8,24) CE(8,16) CE(4,20) CMAX(12,28) CMAX(12,20) CE(4,8) CE(12,16) CE(2,18) CMAX(10,26) CE(10,18) CE(6,22) CMAX(14,30) CMAX(14,22) CE(6,10) CMAX(14,18) CE(2,4) CE(6,8) CE(10,12) CE(14,16) CE(1,17) CMAX(9,25) CE(9,17) CE(5,21) CMAX(13,29) CMAX(13,21) CE(5,9) CE(13,17) CE(3,19) CMAX(11,27) CE(11,19) CE(7,23) CMAX(15,31) CMAX(15,23) CE(7,11) CMAX(15,19) CE(3,5) CE(7,9) CE(11,13) CMAX(15,17) CE(1,2) CE(3,4) CE(5,6) CE(7,8) CE(9,10) CE(11,12) CE(13,14) CMAX(15,16)
#undef CE
#undef CMAX
#undef CMIN
}
constexpr int TK_KROW = 272;
constexpr int TK_LIST = 2 * 128 * TK_KROW;
__device__ __forceinline__ void ph_tk_mfma(const bf16* Q, const bf16* keysl, int* idx, float* gate, int nrows, unsigned char* ldsg) { const int tidx = otid();
    const int lane = tidx & 63, w = __builtin_amdgcn_readfirstlane(tidx >> 6), fr = lane & 15, quad = lane >> 4;
    const lds_cp lds = (lds_cp)ldsg;
    unsigned* lists = (unsigned*)(ldsg + TK_LIST) + (w * 16 + fr) * 32;
    const int nunits = (nrows / 128) * PH;
    int hcur = -1;
    for (int u = blockIdx.x; u < nunits; u += gridDim.x) {
        const int h = u % PH, tile = u / PH;
        __syncthreads();
        if (h != hcur) {
            for (int i = tidx; i < 2 * 128 * 16; i += NT) { const int side = i >> 11, r = (i >> 4) & 127, pc = i & 15;
                *(u32x4*)(ldsg + (side * 128 + r) * TK_KROW + pc * 16) = *(const u32x4*)(keysl + ((size_t)(side * PH + h) * PNK + r) * PKD + pc * 8); }
            hcur = h;
        }
        __syncthreads();
        const int row = tile * 128 + 16 * w + fr;
        float Lb[16];
#pragma unroll
        for (int side = 0; side < 2; ++side) {
            bf16x8 qf[4];
#pragma unroll
            for (int s = 0; s < 4; ++s) qf[s] = *(const bf16x8*)(Q + (size_t)row * DQ + h * 256 + side * 128 + 32 * s + 8 * quad);
            float L[16];
            { float pv[32];
#pragma unroll
              for (int t = 0; t < 8; ++t) {
                f32x4 acc = (f32x4){0.f, 0.f, 0.f, 0.f};
#pragma unroll
                for (int s = 0; s < 4; ++s) { const bf16x8 kf = *(const __attribute__((address_space(3))) bf16x8*)(lds + (side * 128 + 16 * t + fr) * TK_KROW + 64 * s + 16 * quad);
                    acc = __builtin_amdgcn_mfma_f32_16x16x32_bf16(kf, qf[s], acc, 0, 0, 0); }
#pragma unroll
                for (int i = 0; i < 4; ++i) { const unsigned key = 16 * t + 4 * quad + i; pv[4 * t + i] = __uint_as_float((__float_as_uint(acc[i]) & ~0x7fu) | key); }
              }
              top16of32(pv);
#pragma unroll
              for (int j = 0; j < 16; ++j) L[j] = pv[j]; }
            { float A[16], B[16];
#pragma unroll
              for (int j = 0; j < 16; ++j) { auto s = __builtin_amdgcn_permlane16_swap(__float_as_uint(L[j]), __float_as_uint(L[j]), false, false); A[j] = __uint_as_float(s[0]); B[j] = __uint_as_float(s[1]); }
              bitonic_merge16(L, A, B);
#pragma unroll
              for (int j = 0; j < 16; ++j) { auto s = __builtin_amdgcn_permlane32_swap(__float_as_uint(L[j]), __float_as_uint(L[j]), false, false); A[j] = __uint_as_float(s[0]); B[j] = __uint_as_float(s[1]); }
              bitonic_merge16(L, A, B); }
            if (side == 0) {
                if (quad == 0) {
#pragma unroll
                    for (int j = 0; j < 16; ++j) lists[j] = __float_as_uint(L[j]); }
            } else {
#pragma unroll
                for (int j = 0; j < 16; ++j) Lb[j] = L[j];
                if (quad == 0) {
#pragma unroll
                    for (int j = 0; j < 16; ++j) lists[16 + j] = __float_as_uint(L[j]); }
            }
        }

        float C[16];
#pragma unroll
        for (int j = 0; j < 16; ++j) C[j] = -3.0e38f;
#pragma unroll
        for (int r = 0; r < 4; ++r) {
            const float vai = __uint_as_float(lists[4 * r + quad] & ~0x7fu);
            const int irow = 4 * r + quad, len = 16 / (irow + 1);
            constexpr int maxlen[4] = {16, 3, 1, 1};
#pragma unroll
            for (int j = 0; j < maxlen[r]; ++j) { const float s = vai + __uint_as_float(__float_as_uint(Lb[j]) & ~0x7fu);
                const float pkv = __uint_as_float((__float_as_uint(s) & ~0xffu) | (unsigned)(irow * 16 + j));
                ins16(C, j < len ? pkv : -3.0e38f); }
        }
        { float A[16], B[16];
#pragma unroll
          for (int j = 0; j < 16; ++j) { auto s = __builtin_amdgcn_permlane16_swap(__float_as_uint(C[j]), __float_as_uint(C[j]), false, false); A[j] = __uint_as_float(s[0]); B[j] = __uint_as_float(s[1]); }
          bitonic_merge16(C, A, B);
#pragma unroll
          for (int j = 0; j < 16; ++j) { auto s = __builtin_amdgcn_permlane32_swap(__float_as_uint(C[j]), __float_as_uint(C[j]), false, false); A[j] = __uint_as_float(s[0]); B[j] = __uint_as_float(s[1]); }
          bitonic_merge16(C, A, B); }
        const float mx = __uint_as_float(__float_as_uint(C[0]) & ~0xffu);
        float p[16], den = 0.f; int ex[16];
#pragma unroll
        for (int k = 0; k < 16; ++k) { const unsigned cb = __float_as_uint(C[k]); const float sv = __uint_as_float(cb & ~0xffu); p[k] = __expf(sv - mx); den += p[k];
            const unsigned ka = lists[(cb >> 4) & 15] & 0x7fu, kb = lists[16 + (cb & 15)] & 0x7fu; ex[k] = (int)(ka * PNK + kb); }
        const float inv = 1.f / den;
        if (quad == 0) {
            int* ip = idx + (size_t)row * 128 + h * 16; float* gp = gate + (size_t)row * 128 + h * 16;
#pragma unroll
            for (int k = 0; k < 16; k += 4) { *(int4*)(ip + k) = make_int4(ex[k], ex[k + 1], ex[k + 2], ex[k + 3]); *(f32x4*)(gp + k) = (f32x4){p[k] * inv, p[k + 1] * inv, p[k + 2] * inv, p[k + 3] * inv}; }
        }
    }
}
template <int B>
__device__ __forceinline__ void sort16at(float (&v)[64]) {
#define CE(i, j) { const float hi_ = fmaxf(v[B + i], v[B + j]), lo_ = fminf(v[B + i], v[B + j]); v[B + i] = hi_; v[B + j] = lo_; }
    CE(0,1) CE(2,3) CE(0,2) CE(1,3) CE(1,2) CE(4,5) CE(6,7) CE(4,6) CE(5,7) CE(5,6) CE(0,4) CE(2,6) CE(2,4) CE(1,5) CE(3,7) CE(3,5) CE(1,2) CE(3,4) CE(5,6) CE(8,9) CE(10,11) CE(8,10) CE(9,11) CE(9,10) CE(12,13) CE(14,15) CE(12,14) CE(13,15) CE(13,14) CE(8,12) CE(10,14) CE(10,12) CE(9,13) CE(11,15) CE(11,13) CE(9,10) CE(11,12) CE(13,14) CE(0,8) CE(4,12) CE(4,8) CE(2,10) CE(6,14) CE(6,10) CE(2,4) CE(6,8) CE(10,12) CE(1,9) CE(5,13) CE(5,9) CE(3,11) CE(7,15) CE(7,11) CE(3,5) CE(7,9) CE(11,13) CE(1,2) CE(3,4) CE(5,6) CE(7,8) CE(9,10) CE(11,12) CE(13,14)
#undef CE
}
__device__ __forceinline__ void top16of64(float (&v)[64], float (&L)[16]) {
    sort16at<0>(v); sort16at<16>(v); sort16at<32>(v); sort16at<48>(v);
    float A[16], Bv[16], M0[16], M1[16];
#pragma unroll
    for (int j = 0; j < 16; ++j) { A[j] = v[j]; Bv[j] = v[16 + j]; }
    bitonic_merge16(M0, A, Bv);
#pragma unroll
    for (int j = 0; j < 16; ++j) { A[j] = v[32 + j]; Bv[j] = v[48 + j]; }
    bitonic_merge16(M1, A, Bv);
    bitonic_merge16(L, M0, M1);
}
typedef float f32x16 __attribute__((ext_vector_type(16)));
__device__ __forceinline__ void ph_tk32(const bf16* Q, const bf16* keysl, int* idx, float* gate, int nrows, unsigned char* ldsg) { const int tidx = otid();
    const int lane = tidx & 63, w = __builtin_amdgcn_readfirstlane(tidx >> 6), r32 = lane & 31, hh = lane >> 5;
    const lds_cp lds = (lds_cp)ldsg;
    unsigned* lists = (unsigned*)(ldsg + TK_LIST) + (w * 32 + r32) * 32;
    const int nunits = (nrows / 256) * PH;
    int hcur = -1;
    for (int u = blockIdx.x; u < nunits; u += gridDim.x) {
        const int h = u % PH, tile = u / PH;
        __syncthreads();
        if (h != hcur) {
            for (int i = tidx; i < 2 * 128 * 16; i += NT) { const int side = i >> 11, r = (i >> 4) & 127, pc = i & 15;
                *(u32x4*)(ldsg + (side * 128 + r) * TK_KROW + pc * 16) = *(const u32x4*)(keysl + ((size_t)(side * PH + h) * PNK + r) * PKD + pc * 8); }
            hcur = h;
        }
        __syncthreads();
        const int row = tile * 256 + 32 * w + r32;
        float Lb[16];
#pragma unroll
        for (int side = 0; side < 2; ++side) {
            bf16x8 qf[8];
#pragma unroll
            for (int s = 0; s < 8; ++s) qf[s] = *(const bf16x8*)(Q + ((size_t)(((tile * 8 + w) * PH + h) * 2 + side)) * 4096 + s * 512 + hh * 256 + r32 * 8);
            float pv[64];
#pragma unroll
            for (int t = 0; t < 4; ++t) {
                f32x16 acc;
#pragma unroll
                for (int i = 0; i < 16; ++i) acc[i] = 0.f;
#pragma unroll
                for (int s = 0; s < 8; ++s) { const bf16x8 kf = *(const __attribute__((address_space(3))) bf16x8*)(lds + (side * 128 + 32 * t + r32) * TK_KROW + 32 * s + 16 * hh);
                    acc = __builtin_amdgcn_mfma_f32_32x32x16_bf16(kf, qf[s], acc, 0, 0, 0); }
#pragma unroll
                for (int i = 0; i < 16; ++i) { const unsigned key = 32 * t + (i & 3) + 8 * (i >> 2) + 4 * hh; pv[16 * t + i] = __uint_as_float((__float_as_uint(acc[i]) & ~0x7fu) | key); }
            }
            float L[16];
            top16of64(pv, L);
            { float A[16], B[16];
#pragma unroll
              for (int j = 0; j < 16; ++j) { auto s = __builtin_amdgcn_permlane32_swap(__float_as_uint(L[j]), __float_as_uint(L[j]), false, false); A[j] = __uint_as_float(s[0]); B[j] = __uint_as_float(s[1]); }
              bitonic_merge16(L, A, B); }
            if (side == 0) { if (hh == 0) {
#pragma unroll
                    for (int j = 0; j < 16; ++j) lists[j] = __float_as_uint(L[j]); } }
            else {
#pragma unroll
                for (int j = 0; j < 16; ++j) Lb[j] = L[j];
                if (hh == 0) {
#pragma unroll
                    for (int j = 0; j < 16; ++j) lists[16 + j] = __float_as_uint(L[j]); } }
        }
        float C[16];
#pragma unroll
        for (int j = 0; j < 16; ++j) C[j] = -3.0e38f;
#pragma unroll
        for (int r = 0; r < 8; ++r) {
            const float vai = __uint_as_float(lists[2 * r + hh] & ~0x7fu);
            const int irow = 2 * r + hh, len = 16 / (irow + 1);
            constexpr int maxlen[8] = {16, 5, 3, 2, 1, 1, 1, 1};
#pragma unroll
            for (int j = 0; j < maxlen[r]; ++j) { const float s = vai + __uint_as_float(__float_as_uint(Lb[j]) & ~0x7fu);
                const float pkv = __uint_as_float((__float_as_uint(s) & ~0xffu) | (unsigned)(irow * 16 + j));
                ins16(C, j < len ? pkv : -3.0e38f); }
        }
        { float A[16], B[16];
#pragma unroll
          for (int j = 0; j < 16; ++j) { auto s = __builtin_amdgcn_permlane32_swap(__float_as_uint(C[j]), __float_as_uint(C[j]), false, false); A[j] = __uint_as_float(s[0]); B[j] = __uint_as_float(s[1]); }
          bitonic_merge16(C, A, B); }
        const float mx = __uint_as_float(__float_as_uint(C[0]) & ~0xffu);
        float p[16], den = 0.f; int ex[16];
#pragma unroll
        for (int k = 0; k < 16; ++k) { const unsigned cb = __float_as_uint(C[k]); const float sv = __uint_as_float(cb & ~0xffu); p[k] = __expf(sv - mx); den += p[k];
            const unsigned ka = lists[(cb >> 4) & 15] & 0x7fu, kb = lists[16 + (cb & 15)] & 0x7fu; ex[k] = (int)(ka * PNK + kb); }
        const float inv = 1.f / den;
        if (hh == 0) {
            int* ip = idx + (size_t)row * 128 + h * 16; float* gp = gate + (size_t)row * 128 + h * 16;
#pragma unroll
            for (int k = 0; k < 16; k += 4) { *(int4*)(ip + k) = make_int4(ex[k], ex[k + 1], ex[k + 2], ex[k + 3]); *(f32x4*)(gp + k) = (f32x4){p[k] * inv, p[k + 1] * inv, p[k + 2] * inv, p[k + 3] * inv}; }
        }
    }
}
__device__ __forceinline__ float dot16(const float (&hx)[16], const bf16x8 a, const bf16x8 b) {
    float s = 0.f;
#pragma unroll
    for (int j = 0; j < 8; ++j) s += hx[j] * bf2f((bf16)a[j]) + hx[8 + j] * bf2f((bf16)b[j]);
    return s;
}
template <bool FINAL>
__device__ __forceinline__ void ph_peer(const bf16* act, const int* idx, const float* gate, const bf16* U, const bf16* V, const float* modl, int off_g,
                                        float* xlat, float* xctx, const float* fw, int nrows) { const int tidx = otid();
    const int lane = tidx & 63, wave = tidx >> 6;
    for (int row = blockIdx.x * 8 + wave; row < nrows; row += gridDim.x * 8) {
        float hx[16];
        { const bf16x8 a = *(const bf16x8*)(act + (size_t)row * D + lane * 8), b = *(const bf16x8*)(act + (size_t)row * D + 512 + lane * 8);
#pragma unroll
          for (int j = 0; j < 8; ++j) { hx[j] = bf2f((bf16)a[j]); hx[8 + j] = bf2f((bf16)b[j]); } }
        const int myi0 = idx[(size_t)row * 128 + lane], myi1 = idx[(size_t)row * 128 + 64 + lane];
        const float myg0 = gate[(size_t)row * 128 + lane], myg1 = gate[(size_t)row * 128 + 64 + lane];
        float a0 = 0.f, a1 = 0.f;
        for (int base = 0; base < 128; base += 8) {
            bf16x8 ua[8], ub[8];
#pragma unroll
            for (int j = 0; j < 8; ++j) { const int e = rl_i(base < 64 ? myi0 : myi1, (base + j) & 63); const bf16* up = U + (size_t)e * D; ua[j] = *(const bf16x8*)(up + lane * 8); ub[j] = *(const bf16x8*)(up + 512 + lane * 8); }
#pragma unroll
            for (int j = 0; j < 8; ++j) { const float s = wave_sum(dot16(hx, ua[j], ub[j])); if (lane == ((base + j) & 63)) { if (base < 64) a0 = s; else a1 = s; } }
        }
        const float w0 = myg0 * 0.5f * a0 * (1.f + erff(a0 * 0.70710678f)), w1 = myg1 * 0.5f * a1 * (1.f + erff(a1 * 0.70710678f));
        float out[16];
#pragma unroll
        for (int j = 0; j < 16; ++j) out[j] = 0.f;
        for (int base = 0; base < 128; base += 8) {
            bf16x8 va[8], vb[8];
#pragma unroll
            for (int j = 0; j < 8; ++j) { const int e = rl_i(base < 64 ? myi0 : myi1, (base + j) & 63); const bf16* vp = V + (size_t)e * D; va[j] = *(const bf16x8*)(vp + lane * 8); vb[j] = *(const bf16x8*)(vp + 512 + lane * 8); }
#pragma unroll
            for (int j = 0; j < 8; ++j) { const float w = rl_f(base < 64 ? w0 : w1, (base + j) & 63);
#pragma unroll
                for (int q = 0; q < 8; ++q) { out[q] += w * bf2f((bf16)va[j][q]); out[8 + q] += w * bf2f((bf16)vb[j][q]); } }
        }
        const int mi = row < M_LAT ? row / S : 4;
        float* xr = row < M_LAT ? xlat + (size_t)row * D : xctx + (size_t)(row - M_LAT) * D;
        const float* g2 = modl + (size_t)mi * 6 * D + off_g;
        float xn[16]; float ss = 0.f;
#pragma unroll
        for (int hlf = 0; hlf < 2; ++hlf) { const int k = hlf * 512 + lane * 8;
            const f32x4 x0 = *(const f32x4*)(xr + k), x1 = *(const f32x4*)(xr + k + 4), g0 = *(const f32x4*)(g2 + k), g1 = *(const f32x4*)(g2 + k + 4);
            xn[hlf * 8 + 0] = x0.x + g0.x * out[hlf * 8 + 0]; xn[hlf * 8 + 1] = x0.y + g0.y * out[hlf * 8 + 1]; xn[hlf * 8 + 2] = x0.z + g0.z * out[hlf * 8 + 2]; xn[hlf * 8 + 3] = x0.w + g0.w * out[hlf * 8 + 3];
            xn[hlf * 8 + 4] = x1.x + g1.x * out[hlf * 8 + 4]; xn[hlf * 8 + 5] = x1.y + g1.y * out[hlf * 8 + 5]; xn[hlf * 8 + 6] = x1.z + g1.z * out[hlf * 8 + 6]; xn[hlf * 8 + 7] = x1.w + g1.w * out[hlf * 8 + 7]; }
#pragma unroll
        for (int j = 0; j < 16; ++j) ss += xn[j] * xn[j];
        float rs = 1.f;
        if (FINAL) { ss = wave_sum(ss); rs = rsqrtf(ss * (1.f / D) + EPS); }
#pragma unroll
        for (int hlf = 0; hlf < 2; ++hlf) { const int k = hlf * 512 + lane * 8;
            f32x4 o0, o1;
            if (FINAL) { const f32x4 f0 = *(const f32x4*)(fw + k), f1 = *(const f32x4*)(fw + k + 4);
                o0 = (f32x4){xn[hlf * 8 + 0] * rs * f0.x, xn[hlf * 8 + 1] * rs * f0.y, xn[hlf * 8 + 2] * rs * f0.z, xn[hlf * 8 + 3] * rs * f0.w};
                o1 = (f32x4){xn[hlf * 8 + 4] * rs * f1.x, xn[hlf * 8 + 5] * rs * f1.y, xn[hlf * 8 + 6] * rs * f1.z, xn[hlf * 8 + 7] * rs * f1.w}; }
            else { o0 = (f32x4){xn[hlf * 8 + 0], xn[hlf * 8 + 1], xn[hlf * 8 + 2], xn[hlf * 8 + 3]}; o1 = (f32x4){xn[hlf * 8 + 4], xn[hlf * 8 + 5], xn[hlf * 8 + 6], xn[hlf * 8 + 7]}; }
            *(f32x4*)(xr + k) = o0; *(f32x4*)(xr + k + 4) = o1; }
    }
}


__device__ __forceinline__ void ph_quant(const float* src, unsigned char* dst, float* scl, int nrows, int offs  ) { const int tidx = otid();
    const int lane = tidx & 63, wave = tidx >> 6;
    for (int row0 = (blockIdx.x * 8 + wave) * 4; row0 < nrows; row0 += gridDim.x * 8 * 4) {
        f32x4 v[4][4];
#pragma unroll
        for (int r = 0; r < 4; ++r)
#pragma unroll
            for (int j = 0; j < 4; ++j) v[r][j] = *(const f32x4*)(src + (size_t)(row0 + r) * D + lane * 16 + 4 * j);
#pragma unroll
        for (int r = 0; r < 4; ++r) {
            float am = 0.f;
#pragma unroll
            for (int j = 0; j < 4; ++j) am = fmaxf(am, fmaxf(fmaxf(fabsf(v[r][j].x), fabsf(v[r][j].y)), fmaxf(fabsf(v[r][j].z), fabsf(v[r][j].w))));
            am = wave_max(am);
            const float sc = am > 0.f ? am * (1.f / 127.f) : 1.f, inv = 1.f / sc;
            u32x4 o;
#pragma unroll
            for (int j = 0; j < 4; ++j) { const int q0 = (int)rintf(v[r][j].x * inv) + offs, q1 = (int)rintf(v[r][j].y * inv) + offs, q2 = (int)rintf(v[r][j].z * inv) + offs, q3 = (int)rintf(v[r][j].w * inv) + offs;
                o[j] = (unsigned)(q0 & 0xff) | ((unsigned)(q1 & 0xff) << 8) | ((unsigned)(q2 & 0xff) << 16) | ((unsigned)(q3 & 0xff) << 24); }
            *(u32x4*)(dst + (size_t)(row0 + r) * D + lane * 16) = o;
            if (lane == 0) scl[row0 + r] = sc;
        }
    }
}
__device__ __forceinline__ void ph_quant_w(const bf16* src, unsigned char* dst, float* scl, int nrows) { const int tidx = otid();
    const int lane = tidx & 63, wave = tidx >> 6;
    for (int row0 = (blockIdx.x * 8 + wave) * 2; row0 < nrows; row0 += gridDim.x * 16) {
        bf16x8 a[2][2];
#pragma unroll
        for (int r = 0; r < 2; ++r) { a[r][0] = *(const bf16x8*)(src + (size_t)(row0 + r) * D + lane * 16); a[r][1] = *(const bf16x8*)(src + (size_t)(row0 + r) * D + lane * 16 + 8); }
#pragma unroll
        for (int r = 0; r < 2; ++r) { float f[16]; float am = 0.f;
#pragma unroll
            for (int j = 0; j < 8; ++j) { f[j] = bf2f((bf16)a[r][0][j]); f[8 + j] = bf2f((bf16)a[r][1][j]); am = fmaxf(am, fmaxf(fabsf(f[j]), fabsf(f[8 + j]))); }
            am = wave_max(am); const float sc = am > 0.f ? am * (1.f / 127.f) : 1.f, inv = 1.f / sc;
            u32x4 o;
#pragma unroll
            for (int j = 0; j < 4; ++j) { const int q0 = (int)rintf(f[4 * j] * inv), q1 = (int)rintf(f[4 * j + 1] * inv), q2 = (int)rintf(f[4 * j + 2] * inv), q3 = (int)rintf(f[4 * j + 3] * inv);
                o[j] = (unsigned)(q0 & 0xff) | ((unsigned)(q1 & 0xff) << 8) | ((unsigned)(q2 & 0xff) << 16) | ((unsigned)(q3 & 0xff) << 24); }
            *(u32x4*)(dst + (size_t)(row0 + r) * D + lane * 16) = o;
            if (lane == 0) scl[row0 + r] = sc; }
    }
}
__device__ __forceinline__ int xreduce64(int (&p)[64], int lane) {
#pragma unroll
    for (int k = 0; k < 32; ++k) { auto r = __builtin_amdgcn_permlane32_swap((unsigned)p[k], (unsigned)p[k + 32], false, false); p[k] = (int)(r[0] + r[1]); }
#pragma unroll
    for (int k = 0; k < 16; ++k) { auto r = __builtin_amdgcn_permlane16_swap((unsigned)p[k], (unsigned)p[k + 16], false, false); p[k] = (int)(r[0] + r[1]); }
#define XR_STEP(n, M) _Pragma("unroll") for (int k = 0; k < (n) / 2; ++k) { const bool up = (lane & (M)) != 0; const int send = up ? p[k] : p[k + (n) / 2], keep = up ? p[k + (n) / 2] : p[k]; \
        p[k] = keep + __builtin_amdgcn_ds_swizzle(send, ((M) << 10) | 0x1f); }
    XR_STEP(16, 8) XR_STEP(8, 4) XR_STEP(4, 2) XR_STEP(2, 1)
#undef XR_STEP
    return p[0];
}
template <int MODE  >
__device__ __forceinline__ void ph_peer8(bf16* act, const int* idx, const float* gate, const unsigned char* U8, const unsigned char* V8, const float* SU, const float* SV,
                                         const float* modl, int off_g, bf16* xlat, bf16* xctx, float* outf, const float* fw, const float* modn, int nrows) { const int tidx = otid();
    constexpr bool FINAL = (MODE == 2);
    const int lane = tidx & 63, wave = tidx >> 6;
    for (int row = blockIdx.x * 8 + wave; row < nrows; row += gridDim.x * 8) {
        int xq[4]; float sx;
        { const bf16x8 a = *(const bf16x8*)(act + (size_t)row * D + lane * 16), b = *(const bf16x8*)(act + (size_t)row * D + lane * 16 + 8);
          float hx[16]; float am = 0.f;
#pragma unroll
          for (int j = 0; j < 8; ++j) { hx[j] = bf2f((bf16)a[j]); hx[8 + j] = bf2f((bf16)b[j]); am = fmaxf(am, fmaxf(fabsf(hx[j]), fabsf(hx[8 + j]))); }
          am = wave_max(am); sx = am > 0.f ? am * (1.f / 127.f) : 1.f; const float inv = 1.f / sx;
#pragma unroll
          for (int j = 0; j < 4; ++j) { const int q0 = (int)rintf(hx[4 * j] * inv), q1 = (int)rintf(hx[4 * j + 1] * inv), q2 = (int)rintf(hx[4 * j + 2] * inv), q3 = (int)rintf(hx[4 * j + 3] * inv);
              xq[j] = (int)((unsigned)(q0 & 0xff) | ((unsigned)(q1 & 0xff) << 8) | ((unsigned)(q2 & 0xff) << 16) | ((unsigned)(q3 & 0xff) << 24)); } }
        const int myi0 = idx[(size_t)row * 128 + lane], myi1 = idx[(size_t)row * 128 + 64 + lane];
        const float myg0 = gate[(size_t)row * 128 + lane], myg1 = gate[(size_t)row * 128 + 64 + lane];
        const float su0 = SU[myi0], su1 = SU[myi1], sv0 = SV[myi0], sv1 = SV[myi1];
        float wgt[2];
#pragma unroll
        for (int hf = 0; hf < 2; ++hf) {
            int p[64];
#pragma unroll
            for (int base = 0; base < 64; base += 16) {
                u32x4 ub[16];
#pragma unroll
                for (int j = 0; j < 16; ++j) { const int e = rl_i(hf ? myi1 : myi0, base + j); ub[j] = *(const u32x4*)(U8 + (size_t)e * D + lane * 16); }
#pragma unroll
                for (int j = 0; j < 16; ++j) { int s = __builtin_amdgcn_sdot4((int)ub[j].x, xq[0], 0, false); s = __builtin_amdgcn_sdot4((int)ub[j].y, xq[1], s, false);
                    s = __builtin_amdgcn_sdot4((int)ub[j].z, xq[2], s, false); p[base + j] = __builtin_amdgcn_sdot4((int)ub[j].w, xq[3], s, false); }
            }
            const float a = (float)xreduce64(p, lane) * sx * (hf ? su1 : su0);
            wgt[hf] = (hf ? myg1 * sv1 : myg0 * sv0) * 0.5f * a * (1.f + erff(a * 0.70710678f));
        }
        float out[16];
#pragma unroll
        for (int j = 0; j < 16; ++j) out[j] = 0.f;
#pragma unroll 1
        for (int base = 0; base < 128; base += 16) {
            u32x4 vb[16];
#pragma unroll
            for (int j = 0; j < 16; ++j) { const int e = rl_i(base < 64 ? myi0 : myi1, (base + j) & 63); vb[j] = *(const u32x4*)(V8 + (size_t)e * D + lane * 16); }
#pragma unroll
            for (int j = 0; j < 16; ++j) { const float wv = rl_f(base < 64 ? wgt[0] : wgt[1], (base + j) & 63);
#pragma unroll
                for (int q = 0; q < 4; ++q) { const unsigned dw = vb[j][q];
                    out[4 * q + 0] += wv * (float)((int)(dw << 24) >> 24); out[4 * q + 1] += wv * (float)((int)(dw << 16) >> 24); out[4 * q + 2] += wv * (float)((int)(dw << 8) >> 24); out[4 * q + 3] += wv * (float)((int)dw >> 24); } }
        }
        const int mi = row < M_LAT ? row / S : 4;
        bf16* xr = (row < M_LAT ? xlat + (size_t)row * D : xctx + (size_t)(row - M_LAT) * D) + lane * 16;
        const float* g2 = modl + (size_t)mi * 6 * D + off_g + lane * 16;
        float xn[16]; float ss = 0.f;
#pragma unroll
        for (int q = 0; q < 4; ++q) { const f32x4 x0 = ld4res<true>(xr, 4 * q), g0 = *(const f32x4*)(g2 + 4 * q);
            xn[4 * q + 0] = bf2f(f2bf(x0.x + g0.x * out[4 * q + 0])); xn[4 * q + 1] = bf2f(f2bf(x0.y + g0.y * out[4 * q + 1]));
            xn[4 * q + 2] = bf2f(f2bf(x0.z + g0.z * out[4 * q + 2])); xn[4 * q + 3] = bf2f(f2bf(x0.w + g0.w * out[4 * q + 3])); }
#pragma unroll
        for (int j = 0; j < 16; ++j) ss += xn[j] * xn[j];
        float rs = 1.f;
        if (MODE != 0) { ss = wave_sum(ss); rs = rsqrtf(ss * (1.f / D) + EPS); }
#pragma unroll
        for (int q = 0; q < 4; ++q) {
            if (FINAL) { const f32x4 f0 = *(const f32x4*)(fw + lane * 16 + 4 * q); *(f32x4*)(outf + (size_t)row * D + lane * 16 + 4 * q) = (f32x4){xn[4 * q] * rs * f0.x, xn[4 * q + 1] * rs * f0.y, xn[4 * q + 2] * rs * f0.z, xn[4 * q + 3] * rs * f0.w}; }
            else st4res(xr, 4 * q, (f32x4){xn[4 * q], xn[4 * q + 1], xn[4 * q + 2], xn[4 * q + 3]}); }
        if (MODE == 1) {
            const float* sh = modn + (size_t)mi * 6 * D + lane * 16; const float* sc = sh + D; const float* nw = fw + lane * 16;
            u32x4 o0, o1; unsigned pk[8];
#pragma unroll
            for (int q = 0; q < 4; ++q) { const f32x4 w4 = *(const f32x4*)(nw + 4 * q), a4 = *(const f32x4*)(sc + 4 * q), b4 = *(const f32x4*)(sh + 4 * q);
                pk[2 * q] = pg8::cvt_pk_bf16(xn[4 * q] * rs * w4.x * (1.f + a4.x) + b4.x, xn[4 * q + 1] * rs * w4.y * (1.f + a4.y) + b4.y);
                pk[2 * q + 1] = pg8::cvt_pk_bf16(xn[4 * q + 2] * rs * w4.z * (1.f + a4.z) + b4.z, xn[4 * q + 3] * rs * w4.w * (1.f + a4.w) + b4.w); }
            o0 = (u32x4){pk[0], pk[1], pk[2], pk[3]}; o1 = (u32x4){pk[4], pk[5], pk[6], pk[7]};
            *(u32x4*)(act + (size_t)row * D + lane * 16) = o0; *(u32x4*)(act + (size_t)row * D + lane * 16 + 8) = o1;
        }
    }
}

constexpr int PSA_ENT_MAX = 512;
constexpr int PSA_XQ = 0, PSA_ENT = 135168, PSA_ENT_BYTES = 2048, PSA_SX = PSA_ENT + 8 * PSA_ENT_BYTES;
constexpr int PSA_HIST = 152576, PSA_WTOT = PSA_HIST + 8192, PSA_SORT_MAX = 4096;
static_assert(PSA_SX + 132 * 4 <= PSA_HIST && PSA_WTOT + 64 <= LDS_BYTES - 64, "sweep A LDS map");
constexpr int PSB_IDX = 0, PSB_WQ = 33792, PSB_SW = PSB_WQ + 132 * 128, PSB_SS = PSB_SW + 1024;
#ifndef PEER_NSLAB
#define PEER_NSLAB 8
#endif
#ifndef PEER_PSH
static_assert(true, "");
#define PEER_SORTA 1
#define PEER_PSH 11
#endif
__device__ __forceinline__ int reduce32i(int (&p)[32], int lane) {
#pragma unroll
    for (int k = 0; k < 16; ++k) { auto r = __builtin_amdgcn_permlane32_swap((unsigned)p[k], (unsigned)p[k + 16], false, false); p[k] = (int)(r[0] + r[1]); }
#pragma unroll
    for (int k = 0; k < 8; ++k) { auto r = __builtin_amdgcn_permlane16_swap((unsigned)p[k], (unsigned)p[k + 8], false, false); p[k] = (int)(r[0] + r[1]); }
    { const bool up = (lane & 8) != 0;
#pragma unroll
      for (int k = 0; k < 4; ++k) { const int send = up ? p[k] : p[k + 4], keep = up ? p[k + 4] : p[k]; p[k] = keep + __builtin_amdgcn_ds_swizzle(send, (8 << 10) | 0x1f); } }
    { const bool up = (lane & 4) != 0;
#pragma unroll
      for (int k = 0; k < 2; ++k) { const int send = up ? p[k] : p[k + 2], keep = up ? p[k + 2] : p[k]; p[k] = keep + __builtin_amdgcn_ds_swizzle(send, (4 << 10) | 0x1f); } }
    { const bool up = (lane & 2) != 0; const int send = up ? p[0] : p[1], keep = up ? p[1] : p[0]; p[0] = keep + __builtin_amdgcn_ds_swizzle(send, (2 << 10) | 0x1f); }
    p[0] += __builtin_amdgcn_ds_swizzle(p[0], (1 << 10) | 0x1f);
    return p[0];
}
template <int LPS>
__device__ __forceinline__ void reduce16r(int (&p)[16], int lane) {
#pragma unroll
    for (int k = 0; k < 8; ++k) { auto r = __builtin_amdgcn_permlane32_swap((unsigned)p[k], (unsigned)p[k + 8], false, false); p[k] = (int)(r[0] + r[1]); }
#pragma unroll
    for (int k = 0; k < 4; ++k) { auto r = __builtin_amdgcn_permlane16_swap((unsigned)p[k], (unsigned)p[k + 4], false, false); p[k] = (int)(r[0] + r[1]); }
    { const bool up = (lane & 8) != 0;
#pragma unroll
      for (int k = 0; k < 2; ++k) { const int send = up ? p[k] : p[k + 2], keep = up ? p[k + 2] : p[k]; p[k] = keep + __builtin_amdgcn_ds_swizzle(send, (8 << 10) | 0x1f); } }
    if (LPS == 4) { const bool up = (lane & 4) != 0; const int send = up ? p[0] : p[1], keep = up ? p[1] : p[0]; p[0] = keep + __builtin_amdgcn_ds_swizzle(send, (4 << 10) | 0x1f); }
}
template <int MODE  >
__device__ __forceinline__ void ph_peer_sweep(const int* idx, const float* gate, const unsigned char* U8, const unsigned char* V8, const float* SU, const float* SV, const unsigned char* XQ, const float* XS,
                                              float* AW  , const float* modl, int off_g, bf16* xlat, bf16* xctx, float* outf  , const float* nw, const float* modn, unsigned char* xqo, float* xso, int nrows, unsigned char* ldsg) { const int tidx = otid();
    const int lane = tidx & 63, wave = __builtin_amdgcn_readfirstlane(tidx >> 6);
    const int TPW = nrows / (int)gridDim.x, row0 = (int)blockIdx.x * TPW;
    const int J = (TPW - wave + 7) / 8;
    __syncthreads();
    unsigned* ent = (unsigned*)(ldsg + PSA_ENT + wave * PSA_ENT_BYTES); float* sxs = (float*)(ldsg + PSA_SX);
    for (int j = 0; j < J; ++j) { const int tl = wave + 8 * j; *(u32x4*)(ldsg + PSA_XQ + tl * 1024 + lane * 16) = *(const u32x4*)(XQ + (size_t)(row0 + tl) * D + lane * 16); if (lane == 0) sxs[tl] = XS[row0 + tl]; }
    unsigned iab[17];
#pragma unroll
    for (int j = 0; j < 17; ++j) { if (j < J) { const size_t r = (size_t)(row0 + wave + 8 * j) * 128; iab[j] = (unsigned)idx[r + lane] | ((unsigned)idx[r + 64 + lane] << 16); } else iab[j] = 0xffffffffu; }
#if PEER_SORTA
    unsigned* hist = (unsigned*)(ldsg + PSA_HIST); unsigned* srt = (unsigned*)(ldsg + PSA_ENT); unsigned* wtot = (unsigned*)(ldsg + PSA_WTOT);
    ((u32x4*)hist)[tidx] = (u32x4){0u, 0u, 0u, 0u};
    __syncthreads();
#endif
#define IA(j) ((int)(iab[j] & 0xffffu))
#define IB(j) ((int)(iab[j] >> 16))
#pragma unroll 1
    for (int p = 0; p < (NEXP >> PEER_PSH); ++p) {
        const unsigned* lst = ent; int n = 0, cstart = 0, cstride = 32, nov = 0;
#pragma unroll
        for (int j = 0; j < 17; ++j) asm volatile("" : "+v"(iab[j]));
        unsigned lane_o = (unsigned)lane; asm volatile("" : "+v"(lane_o));
#if PEER_SORTA
#pragma unroll
        for (int j = 0; j < 17; ++j) {
            if ((IA(j) >> PEER_PSH) == p) atomicAdd(&hist[IA(j) & 2047], 1u);
            if ((IB(j) >> PEER_PSH) == p) atomicAdd(&hist[IB(j) & 2047], 1u);
        }
        __syncthreads();
        const u32x4 hh4 = ((const u32x4*)hist)[tidx];
        const unsigned hs = hh4.x + hh4.y + hh4.z + hh4.w; unsigned inc = hs;
#pragma unroll
        for (int d = 1; d < 64; d <<= 1) { const unsigned t = (unsigned)__shfl_up((int)inc, d); if (lane >= d) inc += t; }
        if (lane == 63) wtot[wave] = inc;
        __syncthreads();
        unsigned wbase = 0, NS = 0;
#pragma unroll
        for (int w2 = 0; w2 < 8; ++w2) { const unsigned t = wtot[w2]; NS += t; if (w2 < wave) wbase += t; }
        NS = (unsigned)__builtin_amdgcn_readfirstlane((int)NS); wbase = (unsigned)__builtin_amdgcn_readfirstlane((int)wbase);
        { const unsigned ex = wbase + inc - hs; u32x4 o; o.x = ex; o.y = ex + hh4.x; o.z = o.y + hh4.y; o.w = o.z + hh4.z; ((u32x4*)hist)[tidx] = o; }
        __syncthreads();
        if (NS <= (unsigned)PSA_SORT_MAX) {
#pragma unroll
            for (int j = 0; j < 17; ++j) {
                if ((IA(j) >> PEER_PSH) == p) { const unsigned pos = atomicAdd(&hist[IA(j) & 2047], 1u); srt[pos] = (unsigned)IA(j) | (lane_o << 14) | ((unsigned)(wave + 8 * j) << 21); }
                if ((IB(j) >> PEER_PSH) == p) { const unsigned pos = atomicAdd(&hist[IB(j) & 2047], 1u); srt[pos] = (unsigned)IB(j) | ((64u + lane_o) << 14) | ((unsigned)(wave + 8 * j) << 21); }
            }
            __syncthreads();
            ((u32x4*)hist)[tidx] = (u32x4){0u, 0u, 0u, 0u};
            lst = srt; n = (int)NS; cstart = wave * 32; cstride = 256;
        } else {
        ((u32x4*)hist)[tidx] = (u32x4){0u, 0u, 0u, 0u};
#endif
#pragma unroll
        for (int j = 0; j < 17; ++j) {
            const bool in0 = (IA(j) >> PEER_PSH) == p, in1 = (IB(j) >> PEER_PSH) == p;
            const unsigned long long m0 = __ballot(in0), m1 = __ballot(in1);
            const int c0 = __popcll(m0), c1 = __popcll(m1);
            const int r0 = n + (int)__builtin_amdgcn_mbcnt_hi((unsigned)(m0 >> 32), __builtin_amdgcn_mbcnt_lo((unsigned)m0, 0u));
            const int r1 = n + c0 + (int)__builtin_amdgcn_mbcnt_hi((unsigned)(m1 >> 32), __builtin_amdgcn_mbcnt_lo((unsigned)m1, 0u));
            if (in0 && r0 < PSA_ENT_MAX) ent[r0] = (unsigned)IA(j) | (lane_o << 14) | ((unsigned)(wave + 8 * j) << 21);
            if (in1 && r1 < PSA_ENT_MAX) ent[r1] = (unsigned)IB(j) | ((64u + lane_o) << 14) | ((unsigned)(wave + 8 * j) << 21);
            n += c0 + c1;
        }
        nov = n;
        n = min(n, PSA_ENT_MAX);
#if PEER_SORTA
        }
#endif
        {
#pragma unroll 1
            for (int base = cstart; base < n; base += cstride) {
                const unsigned myent = lst[min(base + (lane & 31), n - 1)];
                u32x4 ub[32];
#pragma unroll
                for (int q = 0; q < 32; ++q) { const unsigned ej = (unsigned)rl_i((int)myent, q); ub[q] = *(const u32x4*)(U8 + (size_t)(ej & 0x3fffu) * D + lane * 16); }
                int ps[32];
#pragma unroll
                for (int q = 0; q < 32; ++q) { const int tq = (int)((unsigned)rl_i((int)myent, q) >> 21); const u32x4 xv = *(const u32x4*)(ldsg + PSA_XQ + tq * 1024 + lane * 16);
                    int s = __builtin_amdgcn_sdot4((int)ub[q].x, (int)xv.x, 0, false); s = __builtin_amdgcn_sdot4((int)ub[q].y, (int)xv.y, s, false);
                    s = __builtin_amdgcn_sdot4((int)ub[q].z, (int)xv.z, s, false); ps[q] = __builtin_amdgcn_sdot4((int)ub[q].w, (int)xv.w, s, false); }
                const int tot = reduce32i(ps, lane);
                const int slot = lane >> 1;
                if ((lane & 1) == 0 && base + slot < n) { const unsigned en = lst[base + slot]; const int tl = (int)(en >> 21), pos = (int)((en >> 14) & 127u);
                    AW[(size_t)(row0 + tl) * 128 + pos] = (float)tot * sxs[tl]; }
            }
        }
        if (nov > PSA_ENT_MAX) {
            int cnt = 0;
#pragma unroll 1
            for (int j = 0; j < J; ++j) { const size_t r = (size_t)(row0 + wave + 8 * j) * 128;
#pragma unroll 1
                for (int pos = 0; pos < 128; ++pos) { const int e = idx[r + pos];
                    if ((e >> PEER_PSH) == p) { if (cnt >= PSA_ENT_MAX) { const u32x4 uv = *(const u32x4*)(U8 + (size_t)e * D + lane * 16), xv = *(const u32x4*)(ldsg + PSA_XQ + (wave + 8 * j) * 1024 + lane * 16);
                            int s = __builtin_amdgcn_sdot4((int)uv.x, (int)xv.x, 0, false); s = __builtin_amdgcn_sdot4((int)uv.y, (int)xv.y, s, false); s = __builtin_amdgcn_sdot4((int)uv.z, (int)xv.z, s, false); s = __builtin_amdgcn_sdot4((int)uv.w, (int)xv.w, s, false);
                            const float a = wave_sum((float)s); if (lane == 0) AW[r + pos] = a * sxs[wave + 8 * j]; }
                        ++cnt; } } }
        }
        __syncthreads();
    }
    unsigned short* idxs = (unsigned short*)(ldsg + PSB_IDX); unsigned char* wqb = ldsg + PSB_WQ; float* sws = (float*)(ldsg + PSB_SW); float* ssl = (float*)(ldsg + PSB_SS);
    constexpr int LPS = 64 / PEER_NSLAB, RR = 64 / LPS, NK = 128 / RR, NG = NK / 4;
#pragma unroll
    for (int jb = 0; jb < 18; jb += 3) {
        float aw0[3], aw1[3], g0[3], g1[3], su0[3], su1[3], sv0[3], sv1[3];
#pragma unroll
        for (int q = 0; q < 3; ++q) { const int j = jb + q; if (j < 17 && j < J) { const size_t r = (size_t)(row0 + wave + 8 * j) * 128;
            aw0[q] = AW[r + lane]; aw1[q] = AW[r + 64 + lane]; g0[q] = gate[r + lane]; g1[q] = gate[r + 64 + lane];
            su0[q] = SU[IA(j)]; su1[q] = SU[IB(j)]; sv0[q] = SV[IA(j)]; sv1[q] = SV[IB(j)]; } }
#pragma unroll
        for (int q = 0; q < 3; ++q) { const int j = jb + q; if (j < 17 && j < J) { const int tl = wave + 8 * j;
            const float a0 = aw0[q] * su0[q], a1 = aw1[q] * su1[q];
            const float w0 = g0[q] * sv0[q] * 0.5f * a0 * (1.f + erff(a0 * 0.70710678f)), w1 = g1[q] * sv1[q] * 0.5f * a1 * (1.f + erff(a1 * 0.70710678f));
            const float wm = wave_max(fmaxf(fabsf(w0), fabsf(w1))); const float sw = wm > 0.f ? wm * (1.f / 127.f) : 1.f, inv = 1.f / sw;
            const int q0 = (int)rintf(w0 * inv), q1 = (int)rintf(w1 * inv);
            { const int pos = lane, k = pos / RR, rr = pos % RR; wqb[tl * 128 + ((k >> 2) * RR + rr) * 4 + (k & 3)] = (unsigned char)(q0 & 0xff); }
            { const int pos = 64 + lane, k = pos / RR, rr = pos % RR; wqb[tl * 128 + ((k >> 2) * RR + rr) * 4 + (k & 3)] = (unsigned char)(q1 & 0xff); }
            idxs[tl * 128 + lane] = (unsigned short)IA(j); idxs[tl * 128 + 64 + lane] = (unsigned short)IB(j);
            if (lane == 0) sws[tl] = sw; ssl[tl * 64 + lane] = 0.f; } }
    }
    __syncthreads();
    const int rr = lane / LPS, cc = lane % LPS;
    constexpr int NREPB = ((DUP_MASK >> 10) & 1) ? 2 : 1; constexpr float WSC = 1.f / NREPB;
    constexpr int TB = (NK == 8) ? 4 : 2;
    for (int repB = 0; repB < NREPB; ++repB)
#pragma unroll 1
    for (int s = 0; s < PEER_NSLAB; ++s) {
#pragma unroll 1
        for (int jg = 0; jg < J; jg += TB) {
            u32x4 vb[TB][NK];
#pragma unroll
            for (int q = 0; q < TB; ++q) if (jg + q < J) { const int tl = wave + 8 * (jg + q);
#pragma unroll
                for (int k = 0; k < NK; ++k) { const int e = idxs[tl * 128 + RR * k + rr]; vb[q][k] = *(const u32x4*)(V8 + (size_t)e * D + s * (LPS * 16) + cc * 16); } }
#pragma unroll
            for (int q = 0; q < TB; ++q) if (jg + q < J) { const int tl = wave + 8 * (jg + q), row = row0 + tl;
                int acc[16];
#pragma unroll
                for (int c = 0; c < 16; ++c) acc[c] = 0;
#pragma unroll
                for (int gq = 0; gq < NG; ++gq) { const int wq = *(const int*)(wqb + tl * 128 + (gq * RR + rr) * 4);
#pragma unroll
                    for (int d4 = 0; d4 < 4; ++d4) { const unsigned a = vb[q][4 * gq][d4], b = vb[q][4 * gq + 1][d4], c = vb[q][4 * gq + 2][d4], d = vb[q][4 * gq + 3][d4];
                        const unsigned x0 = __builtin_amdgcn_perm(b, a, 0x05010400u), x1 = __builtin_amdgcn_perm(b, a, 0x07030602u), y0 = __builtin_amdgcn_perm(d, c, 0x05010400u), y1 = __builtin_amdgcn_perm(d, c, 0x07030602u);
                        acc[4 * d4 + 0] = __builtin_amdgcn_sdot4((int)__builtin_amdgcn_perm(y0, x0, 0x05040100u), wq, acc[4 * d4 + 0], false);
                        acc[4 * d4 + 1] = __builtin_amdgcn_sdot4((int)__builtin_amdgcn_perm(y0, x0, 0x07060302u), wq, acc[4 * d4 + 1], false);
                        acc[4 * d4 + 2] = __builtin_amdgcn_sdot4((int)__builtin_amdgcn_perm(y1, x1, 0x05040100u), wq, acc[4 * d4 + 2], false);
                        acc[4 * d4 + 3] = __builtin_amdgcn_sdot4((int)__builtin_amdgcn_perm(y1, x1, 0x07060302u), wq, acc[4 * d4 + 3], false); } }
                reduce16r<LPS>(acc, lane);
                const float sc = sws[tl] * WSC;
                const int mi = row < M_LAT ? row / S : 4;
                bf16* xrow = row < M_LAT ? xlat + (size_t)row * D : xctx + (size_t)(row - M_LAT) * D;
                const float* g2 = modl + (size_t)mi * 6 * D + off_g;
                if (LPS == 4) { const int col = s * 64 + cc * 16 + rr; const bf16 vb = f2bf(bf2f(xrow[col]) + g2[col] * ((float)acc[0] * sc)); xrow[col] = vb; const float v0 = bf2f(vb); if (repB == NREPB - 1) ssl[tl * 64 + lane] += v0 * v0; }
                else { const int col = s * 128 + cc * 16 + 2 * rr; const unsigned xb = *(const unsigned*)(xrow + col); const float2 gg = *(const float2*)(g2 + col);
                    const unsigned ob = pg8::cvt_pk_bf16(__uint_as_float(xb << 16) + gg.x * ((float)acc[0] * sc), __uint_as_float(xb & 0xffff0000u) + gg.y * ((float)acc[1] * sc));
                    *(unsigned*)(xrow + col) = ob; const float v0 = __uint_as_float(ob << 16), v1 = __uint_as_float(ob & 0xffff0000u);
                    if (repB == NREPB - 1) ssl[tl * 64 + lane] += v0 * v0 + v1 * v1; }
            }
        }
        __syncthreads();
    }
    asm volatile("s_waitcnt vmcnt(0)" ::: "memory");
    __builtin_amdgcn_fence(__ATOMIC_ACQUIRE, "agent");
    asm volatile("s_waitcnt vmcnt(0)" ::: "memory");
#pragma unroll 1
    for (int j0 = 0; j0 < J; j0 += 2) {
        f32x4 v[2][4];
#pragma unroll
        for (int t = 0; t < 2; ++t) if (j0 + t < J) { const int row = row0 + wave + 8 * (j0 + t); const bf16* xrow = row < M_LAT ? xlat + (size_t)row * D : xctx + (size_t)(row - M_LAT) * D;
#pragma unroll
            for (int q = 0; q < 4; ++q) v[t][q] = ld4res<true>(xrow, (size_t)(lane + 64 * q) * 4); }
#pragma unroll
        for (int t = 0; t < 2; ++t) if (j0 + t < J) { const int tl = wave + 8 * (j0 + t), row = row0 + tl; const int mi = row < M_LAT ? row / S : 4;
            float* xrow = outf + (size_t)row * D;
            const float rs = rsqrtf(wave_sum(ssl[tl * 64 + lane]) * (1.f / D) + EPS);
            float am = 0.f;
#pragma unroll
            for (int q = 0; q < 4; ++q) { const int k = (lane + 64 * q) * 4; const f32x4 w = *(const f32x4*)(nw + k);
                if (MODE == 2) { f32x4 o; o.x = v[t][q].x * rs * w.x; o.y = v[t][q].y * rs * w.y; o.z = v[t][q].z * rs * w.z; o.w = v[t][q].w * rs * w.w; ((f32x4*)xrow)[lane + 64 * q] = o; }
                else { const f32x4 b = *(const f32x4*)(modn + (size_t)mi * 6 * D + k), a = *(const f32x4*)(modn + (size_t)mi * 6 * D + D + k);
                    v[t][q].x = v[t][q].x * rs * w.x * (1.f + a.x) + b.x; v[t][q].y = v[t][q].y * rs * w.y * (1.f + a.y) + b.y; v[t][q].z = v[t][q].z * rs * w.z * (1.f + a.z) + b.z; v[t][q].w = v[t][q].w * rs * w.w * (1.f + a.w) + b.w;
                    am = fmaxf(am, fmaxf(fmaxf(fabsf(v[t][q].x), fabsf(v[t][q].y)), fmaxf(fabsf(v[t][q].z), fabsf(v[t][q].w)))); } }
            if (MODE == 1) {
                am = wave_max(am); const float sx = am > 0.f ? am * (1.f / 127.f) : 1.f, inv = 1.f / sx;
#pragma unroll
                for (int q = 0; q < 4; ++q) { const int q0 = (int)rintf(v[t][q].x * inv), q1 = (int)rintf(v[t][q].y * inv), q2 = (int)rintf(v[t][q].z * inv), q3 = (int)rintf(v[t][q].w * inv);
                    *(unsigned*)(xqo + (size_t)row * D + (lane + 64 * q) * 4) = (unsigned)(q0 & 0xff) | ((unsigned)(q1 & 0xff) << 8) | ((unsigned)(q2 & 0xff) << 16) | ((unsigned)(q3 & 0xff) << 24); }
                if (lane == 0) xso[row] = sx; }
        }
    }
}
__device__ __forceinline__ void ph_final_norm(float* x, const float* fw, int nrows) { const int tidx = otid();
    const int lane = tidx & 63, wave = tidx >> 6;
    for (int row0 = (blockIdx.x * 8 + wave) * 2; row0 < nrows; row0 += gridDim.x * 16) {
        f32x4 v[2][4];
#pragma unroll
        for (int r = 0; r < 2; ++r)
#pragma unroll
            for (int j = 0; j < 4; ++j) v[r][j] = ((const f32x4*)(x + (size_t)(row0 + r) * D))[lane + 64 * j];
#pragma unroll
        for (int r = 0; r < 2; ++r) { float ss = 0.f;
#pragma unroll
            for (int j = 0; j < 4; ++j) ss += v[r][j].x * v[r][j].x + v[r][j].y * v[r][j].y + v[r][j].z * v[r][j].z + v[r][j].w * v[r][j].w;
            ss = wave_sum(ss); const float rs = rsqrtf(ss * (1.f / D) + EPS);
#pragma unroll
            for (int j = 0; j < 4; ++j) { const f32x4 w = *(const f32x4*)(fw + (lane + 64 * j) * 4); f32x4 o = v[r][j] * rs; o.x *= w.x; o.y *= w.y; o.z *= w.z; o.w *= w.w; ((f32x4*)(x + (size_t)(row0 + r) * D))[lane + 64 * j] = o; } }
    }
}
#define DEFINE_PTRS \
    const float* x = p.in[0]; const float* c = p.in[1]; const float* ctx = p.in[2]; const float* c_ctx = p.in[3]; \
    const float* norm1_w = p.in[4]; const float* norm2_w = p.in[5]; const float* w_ada = p.in[6]; const float* b_ada = p.in[7]; \
    const float* w_in = p.in[8]; const float* w_out = p.in[9]; const float* na_rpb = p.in[10]; \
    const float* dec_f = p.in[11]; const float* dec_b = p.in[12]; const float* gn_w = p.in[13]; \
    const float* pool_w = p.in[14]; const float* pool_scale = p.in[15]; const float* peer_wq = p.in[16]; \
    const float* peer_keys = p.in[17]; const float* peer_u = p.in[18]; const float* peer_v = p.in[19]; const float* final_w = p.in[20]; \
    unsigned char* ws = p.ws; float* out = p.out; \
    float* MOD = (float*)(ws + WS_MOD); float* cosT = (float*)(ws + WS_ROPE); float* sinT = cosT + S * 32; \
    bf16* WI = (bf16*)(ws + WS_WI); bf16* WO = (bf16*)(ws + WS_WO); bf16* WQ = (bf16*)(ws + WS_WQ); bf16* KEYS = (bf16*)(ws + WS_KEYS); \
    bf16* XR = (bf16*)(ws + WS_XR); bf16* XRC = (bf16*)(ws + WS_XRC); bf16* U = (bf16*)(ws + WS_U); bf16* V = (bf16*)(ws + WS_V); bf16* ACT = (bf16*)(ws + WS_ACT); \
    bf16* PX = (bf16*)(ws + WS_PX); bf16* Q = PX; float* ST = (float*)(ws + WS_ST); bf16* STB = (bf16*)(ws + WS_ST); int* IDX = (int*)(ws + WS_IDX); float* GATE = (float*)(ws + WS_GATE); \
    float* TOPV = (float*)(ws + WS_TOPV); int* TOPI = (int*)(ws + WS_TOPI); \
    float* AW = (float*)(ws + WS_AW); (void)AW; \
    unsigned char* WI8 = ws + WS_WI8; unsigned char* WQ8 = ws + WS_WQ8; float* SWI = (float*)(ws + WS_SWI); float* SWQ = (float*)(ws + WS_SWQ); (void)WI8; (void)WQ8; (void)SWI; (void)SWQ; \
    unsigned char* XQ = ws + WS_XQ; float* XS = (float*)(ws + WS_XS); (void)XQ; (void)XS; \
    unsigned char* U8 = ws + WS_U; unsigned char* V8 = ws + WS_V; float* SU = (float*)(ws + WS_SU); float* SV = (float*)(ws + WS_SV); (void)U8; (void)V8; (void)SU; (void)SV; \
    (void)x; (void)c; (void)ctx; (void)c_ctx; (void)norm1_w; (void)norm2_w; (void)w_ada; (void)b_ada; (void)w_in; (void)w_out; (void)na_rpb; (void)dec_f; (void)dec_b; (void)gn_w; \
    (void)pool_w; (void)pool_scale; (void)peer_wq; (void)peer_keys; (void)peer_u; (void)peer_v; (void)final_w; (void)out; (void)MOD; (void)cosT; (void)sinT; (void)WI; (void)WO; (void)WQ; \
    (void)KEYS; (void)XR; (void)XRC; (void)U; (void)V; (void)ACT; (void)PX; (void)Q; (void)ST; (void)IDX; (void)GATE; (void)TOPV; (void)TOPI;
#define GRID_SYNC() xcd_barrier(bar)

template <int l>
__device__ __forceinline__ void layer(const Params& p, unsigned char* lds, const XcdBarrier& bar) {
    DEFINE_PTRS
    constexpr bool last = (l == DEPTH - 1);
    const float* modl = MOD + (size_t)l * 5 * 6 * D;
    constexpr int mrows = last ? M_LAT : M_ALL;
    if (l == 0) { ph_quant_w(WI, WI8, SWI, DEPTH * DPROJ_PAD); ph_quant_w(WQ, WQ8, SWQ, DEPTH * DQ); }
    if (l == 0) { DUP(1) ph_norm<true, false>(x, ctx, norm1_w + l * D, modl, 0, D, nullptr, XQ, XS, M_ALL);
    GRID_SYNC(); }
    else if (gridDim.x != 256) { ph_norm<true, true>(XR, XRC, norm1_w + l * D, modl, 0, D, nullptr, XQ, XS, M_ALL);
    GRID_SYNC(); }
#if USE_PG8
    DUP(2) { pg8::Gemm g{(const pg8::bf16_t*)XQ, (const pg8::bf16_t*)(WI8 + (size_t)l * DPROJ_PAD * D), M_ALL, DPROJ_PAD, D / 2}; pg8::StaticOrder So; So.init(M_ALL, DPROJ_PAD, (int)gridDim.x, (int)blockIdx.x);
      EpiI8Bf16Out E{PX, DPROJ, DPROJ, XS, SWI + l * DPROJ_PAD}; pg8::gemm_phase_i8<EpiI8Bf16Out, pg8::StaticOrder>((PG8_LAS unsigned char*)lds, g, So, E, nullptr); }
#else
    ph_gemm_simple<0>(ACT, WI + (size_t)l * DPROJ_PAD * D, M_ALL, DPROJ_PAD, D, PX, DPROJ, DPROJ, nullptr, nullptr, nullptr, nullptr, nullptr, 0, (bf16*)lds);
#endif
    GRID_SYNC();
#if NA_NAIVE
    ph_na(PX, na_rpb + (size_t)l * NAH * 15 * 31, ACT, mrows);
#else
    DUP(4) { ph_na_mfma(PX, na_rpb + (size_t)l * NAH * 15 * 31, ACT, last ? 1536 : 1584, lds);
    __syncthreads(); }
#endif
    DUP(5) ph_pool(PX, ACT, mrows);
#if RET_NAIVE
    ph_ret_state(PX, cosT, sinT, dec_f + l * RH, dec_b + l * RH, ST, (float*)lds);
#else
    DUP(6) ph_ret_state_mfma(PX, cosT, sinT, dec_f + l * RH, dec_b + l * RH, STB, lds);
#endif
    GRID_SYNC();
#if RET_NAIVE
    ph_ret_scan(dec_f + l * RH, dec_b + l * RH, ST);
#else
    ph_ret_scan_bf(dec_f + l * RH, dec_b + l * RH, STB);
#endif
    GRID_SYNC();
#if RET_NAIVE
    ph_ret_out(PX, cosT, sinT, dec_f + l * RH, dec_b + l * RH, ST, gn_w + l * RW, ACT, last ? 64 : NCH, (float*)lds);
#else
    DUP(7) ph_ret_out_mfma(PX, cosT, sinT, dec_f + l * RH, dec_b + l * RH, STB, gn_w + l * RW, ACT, last ? 64 : NCH, lds);
#endif
    GRID_SYNC();
#if USE_PG8
    DUP(l == 0 ? 11 : 31) { pg8::Gemm g{ACT, WO + (size_t)l * D * D, mrows, D, D}; pg8::StaticOrder So; So.init(mrows, D, (int)gridDim.x, (int)blockIdx.x);
      if (l == 0) { EpiRes<false> E{x, ctx, XR, XRC, modl, 2 * D}; pg8::gemm_phase<EpiRes<false>, pg8::StaticOrder>((PG8_LAS unsigned char*)lds, g, So, E, nullptr); }
      else { EpiRes<true> E{XR, XRC, XR, XRC, modl, 2 * D}; pg8::gemm_phase<EpiRes<true>, pg8::StaticOrder>((PG8_LAS unsigned char*)lds, g, So, E, nullptr); } }
#else
    ph_gemm_simple<1>(ACT, WO + (size_t)l * D * D, mrows, D, D, nullptr, 0, 0, xl, xc, out, XCTX, modl, 2 * D, (bf16*)lds);
#endif
    GRID_SYNC();
    DUP(1) ph_norm<true, true>(XR, XRC, norm2_w + l * D, modl, 3 * D, 4 * D, gridDim.x != 256 ? ACT : nullptr, XQ, XS, mrows);
    GRID_SYNC();
#if USE_PG8
    DUP(3) { pg8::Gemm g{(const pg8::bf16_t*)XQ, (const pg8::bf16_t*)(WQ8 + (size_t)l * DQ * D), mrows, DQ, D / 2}; pg8::StaticOrder So; So.init(mrows, DQ, (int)gridDim.x, (int)blockIdx.x);
#if TK32
      EpiI8QT E{Q, XS, SWQ + l * DQ}; pg8::gemm_phase_i8<EpiI8QT, pg8::StaticOrder>((PG8_LAS unsigned char*)lds, g, So, E, nullptr); }
#else
      EpiI8Bf16Out E{Q, DQ, DQ, XS, SWQ + l * DQ}; pg8::gemm_phase_i8<EpiI8Bf16Out, pg8::StaticOrder>((PG8_LAS unsigned char*)lds, g, So, E, nullptr); }
#endif
#else
    ph_gemm_simple<0>(ACT, WQ + (size_t)l * DQ * D, mrows, DQ, D, Q, DQ, DQ, nullptr, nullptr, nullptr, nullptr, nullptr, 0, (bf16*)lds);
#endif
    GRID_SYNC();
#if 1
#if TK32
    DUP(8) ph_tk32(Q, KEYS + (size_t)l * 2 * PH * PNK * PKD, IDX, GATE, mrows, lds);
#else
    DUP(8) ph_tk_mfma(Q, KEYS + (size_t)l * 2 * PH * PNK * PKD, IDX, GATE, mrows, lds);
#endif
#endif
    GRID_SYNC();
#if PEER_BF16
    ph_peer<last>(ACT, IDX, GATE, U + (size_t)l * NEXP * D, V + (size_t)l * NEXP * D, modl, 5 * D, out, XCTX, final_w, mrows);
#else
    if (gridDim.x == 256) {
        ph_peer_sweep<last ? 2 : 1>(IDX, GATE, U8 + (size_t)l * NEXP * D, V8 + (size_t)l * NEXP * D, SU + l * NEXP, SV + l * NEXP, XQ, XS, AW, modl, 5 * D, XR, XRC, out,
                                    last ? final_w : norm1_w + (l + 1) * D, MOD + (size_t)(l + 1 < DEPTH ? l + 1 : l) * 5 * 6 * D, XQ, XS, mrows, lds);
        if (!last) GRID_SYNC();
    } else {
        ph_peer8<last ? 2 : 0>(ACT, IDX, GATE, U8 + (size_t)l * NEXP * D, V8 + (size_t)l * NEXP * D, SU + l * NEXP, SV + l * NEXP, modl, 5 * D, XR, XRC, out, final_w, nullptr, mrows);
        if (!last) GRID_SYNC();
    }
    return;
#endif
    if (!last) GRID_SYNC();
}

__global__ void __launch_bounds__(NT, 2) mega(Params p) {
    extern __shared__ __attribute__((aligned(16))) unsigned char lds[];
    volatile LAS unsigned* bst = (volatile LAS unsigned*)((LAS unsigned char*)lds + LDS_BYTES - 64);
    if (threadIdx.x < 16) bst[threadIdx.x] = 0u;
    __syncthreads();
    const XcdBarrier bar = xcd_barrier_post((unsigned*)(p.ws + WS_CTL), bst);
    DUP(0) {
        DEFINE_PTRS
        DUP(20) { ph_mods(c, c_ctx, w_ada, b_ada, MOD, (float*)lds);
        __syncthreads();
#if RET_NAIVE
        ph_rope(cosT, sinT);
#endif
        }
        DUP(21)
        { ph_transpose_all(w_in, peer_wq, w_out, WI, WQ, WO, (float*)lds);
          ph_wo_pool(w_out, pool_w, pool_scale, WO, (float*)lds); }
        ph_cvt(peer_keys, KEYS, (size_t)DEPTH * 2 * PH * PNK * PKD / 4);
#if PEER_BF16
        ph_cvt(peer_u, U, (size_t)DEPTH * NEXP * D / 4);
        ph_cvt(peer_v, V, (size_t)DEPTH * NEXP * D / 4);
#else
        DUP(22) { ph_quant(peer_u, U8, SU, DEPTH * NEXP, 0);
        ph_quant(peer_v, V8, SV, DEPTH * NEXP, 0); }
#endif
    }
    GRID_SYNC();
    layer<0>(p, lds, bar);
    layer<1>(p, lds, bar);
}
}

extern "C" void kernel_launch(void* const* d_in, const int* in_sizes, int n_in, void* d_out, int out_size, void* d_ws, size_t ws_size, hipStream_t stream) {
    static int grid = 0;
    if (grid == 0) {
        if (n_in != 21 || out_size != M_LAT * D || ws_size < WS_END) { fprintf(stderr, "kernel_launch: unexpected sizes n_in %d out %d ws %zu (need %zu)\n", n_in, out_size, ws_size, (size_t)WS_END); grid = -1; return; }
        int dev = 0, cus = 0, per_cu = 0;
        if (hipGetDevice(&dev) != hipSuccess || hipDeviceGetAttribute(&cus, hipDeviceAttributeMultiprocessorCount, dev) != hipSuccess) { fprintf(stderr, "kernel_launch: device query failed\n"); grid = -1; return; }
        if (hipFuncSetAttribute((const void*)mega, hipFuncAttributeMaxDynamicSharedMemorySize, LDS_BYTES) != hipSuccess) { fprintf(stderr, "kernel_launch: hipFuncSetAttribute failed\n"); grid = -1; return; }
        if (hipOccupancyMaxActiveBlocksPerMultiprocessor(&per_cu, (const void*)mega, NT, LDS_BYTES) != hipSuccess || per_cu < 1) { fprintf(stderr, "kernel_launch: occupancy query says %d\n", per_cu); grid = -1; (void)hipGetLastError(); return; }
        grid = cus;
    }
    if (grid < 0) return;
    Params p{};
    for (int i = 0; i < 21; ++i) p.in[i] = (const float*)d_in[i];
    p.out = (float*)d_out; p.ws = (unsigned char*)d_ws;
    if (hipMemsetAsync((char*)d_ws + WS_CTL, 0, 65536, stream) != hipSuccess) { fprintf(stderr, "kernel_launch: memset failed\n"); return; }
    hipLaunchKernelGGL(mega, dim3(grid), dim3(NT), LDS_BYTES, stream, p);
    hipError_t e = hipPeekAtLastError();
    if (e != hipSuccess) fprintf(stderr, "kernel_launch: launch failed: %s (grid %d)\n", hipGetErrorString(e), grid);
}
```

```cpp
#include <hip/hip_runtime.h>
#include <cstdio>
#include <cstdint>

#ifndef DUP_MASK
#define DUP_MASK 0
#endif
#ifndef USE_PG8
#define USE_PG8 1
#endif
#ifndef NA_NAIVE
#define NA_NAIVE 0
#endif
#ifndef TK_NAIVE
#define TK_NAIVE 0
#endif
#ifndef RET_NAIVE
#define RET_NAIVE 0
#endif
#ifndef TK32
#define TK32 1
#endif
#ifndef PEER_BF16
#define PEER_BF16 0
#endif
#define DUP(bit) for (int _r = 0; _r < ((((unsigned)DUP_MASK >> (bit)) & 1u) ? 2 : 1); ++_r)

__device__ __forceinline__ int otid() { int t = threadIdx.x; asm volatile("" : "+v"(t)); return t; }

namespace pg8 {

#define PG8_LAS __attribute__((address_space(3)))
typedef unsigned short bf16_t;
typedef short bf16x8 __attribute__((ext_vector_type(8)));
typedef float f32x4 __attribute__((ext_vector_type(4)));
typedef unsigned u32x4 __attribute__((ext_vector_type(4)));
constexpr int BM = 256, BK = 64, HALF = 128, HTB = HALF * BK * 2  , STAGE_BYTES = 8 * HTB, NXCD = 8, WGM = 8;

__host__ __device__ __forceinline__ int lds_byte(int r, int c) { const int st = (r >> 4) * 2 + (c >> 5), rr = r & 15, cc = c & 31, ob = rr * 64 + cc * 2; return st * 1024 + (ob ^ (((ob >> 9) & 1) << 5)); }
__host__ __device__ __forceinline__ void stage_rc(int b, int& R, int& C) { const int st = b / 1024, sb = b % 1024, swz = sb ^ (((sb >> 9) & 1) << 5); R = (st >> 1) * 16 + swz / 64; C = (st & 1) * 32 + (swz % 64) / 2; }
__host__ __device__ __forceinline__ int perm32(int rho) { const int n = rho >> 4, i = rho & 15; return 8 * (i >> 2) + 4 * n + (i & 3); }

struct Unit { int pm, pn; };
struct Gemm { const bf16_t* A; const bf16_t* Bt; int M, N, K; };

struct StaticOrder {
    int nM, nN, nwg, G, c;
    __host__ __device__ __forceinline__ void init(int M, int N, int G_, int c_) { nM = M / BM; nN = N / BM; nwg = nM * nN; G = G_; c = c_; }
    __host__ __device__ __forceinline__ bool next(int i, Unit& u) const {
        const long L = (long)i * G + c; if (L >= nwg) return false;
        int wgid = (int)L; { const int q = nwg / NXCD, r = nwg % NXCD, xcd = wgid % NXCD, off = wgid / NXCD; wgid = (xcd < r ? xcd * (q + 1) : r * (q + 1) + (xcd - r) * q) + off; }
        const int nig = WGM * nN, gid = wgid / nig, fm = gid * WGM, gsz = (nM - fm) < WGM ? (nM - fm) : WGM;
        u.pm = fm + ((wgid % nig) % gsz); u.pn = (wgid % nig) / gsz; return true;
    }
    __device__ __forceinline__ void a_ready(const Unit&) const {}
    __device__ __forceinline__ void done(const Unit&) const {}
};
struct OneUnit { Unit u; __device__ __forceinline__ bool next(int i, Unit& o) const { if (i != 0) return false; o = u; return true; }
    __device__ __forceinline__ void a_ready(const Unit&) const {} __device__ __forceinline__ void done(const Unit&) const {} };

typedef unsigned u32x2 __attribute__((ext_vector_type(2)));
__device__ __forceinline__ unsigned cvt_pk_bf16(float lo, float hi) { unsigned r; asm volatile("v_cvt_pk_bf16_f32 %0, %1, %2" : "=v"(r) : "v"(lo), "v"(hi)); return r; }
typedef __bf16 bf16x2v_t __attribute__((ext_vector_type(2)));
typedef float f32x2v_t __attribute__((ext_vector_type(2)));
__device__ __forceinline__ unsigned cvt_pk_bf16_n(float lo, float hi) { const bf16x2v_t r = __builtin_convertvector((f32x2v_t){lo, hi}, bf16x2v_t); return __builtin_bit_cast(unsigned, r); }
template <class Epi, class Sched, bool STAMP = false>
__device__ __forceinline__ void gemm_phase(PG8_LAS unsigned char* lds, const Gemm g, const Sched& S, const Epi& E, unsigned long long* stamps) {
    const int tid = otid(), wid = __builtin_amdgcn_readfirstlane(tid >> 6), lane = tid & 63, wr = wid >> 2, wc = wid & 3, fr = lane & 15, fq = lane >> 4;
    const int K = g.K, nt = K / BK;
    int ts_lo = 0, ts_hi = 0, nts = 0; const unsigned long long rt_entry = STAMP ? (unsigned long long)wall_clock64() : 0ull;
#define PG8_STAMP() do { if (STAMP && wid == 0 && nts < 64) { const unsigned long long _c = (unsigned long long)clock64(); \
        ts_lo = (lane == nts) ? (int)(unsigned)_c : ts_lo; ts_hi = (lane == nts) ? (int)(unsigned)(_c >> 32) : ts_hi; ++nts; } } while (0)
    PG8_STAMP();
    unsigned voffA[2], voffB[2];
#pragma unroll
    for (int i = 0; i < 2; ++i) { int R, C; stage_rc(tid * 16 + i * 8192, R, C); const int Rb = Epi::PERM ? ((R & ~31) + perm32(R & 31)) : R;
        voffA[i] = (unsigned)(R * K + C) * 2u; voffB[i] = (unsigned)(Rb * K + C) * 2u; }
    const size_t kstep = (size_t)(BK * 2);
    const size_t hstep = (size_t)HALF * K * 2;
    const size_t tstep = 2 * hstep;
    const unsigned ldsw = (unsigned)wid * 1024u;
    const int aoff = lds_byte(wr * 64 + fr, fq * 8), boff = lds_byte(wc * 32 + fr, fq * 8);
#define PG8_SA(b, h) (((b) * 2 + (h)) * HTB)
#define PG8_SB(b, h) ((4 + (b) * 2 + (h)) * HTB)
#define PG8_STAGE(bufoff, gbase, voff) do { _Pragma("unroll") for (int _i = 0; _i < 2; ++_i) \
        __builtin_amdgcn_global_load_lds((const unsigned*)((const char*)(gbase) + (voff)[_i]), (PG8_LAS unsigned*)(lds + (bufoff) + ldsw + _i * 8192), 16, 0, 0); } while (0)
#define PG8_LDA(dst, b, h) do { _Pragma("unroll") for (int m = 0; m < 4; ++m) _Pragma("unroll") for (int k = 0; k < 2; ++k) dst[m][k] = *(const PG8_LAS bf16x8*)(lds + PG8_SA(b, h) + aoff + m * 2048 + k * 1024); } while (0)
#define PG8_LDB(dst, b, h) do { _Pragma("unroll") for (int n = 0; n < 2; ++n) _Pragma("unroll") for (int k = 0; k < 2; ++k) dst[n][k] = *(const PG8_LAS bf16x8*)(lds + PG8_SB(b, h) + boff + n * 2048 + k * 1024); } while (0)
#define PG8_MMA(ai, bj, At, Bt) do { __builtin_amdgcn_s_setprio(1); _Pragma("unroll") for (int m = 0; m < 4; ++m) _Pragma("unroll") for (int n = 0; n < 2; ++n) _Pragma("unroll") for (int k = 0; k < 2; ++k) \
        acc[ai][bj][m][n] = __builtin_amdgcn_mfma_f32_16x16x32_bf16(Bt[n][k], At[m][k], acc[ai][bj][m][n], 0, 0, 0); __builtin_amdgcn_s_setprio(0); } while (0)
#define PG8_WAIT_V(n) asm volatile("s_waitcnt vmcnt(" #n ")" ::: "memory")
#define PG8_WAIT_L(n) asm volatile("s_waitcnt lgkmcnt(" #n ")" ::: "memory")
#define PG8_BAR __builtin_amdgcn_s_barrier()
#define PG8_SCHED __builtin_amdgcn_sched_barrier(0)
    Unit cur, nxt; int ui = 0;
    if (!S.next(0, cur)) return;
    f32x4 acc[2][2][4][2];
#pragma unroll
    for (int a = 0; a < 2; ++a)
#pragma unroll
        for (int b = 0; b < 2; ++b)
#pragma unroll
            for (int m = 0; m < 4; ++m)
#pragma unroll
                for (int n = 0; n < 2; ++n) acc[a][b][m][n] = (f32x4){0.f, 0.f, 0.f, 0.f};
    bf16x8 At[4][2], B0[2][2], B1[2][2];
    const char* cA = (const char*)g.A + (size_t)cur.pm * tstep; const char* cB = (const char*)g.Bt + (size_t)cur.pn * tstep;
    S.a_ready(cur);
    PG8_STAGE(PG8_SB(0, 0), cB, voffB); PG8_STAGE(PG8_SA(0, 0), cA, voffA); PG8_STAGE(PG8_SB(0, 1), cB + hstep, voffB); PG8_STAGE(PG8_SA(0, 1), cA + hstep, voffA);
    if (wr == 1) PG8_BAR;
    PG8_WAIT_V(4); PG8_BAR;
    PG8_STAGE(PG8_SB(1, 0), cB + kstep, voffB); PG8_STAGE(PG8_SA(1, 0), cA + kstep, voffA); PG8_STAGE(PG8_SB(1, 1), cB + hstep + kstep, voffB);
    PG8_WAIT_V(6); PG8_BAR;
    PG8_STAMP();
    for (;;) {
        const bool has_next = S.next(ui + 1, nxt);
        const char* nA = has_next ? (const char*)g.A + (size_t)nxt.pm * tstep : cA; const char* nB = has_next ? (const char*)g.Bt + (size_t)nxt.pn * tstep : cB;
        for (int t = 0; t < nt; t += 2) {
            const bool last = (t == nt - 2);
            const char* a1 = cA + (size_t)(t + 1) * kstep;
            const char* a2 = last ? nA : cA + (size_t)(t + 2) * kstep; const char* b2 = last ? nB : cB + (size_t)(t + 2) * kstep;
            const char* a3 = a2 + kstep; const char* b3 = b2 + kstep;
            if (last && has_next) S.a_ready(nxt);
            PG8_LDB(B0, 0, 0); PG8_SCHED; PG8_LDA(At, 0, 0); PG8_STAGE(PG8_SA(1, 1), a1 + hstep, voffA);
            PG8_WAIT_L(8); PG8_BAR; PG8_WAIT_L(0); PG8_MMA(0, 0, At, B0); PG8_BAR; PG8_SCHED;
            PG8_LDB(B1, 0, 1); PG8_STAGE(PG8_SB(0, 0), b2, voffB);
            PG8_BAR; PG8_WAIT_L(0); PG8_MMA(0, 1, At, B1); PG8_BAR;
            PG8_LDA(At, 0, 1); PG8_STAGE(PG8_SA(0, 0), a2, voffA);
            PG8_BAR; PG8_WAIT_L(0); PG8_MMA(1, 0, At, B0); PG8_BAR; PG8_SCHED;
            PG8_STAGE(PG8_SB(0, 1), b2 + hstep, voffB);
            PG8_WAIT_V(6); PG8_BAR; PG8_MMA(1, 1, At, B1); PG8_BAR;
            PG8_LDB(B0, 1, 0); PG8_SCHED; PG8_LDA(At, 1, 0); PG8_STAGE(PG8_SA(0, 1), a2 + hstep, voffA);
            PG8_WAIT_L(8); PG8_BAR; PG8_WAIT_L(0); PG8_MMA(0, 0, At, B0); PG8_BAR; PG8_SCHED;
            PG8_LDB(B1, 1, 1); PG8_STAGE(PG8_SB(1, 0), b3, voffB);
            PG8_BAR; PG8_WAIT_L(0); PG8_MMA(0, 1, At, B1); PG8_BAR;
            PG8_LDA(At, 1, 1); PG8_STAGE(PG8_SA(1, 0), a3, voffA);
            PG8_BAR; PG8_WAIT_L(0); PG8_MMA(1, 0, At, B0); PG8_BAR; PG8_SCHED;
            PG8_STAGE(PG8_SB(1, 1), b3 + hstep, voffB);
            PG8_WAIT_V(6); PG8_BAR; PG8_MMA(1, 1, At, B1); PG8_BAR;
        }
        PG8_STAMP();
        if constexpr (!Epi::AFTER_DRAIN) { E(acc, cur, wr, wc, fr, fq); S.done(cur); }
        PG8_STAMP();
        if (!has_next) break;
#pragma unroll
        for (int a = 0; a < 2; ++a)
#pragma unroll
            for (int b = 0; b < 2; ++b)
#pragma unroll
                for (int m = 0; m < 4; ++m)
#pragma unroll
                    for (int n = 0; n < 2; ++n) acc[a][b][m][n] = (f32x4){0.f, 0.f, 0.f, 0.f};
        cur = nxt; cA = nA; cB = nB; ++ui;
    }
    PG8_WAIT_V(0);
    if (wr == 0) PG8_BAR;
    PG8_BAR;
    if constexpr (Epi::AFTER_DRAIN) { E.fused(acc, cur, wr, wc, fr, fq, lds, wid, lane); S.done(cur); }
    PG8_STAMP();
    if (STAMP && wid == 0) { stamps[lane] = lane < nts ? (((unsigned long long)(unsigned)ts_hi << 32) | (unsigned)ts_lo) : 0ull;
        if (lane == 62) stamps[62] = rt_entry; if (lane == 63) stamps[63] = (unsigned long long)wall_clock64(); }
#undef PG8_STAMP
#undef PG8_SA
#undef PG8_SB
#undef PG8_STAGE
#undef PG8_LDA
#undef PG8_LDB
#undef PG8_MMA
#undef PG8_WAIT_V
#undef PG8_WAIT_L
#undef PG8_BAR
#undef PG8_SCHED
}

typedef int i32x4 __attribute__((ext_vector_type(4)));
template <class Epi, class Sched, bool STAMP = false>
__device__ __forceinline__ void gemm_phase_i8(PG8_LAS unsigned char* lds, const Gemm g, const Sched& S, const Epi& E, unsigned long long* stamps) {
    const int tid = otid(), wid = __builtin_amdgcn_readfirstlane(tid >> 6), lane = tid & 63, wr = wid >> 2, wc = wid & 3, fr = lane & 15, fq = lane >> 4;
    const int K = g.K, nt = K / BK;
    int ts_lo = 0, ts_hi = 0, nts = 0; const unsigned long long rt_entry = STAMP ? (unsigned long long)wall_clock64() : 0ull;
#define PG8_STAMP() do { if (STAMP && wid == 0 && nts < 64) { const unsigned long long _c = (unsigned long long)clock64(); \
        ts_lo = (lane == nts) ? (int)(unsigned)_c : ts_lo; ts_hi = (lane == nts) ? (int)(unsigned)(_c >> 32) : ts_hi; ++nts; } } while (0)
    PG8_STAMP();
    unsigned voffA[2], voffB[2];
#pragma unroll
    for (int i = 0; i < 2; ++i) { int R, C; stage_rc(tid * 16 + i * 8192, R, C); const int Rb = Epi::PERM ? ((R & ~31) + perm32(R & 31)) : R;
        voffA[i] = (unsigned)(R * K + C) * 2u; voffB[i] = (unsigned)(Rb * K + C) * 2u; }
    const size_t kstep = (size_t)(BK * 2);
    const size_t hstep = (size_t)HALF * K * 2;
    const size_t tstep = 2 * hstep;
    const unsigned ldsw = (unsigned)wid * 1024u;
    const int aoff = lds_byte(wr * 64 + fr, fq * 8), boff = lds_byte(wc * 32 + fr, fq * 8);
#define PG8_SA(b, h) (((b) * 2 + (h)) * HTB)
#define PG8_SB(b, h) ((4 + (b) * 2 + (h)) * HTB)
#define PG8_STAGE(bufoff, gbase, voff) do { _Pragma("unroll") for (int _i = 0; _i < 2; ++_i) \
        __builtin_amdgcn_global_load_lds((const unsigned*)((const char*)(gbase) + (voff)[_i]), (PG8_LAS unsigned*)(lds + (bufoff) + ldsw + _i * 8192), 16, 0, 0); } while (0)
#define PG8_LDA(dst, b, h) do { _Pragma("unroll") for (int m = 0; m < 4; ++m) _Pragma("unroll") for (int k = 0; k < 2; ++k) dst[m][k] = *(const PG8_LAS i32x4*)(lds + PG8_SA(b, h) + aoff + m * 2048 + k * 1024); } while (0)
#define PG8_LDB(dst, b, h) do { _Pragma("unroll") for (int n = 0; n < 2; ++n) _Pragma("unroll") for (int k = 0; k < 2; ++k) dst[n][k] = *(const PG8_LAS i32x4*)(lds + PG8_SB(b, h) + boff + n * 2048 + k * 1024); } while (0)
#define PG8_MMA(ai, bj, At, Bt) do { __builtin_amdgcn_s_setprio(1); _Pragma("unroll") for (int m = 0; m < 4; ++m) _Pragma("unroll") for (int n = 0; n < 2; ++n) _Pragma("unroll") for (int k = 0; k < 2; ++k) \
        acc[ai][bj][m][n] = __builtin_amdgcn_mfma_i32_16x16x64_i8(Bt[n][k], At[m][k], acc[ai][bj][m][n], 0, 0, 0); __builtin_amdgcn_s_setprio(0); } while (0)
#define PG8_WAIT_V(n) asm volatile("s_waitcnt vmcnt(" #n ")" ::: "memory")
#define PG8_WAIT_L(n) asm volatile("s_waitcnt lgkmcnt(" #n ")" ::: "memory")
#define PG8_BAR __builtin_amdgcn_s_barrier()
#define PG8_SCHED __builtin_amdgcn_sched_barrier(0)
    Unit cur, nxt; int ui = 0;
    if (!S.next(0, cur)) return;
    i32x4 acc[2][2][4][2];
#pragma unroll
    for (int a = 0; a < 2; ++a)
#pragma unroll
        for (int b = 0; b < 2; ++b)
#pragma unroll
            for (int m = 0; m < 4; ++m)
#pragma unroll
                for (int n = 0; n < 2; ++n) acc[a][b][m][n] = (i32x4){0, 0, 0, 0};
    i32x4 At[4][2], B0[2][2], B1[2][2];
    const char* cA = (const char*)g.A + (size_t)cur.pm * tstep; const char* cB = (const char*)g.Bt + (size_t)cur.pn * tstep;
    S.a_ready(cur);
    PG8_STAGE(PG8_SB(0, 0), cB, voffB); PG8_STAGE(PG8_SA(0, 0), cA, voffA); PG8_STAGE(PG8_SB(0, 1), cB + hstep, voffB); PG8_STAGE(PG8_SA(0, 1), cA + hstep, voffA);
    if (wr == 1) PG8_BAR;
    PG8_WAIT_V(4); PG8_BAR;
    PG8_STAGE(PG8_SB(1, 0), cB + kstep, voffB); PG8_STAGE(PG8_SA(1, 0), cA + kstep, voffA); PG8_STAGE(PG8_SB(1, 1), cB + hstep + kstep, voffB);
    PG8_WAIT_V(6); PG8_BAR;
    PG8_STAMP();
    for (;;) {
        const bool has_next = S.next(ui + 1, nxt);
        const char* nA = has_next ? (const char*)g.A + (size_t)nxt.pm * tstep : cA; const char* nB = has_next ? (const char*)g.Bt + (size_t)nxt.pn * tstep : cB;
        for (int t = 0; t < nt; t += 2) {
            const bool last = (t == nt - 2);
            const char* a1 = cA + (size_t)(t + 1) * kstep;
            const char* a2 = last ? nA : cA + (size_t)(t + 2) * kstep; const char* b2 = last ? nB : cB + (size_t)(t + 2) * kstep;
            const char* a3 = a2 + kstep; const char* b3 = b2 + kstep;
            if (last && has_next) S.a_ready(nxt);
            PG8_LDB(B0, 0, 0); PG8_SCHED; PG8_LDA(At, 0, 0); PG8_STAGE(PG8_SA(1, 1), a1 + hstep, voffA);
            PG8_WAIT_L(8); PG8_BAR; PG8_WAIT_L(0); PG8_MMA(0, 0, At, B0); PG8_BAR; PG8_SCHED;
            PG8_LDB(B1, 0, 1); PG8_STAGE(PG8_SB(0, 0), b2, voffB);
            PG8_BAR; PG8_WAIT_L(0); PG8_MMA(0, 1, At, B1); PG8_BAR;
            PG8_LDA(At, 0, 1); PG8_STAGE(PG8_SA(0, 0), a2, voffA);
            PG8_BAR; PG8_WAIT_L(0); PG8_MMA(1, 0, At, B0); PG8_BAR; PG8_SCHED;
            PG8_STAGE(PG8_SB(0, 1), b2 + hstep, voffB);
            PG8_WAIT_V(6); PG8_BAR; PG8_MMA(1, 1, At, B1); PG8_BAR;
            PG8_LDB(B0, 1, 0); PG8_SCHED; PG8_LDA(At, 1, 0); PG8_STAGE(PG8_SA(0, 1), a2 + hstep, voffA);
            PG8_WAIT_L(8); PG8_BAR; PG8_WAIT_L(0); PG8_MMA(0, 0, At, B0); PG8_BAR; PG8_SCHED;
            PG8_LDB(B1, 1, 1); PG8_STAGE(PG8_SB(1, 0), b3, voffB);
            PG8_BAR; PG8_WAIT_L(0); PG8_MMA(0, 1, At, B1); PG8_BAR;
            PG8_LDA(At, 1, 1); PG8_STAGE(PG8_SA(1, 0), a3, voffA);
            PG8_BAR; PG8_WAIT_L(0); PG8_MMA(1, 0, At, B0); PG8_BAR; PG8_SCHED;
            PG8_STAGE(PG8_SB(1, 1), b3 + hstep, voffB);
            PG8_WAIT_V(6); PG8_BAR; PG8_MMA(1, 1, At, B1); PG8_BAR;
        }
        PG8_STAMP();
        if constexpr (!Epi::AFTER_DRAIN) { for (int _e = 0; _e < ((((unsigned)DUP_MASK >> 14) & 1u) ? 2 : 1); ++_e) E(acc, cur, wr, wc, fr, fq); S.done(cur); }
        PG8_STAMP();
        if (!has_next) break;
#pragma unroll
        for (int a = 0; a < 2; ++a)
#pragma unroll
            for (int b = 0; b < 2; ++b)
#pragma unroll
                for (int m = 0; m < 4; ++m)
#pragma unroll
                    for (int n = 0; n < 2; ++n) acc[a][b][m][n] = (i32x4){0, 0, 0, 0};
        cur = nxt; cA = nA; cB = nB; ++ui;
    }
    PG8_WAIT_V(0);
    if (wr == 0) PG8_BAR;
    PG8_BAR;
    if constexpr (Epi::AFTER_DRAIN) { E.fused(acc, cur, wr, wc, fr, fq, lds, wid, lane); S.done(cur); }
    PG8_STAMP();
    if (STAMP && wid == 0) { stamps[lane] = lane < nts ? (((unsigned long long)(unsigned)ts_hi << 32) | (unsigned)ts_lo) : 0ull;
        if (lane == 62) stamps[62] = rt_entry; if (lane == 63) stamps[63] = (unsigned long long)wall_clock64(); }
#undef PG8_STAMP
#undef PG8_SA
#undef PG8_SB
#undef PG8_STAGE
#undef PG8_LDA
#undef PG8_LDB
#undef PG8_MMA
#undef PG8_WAIT_V
#undef PG8_WAIT_L
#undef PG8_BAR
#undef PG8_SCHED
}
}

#define XB_TMO      128
#define XB_XCNT(j)  (256  + 64 * (j))
#define XB_XSUB(j)  (1280 + 64 * (j))
#define XB_XGEN(j)  (2304 + 64 * (j))
#define XB_TOP      3328
#define XB_TOPGEN   3392
#define XCD_BAR_WORDS 3456
#define XB_SPIN_CAP (1u << 18)
#define LAS __attribute__((address_space(3)))

__device__ __forceinline__ unsigned xb_ld(unsigned* p)              { return __hip_atomic_load(p, __ATOMIC_RELAXED, __HIP_MEMORY_SCOPE_AGENT); }
__device__ __forceinline__ unsigned xb_add(unsigned* p, unsigned v) { return __hip_atomic_fetch_add(p, v, __ATOMIC_RELAXED, __HIP_MEMORY_SCOPE_AGENT); }
__device__ __forceinline__ unsigned xb_xcc_id() { return (unsigned)__builtin_amdgcn_s_getreg((3 << 11) | 20) & 0xFu; }
#define XB_SPIN(cond, bar) do { unsigned _sp = 0; while (cond) { __builtin_amdgcn_s_sleep(1); \
    if ((++_sp & 255u) == 0u) { if (xb_ld(&(bar)[XB_TMO])) break; if (_sp > XB_SPIN_CAP) { atomicAdd(&(bar)[XB_TMO], 1u); break; } } } } while (0)

struct XcdBarrier {
    unsigned* bar; unsigned x;
    volatile LAS unsigned* st;
};

__device__ __forceinline__ XcdBarrier xcd_barrier_post(unsigned* bar, volatile LAS unsigned* st) {
    XcdBarrier b; b.bar = bar; b.x = xb_xcc_id(); b.st = st;
    if (threadIdx.x == 0) (void)xb_add(&bar[XB_XCNT(b.x)], 1u);
    return b;
}
__device__ __forceinline__ void xcd_barrier_complete(unsigned* bar, unsigned x, unsigned& nloc, unsigned& nx) {
    const unsigned G = gridDim.x * gridDim.y * gridDim.z;
    unsigned sum, cnt, mine, sp = 0u;
    for (;;) {
        sum = 0u; cnt = 0u; mine = 0u;
#pragma unroll
        for (unsigned j = 0; j < 16; ++j) { const unsigned c = xb_ld(&bar[XB_XCNT(j)]); sum += c; cnt += (c > 0u) ? 1u : 0u; mine = (j == x) ? c : mine; }
        if (sum == G) break;
        __builtin_amdgcn_s_sleep(1);
        if ((++sp & 255u) == 0u) { if (xb_ld(&bar[XB_TMO])) break; if (sp > XB_SPIN_CAP) { atomicAdd(&bar[XB_TMO], 1u); break; } }
    }
    nloc = mine > 0u ? mine : 1u; nx = cnt > 0u ? cnt : 1u;
}

__device__ __forceinline__ void xcd_barrier(const XcdBarrier& b) {
    asm volatile("s_waitcnt vmcnt(0)" ::: "memory");
    __syncthreads();
    if (threadIdx.x == 0) {
        unsigned* bar = b.bar;
        __builtin_amdgcn_s_waitcnt(0);
        unsigned nloc = b.st[0], nx = b.st[1];
        if (nloc == 0u) { xcd_barrier_complete(bar, b.x, nloc, nx); b.st[0] = nloc; b.st[1] = nx; }
        const unsigned old = xb_add(&bar[XB_XSUB(b.x)], 1u);
        const unsigned gen = old / nloc;
        if (old + 1u == (gen + 1u) * nloc) {
            __builtin_amdgcn_fence(__ATOMIC_RELEASE, "agent");
            asm volatile("s_waitcnt vmcnt(0)" ::: "memory");
            const unsigned og = xb_add(&bar[XB_TOP], 1u);
            const unsigned tg = og / nx;
            if (og + 1u == (tg + 1u) * nx) xb_add(&bar[XB_TOPGEN], 1u);
            else XB_SPIN(xb_ld(&bar[XB_TOPGEN]) == tg, bar);
            __builtin_amdgcn_fence(__ATOMIC_ACQUIRE, "agent");
            xb_add(&bar[XB_XGEN(b.x)], 1u);
            asm volatile("s_waitcnt vmcnt(0)" ::: "memory");
        } else {
            XB_SPIN(xb_ld(&bar[XB_XGEN(b.x)]) == gen, bar);
            __builtin_amdgcn_fence(__ATOMIC_ACQUIRE, "agent");
            asm volatile("s_waitcnt vmcnt(0)" ::: "memory");
        }
    }
    __syncthreads();
}


namespace {
constexpr int D = 1024, NB = 4, S = 8192, DEPTH = 2, GW = 64, CTX = 256, HD = 64;
constexpr int NAH = 6, RH = 6, NAW = 384, RW = 384, PW = 256;
constexpr int M_LAT = NB * S, M_CTX = NB * CTX, M_ALL = M_LAT + M_CTX;
constexpr int O_NA_Q = 0, O_NA_K = 384, O_NA_V = 768, O_RET_Q = 1152, O_RET_K = 1536, O_RET_V = 1920, O_RET_G = 2304, O_POOL = 2688;
constexpr int DPROJ = 2944, DPROJ_PAD = 3072;
constexpr int PH = 8, PNK = 128, PKD = 128, PTOP = 16, NEXP = 16384, DQ = 2048;
constexpr float EPS = 1e-6f;
constexpr int NCH = S / 128 + 2;
constexpr int NT = 512;
constexpr int LDS_BYTES = 163840;

typedef unsigned short bf16;
typedef short bf16x8 __attribute__((ext_vector_type(8)));
typedef float f32x4 __attribute__((ext_vector_type(4)));
typedef unsigned u32x4 __attribute__((ext_vector_type(4)));

__device__ __forceinline__ float bf2f(bf16 v) { return __uint_as_float(((unsigned)v) << 16); }
__device__ __forceinline__ bf16 f2bf(float f) { unsigned u = __float_as_uint(f); return (bf16)((u + 0x7fffu + ((u >> 16) & 1u)) >> 16); }
__device__ __forceinline__ float silu(float x) { return x / (1.f + __expf(-x)); }
#define SWZ_XOR(v, m) __int_as_float(__builtin_amdgcn_ds_swizzle(__float_as_int(v), ((m) << 10) | 0x1f))
__device__ __forceinline__ float wave_sum(float v) {
    v += SWZ_XOR(v, 1); v += SWZ_XOR(v, 2); v += SWZ_XOR(v, 4); v += SWZ_XOR(v, 8); v += SWZ_XOR(v, 16);
    return __int_as_float(__builtin_amdgcn_readlane(__float_as_int(v), 0)) + __int_as_float(__builtin_amdgcn_readlane(__float_as_int(v), 32));
}
__device__ __forceinline__ float wave_max(float v) {
    v = fmaxf(v, SWZ_XOR(v, 1)); v = fmaxf(v, SWZ_XOR(v, 2)); v = fmaxf(v, SWZ_XOR(v, 4)); v = fmaxf(v, SWZ_XOR(v, 8)); v = fmaxf(v, SWZ_XOR(v, 16));
    return fmaxf(__int_as_float(__builtin_amdgcn_readlane(__float_as_int(v), 0)), __int_as_float(__builtin_amdgcn_readlane(__float_as_int(v), 32)));
}
__device__ __forceinline__ int rl_i(int v, int lane) { return __builtin_amdgcn_readlane(v, lane); }
__device__ __forceinline__ float rl_f(float v, int lane) { return __int_as_float(__builtin_amdgcn_readlane(__float_as_int(v), lane)); }

constexpr size_t MiB = 1u << 20;
constexpr size_t WS_CTL = 0;
constexpr size_t WS_MOD = 1 * MiB;
constexpr size_t WS_ROPE = WS_MOD + 512 * 1024;
constexpr size_t WS_KEYS = 3 * MiB + 512 * 1024;
constexpr size_t WS_SU = 4 * MiB + 512 * 1024, WS_SV = WS_SU + 256 * 1024;
constexpr size_t WS_XS = 5 * MiB;
constexpr size_t WS_SWI = 5 * MiB + 512 * 1024, WS_SWQ = WS_SWI + 65536;
constexpr size_t WS_WO = 6 * MiB;
constexpr size_t WS_WI8 = 10 * MiB, WS_WQ8 = 16 * MiB;
constexpr size_t WS_WI = 20 * MiB;
constexpr size_t WS_WQ = 32 * MiB;
constexpr size_t WS_U = 40 * MiB;
constexpr size_t WS_V = 72 * MiB;
constexpr size_t WS_XQ = 104 * MiB;
constexpr size_t WS_ACT = 137 * MiB;
constexpr size_t WS_PX = 203 * MiB;
constexpr size_t WS_AW = WS_PX + 160 * MiB;
constexpr size_t WS_ST = 393 * MiB;
constexpr size_t WS_XR = 443 * MiB;
constexpr size_t WS_XRC = 507 * MiB;
constexpr size_t WS_END = 509 * MiB;
constexpr size_t WS_IDX = WS_ST, WS_GATE = WS_ST + 17 * MiB;
constexpr size_t WS_TOPV = WS_PX + 133 * MiB, WS_TOPI = WS_ACT;

struct Params { const float* in[21]; float* out; unsigned char* ws; };

__device__ __forceinline__ void ph_mods(const float* c, const float* c_ctx, const float* w_ada, const float* b_ada, float* mod, float* sm  ) { const int tidx = otid();
    const int tid = tidx, ks = tid >> 6, jj = tid & 63;
    float* act = sm; float* red = sm + 5 * D;
    if ((int)blockIdx.x >= DEPTH * 96) return;
    for (int i = tid; i < 5 * D; i += NT) { const float v = i < 4 * D ? c[i] : c_ctx[i - 4 * D]; act[i] = silu(v); }
    __syncthreads();
    for (int vb = blockIdx.x; vb < DEPTH * 96; vb += gridDim.x) {
        const int l = vb / 96, j = (vb % 96) * 64 + jj;
        const float* w = w_ada + (size_t)l * D * 6 * D + (size_t)(ks * 128) * 6 * D + j;
        const float* ap = act + ks * 128;
        float a0 = 0, a1 = 0, a2 = 0, a3 = 0, a4 = 0;
#pragma unroll 32
        for (int k = 0; k < 128; ++k) { const float wv = w[(size_t)k * 6 * D];
            a0 += ap[k] * wv; a1 += ap[D + k] * wv; a2 += ap[2 * D + k] * wv; a3 += ap[3 * D + k] * wv; a4 += ap[4 * D + k] * wv; }
        red[(ks * 5 + 0) * 64 + jj] = a0; red[(ks * 5 + 1) * 64 + jj] = a1; red[(ks * 5 + 2) * 64 + jj] = a2; red[(ks * 5 + 3) * 64 + jj] = a3; red[(ks * 5 + 4) * 64 + jj] = a4;
        __syncthreads();
        if (tid < 320) { const int r = tid >> 6; float s = 0.f;
#pragma unroll
            for (int q = 0; q < 8; ++q) s += red[(q * 5 + r) * 64 + jj];
            mod[((size_t)l * 5 + r) * 6 * D + j] = s + b_ada[l * 6 * D + j]; }
        __syncthreads();
    }
}
__device__ __forceinline__ void ph_rope(float* cosT, float* sinT) { const int tidx = otid();
    for (int gid = blockIdx.x * NT + tidx; gid < S * 32; gid += gridDim.x * NT) {
        const int t = gid / 32, j = gid % 32, jj = j & 15;
        const float inv = powf(10000.f, -(float)jj / 16.f);
        const float pos = j < 16 ? (float)(t / GW) : (float)(t % GW);
        const float ang = pos * inv;
        cosT[gid] = cosf(ang); sinT[gid] = sinf(ang);
    }
}
__device__ __forceinline__ void ph_transpose(const float* W, int K, int N, int Npad, int ldk, bf16* Wt, float* tile  ) { const int tidx = otid();
    const int tid = tidx, nbn = Npad / 64, nvb = nbn * (K / 64);
    for (int vb = blockIdx.x; vb < nvb; vb += gridDim.x) {
        const int n0 = (vb % nbn) * 64, k0 = (vb / nbn) * 64;
        { const int kk = tid >> 4, n4 = (tid & 15) * 4;
#pragma unroll
          for (int i = 0; i < 2; ++i) { const int k = kk + 32 * i; const int n = n0 + n4;
              const f32x4 v = (n < N) ? *(const f32x4*)(W + (size_t)(k0 + k) * N + n) : (f32x4){0.f, 0.f, 0.f, 0.f};
              tile[k * 65 + n4] = v.x; tile[k * 65 + n4 + 1] = v.y; tile[k * 65 + n4 + 2] = v.z; tile[k * 65 + n4 + 3] = v.w; } }
        __syncthreads();
        { const int n = tid >> 3, kc = (tid & 7) * 8;
          u32x4 o; o.x = pg8::cvt_pk_bf16(tile[(kc + 0) * 65 + n], tile[(kc + 1) * 65 + n]); o.y = pg8::cvt_pk_bf16(tile[(kc + 2) * 65 + n], tile[(kc + 3) * 65 + n]);
          o.z = pg8::cvt_pk_bf16(tile[(kc + 4) * 65 + n], tile[(kc + 5) * 65 + n]); o.w = pg8::cvt_pk_bf16(tile[(kc + 6) * 65 + n], tile[(kc + 7) * 65 + n]);
          *(u32x4*)(Wt + (size_t)(n0 + n) * ldk + k0 + kc) = o; }
        __syncthreads();
    }
}
__device__ __forceinline__ void ph_transpose_all(const float* w_in, const float* peer_wq, const float* w_out, bf16* WI, bf16* WQ, bf16* WO, float* tile) { const int tidx = otid();
    constexpr int T_IN = (DPROJ_PAD / 64) * (D / 64), T_Q = (DQ / 64) * (D / 64), T_O = (D / 64) * (768 / 64), T_L = T_IN + T_Q + T_O, T_ALL = DEPTH * T_L;
    const int tid = tidx, G = (int)gridDim.x, c = G - 1 - (int)blockIdx.x;
#define TR_DECODE(vb) const int l_ = (vb) / T_L, r0_ = (vb) % T_L; const int which_ = r0_ < T_IN ? 0 : (r0_ < T_IN + T_Q ? 1 : 2); const int r_ = r0_ - (which_ == 0 ? 0 : (which_ == 1 ? T_IN : T_IN + T_Q)); \
        const int N_ = which_ == 0 ? DPROJ : (which_ == 1 ? DQ : D), nbn_ = which_ == 0 ? DPROJ_PAD / 64 : (which_ == 1 ? DQ / 64 : D / 64); \
        const float* W_ = which_ == 0 ? w_in + (size_t)l_ * D * DPROJ : (which_ == 1 ? peer_wq + (size_t)l_ * D * DQ : w_out + (size_t)l_ * D * D); \
        bf16* Wt_ = which_ == 0 ? WI + (size_t)l_ * DPROJ_PAD * D : (which_ == 1 ? WQ + (size_t)l_ * DQ * D : WO + (size_t)l_ * D * D); \
        const int n0_ = (r_ % nbn_) * 64, k0_ = (r_ / nbn_) * 64;
    for (int vb0 = c; vb0 < T_ALL; vb0 += 4 * G) {
        f32x4 v[4][2];
#pragma unroll
        for (int i = 0; i < 4; ++i) { const int vb = vb0 + i * G;
            if (vb < T_ALL) { TR_DECODE(vb) (void)Wt_; const int kk = tid >> 4, n = n0_ + (tid & 15) * 4;
#pragma unroll
                for (int q = 0; q < 2; ++q) v[i][q] = (n < N_) ? *(const f32x4*)(W_ + (size_t)(k0_ + kk + 32 * q) * N_ + n) : (f32x4){0.f, 0.f, 0.f, 0.f}; } }
#pragma unroll
        for (int i = 0; i < 4; ++i) { const int vb = vb0 + i * G;
            if (vb < T_ALL) { float* tl = tile + i * (64 * 65); const int kk = tid >> 4, n4 = (tid & 15) * 4;
#pragma unroll
                for (int q = 0; q < 2; ++q) { const int k = kk + 32 * q; tl[k * 65 + n4] = v[i][q].x; tl[k * 65 + n4 + 1] = v[i][q].y; tl[k * 65 + n4 + 2] = v[i][q].z; tl[k * 65 + n4 + 3] = v[i][q].w; } } }
        __syncthreads();
#pragma unroll
        for (int i = 0; i < 4; ++i) { const int vb = vb0 + i * G;
            if (vb < T_ALL) { TR_DECODE(vb) (void)W_; (void)N_; const float* tl = tile + i * (64 * 65); const int n = tid >> 3, kc = (tid & 7) * 8;
                u32x4 o; o.x = pg8::cvt_pk_bf16(tl[(kc + 0) * 65 + n], tl[(kc + 1) * 65 + n]); o.y = pg8::cvt_pk_bf16(tl[(kc + 2) * 65 + n], tl[(kc + 3) * 65 + n]);
                o.z = pg8::cvt_pk_bf16(tl[(kc + 4) * 65 + n], tl[(kc + 5) * 65 + n]); o.w = pg8::cvt_pk_bf16(tl[(kc + 6) * 65 + n], tl[(kc + 7) * 65 + n]);
                *(u32x4*)(Wt_ + (size_t)(n0_ + n) * D + k0_ + kc) = o; } }
        __syncthreads();
    }
#undef TR_DECODE
}
__device__ __forceinline__ void ph_wo_pool(const float* w_out_all, const float* pool_w_all, const float* pool_scale_all, bf16* Wo_t_all, float* sm) { const int tidx = otid();
    const int tid = tidx; float* P = sm; float* Ws = sm + 64 * 65;
    for (int vb = (int)gridDim.x - 1 - (int)blockIdx.x; vb < DEPTH * 4 * 16; vb += gridDim.x) {
        const int l = vb >> 6, g = (vb >> 4) & 3, n0 = (vb & 15) * 64;
        const float* w_out = w_out_all + (size_t)l * D * D; const float* pool_w = pool_w_all + (size_t)l * 4 * 64 * 64; const float* pool_scale = pool_scale_all + (size_t)l * PW; bf16* Wo_t = Wo_t_all + (size_t)l * D * D;
        for (int i = tid; i < 4096; i += NT) { const int r = i >> 6, cc = i & 63; P[r * 65 + cc] = pool_w[(g * 64 + r) * 64 + cc] * pool_scale[g * 64 + cc]; Ws[r * 65 + cc] = w_out[(size_t)(768 + g * 64 + r) * D + n0 + cc]; }
        __syncthreads();
        { const int i = tid & 63, nq = tid >> 6;
#pragma unroll 1
          for (int nn = nq * 8; nn < nq * 8 + 8; ++nn) { float s = 0.f;
#pragma unroll 16
              for (int j = 0; j < 64; ++j) s += P[i * 65 + j] * Ws[j * 65 + nn];
              Wo_t[(size_t)(n0 + nn) * D + 768 + g * 64 + i] = f2bf(s); } }
        __syncthreads();
    }
}
__device__ __forceinline__ void ph_cvt(const float* src, bf16* dst, size_t n4) { const int tidx = otid();
    for (size_t i = (size_t)blockIdx.x * NT + tidx; i < n4; i += (size_t)gridDim.x * NT) {
        const f32x4 v = ((const f32x4*)src)[i]; ushort4 o; o.x = f2bf(v.x); o.y = f2bf(v.y); o.z = f2bf(v.z); o.w = f2bf(v.w); ((ushort4*)dst)[i] = o; }
}

template <bool BF> __device__ __forceinline__ f32x4 ld4res(const void* p, size_t idx) {
    if (BF) { const ushort4 v = *(const ushort4*)((const bf16*)p + idx); return (f32x4){bf2f(v.x), bf2f(v.y), bf2f(v.z), bf2f(v.w)}; }
    else return *(const f32x4*)((const float*)p + idx);
}
__device__ __forceinline__ void st4res(bf16* p, size_t idx, f32x4 v) { pg8::u32x2 o; o.x = pg8::cvt_pk_bf16(v.x, v.y); o.y = pg8::cvt_pk_bf16(v.z, v.w); *(pg8::u32x2*)(p + idx) = o; }

template <bool XQOUT, bool INBF>
__device__ __forceinline__ void ph_norm(const void* xlat, const void* xctx, const float* nw, const float* modl, int off_sh, int off_sc, bf16* act  , unsigned char* xq, float* xs, int nrows) { const int tidx = otid();
    const int lane = tidx & 63, wave = tidx >> 6;
    for (int row0 = (blockIdx.x * 8 + wave) * 2; row0 < nrows; row0 += gridDim.x * 16) {
        f32x4 v[2][4];
#pragma unroll
        for (int r = 0; r < 2; ++r) { const int row = row0 + r; const void* src = row < M_LAT ? xlat : xctx; const size_t rb = (size_t)(row < M_LAT ? row : row - M_LAT) * D;
#pragma unroll
            for (int j = 0; j < 4; ++j) v[r][j] = ld4res<INBF>(src, rb + (size_t)(lane + 64 * j) * 4); }
#pragma unroll
        for (int r = 0; r < 2; ++r) { const int row = row0 + r; const int mi = row < M_LAT ? row / S : 4;
            const float* sh = modl + (size_t)mi * 6 * D + off_sh; const float* sc = modl + (size_t)mi * 6 * D + off_sc;
            float ss = 0.f;
#pragma unroll
            for (int j = 0; j < 4; ++j) ss += v[r][j].x * v[r][j].x + v[r][j].y * v[r][j].y + v[r][j].z * v[r][j].z + v[r][j].w * v[r][j].w;
            ss = wave_sum(ss);
            const float rs = rsqrtf(ss * (1.f / D) + EPS);
            f32x4 hv[4]; float am = 0.f;
#pragma unroll
            for (int j = 0; j < 4; ++j) { const int k = (lane + 64 * j) * 4;
                const f32x4 w = *(const f32x4*)(nw + k), a = *(const f32x4*)(sc + k), b = *(const f32x4*)(sh + k);
                hv[j].x = v[r][j].x * rs * w.x * (1.f + a.x) + b.x; hv[j].y = v[r][j].y * rs * w.y * (1.f + a.y) + b.y; hv[j].z = v[r][j].z * rs * w.z * (1.f + a.z) + b.z; hv[j].w = v[r][j].w * rs * w.w * (1.f + a.w) + b.w;
                if (act) { ushort4 o; o.x = f2bf(hv[j].x); o.y = f2bf(hv[j].y); o.z = f2bf(hv[j].z); o.w = f2bf(hv[j].w);
                *(ushort4*)(act + (size_t)row * D + k) = o; }
                am = fmaxf(am, fmaxf(fmaxf(fabsf(hv[j].x), fabsf(hv[j].y)), fmaxf(fabsf(hv[j].z), fabsf(hv[j].w)))); }
            if (XQOUT) { am = wave_max(am); const float sx = am > 0.f ? am * (1.f / 127.f) : 1.f, inv = 1.f / sx;
#pragma unroll
                for (int j = 0; j < 4; ++j) { const int q0 = (int)rintf(hv[j].x * inv), q1 = (int)rintf(hv[j].y * inv), q2 = (int)rintf(hv[j].z * inv), q3 = (int)rintf(hv[j].w * inv);
                    *(unsigned*)(xq + (size_t)row * D + (lane + 64 * j) * 4) = (unsigned)(q0 & 0xff) | ((unsigned)(q1 & 0xff) << 8) | ((unsigned)(q2 & 0xff) << 16) | ((unsigned)(q3 & 0xff) << 24); }
                if (lane == 0) xs[row] = sx; }
        }
    }
}

struct EpiBf16Out {
    static constexpr bool PERM = true, AFTER_DRAIN = false;
    bf16* O; int ldc; int ncols;
    __device__ __forceinline__ void operator()(const pg8::f32x4 (&acc)[2][2][4][2], const pg8::Unit& u, int wr, int wc, int fr, int fq) const {
        const int row0 = u.pm * 256 + wr * 64 + fr, col0 = u.pn * 256 + wc * 32 + 8 * fq;
#pragma unroll
        for (int ai = 0; ai < 2; ++ai)
#pragma unroll
            for (int m = 0; m < 4; ++m) { bf16* rowp = O + (size_t)(row0 + ai * 128 + m * 16) * ldc + col0;
#pragma unroll
                for (int bj = 0; bj < 2; ++bj) { if (col0 + bj * 128 < ncols) { const pg8::f32x4 v0 = acc[ai][bj][m][0], v1 = acc[ai][bj][m][1];
                    u32x4 w; w.x = pg8::cvt_pk_bf16(v0[0], v0[1]); w.y = pg8::cvt_pk_bf16(v0[2], v0[3]); w.z = pg8::cvt_pk_bf16(v1[0], v1[1]); w.w = pg8::cvt_pk_bf16(v1[2], v1[3]);
                    *(u32x4*)(rowp + bj * 128) = w; } } }
    }
};
#ifndef NT_STORE
#define NT_STORE 0
#endif
struct EpiI8Bf16Out {
    static constexpr bool PERM = true, AFTER_DRAIN = false;
    bf16* O; int ldc; int ncols; const float* sa; const float* sb;
    __device__ __forceinline__ void operator()(const pg8::i32x4 (&acc)[2][2][4][2], const pg8::Unit& u, int wr, int wc, int fr, int fq) const {
        const int row0 = u.pm * 256 + wr * 64 + fr, col0 = u.pn * 256 + wc * 32 + 8 * fq;
        f32x4 sbv[2][2];
#pragma unroll
        for (int bj = 0; bj < 2; ++bj) { sbv[bj][0] = *(const f32x4*)(sb + col0 + bj * 128); sbv[bj][1] = *(const f32x4*)(sb + col0 + bj * 128 + 4); }
        float srv[2][4];
#pragma unroll
        for (int ai = 0; ai < 2; ++ai)
#pragma unroll
            for (int m = 0; m < 4; ++m) srv[ai][m] = sa[row0 + ai * 128 + m * 16];
#pragma unroll
        for (int ai = 0; ai < 2; ++ai)
#pragma unroll
            for (int m = 0; m < 4; ++m) { const int row = row0 + ai * 128 + m * 16; const float sr = srv[ai][m]; bf16* rowp = O + (size_t)row * ldc + col0;
#pragma unroll
                for (int bj = 0; bj < 2; ++bj) { if (col0 + bj * 128 < ncols) { const pg8::i32x4 v0 = acc[ai][bj][m][0], v1 = acc[ai][bj][m][1]; const f32x4 s0 = sbv[bj][0] * sr, s1 = sbv[bj][1] * sr;
                    u32x4 w; w.x = pg8::cvt_pk_bf16((float)v0[0] * s0.x, (float)v0[1] * s0.y); w.y = pg8::cvt_pk_bf16((float)v0[2] * s0.z, (float)v0[3] * s0.w);
                    w.z = pg8::cvt_pk_bf16((float)v1[0] * s1.x, (float)v1[1] * s1.y); w.w = pg8::cvt_pk_bf16((float)v1[2] * s1.z, (float)v1[3] * s1.w);
                    if (NT_STORE) __builtin_nontemporal_store(w, (u32x4*)(rowp + bj * 128)); else *(u32x4*)(rowp + bj * 128) = w; } } }
    }
};
struct EpiI8QT {
    static constexpr bool PERM = true, AFTER_DRAIN = false;
    bf16* O; const float* sa; const float* sb;
    __device__ __forceinline__ void operator()(const pg8::i32x4 (&acc)[2][2][4][2], const pg8::Unit& u, int wr, int wc, int fr, int fq) const {
        const int row0 = u.pm * 256 + wr * 64 + fr, col0 = u.pn * 256 + wc * 32 + 8 * fq;
        f32x4 sbv[2][2];
#pragma unroll
        for (int bj = 0; bj < 2; ++bj) { sbv[bj][0] = *(const f32x4*)(sb + col0 + bj * 128); sbv[bj][1] = *(const f32x4*)(sb + col0 + bj * 128 + 4); }
        float srv[2][4];
#pragma unroll
        for (int ai = 0; ai < 2; ++ai)
#pragma unroll
            for (int m = 0; m < 4; ++m) srv[ai][m] = sa[row0 + ai * 128 + m * 16];
        const int sfrag = (2 * wc + (fq >> 1)) * 512 + (fq & 1) * 256;
#pragma unroll
        for (int ai = 0; ai < 2; ++ai)
#pragma unroll
            for (int m = 0; m < 4; ++m) { const int row = row0 + ai * 128 + m * 16; const float sr = srv[ai][m];
#pragma unroll
                for (int bj = 0; bj < 2; ++bj) { const pg8::i32x4 v0 = acc[ai][bj][m][0], v1 = acc[ai][bj][m][1]; const f32x4 s0 = sbv[bj][0] * sr, s1 = sbv[bj][1] * sr;
                    u32x4 w; w.x = pg8::cvt_pk_bf16((float)v0[0] * s0.x, (float)v0[1] * s0.y); w.y = pg8::cvt_pk_bf16((float)v0[2] * s0.z, (float)v0[3] * s0.w);
                    w.z = pg8::cvt_pk_bf16((float)v1[0] * s1.x, (float)v1[1] * s1.y); w.w = pg8::cvt_pk_bf16((float)v1[2] * s1.z, (float)v1[3] * s1.w);
                    *(u32x4*)(O + ((size_t)(((row >> 5) * PH + u.pn) * 2 + bj)) * 4096 + sfrag + (row & 31) * 8) = w; } }
    }
};
template <bool INBF>
struct EpiRes {
    static constexpr bool PERM = false, AFTER_DRAIN = false;
    const void* xin_lat; const void* xin_ctx; bf16* xout_lat; bf16* xout_ctx; const float* modl; int off_g;
    __device__ __forceinline__ void operator()(const pg8::f32x4 (&acc)[2][2][4][2], const pg8::Unit& u, int wr, int wc, int fr, int fq) const {
        const int r0 = u.pm * 256; const bool lat = r0 < M_LAT; const int mi = lat ? r0 / S : 4;
        const void* xin = lat ? xin_lat : xin_ctx; bf16* xout = lat ? xout_lat : xout_ctx;
        const size_t rbase = (size_t)(lat ? r0 : r0 - M_LAT) * D;
        const int col0 = u.pn * 256 + wc * 32 + 4 * fq;
        const float* gp = modl + (size_t)mi * 6 * D + off_g + col0;
        f32x4 gv[2][2];
#pragma unroll
        for (int bj = 0; bj < 2; ++bj)
#pragma unroll
            for (int n = 0; n < 2; ++n) gv[bj][n] = *(const f32x4*)(gp + bj * 128 + n * 16);
#pragma unroll
        for (int ai = 0; ai < 2; ++ai) {
            f32x4 xi[4][2][2];
#pragma unroll
            for (int mm = 0; mm < 4; ++mm) { const size_t off = rbase + (size_t)(ai * 128 + wr * 64 + mm * 16 + fr) * D + col0;
#pragma unroll
                for (int bj = 0; bj < 2; ++bj)
#pragma unroll
                    for (int n = 0; n < 2; ++n) xi[mm][bj][n] = ld4res<INBF>(xin, off + bj * 128 + n * 16); }
#pragma unroll
            for (int mm = 0; mm < 4; ++mm) { const size_t off = rbase + (size_t)(ai * 128 + wr * 64 + mm * 16 + fr) * D + col0;
#pragma unroll
                for (int bj = 0; bj < 2; ++bj)
#pragma unroll
                    for (int n = 0; n < 2; ++n) { const pg8::f32x4 a = acc[ai][bj][mm][n]; const f32x4 gq = gv[bj][n], x4 = xi[mm][bj][n]; f32x4 o;
                        o.x = x4.x + gq.x * a[0]; o.y = x4.y + gq.y * a[1]; o.z = x4.z + gq.z * a[2]; o.w = x4.w + gq.w * a[3];
                        st4res(xout, off + bj * 128 + n * 16, o); } }
            asm volatile("" ::: "memory");
        }
    }
};

template <int EPI>
__device__ __forceinline__ void ph_gemm_simple(const bf16* A, const bf16* Bt, int M, int N, int K, bf16* Cb, int ldc, int ncols,
                                               const float* xin_lat, const float* xin_ctx, float* xout_lat, float* xout_ctx, const float* modl, int off_g, bf16* sm  ) { const int tidx = otid();
    bf16 (*sA)[40] = (bf16 (*)[40])sm; bf16 (*sB)[40] = (bf16 (*)[40])(sm + 128 * 40);
    const int tid = tidx, w = tid >> 6, lane = tid & 63, fr = lane & 15, fq = lane >> 4;
    const int lr = tid >> 2, lc = (tid & 3) * 8;
    const int nbn = N / 64, nvb = (M / 128) * nbn;
    for (int vb = blockIdx.x; vb < nvb; vb += gridDim.x) {
        const int m0 = (vb / nbn) * 128, n0 = (vb % nbn) * 64;
        f32x4 acc[4];
#pragma unroll
        for (int j = 0; j < 4; ++j) acc[j] = (f32x4){0.f, 0.f, 0.f, 0.f};
        for (int k0 = 0; k0 < K; k0 += 32) {
            *(bf16x8*)&sA[lr][lc] = *(const bf16x8*)(A + (size_t)(m0 + lr) * K + k0 + lc);
            if (tid < 256) *(bf16x8*)&sB[lr][lc] = *(const bf16x8*)(Bt + (size_t)(n0 + lr) * K + k0 + lc);
            __syncthreads();
            const bf16x8 a = *(const bf16x8*)&sA[w * 16 + fr][fq * 8];
#pragma unroll
            for (int j = 0; j < 4; ++j) { const bf16x8 b = *(const bf16x8*)&sB[j * 16 + fr][fq * 8]; acc[j] = __builtin_amdgcn_mfma_f32_16x16x32_bf16(a, b, acc[j], 0, 0, 0); }
            __syncthreads();
        }
#pragma unroll
        for (int j = 0; j < 4; ++j)
#pragma unroll
            for (int i = 0; i < 4; ++i) {
                const int row = m0 + w * 16 + fq * 4 + i, col = n0 + j * 16 + fr;
                if (EPI == 0) { if (col < ncols) Cb[(size_t)row * ldc + col] = f2bf(acc[j][i]); }
                else { const int mi = row < M_LAT ? row / S : 4; const float g = modl[(size_t)mi * 6 * D + off_g + col];
                    if (row < M_LAT) xout_lat[(size_t)row * D + col] = xin_lat[(size_t)row * D + col] + g * acc[j][i];
                    else { const size_t o = (size_t)(row - M_LAT) * D + col; xout_ctx[o] = xin_ctx[o] + g * acc[j][i]; } }
            }
    }
}

__device__ __forceinline__ void ph_na(const bf16* px, const float* rpb  , bf16* act, int nrows) { const int tidx = otid();
    for (int gid = blockIdx.x * NT + tidx; gid < nrows * NAH; gid += gridDim.x * NT) {
        const int row = gid / NAH, h = gid % NAH;
        float q[64], o[64];
        const bf16* qp = px + (size_t)row * DPROJ + O_NA_Q + h * 64;
#pragma unroll
        for (int d = 0; d < 64; ++d) { q[d] = bf2f(qp[d]) * 0.125f; o[d] = 0.f; }
        float mx = -1e30f, den = 0.f;
        int b, nwin = 0, rr = 0, cq = 0, r_start = 0, c_start = 0;
        if (row < M_LAT) { b = row / S; const int t = row % S; rr = t / GW; cq = t % GW; r_start = min(max(rr - 4, 0), 128 - 8); c_start = min(max(cq - 8, 0), GW - 16); nwin = 128; }
        else b = (row - M_LAT) / CTX;
        for (int i = 0; i < nwin + CTX; ++i) {
            int krow; float bias = 0.f;
            if (i < nwin) { const int j = i / 16, kc = c_start + (i % 16), kr = r_start + j; krow = b * S + kr * GW + kc;
                bias = rpb[(h * 15 + (kr - rr + 7)) * 31 + (kc - cq + 15)]; }
            else krow = M_LAT + b * CTX + (i - nwin);
            const bf16* kp = px + (size_t)krow * DPROJ + O_NA_K + h * 64;
            float s = 0.f;
#pragma unroll
            for (int d = 0; d < 64; ++d) s += q[d] * bf2f(kp[d]);
            s += bias;
            const float nm = fmaxf(mx, s), corr = __expf(mx - nm), p = __expf(s - nm);
            den = den * corr + p; mx = nm;
            const bf16* vp = px + (size_t)krow * DPROJ + O_NA_V + h * 64;
#pragma unroll
            for (int d = 0; d < 64; ++d) o[d] = o[d] * corr + p * bf2f(vp[d]);
        }
        const float inv = 1.f / den;
        bf16* op = act + (size_t)row * D + h * 64;
#pragma unroll
        for (int d = 0; d < 64; ++d) op[d] = f2bf(o[d] * inv);
    }
}

typedef short s16x4 __attribute__((ext_vector_type(4)));
typedef __attribute__((address_space(3))) const unsigned char* lds_cp;
__device__ __forceinline__ s16x4 vtr(lds_cp p) { return __builtin_bit_cast(s16x4, __builtin_amdgcn_ds_read_tr16_b64_v4i16((__attribute__((address_space(3))) s16x4*)p)); }
__device__ __forceinline__ float xq_max(float x) {
    auto s = __builtin_amdgcn_permlane16_swap(__float_as_uint(x), __float_as_uint(x), false, false);
    x = fmaxf(__uint_as_float(s[0]), __uint_as_float(s[1]));
    auto t = __builtin_amdgcn_permlane32_swap(__float_as_uint(x), __float_as_uint(x), false, false);
    return fmaxf(__uint_as_float(t[0]), __uint_as_float(t[1]));
}
__device__ __forceinline__ float xq_sum(float x) {
    auto s = __builtin_amdgcn_permlane16_swap(__float_as_uint(x), __float_as_uint(x), false, false);
    x = __uint_as_float(s[0]) + __uint_as_float(s[1]);
    auto t = __builtin_amdgcn_permlane32_swap(__float_as_uint(x), __float_as_uint(x), false, false);
    return __uint_as_float(t[0]) + __uint_as_float(t[1]);
}
constexpr int NA_ROWB = 160;
constexpr int NA_KOFF = 0, NA_VOFF = 2 * 64 * NA_ROWB, NA_BOFF = 4 * 64 * NA_ROWB;
__device__ __forceinline__ void ph_na_mfma(const bf16* px, const float* rpb  , bf16* act, int nunits, unsigned char* ldsg) { const int tidx = otid();
    const int lane = tidx & 63, w = __builtin_amdgcn_readfirstlane(tidx >> 6), fr = lane & 15, quad = lane >> 4;
    const lds_cp lds = (lds_cp)ldsg;
    float* sbias = (float*)(ldsg + NA_BOFF);
    constexpr float LOG2E = 1.4426950408889634f;
    const int skey = tidx >> 3, spiece = tidx & 7;
    const int G_ = gridDim.x, vcu = (G_ % 8 == 0) ? ((int)blockIdx.x % 8) * (G_ / 8) + (int)blockIdx.x / 8 : (int)blockIdx.x;
    for (int u = vcu; u < nunits; u += G_) {
        int b, h, wr0 = 0, nwin = 0, rq = 0, g = 0, rs_q = 0, qrow;
        const bool latent = u < 1536;
        if (latent) { b = u / 384; h = (u / 64) % 6; const int rp = u % 64;
            wr0 = min(max(2 * rp - 4, 0), 120); const int rs1 = min(max(2 * rp - 3, 0), 120); nwin = rs1 + 8 - wr0;
            rq = 2 * rp + (w >> 2); g = w & 3; rs_q = min(max(rq - 4, 0), 120); qrow = b * S + rq * GW + 16 * g + fr; }
        else { const int cu = u - 1536; b = cu / 12; h = (cu >> 1) % 6; qrow = M_LAT + b * CTX + (cu & 1) * 128 + 16 * w + fr; }
        const int nchunks = 4 + nwin;
        const int cq = 16 * g + fr, c_start = min(max(cq - 8, 0), 48);
        __syncthreads();
        for (int i = tidx; i < 480; i += NT) sbias[i] = (i & 31) < 31 ? rpb[h * 465 + (i >> 5) * 31 + (i & 31)] * LOG2E : -1e30f;
        bf16x8 qf[2];
        qf[0] = *(const bf16x8*)(px + (size_t)qrow * DPROJ + O_NA_Q + h * 64 + 8 * quad);
        qf[1] = *(const bf16x8*)(px + (size_t)qrow * DPROJ + O_NA_Q + h * 64 + 32 + 8 * quad);
        u32x4 kreg, vreg;
        { const size_t r = (size_t)(M_LAT + b * CTX + skey);
          kreg = *(const u32x4*)(px + r * DPROJ + O_NA_K + h * 64 + spiece * 8); vreg = *(const u32x4*)(px + r * DPROJ + O_NA_V + h * 64 + spiece * 8); }
        *(u32x4*)(ldsg + NA_KOFF + skey * NA_ROWB + spiece * 16) = kreg; *(u32x4*)(ldsg + NA_VOFF + skey * NA_ROWB + spiece * 16) = vreg;
        __syncthreads();
        f32x4 O[4];
#pragma unroll
        for (int dt = 0; dt < 4; ++dt) O[dt] = (f32x4){0.f, 0.f, 0.f, 0.f};
        float m = -1e30f, lsum = 0.f;
        const int cbase = 4 * quad - cq + 15;
        const int vbase = 4 * quad - c_start;
        const int c0 = min(max(16 * g - 8, 0), 32);
        int boff[8];
#pragma unroll
        for (int e = 0; e < 8; ++e) { const int ce = c0 + 16 * (e >> 2) + (e & 3); boff[e] = ((unsigned)(vbase + ce) < 16u) ? 4 * min(max(cbase + ce, 0), 30) : 4 * 31; }
        for (int c = 0; c < nchunks; ++c) {
            const int buf = c & 1;
            if (c + 1 < nchunks) { const int c1 = c + 1; const size_t r = c1 < 4 ? (size_t)(M_LAT + b * CTX + 64 * c1 + skey) : (size_t)(b * S + (wr0 + c1 - 4) * GW + skey);
                kreg = *(const u32x4*)(px + r * DPROJ + O_NA_K + h * 64 + spiece * 8); vreg = *(const u32x4*)(px + r * DPROJ + O_NA_V + h * 64 + spiece * 8); }
            const bool isctx = c < 4; const int kr = wr0 + c - 4;
            const bool use = isctx || (kr >= rs_q && kr < rs_q + 8);
            if (use) {
                const lds_cp kb = lds + NA_KOFF + buf * 64 * NA_ROWB, vb = lds + NA_VOFF + buf * 64 * NA_ROWB;
                const char* brow = (const char*)(sbias + (kr - rq + 7) * 32);
#pragma unroll
                for (int pair = 0; pair < 2; ++pair) {
                    if (!isctx && pair == 1) continue;
                    const int kofs = isctx ? 32 * pair : c0;
                    f32x4 a0 = (f32x4){0.f, 0.f, 0.f, 0.f}, a1 = a0;
#pragma unroll
                    for (int s = 0; s < 2; ++s) {
                        const bf16x8 k0 = *(const __attribute__((address_space(3))) bf16x8*)(kb + (kofs + fr) * NA_ROWB + 64 * s + 16 * quad);
                        const bf16x8 k1 = *(const __attribute__((address_space(3))) bf16x8*)(kb + (kofs + 16 + fr) * NA_ROWB + 64 * s + 16 * quad);
                        a0 = __builtin_amdgcn_mfma_f32_16x16x32_bf16(k0, qf[s], a0, 0, 0, 0);
                        a1 = __builtin_amdgcn_mfma_f32_16x16x32_bf16(k1, qf[s], a1, 0, 0, 0);
                    }
                    typedef float f32x2 __attribute__((ext_vector_type(2)));
                    f32x2 s2[4];
                    { float sc[8];
                      if (isctx) {
#pragma unroll
                          for (int i = 0; i < 4; ++i) { sc[i] = a0[i] * (0.125f * LOG2E); sc[4 + i] = a1[i] * (0.125f * LOG2E); }
                      } else {
#pragma unroll
                          for (int e = 0; e < 8; ++e) { const float bm = *(const float*)(brow + boff[e]);
                              sc[e] = __builtin_fmaf(e < 4 ? a0[e & 3] : a1[e & 3], 0.125f * LOG2E, bm); }
                      }
#pragma unroll
                      for (int k = 0; k < 4; ++k) s2[k] = (f32x2){sc[2 * k], sc[2 * k + 1]}; }
                    float mx = __builtin_fmaxf(__builtin_fmaxf(__builtin_fmaxf(s2[0].x, s2[0].y), __builtin_fmaxf(s2[1].x, s2[1].y)), __builtin_fmaxf(__builtin_fmaxf(s2[2].x, s2[2].y), __builtin_fmaxf(s2[3].x, s2[3].y)));
                    mx = xq_max(mx);
                    if (__any(mx > m + 6.f)) {
                        const float mn = fmaxf(m, mx), corr = __builtin_amdgcn_exp2f(m - mn); m = mn;
                        lsum *= corr;
#pragma unroll
                        for (int dt = 0; dt < 4; ++dt) O[dt] = O[dt] * corr;
                    }
                    float p[8];
                    { const f32x2 m2 = (f32x2){m, m}; f32x2 p2[4];
#pragma unroll
                      for (int k = 0; k < 4; ++k) { const f32x2 t = s2[k] - m2; p2[k] = (f32x2){__builtin_amdgcn_exp2f(t.x), __builtin_amdgcn_exp2f(t.y)}; p[2 * k] = p2[k].x; p[2 * k + 1] = p2[k].y; }
                      const f32x2 q2 = (p2[0] + p2[1]) + (p2[2] + p2[3]); lsum += q2.x + q2.y; }
                    u32x4 pk; pk.x = pg8::cvt_pk_bf16_n(p[0], p[1]); pk.y = pg8::cvt_pk_bf16_n(p[2], p[3]); pk.z = pg8::cvt_pk_bf16_n(p[4], p[5]); pk.w = pg8::cvt_pk_bf16_n(p[6], p[7]);
                    const bf16x8 pb = __builtin_bit_cast(bf16x8, pk);
#pragma unroll
                    for (int dt = 0; dt < 4; ++dt) {
                        const lds_cp va = vb + (kofs + 4 * quad + (fr >> 2)) * NA_ROWB + (16 * dt + 4 * (fr & 3)) * 2;
                        const s16x4 v0 = vtr(va), v1 = vtr(va + 16 * NA_ROWB);
                        bf16x8 A; A[0] = v0[0]; A[1] = v0[1]; A[2] = v0[2]; A[3] = v0[3]; A[4] = v1[0]; A[5] = v1[1]; A[6] = v1[2]; A[7] = v1[3];
                        O[dt] = __builtin_amdgcn_mfma_f32_16x16x32_bf16(A, pb, O[dt], 0, 0, 0);
                    }
                }
            }
            if (c + 1 < nchunks) { const int nb = (c + 1) & 1;
                *(u32x4*)(ldsg + NA_KOFF + nb * 64 * NA_ROWB + skey * NA_ROWB + spiece * 16) = kreg; *(u32x4*)(ldsg + NA_VOFF + nb * 64 * NA_ROWB + skey * NA_ROWB + spiece * 16) = vreg; }
            __syncthreads();
        }
        const float inv = 1.f / xq_sum(lsum);
        bf16* op = act + (size_t)qrow * D + h * 64 + 4 * quad;
#pragma unroll
        for (int dt = 0; dt < 4; ++dt) { pg8::u32x2 o; o.x = pg8::cvt_pk_bf16(O[dt][0] * inv, O[dt][1] * inv); o.y = pg8::cvt_pk_bf16(O[dt][2] * inv, O[dt][3] * inv); *(pg8::u32x2*)(op + 16 * dt) = o; }
    }
}
template <int W>
__device__ __forceinline__ void pool_item(const bf16* px, bf16* act, int row, int oc) {
    int t, T, base;
    if (row < M_LAT) { t = row % S; T = S; base = row - t; } else { t = (row - M_LAT) % CTX; T = CTX; base = row - t; }
    const int lo = max(t - W / 2, 0), hi = min(t + W / 2, T);
    bf16x8 tv[W];
#pragma unroll
    for (int i = 0; i < W; ++i) { const int tt = min(lo + i, hi - 1); tv[i] = *(const bf16x8*)(px + (size_t)(base + tt) * DPROJ + O_POOL + oc * 8); }
    const bf16x8 xv = *(const bf16x8*)(px + (size_t)row * DPROJ + O_POOL + oc * 8);
    float s[8];
#pragma unroll
    for (int j = 0; j < 8; ++j) s[j] = 0.f;
#pragma unroll
    for (int i = 0; i < W; ++i) { const float wgt = (lo + i < hi) ? 1.f : 0.f;
#pragma unroll
        for (int j = 0; j < 8; ++j) s[j] += wgt * bf2f((bf16)tv[i][j]); }
    const float inv = 1.f / (float)(hi - lo);
    u32x4 o; o.x = pg8::cvt_pk_bf16(s[0] * inv - bf2f((bf16)xv[0]), s[1] * inv - bf2f((bf16)xv[1])); o.y = pg8::cvt_pk_bf16(s[2] * inv - bf2f((bf16)xv[2]), s[3] * inv - bf2f((bf16)xv[3]));
    o.z = pg8::cvt_pk_bf16(s[4] * inv - bf2f((bf16)xv[4]), s[5] * inv - bf2f((bf16)xv[5])); o.w = pg8::cvt_pk_bf16(s[6] * inv - bf2f((bf16)xv[6]), s[7] * inv - bf2f((bf16)xv[7]));
    *(u32x4*)(act + (size_t)row * D + 768 + oc * 8) = o;
}
__device__ __forceinline__ void ph_pool(const bf16* px, bf16* act, int nrows) { const int tidx = otid();
    const int per = nrows * 8;
    for (int gid = blockIdx.x * NT + tidx; gid < 4 * per; gid += gridDim.x * NT) {
        const int g = gid / per, r = gid - g * per, row = r >> 3, oc = g * 8 + (r & 7);
        if (g == 0) pool_item<2>(px, act, row, oc); else if (g == 1) pool_item<4>(px, act, row, oc); else if (g == 2) pool_item<8>(px, act, row, oc); else pool_item<16>(px, act, row, oc);
    }
}
__device__ __forceinline__ float rope_elem(const bf16* p, int d, const float* cs, const float* sn, bool rope) {
    const float x = bf2f(p[d]);
    if (!rope) return x;
    const int half = d >> 5, dd = d & 31, j = dd & 15;
    const float c = cs[half * 16 + j], s = sn[half * 16 + j];
    if (dd < 16) { const float x2 = bf2f(p[d + 16]); return x * c - x2 * s; }
    else { const float x1 = bf2f(p[d - 16]); return x1 * s + x * c; }
}
__device__ __forceinline__ int chunk_row0(int b, int ci) { return ci < 64 ? b * S + ci * 128 : M_LAT + b * CTX + (ci - 64) * 128; }
__device__ __forceinline__ void load_kv_chunk(const bf16* px, const float* cosT, const float* sinT, int b, int h, int ci, float* sk, float* sv) { const int tidx = otid();
    const int row0 = chunk_row0(b, ci); const bool rope = ci < 64;
    for (int i = tidx; i < 128 * 64; i += NT) { const int m = i / 64, d = i % 64, row = row0 + m; const int t = rope ? (ci * 128 + m) : 0;
        sk[i] = rope_elem(px + (size_t)row * DPROJ + O_RET_K + h * 64, d, cosT + t * 32, sinT + t * 32, rope) * 0.125f;
        sv[i] = bf2f(px[(size_t)row * DPROJ + O_RET_V + h * 64 + d]); }
}
__device__ __forceinline__ void ph_ret_state(const bf16* px, const float* cosT, const float* sinT, const float* dec_f, const float* dec_b, float* ST, float* sm) { const int tidx = otid();
    float* sk = sm; float* sv = sm + 128 * 64;
    for (int vb = blockIdx.x; vb < NB * RH * NCH; vb += gridDim.x) {
        const int ci = vb % NCH, h = (vb / NCH) % RH, b = vb / (NCH * RH);
        load_kv_chunk(px, cosT, sinT, b, h, ci, sk, sv);
        __syncthreads();
        const float lgf = -log1pf(expf(-dec_f[h])), lgb = -log1pf(expf(-dec_b[h]));
        for (int i = tidx; i < 4096; i += NT) { const int d = i / 64, e = i % 64;
            float af = 0.f, ab = 0.f;
            for (int m = 0; m < 128; ++m) { const float kv = sk[m * 64 + d] * sv[m * 64 + e]; af += expf((127.f - m) * lgf) * kv; ab += expf((float)m * lgb) * kv; }
            ST[((((size_t)(b * RH + h) * 2 + 0) * NCH + ci) * 4096) + i] = af; ST[((((size_t)(b * RH + h) * 2 + 1) * NCH + ci) * 4096) + i] = ab; }
        __syncthreads();
    }
}
__device__ __forceinline__ void ph_ret_scan(const float* dec_f, const float* dec_b, float* ST) { const int tidx = otid();
    for (int gid = blockIdx.x * NT + tidx; gid < NB * RH * 2 * 4096; gid += gridDim.x * NT) {
        const int e = gid % 4096, dir = (gid / 4096) & 1, bh = gid / 8192, h = bh % RH;
        const float lg = -log1pf(expf(-(dir ? dec_b[h] : dec_f[h]))), gg = expf(128.f * lg);
        float* P = ST + ((size_t)bh * 2 + dir) * NCH * 4096 + e;
        float t[64];
#pragma unroll
        for (int c = 0; c < 64; ++c) t[c] = P[(size_t)c * 4096];
        const float k0 = P[(size_t)64 * 4096], k1 = P[(size_t)65 * 4096];
        if (dir == 0) { P[(size_t)64 * 4096] = 0.f; P[(size_t)65 * 4096] = k0; float R = gg * k0 + k1;
#pragma unroll
            for (int c = 0; c < 64; ++c) { const float v = t[c]; t[c] = R; R = gg * R + v; } }
        else { P[(size_t)65 * 4096] = 0.f; P[(size_t)64 * 4096] = k1; float R = k0 + gg * k1;
#pragma unroll
            for (int c = 63; c >= 0; --c) { const float v = t[c]; t[c] = R; R = gg * R + v; } }
#pragma unroll
        for (int c = 0; c < 64; ++c) P[(size_t)c * 4096] = t[c];
    }
}
__device__ __forceinline__ void ph_ret_scan_bf(const float* dec_f, const float* dec_b, bf16* ST) { const int tidx = otid();
    for (int gid = blockIdx.x * NT + tidx; gid < NB * RH * 2 * 2048; gid += gridDim.x * NT) {
        const int e2 = gid % 2048, dir = (gid / 2048) & 1, bh = gid / 4096, h = bh % RH;
        const float lg = -log1pf(expf(-(dir ? dec_b[h] : dec_f[h]))), gg = expf(128.f * lg);
        unsigned* P = (unsigned*)(ST + ((size_t)bh * 2 + dir) * NCH * 4096) + e2;
        unsigned t[64];
#pragma unroll
        for (int c = 0; c < 64; ++c) t[c] = P[(size_t)c * 2048];
        const unsigned k0 = P[(size_t)64 * 2048], k1 = P[(size_t)65 * 2048];
        const float k0x = __uint_as_float(k0 << 16), k0y = __uint_as_float(k0 & 0xffff0000u), k1x = __uint_as_float(k1 << 16), k1y = __uint_as_float(k1 & 0xffff0000u);
        if (dir == 0) { P[(size_t)64 * 2048] = 0u; P[(size_t)65 * 2048] = k0; float Rx = gg * k0x + k1x, Ry = gg * k0y + k1y;
#pragma unroll
            for (int c = 0; c < 64; ++c) { const unsigned v = t[c]; t[c] = pg8::cvt_pk_bf16(Rx, Ry); Rx = gg * Rx + __uint_as_float(v << 16); Ry = gg * Ry + __uint_as_float(v & 0xffff0000u); } }
        else { P[(size_t)65 * 2048] = 0u; P[(size_t)64 * 2048] = k1; float Rx = k0x + gg * k1x, Ry = k0y + gg * k1y;
#pragma unroll
            for (int c = 63; c >= 0; --c) { const unsigned v = t[c]; t[c] = pg8::cvt_pk_bf16(Rx, Ry); Rx = gg * Rx + __uint_as_float(v << 16); Ry = gg * Ry + __uint_as_float(v & 0xffff0000u); } }
#pragma unroll
        for (int c = 0; c < 64; ++c) P[(size_t)c * 2048] = t[c];
    }
}
__device__ __forceinline__ void ph_ret_out(const bf16* px, const float* cosT, const float* sinT, const float* dec_f, const float* dec_b, const float* ST, const float* gn_w, bf16* act, int nci, float* sm) { const int tidx = otid();
    float* sk = sm; float* sv = sm + 128 * 64; float* sy = sm + 2 * 128 * 64; float* sq = sy + 128 * 65;
    const int n = tidx & 127, eq = tidx >> 7;
    for (int vb = blockIdx.x; vb < NB * RH * nci; vb += gridDim.x) {
        const int ci = vb % nci, h = (vb / nci) % RH, b = vb / (nci * RH);
        const int row0 = chunk_row0(b, ci); const bool rope = ci < 64;
        load_kv_chunk(px, cosT, sinT, b, h, ci, sk, sv);
        __syncthreads();
        const int row = row0 + n; const int t = rope ? (ci * 128 + n) : 0;
        const float lgf = -log1pf(expf(-dec_f[h])), lgb = -log1pf(expf(-dec_b[h]));
        float q[64], y[16];
#pragma unroll
        for (int d = 0; d < 64; ++d) { q[d] = rope_elem(px + (size_t)row * DPROJ + O_RET_Q + h * 64, d, cosT + t * 32, sinT + t * 32, rope); if (eq == 0) sq[n * 65 + d] = q[d]; }
        __syncthreads();
#pragma unroll
        for (int e = 0; e < 16; ++e) y[e] = 0.f;
        for (int m = 0; m < 128; ++m) {
            float s = 0.f;
#pragma unroll
            for (int d = 0; d < 64; ++d) s += q[d] * sk[m * 64 + d];
            const float dm = m < n ? expf((float)(n - m) * lgf) : (m > n ? expf((float)(m - n) * lgb) : 2.f);
            s *= dm;
#pragma unroll
            for (int e = 0; e < 16; ++e) y[e] += s * sv[m * 64 + eq * 16 + e];
        }
        const float* Sf = ST + (((size_t)(b * RH + h) * 2 + 0) * NCH + ci) * 4096 + eq * 16; const float* Sb = ST + (((size_t)(b * RH + h) * 2 + 1) * NCH + ci) * 4096 + eq * 16;
        const float xf = expf((float)(n + 1) * lgf), xb = expf((float)(128 - n) * lgb);
#pragma unroll 1
        for (int d = 0; d < 64; ++d) { const float qd = sq[n * 65 + d]; const float qf = qd * xf, qb = qd * xb;
#pragma unroll
            for (int e = 0; e < 16; ++e) y[e] += qf * Sf[d * 64 + e] + qb * Sb[d * 64 + e]; }
#pragma unroll
        for (int e = 0; e < 16; ++e) sy[n * 65 + eq * 16 + e] = y[e];
        __syncthreads();
        float mu = 0.f;
        for (int e = 0; e < 64; ++e) mu += sy[n * 65 + e];
        mu *= (1.f / 64.f); float var = 0.f;
        for (int e = 0; e < 64; ++e) { const float dd = sy[n * 65 + e] - mu; var += dd * dd; }
        const float rs = rsqrtf(var * (1.f / 64.f) + EPS);
        const bf16* gp = px + (size_t)row * DPROJ + O_RET_G + h * 64 + eq * 16; bf16* op = act + (size_t)row * D + NAW + h * 64 + eq * 16;
#pragma unroll
        for (int e = 0; e < 16; ++e) { const float g = bf2f(gp[e]); op[e] = f2bf((y[e] - mu) * rs * gn_w[h * 64 + eq * 16 + e] * silu(g)); }
        __syncthreads();
    }
}


__device__ __forceinline__ void rope8(const bf16* hp, int piece, const float* cs, const float* sn, bool rope, float (&o)[8]) {
    const bf16x8 own = *(const bf16x8*)(hp + piece * 8);
    if (!rope) {
#pragma unroll
        for (int j = 0; j < 8; ++j) o[j] = bf2f((bf16)own[j]);
        return; }
    const bf16x8 par = *(const bf16x8*)(hp + (piece ^ 2) * 8);
    const int half = piece >> 2, pp = piece & 3, tb = half * 16 + 8 * (pp & 1);
    const f32x4 c0 = *(const f32x4*)(cs + tb), c1 = *(const f32x4*)(cs + tb + 4), s0 = *(const f32x4*)(sn + tb), s1 = *(const f32x4*)(sn + tb + 4);
    const float c[8] = {c0.x, c0.y, c0.z, c0.w, c1.x, c1.y, c1.z, c1.w}, s[8] = {s0.x, s0.y, s0.z, s0.w, s1.x, s1.y, s1.z, s1.w};
#pragma unroll
    for (int j = 0; j < 8; ++j) { const float a = bf2f((bf16)own[j]), b = bf2f((bf16)par[j]); o[j] = pp < 2 ? a * c[j] - b * s[j] : b * s[j] + a * c[j]; }
}
__device__ __forceinline__ u32x4 pack8(const float (&o)[8], float sc) {
    u32x4 r; r.x = pg8::cvt_pk_bf16(o[0] * sc, o[1] * sc); r.y = pg8::cvt_pk_bf16(o[2] * sc, o[3] * sc); r.z = pg8::cvt_pk_bf16(o[4] * sc, o[5] * sc); r.w = pg8::cvt_pk_bf16(o[6] * sc, o[7] * sc); return r;
}
__device__ __forceinline__ bf16x8 tr2(lds_cp a, int second_off) {
    const s16x4 v0 = vtr(a), v1 = vtr(a + second_off);
    bf16x8 A; A[0] = v0[0]; A[1] = v0[1]; A[2] = v0[2]; A[3] = v0[3]; A[4] = v1[0]; A[5] = v1[1]; A[6] = v1[2]; A[7] = v1[3]; return A;
}
constexpr int RT_P = 160;
__device__ __forceinline__ void rope_inv8(int odd, float (&inv8)[8]) {
#pragma unroll
    for (int k = 0; k < 8; ++k) inv8[k] = __builtin_amdgcn_exp2f(-(float)(8 * odd + k) * (13.287712379549449f / 16.f)) * 0.15915494309189535f;
}
__device__ __forceinline__ void rope8c(const bf16x8 own, const bf16x8 par, int piece, int t, const float (&inv8)[8], bool rope, float (&o)[8]) {
    if (!rope) {
#pragma unroll
        for (int j = 0; j < 8; ++j) o[j] = bf2f((bf16)own[j]);
        return; }
    const int half = piece >> 2, pp = piece & 3;
    const float pos = (float)(half ? (t % GW) : (t / GW));
#pragma unroll
    for (int j = 0; j < 8; ++j) { const float rev = pos * inv8[j], c = __builtin_amdgcn_cosf(rev), s = __builtin_amdgcn_sinf(rev);
        const float a = bf2f((bf16)own[j]), b = bf2f((bf16)par[j]); o[j] = pp < 2 ? a * c - b * s : b * s + a * c; }
}
__device__ __forceinline__ void rope8r(const bf16x8 own, const bf16x8 par, int piece, const float* cs, const float* sn, bool rope, float (&o)[8]) {
    if (!rope) {
#pragma unroll
        for (int j = 0; j < 8; ++j) o[j] = bf2f((bf16)own[j]);
        return; }
    const int half = piece >> 2, pp = piece & 3, tb = half * 16 + 8 * (pp & 1);
    const f32x4 c0 = *(const f32x4*)(cs + tb), c1 = *(const f32x4*)(cs + tb + 4), s0 = *(const f32x4*)(sn + tb), s1 = *(const f32x4*)(sn + tb + 4);
    const float c[8] = {c0.x, c0.y, c0.z, c0.w, c1.x, c1.y, c1.z, c1.w}, s[8] = {s0.x, s0.y, s0.z, s0.w, s1.x, s1.y, s1.z, s1.w};
#pragma unroll
    for (int j = 0; j < 8; ++j) { const float a = bf2f((bf16)own[j]), b = bf2f((bf16)par[j]); o[j] = pp < 2 ? a * c[j] - b * s[j] : b * s[j] + a * c[j]; }
}
__device__ __forceinline__ void ph_ret_state_mfma(const bf16* px, const float* cosT, const float* sinT, const float* dec_f, const float* dec_b, bf16* ST, unsigned char* ldsg) { const int tidx = otid();
    const int lane = tidx & 63, w = __builtin_amdgcn_readfirstlane(tidx >> 6), fr = lane & 15, quad = lane >> 4;
    const lds_cp lds = (lds_cp)ldsg;
    constexpr int KF = 0, KB = 128 * RT_P, VS = 2 * 128 * RT_P;
    constexpr int NU = NB * RH * NCH;
    bf16x8 kown[2], kpar[2]; u32x4 vv[2];
#define R1_ISSUE(vbx) do { const int ci_ = (vbx) % NCH, h_ = ((vbx) / NCH) % RH, b_ = (vbx) / (NCH * RH); const int row0_ = chunk_row0(b_, ci_); \
        _Pragma("unroll") for (int it = 0; it < 2; ++it) { const int item = tidx + NT * it, m = item >> 3, piece = item & 7; const bf16* rp = px + (size_t)(row0_ + m) * DPROJ; \
            kown[it] = *(const bf16x8*)(rp + O_RET_K + h_ * 64 + piece * 8); kpar[it] = *(const bf16x8*)(rp + O_RET_K + h_ * 64 + (piece ^ 2) * 8); vv[it] = *(const u32x4*)(rp + O_RET_V + h_ * 64 + piece * 8); } } while (0)
    float invk[8]; rope_inv8(tidx & 1, invk);
    int vb = blockIdx.x;
    if (vb < NU) R1_ISSUE(vb);
    for (; vb < NU; vb += gridDim.x) {
        const int ci = vb % NCH, h = (vb / NCH) % RH, b = vb / (NCH * RH);
        const bool rope = ci < 64;
        const float lgf = -log1pf(expf(-dec_f[h])), lgb = -log1pf(expf(-dec_b[h]));
        __syncthreads();
#pragma unroll
        for (int it = 0; it < 2; ++it) { const int item = tidx + NT * it, m = item >> 3, piece = item & 7; const int t = rope ? (ci * 128 + m) : 0;
            float o[8]; rope8c(kown[it], kpar[it], piece, t, invk, rope, o);
            *(u32x4*)(ldsg + KF + m * RT_P + piece * 16) = pack8(o, 0.125f * expf((127.f - (float)m) * lgf));
            *(u32x4*)(ldsg + KB + m * RT_P + piece * 16) = pack8(o, 0.125f * expf((float)m * lgb));
            *(u32x4*)(ldsg + VS + m * RT_P + piece * 16) = vv[it]; }
        if (vb + (int)gridDim.x < NU) R1_ISSUE(vb + (int)gridDim.x);
        __syncthreads();
        const int dir = w >> 2, dt = w & 3;
        const lds_cp kb = lds + (dir ? KB : KF);
        bf16x8 A[4];
#pragma unroll
        for (int ks = 0; ks < 4; ++ks) A[ks] = tr2(kb + (32 * ks + 8 * quad + (fr >> 2)) * RT_P + (16 * dt + 4 * (fr & 3)) * 2, 4 * RT_P);
        bf16* outp = ST + ((((size_t)(b * RH + h) * 2 + dir) * NCH + ci) * 4096);
#pragma unroll
        for (int et = 0; et < 4; ++et) {
            f32x4 acc = (f32x4){0.f, 0.f, 0.f, 0.f};
#pragma unroll
            for (int ks = 0; ks < 4; ++ks) { const bf16x8 Bv = tr2(lds + VS + (32 * ks + 8 * quad + (fr >> 2)) * RT_P + (16 * et + 4 * (fr & 3)) * 2, 4 * RT_P);
                acc = __builtin_amdgcn_mfma_f32_16x16x32_bf16(A[ks], Bv, acc, 0, 0, 0); }
#pragma unroll
            for (int i = 0; i < 4; ++i) outp[(16 * dt + 4 * quad + i) * 64 + 16 * et + fr] = f2bf(acc[i]);
        }
    }
#undef R1_ISSUE
}
__device__ __forceinline__ void ph_ret_out_mfma(const bf16* px, const float* cosT, const float* sinT, const float* dec_f, const float* dec_b, const bf16* ST, const float* gn_w, bf16* act, int nci, unsigned char* ldsg) { const int tidx = otid();
    const int lane = tidx & 63, w = __builtin_amdgcn_readfirstlane(tidx >> 6), fr = lane & 15, quad = lane >> 4;
    const lds_cp lds = (lds_cp)ldsg;
    constexpr int KS = 0, VS = 128 * RT_P, SF = 2 * 128 * RT_P, SB = SF + 64 * RT_P;
    constexpr float LOG2E = 1.4426950408889634f;
    const int NU = NB * RH * nci;
    bf16x8 kown[2], kpar[2], qown[2], qpar[2]; u32x4 vv[2]; u32x4 sfu, sbu;
#define R3_ISSUE(vbx) do { const int ci_ = (vbx) % nci, h_ = ((vbx) / nci) % RH, b_ = (vbx) / (nci * RH); const int row0_ = chunk_row0(b_, ci_); \
        _Pragma("unroll") for (int it = 0; it < 2; ++it) { const int item = tidx + NT * it, m = item >> 3, piece = item & 7; const bf16* rp = px + (size_t)(row0_ + m) * DPROJ; \
            kown[it] = *(const bf16x8*)(rp + O_RET_K + h_ * 64 + piece * 8); kpar[it] = *(const bf16x8*)(rp + O_RET_K + h_ * 64 + (piece ^ 2) * 8); vv[it] = *(const u32x4*)(rp + O_RET_V + h_ * 64 + piece * 8); } \
        { const bf16* Sf_ = ST + (((size_t)(b_ * RH + h_) * 2 + 0) * NCH + ci_) * 4096; const bf16* Sb_ = ST + (((size_t)(b_ * RH + h_) * 2 + 1) * NCH + ci_) * 4096; const int d_ = tidx >> 3, e0_ = (tidx & 7) * 8; \
          sfu = *(const u32x4*)(Sf_ + d_ * 64 + e0_); sbu = *(const u32x4*)(Sb_ + d_ * 64 + e0_); } \
        { const bf16* qp = px + (size_t)(row0_ + 16 * w + fr) * DPROJ + O_RET_Q + h_ * 64; \
          _Pragma("unroll") for (int s = 0; s < 2; ++s) { qown[s] = *(const bf16x8*)(qp + (4 * s + quad) * 8); qpar[s] = *(const bf16x8*)(qp + ((4 * s + quad) ^ 2) * 8); } } } while (0)
    float invk[8], invq[8]; rope_inv8(tidx & 1, invk); rope_inv8(quad & 1, invq);
    int vb = blockIdx.x;
    if (vb < NU) R3_ISSUE(vb);
    for (; vb < NU; vb += gridDim.x) {
        const int ci = vb % nci, h = (vb / nci) % RH, b = vb / (nci * RH);
        const int row0 = chunk_row0(b, ci); const bool rope = ci < 64;
        const float lgf2 = -log1pf(expf(-dec_f[h])) * LOG2E, lgb2 = -log1pf(expf(-dec_b[h])) * LOG2E;
        __syncthreads();
#pragma unroll
        for (int it = 0; it < 2; ++it) { const int item = tidx + NT * it, m = item >> 3, piece = item & 7; const int t = rope ? (ci * 128 + m) : 0;
            float o[8]; rope8c(kown[it], kpar[it], piece, t, invk, rope, o);
            *(u32x4*)(ldsg + KS + m * RT_P + piece * 16) = pack8(o, 0.125f);
            *(u32x4*)(ldsg + VS + m * RT_P + piece * 16) = vv[it]; }
        { const int d = tidx >> 3, e0 = (tidx & 7) * 8;
          *(u32x4*)(ldsg + SF + d * RT_P + e0 * 2) = sfu; *(u32x4*)(ldsg + SB + d * RT_P + e0 * 2) = sbu; }
        const int nloc = 16 * w + fr, row = row0 + nloc; const int tq = rope ? (ci * 128 + nloc) : 0;
        bf16x8 qf[2];
#pragma unroll
        for (int s = 0; s < 2; ++s) { float o[8]; rope8c(qown[s], qpar[s], 4 * s + quad, tq, invq, rope, o); qf[s] = __builtin_bit_cast(bf16x8, pack8(o, 1.f)); }
        if (vb + (int)gridDim.x < NU) R3_ISSUE(vb + (int)gridDim.x);
        __syncthreads();
        f32x4 Y[4];
#pragma unroll
        for (int et = 0; et < 4; ++et) Y[et] = (f32x4){0.f, 0.f, 0.f, 0.f};
        float lf[4], lb[4];
#pragma unroll
        for (int i = 0; i < 4; ++i) { const float dl = (float)(fr - 4 * quad - i); lf[i] = __builtin_amdgcn_exp2f(dl * lgf2); lb[i] = __builtin_amdgcn_exp2f(-dl * lgb2); }
#pragma unroll
        for (int mp = 0; mp < 4; ++mp) {
            float p[8];
#pragma unroll
            for (int t2 = 0; t2 < 2; ++t2) { const int mt = 2 * mp + t2;
                f32x4 acc = (f32x4){0.f, 0.f, 0.f, 0.f};
#pragma unroll
                for (int s = 0; s < 2; ++s) { const bf16x8 kf = *(const __attribute__((address_space(3))) bf16x8*)(lds + KS + (16 * mt + fr) * RT_P + 64 * s + 16 * quad);
                    acc = __builtin_amdgcn_mfma_f32_16x16x32_bf16(kf, qf[s], acc, 0, 0, 0); }
                if (mt == w) {
#pragma unroll
                    for (int i = 0; i < 4; ++i) { const int df = fr - 4 * quad - i;
                        const float dm = df > 0 ? lf[i] : (df < 0 ? lb[i] : 2.f);
                        p[4 * t2 + i] = acc[i] * dm; }
                } else {
                    const float tf = mt < w ? __builtin_amdgcn_exp2f((float)(16 * (w - mt)) * lgf2) : __builtin_amdgcn_exp2f((float)(16 * (mt - w)) * lgb2);
#pragma unroll
                    for (int i = 0; i < 4; ++i) p[4 * t2 + i] = acc[i] * ((mt < w ? lf[i] : lb[i]) * tf);
                } }
            u32x4 pk; pk.x = pg8::cvt_pk_bf16(p[0], p[1]); pk.y = pg8::cvt_pk_bf16(p[2], p[3]); pk.z = pg8::cvt_pk_bf16(p[4], p[5]); pk.w = pg8::cvt_pk_bf16(p[6], p[7]);
            const bf16x8 pb = __builtin_bit_cast(bf16x8, pk);
#pragma unroll
            for (int et = 0; et < 4; ++et) { const bf16x8 A = tr2(lds + VS + (32 * mp + 4 * quad + (fr >> 2)) * RT_P + (16 * et + 4 * (fr & 3)) * 2, 16 * RT_P);
                Y[et] = __builtin_amdgcn_mfma_f32_16x16x32_bf16(A, pb, Y[et], 0, 0, 0); }
        }
        const float xf = __builtin_amdgcn_exp2f((float)(nloc + 1) * lgf2), xb = __builtin_amdgcn_exp2f((float)(128 - nloc) * lgb2);
#pragma unroll
        for (int et = 0; et < 4; ++et) {
            f32x4 cf = (f32x4){0.f, 0.f, 0.f, 0.f}, cb = cf;
#pragma unroll
            for (int ks = 0; ks < 2; ++ks) { const int ro = (32 * ks + 8 * quad + (fr >> 2)) * RT_P + (16 * et + 4 * (fr & 3)) * 2;
                cf = __builtin_amdgcn_mfma_f32_16x16x32_bf16(tr2(lds + SF + ro, 4 * RT_P), qf[ks], cf, 0, 0, 0);
                cb = __builtin_amdgcn_mfma_f32_16x16x32_bf16(tr2(lds + SB + ro, 4 * RT_P), qf[ks], cb, 0, 0, 0); }
            Y[et] = Y[et] + cf * xf + cb * xb;
        }
        float s1 = 0.f;
#pragma unroll
        for (int et = 0; et < 4; ++et) s1 += (Y[et][0] + Y[et][1]) + (Y[et][2] + Y[et][3]);
        const float mu = xq_sum(s1) * (1.f / 64.f);
        float s2 = 0.f;
#pragma unroll
        for (int et = 0; et < 4; ++et)
#pragma unroll
            for (int i = 0; i < 4; ++i) { const float dd = Y[et][i] - mu; s2 += dd * dd; }
        const float rs = rsqrtf(xq_sum(s2) * (1.f / 64.f) + EPS);
        const bf16* gp = px + (size_t)row * DPROJ + O_RET_G + h * 64 + 4 * quad; bf16* op = act + (size_t)row * D + NAW + h * 64 + 4 * quad; const float* gw = gn_w + h * 64 + 4 * quad;
#pragma unroll
        for (int et = 0; et < 4; ++et) { const ushort4 gv = *(const ushort4*)(gp + 16 * et); const f32x4 wv = *(const f32x4*)(gw + 16 * et);
            const float o0 = (Y[et][0] - mu) * rs * wv.x * silu(bf2f(gv.x)), o1 = (Y[et][1] - mu) * rs * wv.y * silu(bf2f(gv.y)), o2 = (Y[et][2] - mu) * rs * wv.z * silu(bf2f(gv.z)), o3 = (Y[et][3] - mu) * rs * wv.w * silu(bf2f(gv.w));
            pg8::u32x2 o; o.x = pg8::cvt_pk_bf16(o0, o1); o.y = pg8::cvt_pk_bf16(o2, o3); *(pg8::u32x2*)(op + 16 * et) = o; }
    }
#undef R3_ISSUE
}
__device__ __forceinline__ void ph_topk1(const bf16* Q, const bf16* keysl, float* topv, int* topi, int nrows, bf16* sm) { const int tidx = otid();
    bf16 (*sk)[136] = (bf16 (*)[136])sm;
    const int nrt = nrows / NT;
    for (int vb = blockIdx.x; vb < nrt * 16; vb += gridDim.x) {
        const int hs = vb % 16, side = hs & 1, h = hs >> 1, row = (vb / 16) * NT + tidx;
        const bf16* kp = keysl + ((size_t)(side * PH + h) * PNK) * PKD;
        for (int i = tidx; i < 128 * 128; i += NT) sk[i / 128][i % 128] = kp[i];
        __syncthreads();
        float q[128];
        const bf16* qp = Q + (size_t)row * DQ + h * 256 + side * 128;
#pragma unroll
        for (int d = 0; d < 128; ++d) q[d] = bf2f(qp[d]);
        float tv[16]; int ti[16];
#pragma unroll
        for (int j = 0; j < 16; ++j) { tv[j] = -3e38f; ti[j] = 0; }
        for (int kk = 0; kk < 128; ++kk) {
            float s = 0.f;
#pragma unroll
            for (int d = 0; d < 128; ++d) s += q[d] * bf2f(sk[kk][d]);
            int si = kk;
#pragma unroll
            for (int j = 0; j < 16; ++j) { if (s > tv[j]) { const float tvv = tv[j]; const int tii = ti[j]; tv[j] = s; ti[j] = si; s = tvv; si = tii; } }
        }
        const size_t o = (((size_t)row * PH + h) * 2 + side) * 16;
#pragma unroll
        for (int j = 0; j < 16; ++j) { topv[o + j] = tv[j]; topi[o + j] = ti[j]; }
        __syncthreads();
    }
}
__device__ __forceinline__ void ph_topk2(const float* topv, const int* topi, int* idx, float* gate, int nrows) { const int tidx = otid();
    for (int gid = blockIdx.x * NT + tidx; gid < nrows * PH; gid += gridDim.x * NT) {
        const size_t o = (size_t)gid * 32;
        float vb[16];
#pragma unroll
        for (int j = 0; j < 16; ++j) vb[j] = topv[o + 16 + j];
        float tv[16]; int ti[16];
#pragma unroll
        for (int j = 0; j < 16; ++j) { tv[j] = -3e38f; ti[j] = 0; }
#pragma unroll 1
        for (int i = 0; i < 16; ++i) { const float vai = topv[o + i];
#pragma unroll
            for (int jb = 0; jb < 16; ++jb) { float s = vai + vb[jb]; int si = i * 16 + jb;
#pragma unroll
                for (int j = 0; j < 16; ++j) { if (s > tv[j]) { const float tvv = tv[j]; const int tii = ti[j]; tv[j] = s; ti[j] = si; s = tvv; si = tii; } } } }
        const float mx = tv[0]; float den = 0.f, p[16];
#pragma unroll
        for (int j = 0; j < 16; ++j) { p[j] = __expf(tv[j] - mx); den += p[j]; }
        const float inv = 1.f / den;
        const size_t oo = (size_t)gid * 16;
#pragma unroll
        for (int j = 0; j < 16; ++j) { const int ia = topi[o + (ti[j] >> 4)], ib = topi[o + 16 + (ti[j] & 15)]; idx[oo + j] = ia * PNK + ib; gate[oo + j] = p[j] * inv; }
    }
}


__device__ __forceinline__ void ins16(float (&L)[16], float v) {
#pragma unroll
    for (int j = 15; j >= 1; --j) L[j] = __builtin_amdgcn_fmed3f(L[j - 1], v, L[j]);
    L[0] = fmaxf(L[0], v);
}
__device__ __forceinline__ void bitonic_merge16(float (&L)[16], const float (&A)[16], const float (&B)[16]) {
#pragma unroll
    for (int j = 0; j < 16; ++j) L[j] = fmaxf(A[j], B[15 - j]);
#pragma unroll
    for (int st = 8; st >= 1; st >>= 1)
#pragma unroll
        for (int j = 0; j < 16; ++j) if ((j & st) == 0) { const float hi = fmaxf(L[j], L[j + st]), lo = fminf(L[j], L[j + st]); L[j] = hi; L[j + st] = lo; }
}
__device__ __forceinline__ void top16of32(float (&v)[32]) {
#define CE(i, j) { const float hi_ = fmaxf(v[i], v[j]), lo_ = fminf(v[i], v[j]); v[i] = hi_; v[j] = lo_; }
#define CMAX(i, j) { v[i] = fmaxf(v[i], v[j]); }
#define CMIN(i, j) { v[j] = fminf(v[i], v[j]); }
    CE(0,1) CE(2,3) CE(0,2) CE(1,3) CE(1,2) CE(4,5) CE(6,7) CE(4,6) CE(5,7) CE(5,6) CE(0,4) CE(2,6) CE(2,4) CE(1,5) CE(3,7) CE(3,5) CE(1,2) CE(3,4) CE(5,6) CE(8,9) CE(10,11) CE(8,10) CE(9,11) CE(9,10) CE(12,13) CE(14,15) CE(12,14) CE(13,15) CE(13,14) CE(8,12) CE(10,14) CE(10,12) CE(9,13) CE(11,15) CE(11,13) CE(9,10) CE(11,12) CE(13,14) CE(0,8) CE(4,12) CE(4,8) CE(2,10) CE(6,14) CE(6,10) CE(2,4) CE(6,8) CE(10,12) CE(1,9) CE(5,13) CE(5,9) CE(3,11) CE(7,15) CE(7,11) CE(3,5) CE(7,9) CE(11,13) CE(1,2) CE(3,4) CE(5,6) CE(7,8) CE(9,10) CE(11,12) CE(13,14) CE(16,17) CE(18,19) CE(16,18) CE(17,19) CE(17,18) CE(20,21) CE(22,23) CE(20,22) CE(21,23) CE(21,22) CE(16,20) CE(18,22) CE(18,20) CE(17,21) CE(19,23) CE(19,21) CE(17,18) CE(19,20) CE(21,22) CE(24,25) CE(26,27) CE(24,26) CE(25,27) CE(25,26) CE(28,29) CE(30,31) CE(28,30) CE(29,31) CE(29,30) CE(24,28) CE(26,30) CE(26,28) CE(25,29) CE(27,31) CE(27,29) CE(25,26) CE(27,28) CE(29,30) CE(16,24) CE(20,28) CE(20,24) CE(18,26) CE(22,30) CE(22,26) CE(18,20) CE(22,24) CE(26,28) CE(17,25) CE(21,29) CE(21,25) CE(19,27) CE(23,31) CE(23,27) CE(19,21) CE(23,25) CE(27,29) CE(17,18) CE(19,20) CE(21,22) CE(23,24) CE(25,26) CE(27,28) CE(29,30) CE(0,16) CMAX(8,24) CE(8,16) CE(4,20) CMAX(12,28) CMAX(12,20) CE(4,8) CE(12,16) CE(2,18) CMAX(10,26) CE(10,18) CE(6,22) CMAX(14,30) CMAX(14,22) CE(6,10) CMAX(14,18) CE(2,4) CE(6,8) CE(10,12) CE(14,16) CE(1,17) CMAX(9,25) CE(9,17) CE(5,21) CMAX(13,29) CMAX(13,21) CE(5,9) CE(13,17) CE(3,19) CMAX(11,27) CE(11,19) CE(7,23) CMAX(15,31) CMAX(15,23) CE(7,11) CMAX(15,19) CE(3,5) CE(7,9) CE(11,13) CMAX(15,17) CE(1,2) CE(3,4) CE(5,6) CE(7,8) CE(9,10) CE(11,12) CE(13,14) CMAX(15,16)
#undef CE
#undef CMAX
#undef CMIN
}
constexpr int TK_KROW = 272;
constexpr int TK_LIST = 2 * 128 * TK_KROW;
__device__ __forceinline__ void ph_tk_mfma(const bf16* Q, const bf16* keysl, int* idx, float* gate, int nrows, unsigned char* ldsg) { const int tidx = otid();
    const int lane = tidx & 63, w = __builtin_amdgcn_readfirstlane(tidx >> 6), fr = lane & 15, quad = lane >> 4;
    const lds_cp lds = (lds_cp)ldsg;
    unsigned* lists = (unsigned*)(ldsg + TK_LIST) + (w * 16 + fr) * 32;
    const int nunits = (nrows / 128) * PH;
    int hcur = -1;
    for (int u = blockIdx.x; u < nunits; u += gridDim.x) {
        const int h = u % PH, tile = u / PH;
        __syncthreads();
        if (h != hcur) {
            for (int i = tidx; i < 2 * 128 * 16; i += NT) { const int side = i >> 11, r = (i >> 4) & 127, pc = i & 15;
                *(u32x4*)(ldsg + (side * 128 + r) * TK_KROW + pc * 16) = *(const u32x4*)(keysl + ((size_t)(side * PH + h) * PNK + r) * PKD + pc * 8); }
            hcur = h;
        }
        __syncthreads();
        const int row = tile * 128 + 16 * w + fr;
        float Lb[16];
#pragma unroll
        for (int side = 0; side < 2; ++side) {
            bf16x8 qf[4];
#pragma unroll
            for (int s = 0; s < 4; ++s) qf[s] = *(const bf16x8*)(Q + (size_t)row * DQ + h * 256 + side * 128 + 32 * s + 8 * quad);
            float L[16];
            { float pv[32];
#pragma unroll
              for (int t = 0; t < 8; ++t) {
                f32x4 acc = (f32x4){0.f, 0.f, 0.f, 0.f};
#pragma unroll
                for (int s = 0; s < 4; ++s) { const bf16x8 kf = *(const __attribute__((address_space(3))) bf16x8*)(lds + (side * 128 + 16 * t + fr) * TK_KROW + 64 * s + 16 * quad);
                    acc = __builtin_amdgcn_mfma_f32_16x16x32_bf16(kf, qf[s], acc, 0, 0, 0); }
#pragma unroll
                for (int i = 0; i < 4; ++i) { const unsigned key = 16 * t + 4 * quad + i; pv[4 * t + i] = __uint_as_float((__float_as_uint(acc[i]) & ~0x7fu) | key); }
              }
              top16of32(pv);
#pragma unroll
              for (int j = 0; j < 16; ++j) L[j] = pv[j]; }
            { float A[16], B[16];
#pragma unroll
              for (int j = 0; j < 16; ++j) { auto s = __builtin_amdgcn_permlane16_swap(__float_as_uint(L[j]), __float_as_uint(L[j]), false, false); A[j] = __uint_as_float(s[0]); B[j] = __uint_as_float(s[1]); }
              bitonic_merge16(L, A, B);
#pragma unroll
              for (int j = 0; j < 16; ++j) { auto s = __builtin_amdgcn_permlane32_swap(__float_as_uint(L[j]), __float_as_uint(L[j]), false, false); A[j] = __uint_as_float(s[0]); B[j] = __uint_as_float(s[1]); }
              bitonic_merge16(L, A, B); }
            if (side == 0) {
                if (quad == 0) {
#pragma unroll
                    for (int j = 0; j < 16; ++j) lists[j] = __float_as_uint(L[j]); }
            } else {
#pragma unroll
                for (int j = 0; j < 16; ++j) Lb[j] = L[j];
                if (quad == 0) {
#pragma unroll
                    for (int j = 0; j < 16; ++j) lists[16 + j] = __float_as_uint(L[j]); }
            }
        }

        float C[16];
#pragma unroll
        for (int j = 0; j < 16; ++j) C[j] = -3.0e38f;
#pragma unroll
        for (int r = 0; r < 4; ++r) {
            const float vai = __uint_as_float(lists[4 * r + quad] & ~0x7fu);
            const int irow = 4 * r + quad, len = 16 / (irow + 1);
            constexpr int maxlen[4] = {16, 3, 1, 1};
#pragma unroll
            for (int j = 0; j < maxlen[r]; ++j) { const float s = vai + __uint_as_float(__float_as_uint(Lb[j]) & ~0x7fu);
                const float pkv = __uint_as_float((__float_as_uint(s) & ~0xffu) | (unsigned)(irow * 16 + j));
                ins16(C, j < len ? pkv : -3.0e38f); }
        }
        { float A[16], B[16];
#pragma unroll
          for (int j = 0; j < 16; ++j) { auto s = __builtin_amdgcn_permlane16_swap(__float_as_uint(C[j]), __float_as_uint(C[j]), false, false); A[j] = __uint_as_float(s[0]); B[j] = __uint_as_float(s[1]); }
          bitonic_merge16(C, A, B);
#pragma unroll
          for (int j = 0; j < 16; ++j) { auto s = __builtin_amdgcn_permlane32_swap(__float_as_uint(C[j]), __float_as_uint(C[j]), false, false); A[j] = __uint_as_float(s[0]); B[j] = __uint_as_float(s[1]); }
          bitonic_merge16(C, A, B); }
        const float mx = __uint_as_float(__float_as_uint(C[0]) & ~0xffu);
        float p[16], den = 0.f; int ex[16];
#pragma unroll
        for (int k = 0; k < 16; ++k) { const unsigned cb = __float_as_uint(C[k]); const float sv = __uint_as_float(cb & ~0xffu); p[k] = __expf(sv - mx); den += p[k];
            const unsigned ka = lists[(cb >> 4) & 15] & 0x7fu, kb = lists[16 + (cb & 15)] & 0x7fu; ex[k] = (int)(ka * PNK + kb); }
        const float inv = 1.f / den;
        if (quad == 0) {
            int* ip = idx + (size_t)row * 128 + h * 16; float* gp = gate + (size_t)row * 128 + h * 16;
#pragma unroll
            for (int k = 0; k < 16; k += 4) { *(int4*)(ip + k) = make_int4(ex[k], ex[k + 1], ex[k + 2], ex[k + 3]); *(f32x4*)(gp + k) = (f32x4){p[k] * inv, p[k + 1] * inv, p[k + 2] * inv, p[k + 3] * inv}; }
        }
    }
}
template <int B>
__device__ __forceinline__ void sort16at(float (&v)[64]) {
#define CE(i, j) { const float hi_ = fmaxf(v[B + i], v[B + j]), lo_ = fminf(v[B + i], v[B + j]); v[B + i] = hi_; v[B + j] = lo_; }
    CE(0,1) CE(2,3) CE(0,2) CE(1,3) CE(1,2) CE(4,5) CE(6,7) CE(4,6) CE(5,7) CE(5,6) CE(0,4) CE(2,6) CE(2,4) CE(1,5) CE(3,7) CE(3,5) CE(1,2) CE(3,4) CE(5,6) CE(8,9) CE(10,11) CE(8,10) CE(9,11) CE(9,10) CE(12,13) CE(14,15) CE(12,14) CE(13,15) CE(13,14) CE(8,12) CE(10,14) CE(10,12) CE(9,13) CE(11,15) CE(11,13) CE(9,10) CE(11,12) CE(13,14) CE(0,8) CE(4,12) CE(4,8) CE(2,10) CE(6,14) CE(6,10) CE(2,4) CE(6,8) CE(10,12) CE(1,9) CE(5,13) CE(5,9) CE(3,11) CE(7,15) CE(7,11) CE(3,5) CE(7,9) CE(11,13) CE(1,2) CE(3,4) CE(5,6) CE(7,8) CE(9,10) CE(11,12) CE(13,14)
#undef CE
}
__device__ __forceinline__ void top16of64(float (&v)[64], float (&L)[16]) {
    sort16at<0>(v); sort16at<16>(v); sort16at<32>(v); sort16at<48>(v);
    float A[16], Bv[16], M0[16], M1[16];
#pragma unroll
    for (int j = 0; j < 16; ++j) { A[j] = v[j]; Bv[j] = v[16 + j]; }
    bitonic_merge16(M0, A, Bv);
#pragma unroll
    for (int j = 0; j < 16; ++j) { A[j] = v[32 + j]; Bv[j] = v[48 + j]; }
    bitonic_merge16(M1, A, Bv);
    bitonic_merge16(L, M0, M1);
}
typedef float f32x16 __attribute__((ext_vector_type(16)));
__device__ __forceinline__ void ph_tk32(const bf16* Q, const bf16* keysl, int* idx, float* gate, int nrows, unsigned char* ldsg) { const int tidx = otid();
    const int lane = tidx & 63, w = __builtin_amdgcn_readfirstlane(tidx >> 6), r32 = lane & 31, hh = lane >> 5;
    const lds_cp lds = (lds_cp)ldsg;
    unsigned* lists = (unsigned*)(ldsg + TK_LIST) + (w * 32 + r32) * 32;
    const int nunits = (nrows / 256) * PH;
    int hcur = -1;
    for (int u = blockIdx.x; u < nunits; u += gridDim.x) {
        const int h = u % PH, tile = u / PH;
        __syncthreads();
        if (h != hcur) {
            for (int i = tidx; i < 2 * 128 * 16; i += NT) { const int side = i >> 11, r = (i >> 4) & 127, pc = i & 15;
                *(u32x4*)(ldsg + (side * 128 + r) * TK_KROW + pc * 16) = *(const u32x4*)(keysl + ((size_t)(side * PH + h) * PNK + r) * PKD + pc * 8); }
            hcur = h;
        }
        __syncthreads();
        const int row = tile * 256 + 32 * w + r32;
        float Lb[16];
#pragma unroll
        for (int side = 0; side < 2; ++side) {
            bf16x8 qf[8];
#pragma unroll
            for (int s = 0; s < 8; ++s) qf[s] = *(const bf16x8*)(Q + ((size_t)(((tile * 8 + w) * PH + h) * 2 + side)) * 4096 + s * 512 + hh * 256 + r32 * 8);
            float pv[64];
#pragma unroll
            for (int t = 0; t < 4; ++t) {
                f32x16 acc;
#pragma unroll
                for (int i = 0; i < 16; ++i) acc[i] = 0.f;
#pragma unroll
                for (int s = 0; s < 8; ++s) { const bf16x8 kf = *(const __attribute__((address_space(3))) bf16x8*)(lds + (side * 128 + 32 * t + r32) * TK_KROW + 32 * s + 16 * hh);
                    acc = __builtin_amdgcn_mfma_f32_32x32x16_bf16(kf, qf[s], acc, 0, 0, 0); }
#pragma unroll
                for (int i = 0; i < 16; ++i) { const unsigned key = 32 * t + (i & 3) + 8 * (i >> 2) + 4 * hh; pv[16 * t + i] = __uint_as_float((__float_as_uint(acc[i]) & ~0x7fu) | key); }
            }
            float L[16];
            top16of64(pv, L);
            { float A[16], B[16];
#pragma unroll
              for (int j = 0; j < 16; ++j) { auto s = __builtin_amdgcn_permlane32_swap(__float_as_uint(L[j]), __float_as_uint(L[j]), false, false); A[j] = __uint_as_float(s[0]); B[j] = __uint_as_float(s[1]); }
              bitonic_merge16(L, A, B); }
            if (side == 0) { if (hh == 0) {
#pragma unroll
                    for (int j = 0; j < 16; ++j) lists[j] = __float_as_uint(L[j]); } }
            else {
#pragma unroll
                for (int j = 0; j < 16; ++j) Lb[j] = L[j];
                if (hh == 0) {
#pragma unroll
                    for (int j = 0; j < 16; ++j) lists[16 + j] = __float_as_uint(L[j]); } }
        }
        float C[16];
#pragma unroll
        for (int j = 0; j < 16; ++j) C[j] = -3.0e38f;
#pragma unroll
        for (int r = 0; r < 8; ++r) {
            const float vai = __uint_as_float(lists[2 * r + hh] & ~0x7fu);
            const int irow = 2 * r + hh, len = 16 / (irow + 1);
            constexpr int maxlen[8] = {16, 5, 3, 2, 1, 1, 1, 1};
#pragma unroll
            for (int j = 0; j < maxlen[r]; ++j) { const float s = vai + __uint_as_float(__float_as_uint(Lb[j]) & ~0x7fu);
                const float pkv = __uint_as_float((__float_as_uint(s) & ~0xffu) | (unsigned)(irow * 16 + j));
                ins16(C, j < len ? pkv : -3.0e38f); }
        }
        { float A[16], B[16];
#pragma unroll
          for (int j = 0; j < 16; ++j) { auto s = __builtin_amdgcn_permlane32_swap(__float_as_uint(C[j]), __float_as_uint(C[j]), false, false); A[j] = __uint_as_float(s[0]); B[j] = __uint_as_float(s[1]); }
          bitonic_merge16(C, A, B); }
        const float mx = __uint_as_float(__float_as_uint(C[0]) & ~0xffu);
        float p[16], den = 0.f; int ex[16];
#pragma unroll
        for (int k = 0; k < 16; ++k) { const unsigned cb = __float_as_uint(C[k]); const float sv = __uint_as_float(cb & ~0xffu); p[k] = __expf(sv - mx); den += p[k];
            const unsigned ka = lists[(cb >> 4) & 15] & 0x7fu, kb = lists[16 + (cb & 15)] & 0x7fu; ex[k] = (int)(ka * PNK + kb); }
        const float inv = 1.f / den;
        if (hh == 0) {
            int* ip = idx + (size_t)row * 128 + h * 16; float* gp = gate + (size_t)row * 128 + h * 16;
#pragma unroll
            for (int k = 0; k < 16; k += 4) { *(int4*)(ip + k) = make_int4(ex[k], ex[k + 1], ex[k + 2], ex[k + 3]); *(f32x4*)(gp + k) = (f32x4){p[k] * inv, p[k + 1] * inv, p[k + 2] * inv, p[k + 3] * inv}; }
        }
    }
}
__device__ __forceinline__ float dot16(const float (&hx)[16], const bf16x8 a, const bf16x8 b) {
    float s = 0.f;
#pragma unroll
    for (int j = 0; j < 8; ++j) s += hx[j] * bf2f((bf16)a[j]) + hx[8 + j] * bf2f((bf16)b[j]);
    return s;
}
template <bool FINAL>
__device__ __forceinline__ void ph_peer(const bf16* act, const int* idx, const float* gate, const bf16* U, const bf16* V, const float* modl, int off_g,
                                        float* xlat, float* xctx, const float* fw, int nrows) { const int tidx = otid();
    const int lane = tidx & 63, wave = tidx >> 6;
    for (int row = blockIdx.x * 8 + wave; row < nrows; row += gridDim.x * 8) {
        float hx[16];
        { const bf16x8 a = *(const bf16x8*)(act + (size_t)row * D + lane * 8), b = *(const bf16x8*)(act + (size_t)row * D + 512 + lane * 8);
#pragma unroll
          for (int j = 0; j < 8; ++j) { hx[j] = bf2f((bf16)a[j]); hx[8 + j] = bf2f((bf16)b[j]); } }
        const int myi0 = idx[(size_t)row * 128 + lane], myi1 = idx[(size_t)row * 128 + 64 + lane];
        const float myg0 = gate[(size_t)row * 128 + lane], myg1 = gate[(size_t)row * 128 + 64 + lane];
        float a0 = 0.f, a1 = 0.f;
        for (int base = 0; base < 128; base += 8) {
            bf16x8 ua[8], ub[8];
#pragma unroll
            for (int j = 0; j < 8; ++j) { const int e = rl_i(base < 64 ? myi0 : myi1, (base + j) & 63); const bf16* up = U + (size_t)e * D; ua[j] = *(const bf16x8*)(up + lane * 8); ub[j] = *(const bf16x8*)(up + 512 + lane * 8); }
#pragma unroll
            for (int j = 0; j < 8; ++j) { const float s = wave_sum(dot16(hx, ua[j], ub[j])); if (lane == ((base + j) & 63)) { if (base < 64) a0 = s; else a1 = s; } }
        }
        const float w0 = myg0 * 0.5f * a0 * (1.f + erff(a0 * 0.70710678f)), w1 = myg1 * 0.5f * a1 * (1.f + erff(a1 * 0.70710678f));
        float out[16];
#pragma unroll
        for (int j = 0; j < 16; ++j) out[j] = 0.f;
        for (int base = 0; base < 128; base += 8) {
            bf16x8 va[8], vb[8];
#pragma unroll
            for (int j = 0; j < 8; ++j) { const int e = rl_i(base < 64 ? myi0 : myi1, (base + j) & 63); const bf16* vp = V + (size_t)e * D; va[j] = *(const bf16x8*)(vp + lane * 8); vb[j] = *(const bf16x8*)(vp + 512 + lane * 8); }
#pragma unroll
            for (int j = 0; j < 8; ++j) { const float w = rl_f(base < 64 ? w0 : w1, (base + j) & 63);
#pragma unroll
                for (int q = 0; q < 8; ++q) { out[q] += w * bf2f((bf16)va[j][q]); out[8 + q] += w * bf2f((bf16)vb[j][q]); } }
        }
        const int mi = row < M_LAT ? row / S : 4;
        float* xr = row < M_LAT ? xlat + (size_t)row * D : xctx + (size_t)(row - M_LAT) * D;
        const float* g2 = modl + (size_t)mi * 6 * D + off_g;
        float xn[16]; float ss = 0.f;
#pragma unroll
        for (int hlf = 0; hlf < 2; ++hlf) { const int k = hlf * 512 + lane * 8;
            const f32x4 x0 = *(const f32x4*)(xr + k), x1 = *(const f32x4*)(xr + k + 4), g0 = *(const f32x4*)(g2 + k), g1 = *(const f32x4*)(g2 + k + 4);
            xn[hlf * 8 + 0] = x0.x + g0.x * out[hlf * 8 + 0]; xn[hlf * 8 + 1] = x0.y + g0.y * out[hlf * 8 + 1]; xn[hlf * 8 + 2] = x0.z + g0.z * out[hlf * 8 + 2]; xn[hlf * 8 + 3] = x0.w + g0.w * out[hlf * 8 + 3];
            xn[hlf * 8 + 4] = x1.x + g1.x * out[hlf * 8 + 4]; xn[hlf * 8 + 5] = x1.y + g1.y * out[hlf * 8 + 5]; xn[hlf * 8 + 6] = x1.z + g1.z * out[hlf * 8 + 6]; xn[hlf * 8 + 7] = x1.w + g1.w * out[hlf * 8 + 7]; }
#pragma unroll
        for (int j = 0; j < 16; ++j) ss += xn[j] * xn[j];
        float rs = 1.f;
        if (FINAL) { ss = wave_sum(ss); rs = rsqrtf(ss * (1.f / D) + EPS); }
#pragma unroll
        for (int hlf = 0; hlf < 2; ++hlf) { const int k = hlf * 512 + lane * 8;
            f32x4 o0, o1;
            if (FINAL) { const f32x4 f0 = *(const f32x4*)(fw + k), f1 = *(const f32x4*)(fw + k + 4);
                o0 = (f32x4){xn[hlf * 8 + 0] * rs * f0.x, xn[hlf * 8 + 1] * rs * f0.y, xn[hlf * 8 + 2] * rs * f0.z, xn[hlf * 8 + 3] * rs * f0.w};
                o1 = (f32x4){xn[hlf * 8 + 4] * rs * f1.x, xn[hlf * 8 + 5] * rs * f1.y, xn[hlf * 8 + 6] * rs * f1.z, xn[hlf * 8 + 7] * rs * f1.w}; }
            else { o0 = (f32x4){xn[hlf * 8 + 0], xn[hlf * 8 + 1], xn[hlf * 8 + 2], xn[hlf * 8 + 3]}; o1 = (f32x4){xn[hlf * 8 + 4], xn[hlf * 8 + 5], xn[hlf * 8 + 6], xn[hlf * 8 + 7]}; }
            *(f32x4*)(xr + k) = o0; *(f32x4*)(xr + k + 4) = o1; }
    }
}


__device__ __forceinline__ void ph_quant(const float* src, unsigned char* dst, float* scl, int nrows, int offs  ) { const int tidx = otid();
    const int lane = tidx & 63, wave = tidx >> 6;
    for (int row0 = (blockIdx.x * 8 + wave) * 4; row0 < nrows; row0 += gridDim.x * 8 * 4) {
        f32x4 v[4][4];
#pragma unroll
        for (int r = 0; r < 4; ++r)
#pragma unroll
            for (int j = 0; j < 4; ++j) v[r][j] = *(const f32x4*)(src + (size_t)(row0 + r) * D + lane * 16 + 4 * j);
#pragma unroll
        for (int r = 0; r < 4; ++r) {
            float am = 0.f;
#pragma unroll
            for (int j = 0; j < 4; ++j) am = fmaxf(am, fmaxf(fmaxf(fabsf(v[r][j].x), fabsf(v[r][j].y)), fmaxf(fabsf(v[r][j].z), fabsf(v[r][j].w))));
            am = wave_max(am);
            const float sc = am > 0.f ? am * (1.f / 127.f) : 1.f, inv = 1.f / sc;
            u32x4 o;
#pragma unroll
            for (int j = 0; j < 4; ++j) { const int q0 = (int)rintf(v[r][j].x * inv) + offs, q1 = (int)rintf(v[r][j].y * inv) + offs, q2 = (int)rintf(v[r][j].z * inv) + offs, q3 = (int)rintf(v[r][j].w * inv) + offs;
                o[j] = (unsigned)(q0 & 0xff) | ((unsigned)(q1 & 0xff) << 8) | ((unsigned)(q2 & 0xff) << 16) | ((unsigned)(q3 & 0xff) << 24); }
            *(u32x4*)(dst + (size_t)(row0 + r) * D + lane * 16) = o;
            if (lane == 0) scl[row0 + r] = sc;
        }
    }
}
__device__ __forceinline__ void ph_quant_w(const bf16* src, unsigned char* dst, float* scl, int nrows) { const int tidx = otid();
    const int lane = tidx & 63, wave = tidx >> 6;
    for (int row0 = (blockIdx.x * 8 + wave) * 2; row0 < nrows; row0 += gridDim.x * 16) {
        bf16x8 a[2][2];
#pragma unroll
        for (int r = 0; r < 2; ++r) { a[r][0] = *(const bf16x8*)(src + (size_t)(row0 + r) * D + lane * 16); a[r][1] = *(const bf16x8*)(src + (size_t)(row0 + r) * D + lane * 16 + 8); }
#pragma unroll
        for (int r = 0; r < 2; ++r) { float f[16]; float am = 0.f;
#pragma unroll
            for (int j = 0; j < 8; ++j) { f[j] = bf2f((bf16)a[r][0][j]); f[8 + j] = bf2f((bf16)a[r][1][j]); am = fmaxf(am, fmaxf(fabsf(f[j]), fabsf(f[8 + j]))); }
            am = wave_max(am); const float sc = am > 0.f ? am * (1.f / 127.f) : 1.f, inv = 1.f / sc;
            u32x4 o;
#pragma unroll
            for (int j = 0; j < 4; ++j) { const int q0 = (int)rintf(f[4 * j] * inv), q1 = (int)rintf(f[4 * j + 1] * inv), q2 = (int)rintf(f[4 * j + 2] * inv), q3 = (int)rintf(f[4 * j + 3] * inv);
                o[j] = (unsigned)(q0 & 0xff) | ((unsigned)(q1 & 0xff) << 8) | ((unsigned)(q2 & 0xff) << 16) | ((unsigned)(q3 & 0xff) << 24); }
            *(u32x4*)(dst + (size_t)(row0 + r) * D + lane * 16) = o;
            if (lane == 0) scl[row0 + r] = sc; }
    }
}
__device__ __forceinline__ int xreduce64(int (&p)[64], int lane) {
#pragma unroll
    for (int k = 0; k < 32; ++k) { auto r = __builtin_amdgcn_permlane32_swap((unsigned)p[k], (unsigned)p[k + 32], false, false); p[k] = (int)(r[0] + r[1]); }
#pragma unroll
    for (int k = 0; k < 16; ++k) { auto r = __builtin_amdgcn_permlane16_swap((unsigned)p[k], (unsigned)p[k + 16], false, false); p[k] = (int)(r[0] + r[1]); }
#define XR_STEP(n, M) _Pragma("unroll") for (int k = 0; k < (n) / 2; ++k) { const bool up = (lane & (M)) != 0; const int send = up ? p[k] : p[k + (n) / 2], keep = up ? p[k + (n) / 2] : p[k]; \
        p[k] = keep + __builtin_amdgcn_ds_swizzle(send, ((M) << 10) | 0x1f); }
    XR_STEP(16, 8) XR_STEP(8, 4) XR_STEP(4, 2) XR_STEP(2, 1)
#undef XR_STEP
    return p[0];
}
template <int MODE  >
__device__ __forceinline__ void ph_peer8(bf16* act, const int* idx, const float* gate, const unsigned char* U8, const unsigned char* V8, const float* SU, const float* SV,
                                         const float* modl, int off_g, bf16* xlat, bf16* xctx, float* outf, const float* fw, const float* modn, int nrows) { const int tidx = otid();
    constexpr bool FINAL = (MODE == 2);
    const int lane = tidx & 63, wave = tidx >> 6;
    for (int row = blockIdx.x * 8 + wave; row < nrows; row += gridDim.x * 8) {
        int xq[4]; float sx;
        { const bf16x8 a = *(const bf16x8*)(act + (size_t)row * D + lane * 16), b = *(const bf16x8*)(act + (size_t)row * D + lane * 16 + 8);
          float hx[16]; float am = 0.f;
#pragma unroll
          for (int j = 0; j < 8; ++j) { hx[j] = bf2f((bf16)a[j]); hx[8 + j] = bf2f((bf16)b[j]); am = fmaxf(am, fmaxf(fabsf(hx[j]), fabsf(hx[8 + j]))); }
          am = wave_max(am); sx = am > 0.f ? am * (1.f / 127.f) : 1.f; const float inv = 1.f / sx;
#pragma unroll
          for (int j = 0; j < 4; ++j) { const int q0 = (int)rintf(hx[4 * j] * inv), q1 = (int)rintf(hx[4 * j + 1] * inv), q2 = (int)rintf(hx[4 * j + 2] * inv), q3 = (int)rintf(hx[4 * j + 3] * inv);
              xq[j] = (int)((unsigned)(q0 & 0xff) | ((unsigned)(q1 & 0xff) << 8) | ((unsigned)(q2 & 0xff) << 16) | ((unsigned)(q3 & 0xff) << 24)); } }
        const int myi0 = idx[(size_t)row * 128 + lane], myi1 = idx[(size_t)row * 128 + 64 + lane];
        const float myg0 = gate[(size_t)row * 128 + lane], myg1 = gate[(size_t)row * 128 + 64 + lane];
        const float su0 = SU[myi0], su1 = SU[myi1], sv0 = SV[myi0], sv1 = SV[myi1];
        float wgt[2];
#pragma unroll
        for (int hf = 0; hf < 2; ++hf) {
            int p[64];
#pragma unroll
            for (int base = 0; base < 64; base += 16) {
                u32x4 ub[16];
#pragma unroll
                for (int j = 0; j < 16; ++j) { const int e = rl_i(hf ? myi1 : myi0, base + j); ub[j] = *(const u32x4*)(U8 + (size_t)e * D + lane * 16); }
#pragma unroll
                for (int j = 0; j < 16; ++j) { int s = __builtin_amdgcn_sdot4((int)ub[j].x, xq[0], 0, false); s = __builtin_amdgcn_sdot4((int)ub[j].y, xq[1], s, false);
                    s = __builtin_amdgcn_sdot4((int)ub[j].z, xq[2], s, false); p[base + j] = __builtin_amdgcn_sdot4((int)ub[j].w, xq[3], s, false); }
            }
            const float a = (float)xreduce64(p, lane) * sx * (hf ? su1 : su0);
            wgt[hf] = (hf ? myg1 * sv1 : myg0 * sv0) * 0.5f * a * (1.f + erff(a * 0.70710678f));
        }
        float out[16];
#pragma unroll
        for (int j = 0; j < 16; ++j) out[j] = 0.f;
#pragma unroll 1
        for (int base = 0; base < 128; base += 16) {
            u32x4 vb[16];
#pragma unroll
            for (int j = 0; j < 16; ++j) { const int e = rl_i(base < 64 ? myi0 : myi1, (base + j) & 63); vb[j] = *(const u32x4*)(V8 + (size_t)e * D + lane * 16); }
#pragma unroll
            for (int j = 0; j < 16; ++j) { const float wv = rl_f(base < 64 ? wgt[0] : wgt[1], (base + j) & 63);
#pragma unroll
                for (int q = 0; q < 4; ++q) { const unsigned dw = vb[j][q];
                    out[4 * q + 0] += wv * (float)((int)(dw << 24) >> 24); out[4 * q + 1] += wv * (float)((int)(dw << 16) >> 24); out[4 * q + 2] += wv * (float)((int)(dw << 8) >> 24); out[4 * q + 3] += wv * (float)((int)dw >> 24); } }
        }
        const int mi = row < M_LAT ? row / S : 4;
        bf16* xr = (row < M_LAT ? xlat + (size_t)row * D : xctx + (size_t)(row - M_LAT) * D) + lane * 16;
        const float* g2 = modl + (size_t)mi * 6 * D + off_g + lane * 16;
        float xn[16]; float ss = 0.f;
#pragma unroll
        for (int q = 0; q < 4; ++q) { const f32x4 x0 = ld4res<true>(xr, 4 * q), g0 = *(const f32x4*)(g2 + 4 * q);
            xn[4 * q + 0] = bf2f(f2bf(x0.x + g0.x * out[4 * q + 0])); xn[4 * q + 1] = bf2f(f2bf(x0.y + g0.y * out[4 * q + 1]));
            xn[4 * q + 2] = bf2f(f2bf(x0.z + g0.z * out[4 * q + 2])); xn[4 * q + 3] = bf2f(f2bf(x0.w + g0.w * out[4 * q + 3])); }
#pragma unroll
        for (int j = 0; j < 16; ++j) ss += xn[j] * xn[j];
        float rs = 1.f;
        if (MODE != 0) { ss = wave_sum(ss); rs = rsqrtf(ss * (1.f / D) + EPS); }
#pragma unroll
        for (int q = 0; q < 4; ++q) {
            if (FINAL) { const f32x4 f0 = *(const f32x4*)(fw + lane * 16 + 4 * q); *(f32x4*)(outf + (size_t)row * D + lane * 16 + 4 * q) = (f32x4){xn[4 * q] * rs * f0.x, xn[4 * q + 1] * rs * f0.y, xn[4 * q + 2] * rs * f0.z, xn[4 * q + 3] * rs * f0.w}; }
            else st4res(xr, 4 * q, (f32x4){xn[4 * q], xn[4 * q + 1], xn[4 * q + 2], xn[4 * q + 3]}); }
        if (MODE == 1) {
            const float* sh = modn + (size_t)mi * 6 * D + lane * 16; const float* sc = sh + D; const float* nw = fw + lane * 16;
            u32x4 o0, o1; unsigned pk[8];
#pragma unroll
            for (int q = 0; q < 4; ++q) { const f32x4 w4 = *(const f32x4*)(nw + 4 * q), a4 = *(const f32x4*)(sc + 4 * q), b4 = *(const f32x4*)(sh + 4 * q);
                pk[2 * q] = pg8::cvt_pk_bf16(xn[4 * q] * rs * w4.x * (1.f + a4.x) + b4.x, xn[4 * q + 1] * rs * w4.y * (1.f + a4.y) + b4.y);
                pk[2 * q + 1] = pg8::cvt_pk_bf16(xn[4 * q + 2] * rs * w4.z * (1.f + a4.z) + b4.z, xn[4 * q + 3] * rs * w4.w * (1.f + a4.w) + b4.w); }
            o0 = (u32x4){pk[0], pk[1], pk[2], pk[3]}; o1 = (u32x4){pk[4], pk[5], pk[6], pk[7]};
            *(u32x4*)(act + (size_t)row * D + lane * 16) = o0; *(u32x4*)(act + (size_t)row * D + lane * 16 + 8) = o1;
        }
    }
}

constexpr int PSA_ENT_MAX = 512;
constexpr int PSA_XQ = 0, PSA_ENT = 135168, PSA_ENT_BYTES = 2048, PSA_SX = PSA_ENT + 8 * PSA_ENT_BYTES;
constexpr int PSA_HIST = 152576, PSA_WTOT = PSA_HIST + 8192, PSA_SORT_MAX = 4096;
static_assert(PSA_SX + 132 * 4 <= PSA_HIST && PSA_WTOT + 64 <= LDS_BYTES - 64, "sweep A LDS map");
constexpr int PSB_IDX = 0, PSB_WQ = 33792, PSB_SW = PSB_WQ + 132 * 128, PSB_SS = PSB_SW + 1024;
#ifndef PEER_NSLAB
#define PEER_NSLAB 8
#endif
#ifndef PEER_PSH
static_assert(true, "");
#define PEER_SORTA 1
#define PEER_PSH 11
#endif
__device__ __forceinline__ int reduce32i(int (&p)[32], int lane) {
#pragma unroll
    for (int k = 0; k < 16; ++k) { auto r = __builtin_amdgcn_permlane32_swap((unsigned)p[k], (unsigned)p[k + 16], false, false); p[k] = (int)(r[0] + r[1]); }
#pragma unroll
    for (int k = 0; k < 8; ++k) { auto r = __builtin_amdgcn_permlane16_swap((unsigned)p[k], (unsigned)p[k + 8], false, false); p[k] = (int)(r[0] + r[1]); }
    { const bool up = (lane & 8) != 0;
#pragma unroll
      for (int k = 0; k < 4; ++k) { const int send = up ? p[k] : p[k + 4], keep = up ? p[k + 4] : p[k]; p[k] = keep + __builtin_amdgcn_ds_swizzle(send, (8 << 10) | 0x1f); } }
    { const bool up = (lane & 4) != 0;
#pragma unroll
      for (int k = 0; k < 2; ++k) { const int send = up ? p[k] : p[k + 2], keep = up ? p[k + 2] : p[k]; p[k] = keep + __builtin_amdgcn_ds_swizzle(send, (4 << 10) | 0x1f); } }
    { const bool up = (lane & 2) != 0; const int send = up ? p[0] : p[1], keep = up ? p[1] : p[0]; p[0] = keep + __builtin_amdgcn_ds_swizzle(send, (2 << 10) | 0x1f); }
    p[0] += __builtin_amdgcn_ds_swizzle(p[0], (1 << 10) | 0x1f);
    return p[0];
}
template <int LPS>
__device__ __forceinline__ void reduce16r(int (&p)[16], int lane) {
#pragma unroll
    for (int k = 0; k < 8; ++k) { auto r = __builtin_amdgcn_permlane32_swap((unsigned)p[k], (unsigned)p[k + 8], false, false); p[k] = (int)(r[0] + r[1]); }
#pragma unroll
    for (int k = 0; k < 4; ++k) { auto r = __builtin_amdgcn_permlane16_swap((unsigned)p[k], (unsigned)p[k + 4], false, false); p[k] = (int)(r[0] + r[1]); }
    { const bool up = (lane & 8) != 0;
#pragma unroll
      for (int k = 0; k < 2; ++k) { const int send = up ? p[k] : p[k + 2], keep = up ? p[k + 2] : p[k]; p[k] = keep + __builtin_amdgcn_ds_swizzle(send, (8 << 10) | 0x1f); } }
    if (LPS == 4) { const bool up = (lane & 4) != 0; const int send = up ? p[0] : p[1], keep = up ? p[1] : p[0]; p[0] = keep + __builtin_amdgcn_ds_swizzle(send, (4 << 10) | 0x1f); }
}
template <int MODE  >
__device__ __forceinline__ void ph_peer_sweep(const int* idx, const float* gate, const unsigned char* U8, const unsigned char* V8, const float* SU, const float* SV, const unsigned char* XQ, const float* XS,
                                              float* AW  , const float* modl, int off_g, bf16* xlat, bf16* xctx, float* outf  , const float* nw, const float* modn, unsigned char* xqo, float* xso, int nrows, unsigned char* ldsg) { const int tidx = otid();
    const int lane = tidx & 63, wave = __builtin_amdgcn_readfirstlane(tidx >> 6);
    const int TPW = nrows / (int)gridDim.x, row0 = (int)blockIdx.x * TPW;
    const int J = (TPW - wave + 7) / 8;
    __syncthreads();
    unsigned* ent = (unsigned*)(ldsg + PSA_ENT + wave * PSA_ENT_BYTES); float* sxs = (float*)(ldsg + PSA_SX);
    for (int j = 0; j < J; ++j) { const int tl = wave + 8 * j; *(u32x4*)(ldsg + PSA_XQ + tl * 1024 + lane * 16) = *(const u32x4*)(XQ + (size_t)(row0 + tl) * D + lane * 16); if (lane == 0) sxs[tl] = XS[row0 + tl]; }
    unsigned iab[17];
#pragma unroll
    for (int j = 0; j < 17; ++j) { if (j < J) { const size_t r = (size_t)(row0 + wave + 8 * j) * 128; iab[j] = (unsigned)idx[r + lane] | ((unsigned)idx[r + 64 + lane] << 16); } else iab[j] = 0xffffffffu; }
#if PEER_SORTA
    unsigned* hist = (unsigned*)(ldsg + PSA_HIST); unsigned* srt = (unsigned*)(ldsg + PSA_ENT); unsigned* wtot = (unsigned*)(ldsg + PSA_WTOT);
    ((u32x4*)hist)[tidx] = (u32x4){0u, 0u, 0u, 0u};
    __syncthreads();
#endif
#define IA(j) ((int)(iab[j] & 0xffffu))
#define IB(j) ((int)(iab[j] >> 16))
#pragma unroll 1
    for (int p = 0; p < (NEXP >> PEER_PSH); ++p) {
        const unsigned* lst = ent; int n = 0, cstart = 0, cstride = 32, nov = 0;
#pragma unroll
        for (int j = 0; j < 17; ++j) asm volatile("" : "+v"(iab[j]));
        unsigned lane_o = (unsigned)lane; asm volatile("" : "+v"(lane_o));
#if PEER_SORTA
#pragma unroll
        for (int j = 0; j < 17; ++j) {
            if ((IA(j) >> PEER_PSH) == p) atomicAdd(&hist[IA(j) & 2047], 1u);
            if ((IB(j) >> PEER_PSH) == p) atomicAdd(&hist[IB(j) & 2047], 1u);
        }
        __syncthreads();
        const u32x4 hh4 = ((const u32x4*)hist)[tidx];
        const unsigned hs = hh4.x + hh4.y + hh4.z + hh4.w; unsigned inc = hs;
#pragma unroll
        for (int d = 1; d < 64; d <<= 1) { const unsigned t = (unsigned)__shfl_up((int)inc, d); if (lane >= d) inc += t; }
        if (lane == 63) wtot[wave] = inc;
        __syncthreads();
        unsigned wbase = 0, NS = 0;
#pragma unroll
        for (int w2 = 0; w2 < 8; ++w2) { const unsigned t = wtot[w2]; NS += t; if (w2 < wave) wbase += t; }
        NS = (unsigned)__builtin_amdgcn_readfirstlane((int)NS); wbase = (unsigned)__builtin_amdgcn_readfirstlane((int)wbase);
        { const unsigned ex = wbase + inc - hs; u32x4 o; o.x = ex; o.y = ex + hh4.x; o.z = o.y + hh4.y; o.w = o.z + hh4.z; ((u32x4*)hist)[tidx] = o; }
        __syncthreads();
        if (NS <= (unsigned)PSA_SORT_MAX) {
#pragma unroll
            for (int j = 0; j < 17; ++j) {
                if ((IA(j) >> PEER_PSH) == p) { const unsigned pos = atomicAdd(&hist[IA(j) & 2047], 1u); srt[pos] = (unsigned)IA(j) | (lane_o << 14) | ((unsigned)(wave + 8 * j) << 21); }
                if ((IB(j) >> PEER_PSH) == p) { const unsigned pos = atomicAdd(&hist[IB(j) & 2047], 1u); srt[pos] = (unsigned)IB(j) | ((64u + lane_o) << 14) | ((unsigned)(wave + 8 * j) << 21); }
            }
            __syncthreads();
            ((u32x4*)hist)[tidx] = (u32x4){0u, 0u, 0u, 0u};
            lst = srt; n = (int)NS; cstart = wave * 32; cstride = 256;
        } else {
        ((u32x4*)hist)[tidx] = (u32x4){0u, 0u, 0u, 0u};
#endif
#pragma unroll
        for (int j = 0; j < 17; ++j) {
            const bool in0 = (IA(j) >> PEER_PSH) == p, in1 = (IB(j) >> PEER_PSH) == p;
            const unsigned long long m0 = __ballot(in0), m1 = __ballot(in1);
            const int c0 = __popcll(m0), c1 = __popcll(m1);
            const int r0 = n + (int)__builtin_amdgcn_mbcnt_hi((unsigned)(m0 >> 32), __builtin_amdgcn_mbcnt_lo((unsigned)m0, 0u));
            const int r1 = n + c0 + (int)__builtin_amdgcn_mbcnt_hi((unsigned)(m1 >> 32), __builtin_amdgcn_mbcnt_lo((unsigned)m1, 0u));
            if (in0 && r0 < PSA_ENT_MAX) ent[r0] = (unsigned)IA(j) | (lane_o << 14) | ((unsigned)(wave + 8 * j) << 21);
            if (in1 && r1 < PSA_ENT_MAX) ent[r1] = (unsigned)IB(j) | ((64u + lane_o) << 14) | ((unsigned)(wave + 8 * j) << 21);
            n += c0 + c1;
        }
        nov = n;
        n = min(n, PSA_ENT_MAX);
#if PEER_SORTA
        }
#endif
        {
#pragma unroll 1
            for (int base = cstart; base < n; base += cstride) {
                const unsigned myent = lst[min(base + (lane & 31), n - 1)];
                u32x4 ub[32];
#pragma unroll
                for (int q = 0; q < 32; ++q) { const unsigned ej = (unsigned)rl_i((int)myent, q); ub[q] = *(const u32x4*)(U8 + (size_t)(ej & 0x3fffu) * D + lane * 16); }
                int ps[32];
#pragma unroll
                for (int q = 0; q < 32; ++q) { const int tq = (int)((unsigned)rl_i((int)myent, q) >> 21); const u32x4 xv = *(const u32x4*)(ldsg + PSA_XQ + tq * 1024 + lane * 16);
                    int s = __builtin_amdgcn_sdot4((int)ub[q].x, (int)xv.x, 0, false); s = __builtin_amdgcn_sdot4((int)ub[q].y, (int)xv.y, s, false);
                    s = __builtin_amdgcn_sdot4((int)ub[q].z, (int)xv.z, s, false); ps[q] = __builtin_amdgcn_sdot4((int)ub[q].w, (int)xv.w, s, false); }
                const int tot = reduce32i(ps, lane);
                const int slot = lane >> 1;
                if ((lane & 1) == 0 && base + slot < n) { const unsigned en = lst[base + slot]; const int tl = (int)(en >> 21), pos = (int)((en >> 14) & 127u);
                    AW[(size_t)(row0 + tl) * 128 + pos] = (float)tot * sxs[tl]; }
            }
        }
        if (nov > PSA_ENT_MAX) {
            int cnt = 0;
#pragma unroll 1
            for (int j = 0; j < J; ++j) { const size_t r = (size_t)(row0 + wave + 8 * j) * 128;
#pragma unroll 1
                for (int pos = 0; pos < 128; ++pos) { const int e = idx[r + pos];
                    if ((e >> PEER_PSH) == p) { if (cnt >= PSA_ENT_MAX) { const u32x4 uv = *(const u32x4*)(U8 + (size_t)e * D + lane * 16), xv = *(const u32x4*)(ldsg + PSA_XQ + (wave + 8 * j) * 1024 + lane * 16);
                            int s = __builtin_amdgcn_sdot4((int)uv.x, (int)xv.x, 0, false); s = __builtin_amdgcn_sdot4((int)uv.y, (int)xv.y, s, false); s = __builtin_amdgcn_sdot4((int)uv.z, (int)xv.z, s, false); s = __builtin_amdgcn_sdot4((int)uv.w, (int)xv.w, s, false);
                            const float a = wave_sum((float)s); if (lane == 0) AW[r + pos] = a * sxs[wave + 8 * j]; }
                        ++cnt; } } }
        }
        __syncthreads();
    }
    unsigned short* idxs = (unsigned short*)(ldsg + PSB_IDX); unsigned char* wqb = ldsg + PSB_WQ; float* sws = (float*)(ldsg + PSB_SW); float* ssl = (float*)(ldsg + PSB_SS);
    constexpr int LPS = 64 / PEER_NSLAB, RR = 64 / LPS, NK = 128 / RR, NG = NK / 4;
#pragma unroll
    for (int jb = 0; jb < 18; jb += 3) {
        float aw0[3], aw1[3], g0[3], g1[3], su0[3], su1[3], sv0[3], sv1[3];
#pragma unroll
        for (int q = 0; q < 3; ++q) { const int j = jb + q; if (j < 17 && j < J) { const size_t r = (size_t)(row0 + wave + 8 * j) * 128;
            aw0[q] = AW[r + lane]; aw1[q] = AW[r + 64 + lane]; g0[q] = gate[r + lane]; g1[q] = gate[r + 64 + lane];
            su0[q] = SU[IA(j)]; su1[q] = SU[IB(j)]; sv0[q] = SV[IA(j)]; sv1[q] = SV[IB(j)]; } }
#pragma unroll
        for (int q = 0; q < 3; ++q) { const int j = jb + q; if (j < 17 && j < J) { const int tl = wave + 8 * j;
            const float a0 = aw0[q] * su0[q], a1 = aw1[q] * su1[q];
            const float w0 = g0[q] * sv0[q] * 0.5f * a0 * (1.f + erff(a0 * 0.70710678f)), w1 = g1[q] * sv1[q] * 0.5f * a1 * (1.f + erff(a1 * 0.70710678f));
            const float wm = wave_max(fmaxf(fabsf(w0), fabsf(w1))); const float sw = wm > 0.f ? wm * (1.f / 127.f) : 1.f, inv = 1.f / sw;
            const int q0 = (int)rintf(w0 * inv), q1 = (int)rintf(w1 * inv);
            { const int pos = lane, k = pos / RR, rr = pos % RR; wqb[tl * 128 + ((k >> 2) * RR + rr) * 4 + (k & 3)] = (unsigned char)(q0 & 0xff); }
            { const int pos = 64 + lane, k = pos / RR, rr = pos % RR; wqb[tl * 128 + ((k >> 2) * RR + rr) * 4 + (k & 3)] = (unsigned char)(q1 & 0xff); }
            idxs[tl * 128 + lane] = (unsigned short)IA(j); idxs[tl * 128 + 64 + lane] = (unsigned short)IB(j);
            if (lane == 0) sws[tl] = sw; ssl[tl * 64 + lane] = 0.f; } }
    }
    __syncthreads();
    const int rr = lane / LPS, cc = lane % LPS;
    constexpr int NREPB = ((DUP_MASK >> 10) & 1) ? 2 : 1; constexpr float WSC = 1.f / NREPB;
    constexpr int TB = (NK == 8) ? 4 : 2;
    for (int repB = 0; repB < NREPB; ++repB)
#pragma unroll 1
    for (int s = 0; s < PEER_NSLAB; ++s) {
#pragma unroll 1
        for (int jg = 0; jg < J; jg += TB) {
            u32x4 vb[TB][NK];
#pragma unroll
            for (int q = 0; q < TB; ++q) if (jg + q < J) { const int tl = wave + 8 * (jg + q);
#pragma unroll
                for (int k = 0; k < NK; ++k) { const int e = idxs[tl * 128 + RR * k + rr]; vb[q][k] = *(const u32x4*)(V8 + (size_t)e * D + s * (LPS * 16) + cc * 16); } }
#pragma unroll
            for (int q = 0; q < TB; ++q) if (jg + q < J) { const int tl = wave + 8 * (jg + q), row = row0 + tl;
                int acc[16];
#pragma unroll
                for (int c = 0; c < 16; ++c) acc[c] = 0;
#pragma unroll
                for (int gq = 0; gq < NG; ++gq) { const int wq = *(const int*)(wqb + tl * 128 + (gq * RR + rr) * 4);
#pragma unroll
                    for (int d4 = 0; d4 < 4; ++d4) { const unsigned a = vb[q][4 * gq][d4], b = vb[q][4 * gq + 1][d4], c = vb[q][4 * gq + 2][d4], d = vb[q][4 * gq + 3][d4];
                        const unsigned x0 = __builtin_amdgcn_perm(b, a, 0x05010400u), x1 = __builtin_amdgcn_perm(b, a, 0x07030602u), y0 = __builtin_amdgcn_perm(d, c, 0x05010400u), y1 = __builtin_amdgcn_perm(d, c, 0x07030602u);
                        acc[4 * d4 + 0] = __builtin_amdgcn_sdot4((int)__builtin_amdgcn_perm(y0, x0, 0x05040100u), wq, acc[4 * d4 + 0], false);
                        acc[4 * d4 + 1] = __builtin_amdgcn_sdot4((int)__builtin_amdgcn_perm(y0, x0, 0x07060302u), wq, acc[4 * d4 + 1], false);
                        acc[4 * d4 + 2] = __builtin_amdgcn_sdot4((int)__builtin_amdgcn_perm(y1, x1, 0x05040100u), wq, acc[4 * d4 + 2], false);
                        acc[4 * d4 + 3] = __builtin_amdgcn_sdot4((int)__builtin_amdgcn_perm(y1, x1, 0x07060302u), wq, acc[4 * d4 + 3], false); } }
                reduce16r<LPS>(acc, lane);
                const float sc = sws[tl] * WSC;
                const int mi = row < M_LAT ? row / S : 4;
                bf16* xrow = row < M_LAT ? xlat + (size_t)row * D : xctx + (size_t)(row - M_LAT) * D;
                const float* g2 = modl + (size_t)mi * 6 * D + off_g;
                if (LPS == 4) { const int col = s * 64 + cc * 16 + rr; const bf16 vb = f2bf(bf2f(xrow[col]) + g2[col] * ((float)acc[0] * sc)); xrow[col] = vb; const float v0 = bf2f(vb); if (repB == NREPB - 1) ssl[tl * 64 + lane] += v0 * v0; }
                else { const int col = s * 128 + cc * 16 + 2 * rr; const unsigned xb = *(const unsigned*)(xrow + col); const float2 gg = *(const float2*)(g2 + col);
                    const unsigned ob = pg8::cvt_pk_bf16(__uint_as_float(xb << 16) + gg.x * ((float)acc[0] * sc), __uint_as_float(xb & 0xffff0000u) + gg.y * ((float)acc[1] * sc));
                    *(unsigned*)(xrow + col) = ob; const float v0 = __uint_as_float(ob << 16), v1 = __uint_as_float(ob & 0xffff0000u);
                    if (repB == NREPB - 1) ssl[tl * 64 + lane] += v0 * v0 + v1 * v1; }
            }
        }
        __syncthreads();
    }
    asm volatile("s_waitcnt vmcnt(0)" ::: "memory");
    __builtin_amdgcn_fence(__ATOMIC_ACQUIRE, "agent");
    asm volatile("s_waitcnt vmcnt(0)" ::: "memory");
#pragma unroll 1
    for (int j0 = 0; j0 < J; j0 += 2) {
        f32x4 v[2][4];
#pragma unroll
        for (int t = 0; t < 2; ++t) if (j0 + t < J) { const int row = row0 + wave + 8 * (j0 + t); const bf16* xrow = row < M_LAT ? xlat + (size_t)row * D : xctx + (size_t)(row - M_LAT) * D;
#pragma unroll
            for (int q = 0; q < 4; ++q) v[t][q] = ld4res<true>(xrow, (size_t)(lane + 64 * q) * 4); }
#pragma unroll
        for (int t = 0; t < 2; ++t) if (j0 + t < J) { const int tl = wave + 8 * (j0 + t), row = row0 + tl; const int mi = row < M_LAT ? row / S : 4;
            float* xrow = outf + (size_t)row * D;
            const float rs = rsqrtf(wave_sum(ssl[tl * 64 + lane]) * (1.f / D) + EPS);
            float am = 0.f;
#pragma unroll
            for (int q = 0; q < 4; ++q) { const int k = (lane + 64 * q) * 4; const f32x4 w = *(const f32x4*)(nw + k);
                if (MODE == 2) { f32x4 o; o.x = v[t][q].x * rs * w.x; o.y = v[t][q].y * rs * w.y; o.z = v[t][q].z * rs * w.z; o.w = v[t][q].w * rs * w.w; ((f32x4*)xrow)[lane + 64 * q] = o; }
                else { const f32x4 b = *(const f32x4*)(modn + (size_t)mi * 6 * D + k), a = *(const f32x4*)(modn + (size_t)mi * 6 * D + D + k);
                    v[t][q].x = v[t][q].x * rs * w.x * (1.f + a.x) + b.x; v[t][q].y = v[t][q].y * rs * w.y * (1.f + a.y) + b.y; v[t][q].z = v[t][q].z * rs * w.z * (1.f + a.z) + b.z; v[t][q].w = v[t][q].w * rs * w.w * (1.f + a.w) + b.w;
                    am = fmaxf(am, fmaxf(fmaxf(fabsf(v[t][q].x), fabsf(v[t][q].y)), fmaxf(fabsf(v[t][q].z), fabsf(v[t][q].w)))); } }
            if (MODE == 1) {
                am = wave_max(am); const float sx = am > 0.f ? am * (1.f / 127.f) : 1.f, inv = 1.f / sx;
#pragma unroll
                for (int q = 0; q < 4; ++q) { const int q0 = (int)rintf(v[t][q].x * inv), q1 = (int)rintf(v[t][q].y * inv), q2 = (int)rintf(v[t][q].z * inv), q3 = (int)rintf(v[t][q].w * inv);
                    *(unsigned*)(xqo + (size_t)row * D + (lane + 64 * q) * 4) = (unsigned)(q0 & 0xff) | ((unsigned)(q1 & 0xff) << 8) | ((unsigned)(q2 & 0xff) << 16) | ((unsigned)(q3 & 0xff) << 24); }
                if (lane == 0) xso[row] = sx; }
        }
    }
}
__device__ __forceinline__ void ph_final_norm(float* x, const float* fw, int nrows) { const int tidx = otid();
    const int lane = tidx & 63, wave = tidx >> 6;
    for (int row0 = (blockIdx.x * 8 + wave) * 2; row0 < nrows; row0 += gridDim.x * 16) {
        f32x4 v[2][4];
#pragma unroll
        for (int r = 0; r < 2; ++r)
#pragma unroll
            for (int j = 0; j < 4; ++j) v[r][j] = ((const f32x4*)(x + (size_t)(row0 + r) * D))[lane + 64 * j];
#pragma unroll
        for (int r = 0; r < 2; ++r) { float ss = 0.f;
#pragma unroll
            for (int j = 0; j < 4; ++j) ss += v[r][j].x * v[r][j].x + v[r][j].y * v[r][j].y + v[r][j].z * v[r][j].z + v[r][j].w * v[r][j].w;
            ss = wave_sum(ss); const float rs = rsqrtf(ss * (1.f / D) + EPS);
#pragma unroll
            for (int j = 0; j < 4; ++j) { const f32x4 w = *(const f32x4*)(fw + (lane + 64 * j) * 4); f32x4 o = v[r][j] * rs; o.x *= w.x; o.y *= w.y; o.z *= w.z; o.w *= w.w; ((f32x4*)(x + (size_t)(row0 + r) * D))[lane + 64 * j] = o; } }
    }
}
#define DEFINE_PTRS \
    const float* x = p.in[0]; const float* c = p.in[1]; const float* ctx = p.in[2]; const float* c_ctx = p.in[3]; \
    const float* norm1_w = p.in[4]; const float* norm2_w = p.in[5]; const float* w_ada = p.in[6]; const float* b_ada = p.in[7]; \
    const float* w_in = p.in[8]; const float* w_out = p.in[9]; const float* na_rpb = p.in[10]; \
    const float* dec_f = p.in[11]; const float* dec_b = p.in[12]; const float* gn_w = p.in[13]; \
    const float* pool_w = p.in[14]; const float* pool_scale = p.in[15]; const float* peer_wq = p.in[16]; \
    const float* peer_keys = p.in[17]; const float* peer_u = p.in[18]; const float* peer_v = p.in[19]; const float* final_w = p.in[20]; \
    unsigned char* ws = p.ws; float* out = p.out; \
    float* MOD = (float*)(ws + WS_MOD); float* cosT = (float*)(ws + WS_ROPE); float* sinT = cosT + S * 32; \
    bf16* WI = (bf16*)(ws + WS_WI); bf16* WO = (bf16*)(ws + WS_WO); bf16* WQ = (bf16*)(ws + WS_WQ); bf16* KEYS = (bf16*)(ws + WS_KEYS); \
    bf16* XR = (bf16*)(ws + WS_XR); bf16* XRC = (bf16*)(ws + WS_XRC); bf16* U = (bf16*)(ws + WS_U); bf16* V = (bf16*)(ws + WS_V); bf16* ACT = (bf16*)(ws + WS_ACT); \
    bf16* PX = (bf16*)(ws + WS_PX); bf16* Q = PX; float* ST = (float*)(ws + WS_ST); bf16* STB = (bf16*)(ws + WS_ST); int* IDX = (int*)(ws + WS_IDX); float* GATE = (float*)(ws + WS_GATE); \
    float* TOPV = (float*)(ws + WS_TOPV); int* TOPI = (int*)(ws + WS_TOPI); \
    float* AW = (float*)(ws + WS_AW); (void)AW; \
    unsigned char* WI8 = ws + WS_WI8; unsigned char* WQ8 = ws + WS_WQ8; float* SWI = (float*)(ws + WS_SWI); float* SWQ = (float*)(ws + WS_SWQ); (void)WI8; (void)WQ8; (void)SWI; (void)SWQ; \
    unsigned char* XQ = ws + WS_XQ; float* XS = (float*)(ws + WS_XS); (void)XQ; (void)XS; \
    unsigned char* U8 = ws + WS_U; unsigned char* V8 = ws + WS_V; float* SU = (float*)(ws + WS_SU); float* SV = (float*)(ws + WS_SV); (void)U8; (void)V8; (void)SU; (void)SV; \
    (void)x; (void)c; (void)ctx; (void)c_ctx; (void)norm1_w; (void)norm2_w; (void)w_ada; (void)b_ada; (void)w_in; (void)w_out; (void)na_rpb; (void)dec_f; (void)dec_b; (void)gn_w; \
    (void)pool_w; (void)pool_scale; (void)peer_wq; (void)peer_keys; (void)peer_u; (void)peer_v; (void)final_w; (void)out; (void)MOD; (void)cosT; (void)sinT; (void)WI; (void)WO; (void)WQ; \
    (void)KEYS; (void)XR; (void)XRC; (void)U; (void)V; (void)ACT; (void)PX; (void)Q; (void)ST; (void)IDX; (void)GATE; (void)TOPV; (void)TOPI;
#define GRID_SYNC() xcd_barrier(bar)

template <int l>
__device__ __forceinline__ void layer(const Params& p, unsigned char* lds, const XcdBarrier& bar) {
    DEFINE_PTRS
    constexpr bool last = (l == DEPTH - 1);
    const float* modl = MOD + (size_t)l * 5 * 6 * D;
    constexpr int mrows = last ? M_LAT : M_ALL;
    if (l == 0) { ph_quant_w(WI, WI8, SWI, DEPTH * DPROJ_PAD); ph_quant_w(WQ, WQ8, SWQ, DEPTH * DQ); }
    if (l == 0) { DUP(1) ph_norm<true, false>(x, ctx, norm1_w + l * D, modl, 0, D, nullptr, XQ, XS, M_ALL);
    GRID_SYNC(); }
    else if (gridDim.x != 256) { ph_norm<true, true>(XR, XRC, norm1_w + l * D, modl, 0, D, nullptr, XQ, XS, M_ALL);
    GRID_SYNC(); }
#if USE_PG8
    DUP(2) { pg8::Gemm g{(const pg8::bf16_t*)XQ, (const pg8::bf16_t*)(WI8 + (size_t)l * DPROJ_PAD * D), M_ALL, DPROJ_PAD, D / 2}; pg8::StaticOrder So; So.init(M_ALL, DPROJ_PAD, (int)gridDim.x, (int)blockIdx.x);
      EpiI8Bf16Out E{PX, DPROJ, DPROJ, XS, SWI + l * DPROJ_PAD}; pg8::gemm_phase_i8<EpiI8Bf16Out, pg8::StaticOrder>((PG8_LAS unsigned char*)lds, g, So, E, nullptr); }
#else
    ph_gemm_simple<0>(ACT, WI + (size_t)l * DPROJ_PAD * D, M_ALL, DPROJ_PAD, D, PX, DPROJ, DPROJ, nullptr, nullptr, nullptr, nullptr, nullptr, 0, (bf16*)lds);
#endif
    GRID_SYNC();
#if NA_NAIVE
    ph_na(PX, na_rpb + (size_t)l * NAH * 15 * 31, ACT, mrows);
#else
    DUP(4) { ph_na_mfma(PX, na_rpb + (size_t)l * NAH * 15 * 31, ACT, last ? 1536 : 1584, lds);
    __syncthreads(); }
#endif
    DUP(5) ph_pool(PX, ACT, mrows);
#if RET_NAIVE
    ph_ret_state(PX, cosT, sinT, dec_f + l * RH, dec_b + l * RH, ST, (float*)lds);
#else
    DUP(6) ph_ret_state_mfma(PX, cosT, sinT, dec_f + l * RH, dec_b + l * RH, STB, lds);
#endif
    GRID_SYNC();
#if RET_NAIVE
    ph_ret_scan(dec_f + l * RH, dec_b + l * RH, ST);
#else
    ph_ret_scan_bf(dec_f + l * RH, dec_b + l * RH, STB);
#endif
    GRID_SYNC();
#if RET_NAIVE
    ph_ret_out(PX, cosT, sinT, dec_f + l * RH, dec_b + l * RH, ST, gn_w + l * RW, ACT, last ? 64 : NCH, (float*)lds);
#else
    DUP(7) ph_ret_out_mfma(PX, cosT, sinT, dec_f + l * RH, dec_b + l * RH, STB, gn_w + l * RW, ACT, last ? 64 : NCH, lds);
#endif
    GRID_SYNC();
#if USE_PG8
    DUP(l == 0 ? 11 : 31) { pg8::Gemm g{ACT, WO + (size_t)l * D * D, mrows, D, D}; pg8::StaticOrder So; So.init(mrows, D, (int)gridDim.x, (int)blockIdx.x);
      if (l == 0) { EpiRes<false> E{x, ctx, XR, XRC, modl, 2 * D}; pg8::gemm_phase<EpiRes<false>, pg8::StaticOrder>((PG8_LAS unsigned char*)lds, g, So, E, nullptr); }
      else { EpiRes<true> E{XR, XRC, XR, XRC, modl, 2 * D}; pg8::gemm_phase<EpiRes<true>, pg8::StaticOrder>((PG8_LAS unsigned char*)lds, g, So, E, nullptr); } }
#else
    ph_gemm_simple<1>(ACT, WO + (size_t)l * D * D, mrows, D, D, nullptr, 0, 0, xl, xc, out, XCTX, modl, 2 * D, (bf16*)lds);
#endif
    GRID_SYNC();
    DUP(1) ph_norm<true, true>(XR, XRC, norm2_w + l * D, modl, 3 * D, 4 * D, gridDim.x != 256 ? ACT : nullptr, XQ, XS, mrows);
    GRID_SYNC();
#if USE_PG8
    DUP(3) { pg8::Gemm g{(const pg8::bf16_t*)XQ, (const pg8::bf16_t*)(WQ8 + (size_t)l * DQ * D), mrows, DQ, D / 2}; pg8::StaticOrder So; So.init(mrows, DQ, (int)gridDim.x, (int)blockIdx.x);
#if TK32
      EpiI8QT E{Q, XS, SWQ + l * DQ}; pg8::gemm_phase_i8<EpiI8QT, pg8::StaticOrder>((PG8_LAS unsigned char*)lds, g, So, E, nullptr); }
#else
      EpiI8Bf16Out E{Q, DQ, DQ, XS, SWQ + l * DQ}; pg8::gemm_phase_i8<EpiI8Bf16Out, pg8::StaticOrder>((PG8_LAS unsigned char*)lds, g, So, E, nullptr); }
#endif
#else
    ph_gemm_simple<0>(ACT, WQ + (size_t)l * DQ * D, mrows, DQ, D, Q, DQ, DQ, nullptr, nullptr, nullptr, nullptr, nullptr, 0, (bf16*)lds);
#endif
    GRID_SYNC();
#if 1
#if TK32
    DUP(8) ph_tk32(Q, KEYS + (size_t)l * 2 * PH * PNK * PKD, IDX, GATE, mrows, lds);
#else
    DUP(8) ph_tk_mfma(Q, KEYS + (size_t)l * 2 * PH * PNK * PKD, IDX, GATE, mrows, lds);
#endif
#endif
    GRID_SYNC();
#if PEER_BF16
    ph_peer<last>(ACT, IDX, GATE, U + (size_t)l * NEXP * D, V + (size_t)l * NEXP * D, modl, 5 * D, out, XCTX, final_w, mrows);
#else
    if (gridDim.x == 256) {
        ph_peer_sweep<last ? 2 : 1>(IDX, GATE, U8 + (size_t)l * NEXP * D, V8 + (size_t)l * NEXP * D, SU + l * NEXP, SV + l * NEXP, XQ, XS, AW, modl, 5 * D, XR, XRC, out,
                                    last ? final_w : norm1_w + (l + 1) * D, MOD + (size_t)(l + 1 < DEPTH ? l + 1 : l) * 5 * 6 * D, XQ, XS, mrows, lds);
        if (!last) GRID_SYNC();
    } else {
        ph_peer8<last ? 2 : 0>(ACT, IDX, GATE, U8 + (size_t)l * NEXP * D, V8 + (size_t)l * NEXP * D, SU + l * NEXP, SV + l * NEXP, modl, 5 * D, XR, XRC, out, final_w, nullptr, mrows);
        if (!last) GRID_SYNC();
    }
    return;
#endif
    if (!last) GRID_SYNC();
}

__global__ void __launch_bounds__(NT, 2) mega(Params p) {
    extern __shared__ __attribute__((aligned(16))) unsigned char lds[];
    volatile LAS unsigned* bst = (volatile LAS unsigned*)((LAS unsigned char*)lds + LDS_BYTES - 64);
    if (threadIdx.x < 16) bst[threadIdx.x] = 0u;
    __syncthreads();
    const XcdBarrier bar = xcd_barrier_post((unsigned*)(p.ws + WS_CTL), bst);
    DUP(0) {
        DEFINE_PTRS
        DUP(20) { ph_mods(c, c_ctx, w_ada, b_ada, MOD, (float*)lds);
        __syncthreads();
#if RET_NAIVE
        ph_rope(cosT, sinT);
#endif
        }
        DUP(21)
        { ph_transpose_all(w_in, peer_wq, w_out, WI, WQ, WO, (float*)lds);
          ph_wo_pool(w_out, pool_w, pool_scale, WO, (float*)lds); }
        ph_cvt(peer_keys, KEYS, (size_t)DEPTH * 2 * PH * PNK * PKD / 4);
#if PEER_BF16
        ph_cvt(peer_u, U, (size_t)DEPTH * NEXP * D / 4);
        ph_cvt(peer_v, V, (size_t)DEPTH * NEXP * D / 4);
#else
        DUP(22) { ph_quant(peer_u, U8, SU, DEPTH * NEXP, 0);
        ph_quant(peer_v, V8, SV, DEPTH * NEXP, 0); }
#endif
    }
    GRID_SYNC();
    layer<0>(p, lds, bar);
    layer<1>(p, lds, bar);
}
}

extern "C" void kernel_launch(void* const* d_in, const int* in_sizes, int n_in, void* d_out, int out_size, void* d_ws, size_t ws_size, hipStream_t stream) {
    static int grid = 0;
    if (grid == 0) {
        if (n_in != 21 || out_size != M_LAT * D || ws_size < WS_END) { fprintf(stderr, "kernel_launch: unexpected sizes n_in %d out %d ws %zu (need %zu)\n", n_in, out_size, ws_size, (size_t)WS_END); grid = -1; return; }
        int dev = 0, cus = 0, per_cu = 0;
        if (hipGetDevice(&dev) != hipSuccess || hipDeviceGetAttribute(&cus, hipDeviceAttributeMultiprocessorCount, dev) != hipSuccess) { fprintf(stderr, "kernel_launch: device query failed\n"); grid = -1; return; }
        if (hipFuncSetAttribute((const void*)mega, hipFuncAttributeMaxDynamicSharedMemorySize, LDS_BYTES) != hipSuccess) { fprintf(stderr, "kernel_launch: hipFuncSetAttribute failed\n"); grid = -1; return; }
        if (hipOccupancyMaxActiveBlocksPerMultiprocessor(&per_cu, (const void*)mega, NT, LDS_BYTES) != hipSuccess || per_cu < 1) { fprintf(stderr, "kernel_launch: occupancy query says %d\n", per_cu); grid = -1; (void)hipGetLastError(); return; }
        grid = cus;
    }
    if (grid < 0) return;
    Params p{};
    for (int i = 0; i < 21; ++i) p.in[i] = (const float*)d_in[i];
    p.out = (float*)d_out; p.ws = (unsigned char*)d_ws;
    if (hipMemsetAsync((char*)d_ws + WS_CTL, 0, 65536, stream) != hipSuccess) { fprintf(stderr, "kernel_launch: memset failed\n"); return; }
    hipLaunchKernelGGL(mega, dim3(grid), dim3(NT), LDS_BYTES, stream, p);
    hipError_t e = hipPeekAtLastError();
    if (e != hipSuccess) fprintf(stderr, "kernel_launch: launch failed: %s (grid %d)\n", hipGetErrorString(e), grid);
}
```

```cpp
#include <hip/hip_runtime.h>
#include <cstdio>
#include <cstdint>

#ifndef DUP_MASK
#define DUP_MASK 0
#endif
#ifndef USE_PG8
#define USE_PG8 1
#endif
#ifndef NA_NAIVE
#define NA_NAIVE 0
#endif
#ifndef TK_NAIVE
#define TK_NAIVE 0
#endif
#ifndef RET_NAIVE
#define RET_NAIVE 0
#endif
#ifndef TK32
#define TK32 1
#endif
#ifndef PEER_BF16
#define PEER_BF16 0
#endif
#define DUP(bit) for (int _r = 0; _r < ((((unsigned)DUP_MASK >> (bit)) & 1u) ? 2 : 1); ++_r)

__device__ __forceinline__ int otid() { int t = threadIdx.x; asm volatile("" : "+v"(t)); return t; }

namespace pg8 {

#define PG8_LAS __attribute__((address_space(3)))
typedef unsigned short bf16_t;
typedef short bf16x8 __attribute__((ext_vector_type(8)));
typedef float f32x4 __attribute__((ext_vector_type(4)));
typedef unsigned u32x4 __attribute__((ext_vector_type(4)));
constexpr int BM = 256, BK = 64, HALF = 128, HTB = HALF * BK * 2  , STAGE_BYTES = 8 * HTB, NXCD = 8, WGM = 8;

__host__ __device__ __forceinline__ int lds_byte(int r, int c) { const int st = (r >> 4) * 2 + (c >> 5), rr = r & 15, cc = c & 31, ob = rr * 64 + cc * 2; return st * 1024 + (ob ^ (((ob >> 9) & 1) << 5)); }
__host__ __device__ __forceinline__ void stage_rc(int b, int& R, int& C) { const int st = b / 1024, sb = b % 1024, swz = sb ^ (((sb >> 9) & 1) << 5); R = (st >> 1) * 16 + swz / 64; C = (st & 1) * 32 + (swz % 64) / 2; }
__host__ __device__ __forceinline__ int perm32(int rho) { const int n = rho >> 4, i = rho & 15; return 8 * (i >> 2) + 4 * n + (i & 3); }

struct Unit { int pm, pn; };
struct Gemm { const bf16_t* A; const bf16_t* Bt; int M, N, K; };

struct StaticOrder {
    int nM, nN, nwg, G, c;
    __host__ __device__ __forceinline__ void init(int M, int N, int G_, int c_) { nM = M / BM; nN = N / BM; nwg = nM * nN; G = G_; c = c_; }
    __host__ __device__ __forceinline__ bool next(int i, Unit& u) const {
        const long L = (long)i * G + c; if (L >= nwg) return false;
        int wgid = (int)L; { const int q = nwg / NXCD, r = nwg % NXCD, xcd = wgid % NXCD, off = wgid / NXCD; wgid = (xcd < r ? xcd * (q + 1) : r * (q + 1) + (xcd - r) * q) + off; }
        const int nig = WGM * nN, gid = wgid / nig, fm = gid * WGM, gsz = (nM - fm) < WGM ? (nM - fm) : WGM;
        u.pm = fm + ((wgid % nig) % gsz); u.pn = (wgid % nig) / gsz; return true;
    }
    __device__ __forceinline__ void a_ready(const Unit&) const {}
    __device__ __forceinline__ void done(const Unit&) const {}
};
struct OneUnit { Unit u; __device__ __forceinline__ bool next(int i, Unit& o) const { if (i != 0) return false; o = u; return true; }
    __device__ __forceinline__ void a_ready(const Unit&) const {} __device__ __forceinline__ void done(const Unit&) const {} };

typedef unsigned u32x2 __attribute__((ext_vector_type(2)));
__device__ __forceinline__ unsigned cvt_pk_bf16(float lo, float hi) { unsigned r; asm volatile("v_cvt_pk_bf16_f32 %0, %1, %2" : "=v"(r) : "v"(lo), "v"(hi)); return r; }
typedef __bf16 bf16x2v_t __attribute__((ext_vector_type(2)));
typedef float f32x2v_t __attribute__((ext_vector_type(2)));
__device__ __forceinline__ unsigned cvt_pk_bf16_n(float lo, float hi) { const bf16x2v_t r = __builtin_convertvector((f32x2v_t){lo, hi}, bf16x2v_t); return __builtin_bit_cast(unsigned, r); }
template <class Epi, class Sched, bool STAMP = false>
__device__ __forceinline__ void gemm_phase(PG8_LAS unsigned char* lds, const Gemm g, const Sched& S, const Epi& E, unsigned long long* stamps) {
    const int tid = otid(), wid = __builtin_amdgcn_readfirstlane(tid >> 6), lane = tid & 63, wr = wid >> 2, wc = wid & 3, fr = lane & 15, fq = lane >> 4;
    const int K = g.K, nt = K / BK;
    int ts_lo = 0, ts_hi = 0, nts = 0; const unsigned long long rt_entry = STAMP ? (unsigned long long)wall_clock64() : 0ull;
#define PG8_STAMP() do { if (STAMP && wid == 0 && nts < 64) { const unsigned long long _c = (unsigned long long)clock64(); \
        ts_lo = (lane == nts) ? (int)(unsigned)_c : ts_lo; ts_hi = (lane == nts) ? (int)(unsigned)(_c >> 32) : ts_hi; ++nts; } } while (0)
    PG8_STAMP();
    unsigned voffA[2], voffB[2];
#pragma unroll
    for (int i = 0; i < 2; ++i) { int R, C; stage_rc(tid * 16 + i * 8192, R, C); const int Rb = Epi::PERM ? ((R & ~31) + perm32(R & 31)) : R;
        voffA[i] = (unsigned)(R * K + C) * 2u; voffB[i] = (unsigned)(Rb * K + C) * 2u; }
    const size_t kstep = (size_t)(BK * 2);
    const size_t hstep = (size_t)HALF * K * 2;
    const size_t tstep = 2 * hstep;
    const unsigned ldsw = (unsigned)wid * 1024u;
    const int aoff = lds_byte(wr * 64 + fr, fq * 8), boff = lds_byte(wc * 32 + fr, fq * 8);
#define PG8_SA(b, h) (((b) * 2 + (h)) * HTB)
#define PG8_SB(b, h) ((4 + (b) * 2 + (h)) * HTB)
#define PG8_STAGE(bufoff, gbase, voff) do { _Pragma("unroll") for (int _i = 0; _i < 2; ++_i) \
        __builtin_amdgcn_global_load_lds((const unsigned*)((const char*)(gbase) + (voff)[_i]), (PG8_LAS unsigned*)(lds + (bufoff) + ldsw + _i * 8192), 16, 0, 0); } while (0)
#define PG8_LDA(dst, b, h) do { _Pragma("unroll") for (int m = 0; m < 4; ++m) _Pragma("unroll") for (int k = 0; k < 2; ++k) dst[m][k] = *(const PG8_LAS bf16x8*)(lds + PG8_SA(b, h) + aoff + m * 2048 + k * 1024); } while (0)
#define PG8_LDB(dst, b, h) do { _Pragma("unroll") for (int n = 0; n < 2; ++n) _Pragma("unroll") for (int k = 0; k < 2; ++k) dst[n][k] = *(const PG8_LAS bf16x8*)(lds + PG8_SB(b, h) + boff + n * 2048 + k * 1024); } while (0)
#define PG8_MMA(ai, bj, At, Bt) do { __builtin_amdgcn_s_setprio(1); _Pragma("unroll") for (int m = 0; m < 4; ++m) _Pragma("unroll") for (int n = 0; n < 2; ++n) _Pragma("unroll") for (int k = 0; k < 2; ++k) \
        acc[ai][bj][m][n] = __builtin_amdgcn_mfma_f32_16x16x32_bf16(Bt[n][k], At[m][k], acc[ai][bj][m][n], 0, 0, 0); __builtin_amdgcn_s_setprio(0); } while (0)
#define PG8_WAIT_V(n) asm volatile("s_waitcnt vmcnt(" #n ")" ::: "memory")
#define PG8_WAIT_L(n) asm volatile("s_waitcnt lgkmcnt(" #n ")" ::: "memory")
#define PG8_BAR __builtin_amdgcn_s_barrier()
#define PG8_SCHED __builtin_amdgcn_sched_barrier(0)
    Unit cur, nxt; int ui = 0;
    if (!S.next(0, cur)) return;
    f32x4 acc[2][2][4][2];
#pragma unroll
    for (int a = 0; a < 2; ++a)
#pragma unroll
        for (int b = 0; b < 2; ++b)
#pragma unroll
            for (int m = 0; m < 4; ++m)
#pragma unroll
                for (int n = 0; n < 2; ++n) acc[a][b][m][n] = (f32x4){0.f, 0.f, 0.f, 0.f};
    bf16x8 At[4][2], B0[2][2], B1[2][2];
    const char* cA = (const char*)g.A + (size_t)cur.pm * tstep; const char* cB = (const char*)g.Bt + (size_t)cur.pn * tstep;
    S.a_ready(cur);
    PG8_STAGE(PG8_SB(0, 0), cB, voffB); PG8_STAGE(PG8_SA(0, 0), cA, voffA); PG8_STAGE(PG8_SB(0, 1), cB + hstep, voffB); PG8_STAGE(PG8_SA(0, 1), cA + hstep, voffA);
    if (wr == 1) PG8_BAR;
    PG8_WAIT_V(4); PG8_BAR;
    PG8_STAGE(PG8_SB(1, 0), cB + kstep, voffB); PG8_STAGE(PG8_SA(1, 0), cA + kstep, voffA); PG8_STAGE(PG8_SB(1, 1), cB + hstep + kstep, voffB);
    PG8_WAIT_V(6); PG8_BAR;
    PG8_STAMP();
    for (;;) {
        const bool has_next = S.next(ui + 1, nxt);
        const char* nA = has_next ? (const char*)g.A + (size_t)nxt.pm * tstep : cA; const char* nB = has_next ? (const char*)g.Bt + (size_t)nxt.pn * tstep : cB;
        for (int t = 0; t < nt; t += 2) {
            const bool last = (t == nt - 2);
            const char* a1 = cA + (size_t)(t + 1) * kstep;
            const char* a2 = last ? nA : cA + (size_t)(t + 2) * kstep; const char* b2 = last ? nB : cB + (size_t)(t + 2) * kstep;
            const char* a3 = a2 + kstep; const char* b3 = b2 + kstep;
            if (last && has_next) S.a_ready(nxt);
            PG8_LDB(B0, 0, 0); PG8_SCHED; PG8_LDA(At, 0, 0); PG8_STAGE(PG8_SA(1, 1), a1 + hstep, voffA);
            PG8_WAIT_L(8); PG8_BAR; PG8_WAIT_L(0); PG8_MMA(0, 0, At, B0); PG8_BAR; PG8_SCHED;
            PG8_LDB(B1, 0, 1); PG8_STAGE(PG8_SB(0, 0), b2, voffB);
            PG8_BAR; PG8_WAIT_L(0); PG8_MMA(0, 1, At, B1); PG8_BAR;
            PG8_LDA(At, 0, 1); PG8_STAGE(PG8_SA(0, 0), a2, voffA);
            PG8_BAR; PG8_WAIT_L(0); PG8_MMA(1, 0, At, B0); PG8_BAR; PG8_SCHED;
            PG8_STAGE(PG8_SB(0, 1), b2 + hstep, voffB);
            PG8_WAIT_V(6); PG8_BAR; PG8_MMA(1, 1, At, B1); PG8_BAR;
            PG8_LDB(B0, 1, 0); PG8_SCHED; PG8_LDA(At, 1, 0); PG8_STAGE(PG8_SA(0, 1), a2 + hstep, voffA);
            PG8_WAIT_L(8); PG8_BAR; PG8_WAIT_L(0); PG8_MMA(0, 0, At, B0); PG8_BAR; PG8_SCHED;
            PG8_LDB(B1, 1, 1); PG8_STAGE(PG8_SB(1, 0), b3, voffB);
            PG8_BAR; PG8_WAIT_L(0); PG8_MMA(0, 1, At, B1); PG8_BAR;
            PG8_LDA(At, 1, 1); PG8_STAGE(PG8_SA(1, 0), a3, voffA);
            PG8_BAR; PG8_WAIT_L(0); PG8_MMA(1, 0, At, B0); PG8_BAR; PG8_SCHED;
            PG8_STAGE(PG8_SB(1, 1), b3 + hstep, voffB);
            PG8_WAIT_V(6); PG8_BAR; PG8_MMA(1, 1, At, B1); PG8_BAR;
        }
        PG8_STAMP();
        if constexpr (!Epi::AFTER_DRAIN) { E(acc, cur, wr, wc, fr, fq); S.done(cur); }
        PG8_STAMP();
        if (!has_next) break;
#pragma unroll
        for (int a = 0; a < 2; ++a)
#pragma unroll
            for (int b = 0; b < 2; ++b)
#pragma unroll
                for (int m = 0; m < 4; ++m)
#pragma unroll
                    for (int n = 0; n < 2; ++n) acc[a][b][m][n] = (f32x4){0.f, 0.f, 0.f, 0.f};
        cur = nxt; cA = nA; cB = nB; ++ui;
    }
    PG8_WAIT_V(0);
    if (wr == 0) PG8_BAR;
    PG8_BAR;
    if constexpr (Epi::AFTER_DRAIN) { E.fused(acc, cur, wr, wc, fr, fq, lds, wid, lane); S.done(cur); }
    PG8_STAMP();
    if (STAMP && wid == 0) { stamps[lane] = lane < nts ? (((unsigned long long)(unsigned)ts_hi << 32) | (unsigned)ts_lo) : 0ull;
        if (lane == 62) stamps[62] = rt_entry; if (lane == 63) stamps[63] = (unsigned long long)wall_clock64(); }
#undef PG8_STAMP
#undef PG8_SA
#undef PG8_SB
#undef PG8_STAGE
#undef PG8_LDA
#undef PG8_LDB
#undef PG8_MMA
#undef PG8_WAIT_V
#undef PG8_WAIT_L
#undef PG8_BAR
#undef PG8_SCHED
}

typedef int i32x4 __attribute__((ext_vector_type(4)));
template <class Epi, class Sched, bool STAMP = false>
__device__ __forceinline__ void gemm_phase_i8(PG8_LAS unsigned char* lds, const Gemm g, const Sched& S, const Epi& E, unsigned long long* stamps) {
    const int tid = otid(), wid = __builtin_amdgcn_readfirstlane(tid >> 6), lane = tid & 63, wr = wid >> 2, wc = wid & 3, fr = lane & 15, fq = lane >> 4;
    const int K = g.K, nt = K / BK;
    int ts_lo = 0, ts_hi = 0, nts = 0; const unsigned long long rt_entry = STAMP ? (unsigned long long)wall_clock64() : 0ull;
#define PG8_STAMP() do { if (STAMP && wid == 0 && nts < 64) { const unsigned long long _c = (unsigned long long)clock64(); \
        ts_lo = (lane == nts) ? (int)(unsigned)_c : ts_lo; ts_hi = (lane == nts) ? (int)(unsigned)(_c >> 32) : ts_hi; ++nts; } } while (0)
    PG8_STAMP();
    unsigned voffA[2], voffB[2];
#pragma unroll
    for (int i = 0; i < 2; ++i) { int R, C; stage_rc(tid * 16 + i * 8192, R, C); const int Rb = Epi::PERM ? ((R & ~31) + perm32(R & 31)) : R;
        voffA[i] = (unsigned)(R * K + C) * 2u; voffB[i] = (unsigned)(Rb * K + C) * 2u; }
    const size_t kstep = (size_t)(BK * 2);
    const size_t hstep = (size_t)HALF * K * 2;
    const size_t tstep = 2 * hstep;
    const unsigned ldsw = (unsigned)wid * 1024u;
    const int aoff = lds_byte(wr * 64 + fr, fq * 8), boff = lds_byte(wc * 32 + fr, fq * 8);
#define PG8_SA(b, h) (((b) * 2 + (h)) * HTB)
#define PG8_SB(b, h) ((4 + (b) * 2 + (h)) * HTB)
#define PG8_STAGE(bufoff, gbase, voff) do { _Pragma("unroll") for (int _i = 0; _i < 2; ++_i) \
        __builtin_amdgcn_global_load_lds((const unsigned*)((const char*)(gbase) + (voff)[_i]), (PG8_LAS unsigned*)(lds + (bufoff) + ldsw + _i * 8192), 16, 0, 0); } while (0)
#define PG8_LDA(dst, b, h) do { _Pragma("unroll") for (int m = 0; m < 4; ++m) _Pragma("unroll") for (int k = 0; k < 2; ++k) dst[m][k] = *(const PG8_LAS i32x4*)(lds + PG8_SA(b, h) + aoff + m * 2048 + k * 1024); } while (0)
#define PG8_LDB(dst, b, h) do { _Pragma("unroll") for (int n = 0; n < 2; ++n) _Pragma("unroll") for (int k = 0; k < 2; ++k) dst[n][k] = *(const PG8_LAS i32x4*)(lds + PG8_SB(b, h) + boff + n * 2048 + k * 1024); } while (0)
#define PG8_MMA(ai, bj, At, Bt) do { __builtin_amdgcn_s_setprio(1); _Pragma("unroll") for (int m = 0; m < 4; ++m) _Pragma("unroll") for (int n = 0; n < 2; ++n) _Pragma("unroll") for (int k = 0; k < 2; ++k) \
        acc[ai][bj][m][n] = __builtin_amdgcn_mfma_i32_16x16x64_i8(Bt[n][k], At[m][k], acc[ai][bj][m][n], 0, 0, 0); __builtin_amdgcn_s_setprio(0); } while (0)
#define PG8_WAIT_V(n) asm volatile("s_waitcnt vmcnt(" #n ")" ::: "memory")
#define PG8_WAIT_L(n) asm volatile("s_waitcnt lgkmcnt(" #n ")" ::: "memory")
#define PG8_BAR __builtin_amdgcn_s_barrier()
#define PG8_SCHED __builtin_amdgcn_sched_barrier(0)
    Unit cur, nxt; int ui = 0;
    if (!S.next(0, cur)) return;
    i32x4 acc[2][2][4][2];
#pragma unroll
    for (int a = 0; a < 2; ++a)
#pragma unroll
        for (int b = 0; b < 2; ++b)
#pragma unroll
            for (int m = 0; m < 4; ++m)
#pragma unroll
                for (int n = 0; n < 2; ++n) acc[a][b][m][n] = (i32x4){0, 0, 0, 0};
    i32x4 At[4][2], B0[2][2], B1[2][2];
    const char* cA = (const char*)g.A + (size_t)cur.pm * tstep; const char* cB = (const char*)g.Bt + (size_t)cur.pn * tstep;
    S.a_ready(cur);
    PG8_STAGE(PG8_SB(0, 0), cB, voffB); PG8_STAGE(PG8_SA(0, 0), cA, voffA); PG8_STAGE(PG8_SB(0, 1), cB + hstep, voffB); PG8_STAGE(PG8_SA(0, 1), cA + hstep, voffA);
    if (wr == 1) PG8_BAR;
    PG8_WAIT_V(4); PG8_BAR;
    PG8_STAGE(PG8_SB(1, 0), cB + kstep, voffB); PG8_STAGE(PG8_SA(1, 0), cA + kstep, voffA); PG8_STAGE(PG8_SB(1, 1), cB + hstep + kstep, voffB);
    PG8_WAIT_V(6); PG8_BAR;
    PG8_STAMP();
    for (;;) {
        const bool has_next = S.next(ui + 1, nxt);
        const char* nA = has_next ? (const char*)g.A + (size_t)nxt.pm * tstep : cA; const char* nB = has_next ? (const char*)g.Bt + (size_t)nxt.pn * tstep : cB;
        for (int t = 0; t < nt; t += 2) {
            const bool last = (t == nt - 2);
            const char* a1 = cA + (size_t)(t + 1) * kstep;
            const char* a2 = last ? nA : cA + (size_t)(t + 2) * kstep; const char* b2 = last ? nB : cB + (size_t)(t + 2) * kstep;
            const char* a3 = a2 + kstep; const char* b3 = b2 + kstep;
            if (last && has_next) S.a_ready(nxt);
            PG8_LDB(B0, 0, 0); PG8_SCHED; PG8_LDA(At, 0, 0); PG8_STAGE(PG8_SA(1, 1), a1 + hstep, voffA);
            PG8_WAIT_L(8); PG8_BAR; PG8_WAIT_L(0); PG8_MMA(0, 0, At, B0); PG8_BAR; PG8_SCHED;
            PG8_LDB(B1, 0, 1); PG8_STAGE(PG8_SB(0, 0), b2, voffB);
            PG8_BAR; PG8_WAIT_L(0); PG8_MMA(0, 1, At, B1); PG8_BAR;
            PG8_LDA(At, 0, 1); PG8_STAGE(PG8_SA(0, 0), a2, voffA);
            PG8_BAR; PG8_WAIT_L(0); PG8_MMA(1, 0, At, B0); PG8_BAR; PG8_SCHED;
            PG8_STAGE(PG8_SB(0, 1), b2 + hstep, voffB);
            PG8_WAIT_V(6); PG8_BAR; PG8_MMA(1, 1, At, B1); PG8_BAR;
            PG8_LDB(B0, 1, 0); PG8_SCHED; PG8_LDA(At, 1, 0); PG8_STAGE(PG8_SA(0, 1), a2 + hstep, voffA);
            PG8_WAIT_L(8); PG8_BAR; PG8_WAIT_L(0); PG8_MMA(0, 0, At, B0); PG8_BAR; PG8_SCHED;
            PG8_LDB(B1, 1, 1); PG8_STAGE(PG8_SB(1, 0), b3, voffB);
            PG8_BAR; PG8_WAIT_L(0); PG8_MMA(0, 1, At, B1); PG8_BAR;
            PG8_LDA(At, 1, 1); PG8_STAGE(PG8_SA(1, 0), a3, voffA);
            PG8_BAR; PG8_WAIT_L(0); PG8_MMA(1, 0, At, B0); PG8_BAR; PG8_SCHED;
            PG8_STAGE(PG8_SB(1, 1), b3 + hstep, voffB);
            PG8_WAIT_V(6); PG8_BAR; PG8_MMA(1, 1, At, B1); PG8_BAR;
        }
        PG8_STAMP();
        if constexpr (!Epi::AFTER_DRAIN) { for (int _e = 0; _e < ((((unsigned)DUP_MASK >> 14) & 1u) ? 2 : 1); ++_e) E(acc, cur, wr, wc, fr, fq); S.done(cur); }
        PG8_STAMP();
        if (!has_next) break;
#pragma unroll
        for (int a = 0; a < 2; ++a)
#pragma unroll
            for (int b = 0; b < 2; ++b)
#pragma unroll
                for (int m = 0; m < 4; ++m)
#pragma unroll
                    for (int n = 0; n < 2; ++n) acc[a][b][m][n] = (i32x4){0, 0, 0, 0};
        cur = nxt; cA = nA; cB = nB; ++ui;
    }
    PG8_WAIT_V(0);
    if (wr == 0) PG8_BAR;
    PG8_BAR;
    if constexpr (Epi::AFTER_DRAIN) { E.fused(acc, cur, wr, wc, fr, fq, lds, wid, lane); S.done(cur); }
    PG8_STAMP();
    if (STAMP && wid == 0) { stamps[lane] = lane < nts ? (((unsigned long long)(unsigned)ts_hi << 32) | (unsigned)ts_lo) : 0ull;
        if (lane == 62) stamps[62] = rt_entry; if (lane == 63) stamps[63] = (unsigned long long)wall_clock64(); }
#undef PG8_STAMP
#undef PG8_SA
#undef PG8_SB
#undef PG8_STAGE
#undef PG8_LDA
#undef PG8_LDB
#undef PG8_MMA
#undef PG8_WAIT_V
#undef PG8_WAIT_L
#undef PG8_BAR
#undef PG8_SCHED
}
}

#define XB_TMO      128
#define XB_XCNT(j)  (256  + 64 * (j))
#define XB_XSUB(j)  (1280 + 64 * (j))
#define XB_XGEN(j)  (2304 + 64 * (j))
#define XB_TOP      3328
#define XB_TOPGEN   3392
#define XCD_BAR_WORDS 3456
#define XB_SPIN_CAP (1u << 18)
#define LAS __attribute__((address_space(3)))

__device__ __forceinline__ unsigned xb_ld(unsigned* p)              { return __hip_atomic_load(p, __ATOMIC_RELAXED, __HIP_MEMORY_SCOPE_AGENT); }
__device__ __forceinline__ unsigned xb_add(unsigned* p, unsigned v) { return __hip_atomic_fetch_add(p, v, __ATOMIC_RELAXED, __HIP_MEMORY_SCOPE_AGENT); }
__device__ __forceinline__ unsigned xb_xcc_id() { return (unsigned)__builtin_amdgcn_s_getreg((3 << 11) | 20) & 0xFu; }
#define XB_SPIN(cond, bar) do { unsigned _sp = 0; while (cond) { __builtin_amdgcn_s_sleep(1); \
    if ((++_sp & 255u) == 0u) { if (xb_ld(&(bar)[XB_TMO])) break; if (_sp > XB_SPIN_CAP) { atomicAdd(&(bar)[XB_TMO], 1u); break; } } } } while (0)

struct XcdBarrier {
    unsigned* bar; unsigned x;
    volatile LAS unsigned* st;
};

__device__ __forceinline__ XcdBarrier xcd_barrier_post(unsigned* bar, volatile LAS unsigned* st) {
    XcdBarrier b; b.bar = bar; b.x = xb_xcc_id(); b.st = st;
    if (threadIdx.x == 0) (void)xb_add(&bar[XB_XCNT(b.x)], 1u);
    return b;
}
__device__ __forceinline__ void xcd_barrier_complete(unsigned* bar, unsigned x, unsigned& nloc, unsigned& nx) {
    const unsigned G = gridDim.x * gridDim.y * gridDim.z;
    unsigned sum, cnt, mine, sp = 0u;
    for (;;) {
        sum = 0u; cnt = 0u; mine = 0u;
#pragma unroll
        for (unsigned j = 0; j < 16; ++j) { const unsigned c = xb_ld(&bar[XB_XCNT(j)]); sum += c; cnt += (c > 0u) ? 1u : 0u; mine = (j == x) ? c : mine; }
        if (sum == G) break;
        __builtin_amdgcn_s_sleep(1);
        if ((++sp & 255u) == 0u) { if (xb_ld(&bar[XB_TMO])) break; if (sp > XB_SPIN_CAP) { atomicAdd(&bar[XB_TMO], 1u); break; } }
    }
    nloc = mine > 0u ? mine : 1u; nx = cnt > 0u ? cnt : 1u;
}

__device__ __forceinline__ void xcd_barrier(const XcdBarrier& b) {
    asm volatile("s_waitcnt vmcnt(0)" ::: "memory");
    __syncthreads();
    if (threadIdx.x == 0) {
        unsigned* bar = b.bar;
        __builtin_amdgcn_s_waitcnt(0);
        unsigned nloc = b.st[0], nx = b.st[1];
        if (nloc == 0u) { xcd_barrier_complete(bar, b.x, nloc, nx); b.st[0] = nloc; b.st[1] = nx; }
        const unsigned old = xb_add(&bar[XB_XSUB(b.x)], 1u);
        const unsigned gen = old / nloc;
        if (old + 1u == (gen + 1u) * nloc) {
            __builtin_amdgcn_fence(__ATOMIC_RELEASE, "agent");
            asm volatile("s_waitcnt vmcnt(0)" ::: "memory");
            const unsigned og = xb_add(&bar[XB_TOP], 1u);
            const unsigned tg = og / nx;
            if (og + 1u == (tg + 1u) * nx) xb_add(&bar[XB_TOPGEN], 1u);
            else XB_SPIN(xb_ld(&bar[XB_TOPGEN]) == tg, bar);
            __builtin_amdgcn_fence(__ATOMIC_ACQUIRE, "agent");
            xb_add(&bar[XB_XGEN(b.x)], 1u);
            asm volatile("s_waitcnt vmcnt(0)" ::: "memory");
        } else {
            XB_SPIN(xb_ld(&bar[XB_XGEN(b.x)]) == gen, bar);
            __builtin_amdgcn_fence(__ATOMIC_ACQUIRE, "agent");
            asm volatile("s_waitcnt vmcnt(0)" ::: "memory");
        }
    }
    __syncthreads();
}


namespace {
constexpr int D = 1024, NB = 4, S = 8192, DEPTH = 2, GW = 64, CTX = 256, HD = 64;
constexpr int NAH = 6, RH = 6, NAW = 384, RW = 384, PW = 256;
constexpr int M_LAT = NB * S, M_CTX = NB * CTX, M_ALL = M_LAT + M_CTX;
constexpr int O_NA_Q = 0, O_NA_K = 384, O_NA_V = 768, O_RET_Q = 1152, O_RET_K = 1536, O_RET_V = 1920, O_RET_G = 2304, O_POOL = 2688;
constexpr int DPROJ = 2944, DPROJ_PAD = 3072;
constexpr int PH = 8, PNK = 128, PKD = 128, PTOP = 16, NEXP = 16384, DQ = 2048;
constexpr float EPS = 1e-6f;
constexpr int NCH = S / 128 + 2;
constexpr int NT = 512;
constexpr int LDS_BYTES = 163840;

typedef unsigned short bf16;
typedef short bf16x8 __attribute__((ext_vector_type(8)));
typedef float f32x4 __attribute__((ext_vector_type(4)));
typedef unsigned u32x4 __attribute__((ext_vector_type(4)));

__device__ __forceinline__ float bf2f(bf16 v) { return __uint_as_float(((unsigned)v) << 16); }
__device__ __forceinline__ bf16 f2bf(float f) { unsigned u = __float_as_uint(f); return (bf16)((u + 0x7fffu + ((u >> 16) & 1u)) >> 16); }
__device__ __forceinline__ float silu(float x) { return x / (1.f + __expf(-x)); }
#define SWZ_XOR(v, m) __int_as_float(__builtin_amdgcn_ds_swizzle(__float_as_int(v), ((m) << 10) | 0x1f))
__device__ __forceinline__ float wave_sum(float v) {
    v += SWZ_XOR(v, 1); v += SWZ_XOR(v, 2); v += SWZ_XOR(v, 4); v += SWZ_XOR(v, 8); v += SWZ_XOR(v, 16);
    return __int_as_float(__builtin_amdgcn_readlane(__float_as_int(v), 0)) + __int_as_float(__builtin_amdgcn_readlane(__float_as_int(v), 32));
}
__device__ __forceinline__ float wave_max(float v) {
    v = fmaxf(v, SWZ_XOR(v, 1)); v = fmaxf(v, SWZ_XOR(v, 2)); v = fmaxf(v, SWZ_XOR(v, 4)); v = fmaxf(v, SWZ_XOR(v, 8)); v = fmaxf(v, SWZ_XOR(v, 16));
    return fmaxf(__int_as_float(__builtin_amdgcn_readlane(__float_as_int(v), 0)), __int_as_float(__builtin_amdgcn_readlane(__float_as_int(v), 32)));
}
__device__ __forceinline__ int rl_i(int v, int lane) { return __builtin_amdgcn_readlane(v, lane); }
__device__ __forceinline__ float rl_f(float v, int lane) { return __int_as_float(__builtin_amdgcn_readlane(__float_as_int(v), lane)); }

constexpr size_t MiB = 1u << 20;
constexpr size_t WS_CTL = 0;
constexpr size_t WS_MOD = 1 * MiB;
constexpr size_t WS_ROPE = WS_MOD + 512 * 1024;
constexpr size_t WS_KEYS = 3 * MiB + 512 * 1024;
constexpr size_t WS_SU = 4 * MiB + 512 * 1024, WS_SV = WS_SU + 256 * 1024;
constexpr size_t WS_XS = 5 * MiB;
constexpr size_t WS_SWI = 5 * MiB + 512 * 1024, WS_SWQ = WS_SWI + 65536;
constexpr size_t WS_WO = 6 * MiB;
constexpr size_t WS_WI8 = 10 * MiB, WS_WQ8 = 16 * MiB;
constexpr size_t WS_WI = 20 * MiB;
constexpr size_t WS_WQ = 32 * MiB;
constexpr size_t WS_U = 40 * MiB;
constexpr size_t WS_V = 72 * MiB;
constexpr size_t WS_XQ = 104 * MiB;
constexpr size_t WS_ACT = 137 * MiB;
constexpr size_t WS_PX = 203 * MiB;
constexpr size_t WS_AW = WS_PX + 160 * MiB;
constexpr size_t WS_ST = 393 * MiB;
constexpr size_t WS_XR = 443 * MiB;
constexpr size_t WS_XRC = 507 * MiB;
constexpr size_t WS_END = 509 * MiB;
constexpr size_t WS_IDX = WS_ST, WS_GATE = WS_ST + 17 * MiB;
constexpr size_t WS_TOPV = WS_PX + 133 * MiB, WS_TOPI = WS_ACT;

struct Params { const float* in[21]; float* out; unsigned char* ws; };

__device__ __forceinline__ void ph_mods(const float* c, const float* c_ctx, const float* w_ada, const float* b_ada, float* mod, float* sm  ) { const int tidx = otid();
    const int tid = tidx, ks = tid >> 6, jj = tid & 63;
    float* act = sm; float* red = sm + 5 * D;
    if ((int)blockIdx.x >= DEPTH * 96) return;
    for (int i = tid; i < 5 * D; i += NT) { const float v = i < 4 * D ? c[i] : c_ctx[i - 4 * D]; act[i] = silu(v); }
    __syncthreads();
    for (int vb = blockIdx.x; vb < DEPTH * 96; vb += gridDim.x) {
        const int l = vb / 96, j = (vb % 96) * 64 + jj;
        const float* w = w_ada + (size_t)l * D * 6 * D + (size_t)(ks * 128) * 6 * D + j;
        const float* ap = act + ks * 128;
        float a0 = 0, a1 = 0, a2 = 0, a3 = 0, a4 = 0;
#pragma unroll 32
        for (int k = 0; k < 128; ++k) { const float wv = w[(size_t)k * 6 * D];
            a0 += ap[k] * wv; a1 += ap[D + k] * wv; a2 += ap[2 * D + k] * wv; a3 += ap[3 * D + k] * wv; a4 += ap[4 * D + k] * wv; }
        red[(ks * 5 + 0) * 64 + jj] = a0; red[(ks * 5 + 1) * 64 + jj] = a1; red[(ks * 5 + 2) * 64 + jj] = a2; red[(ks * 5 + 3) * 64 + jj] = a3; red[(ks * 5 + 4) * 64 + jj] = a4;
        __syncthreads();
        if (tid < 320) { const int r = tid >> 6; float s = 0.f;
#pragma unroll
            for (int q = 0; q < 8; ++q) s += red[(q * 5 + r) * 64 + jj];
            mod[((size_t)l * 5 + r) * 6 * D + j] = s + b_ada[l * 6 * D + j]; }
        __syncthreads();
    }
}
__device__ __forceinline__ void ph_rope(float* cosT, float* sinT) { const int tidx = otid();
    for (int gid = blockIdx.x * NT + tidx; gid < S * 32; gid += gridDim.x * NT) {
        const int t = gid / 32, j = gid % 32, jj = j & 15;
        const float inv = powf(10000.f, -(float)jj / 16.f);
        const float pos = j < 16 ? (float)(t / GW) : (float)(t % GW);
        const float ang = pos * inv;
        cosT[gid] = cosf(ang); sinT[gid] = sinf(ang);
    }
}
__device__ __forceinline__ void ph_transpose(const float* W, int K, int N, int Npad, int ldk, bf16* Wt, float* tile  ) { const int tidx = otid();
    const int tid = tidx, nbn = Npad / 64, nvb = nbn * (K / 64);
    for (int vb = blockIdx.x; vb < nvb; vb += gridDim.x) {
        const int n0 = (vb % nbn) * 64, k0 = (vb / nbn) * 64;
        { const int kk = tid >> 4, n4 = (tid & 15) * 4;
#pragma unroll
          for (int i = 0; i < 2; ++i) { const int k = kk + 32 * i; const int n = n0 + n4;
              const f32x4 v = (n < N) ? *(const f32x4*)(W + (size_t)(k0 + k) * N + n) : (f32x4){0.f, 0.f, 0.f, 0.f};
              tile[k * 65 + n4] = v.x; tile[k * 65 + n4 + 1] = v.y; tile[k * 65 + n4 + 2] = v.z; tile[k * 65 + n4 + 3] = v.w; } }
        __syncthreads();
        { const int n = tid >> 3, kc = (tid & 7) * 8;
          u32x4 o; o.x = pg8::cvt_pk_bf16(tile[(kc + 0) * 65 + n], tile[(kc + 1) * 65 + n]); o.y = pg8::cvt_pk_bf16(tile[(kc + 2) * 65 + n], tile[(kc + 3) * 65 + n]);
          o.z = pg8::cvt_pk_bf16(tile[(kc + 4) * 65 + n], tile[(kc + 5) * 65 + n]); o.w = pg8::cvt_pk_bf16(tile[(kc + 6) * 65 + n], tile[(kc + 7) * 65 + n]);
          *(u32x4*)(Wt + (size_t)(n0 + n) * ldk + k0 + kc) = o; }
        __syncthreads();
    }
}
__device__ __forceinline__ void ph_transpose_all(const float* w_in, const float* peer_wq, const float* w_out, bf16* WI, bf16* WQ, bf16* WO, float* tile) { const int tidx = otid();
    constexpr int T_IN = (DPROJ_PAD / 64) * (D / 64), T_Q = (DQ / 64) * (D / 64), T_O = (D / 64) * (768 / 64), T_L = T_IN + T_Q + T_O, T_ALL = DEPTH * T_L;
    const int tid = tidx, G = (int)gridDim.x, c = G - 1 - (int)blockIdx.x;
#define TR_DECODE(vb) const int l_ = (vb) / T_L, r0_ = (vb) % T_L; const int which_ = r0_ < T_IN ? 0 : (r0_ < T_IN + T_Q ? 1 : 2); const int r_ = r0_ - (which_ == 0 ? 0 : (which_ == 1 ? T_IN : T_IN + T_Q)); \
        const int N_ = which_ == 0 ? DPROJ : (which_ == 1 ? DQ : D), nbn_ = which_ == 0 ? DPROJ_PAD / 64 : (which_ == 1 ? DQ / 64 : D / 64); \
        const float* W_ = which_ == 0 ? w_in + (size_t)l_ * D * DPROJ : (which_ == 1 ? peer_wq + (size_t)l_ * D * DQ : w_out + (size_t)l_ * D * D); \
        bf16* Wt_ = which_ == 0 ? WI + (size_t)l_ * DPROJ_PAD * D : (which_ == 1 ? WQ + (size_t)l_ * DQ * D : WO + (size_t)l_ * D * D); \
        const int n0_ = (r_ % nbn_) * 64, k0_ = (r_ / nbn_) * 64;
    for (int vb0 = c; vb0 < T_ALL; vb0 += 4 * G) {
        f32x4 v[4][2];
#pragma unroll
        for (int i = 0; i < 4; ++i) { const int vb = vb0 + i * G;
            if (vb < T_ALL) { TR_DECODE(vb) (void)Wt_; const int kk = tid >> 4, n = n0_ + (tid & 15) * 4;
#pragma unroll
                for (int q = 0; q < 2; ++q) v[i][q] = (n < N_) ? *(const f32x4*)(W_ + (size_t)(k0_ + kk + 32 * q) * N_ + n) : (f32x4){0.f, 0.f, 0.f, 0.f}; } }
#pragma unroll
        for (int i = 0; i < 4; ++i) { const int vb = vb0 + i * G;
            if (vb < T_ALL) { float* tl = tile + i * (64 * 65); const int kk = tid >> 4, n4 = (tid & 15) * 4;
#pragma unroll
                for (int q = 0; q < 2; ++q) { const int k = kk + 32 * q; tl[k * 65 + n4] = v[i][q].x; tl[k * 65 + n4 + 1] = v[i][q].y; tl[k * 65 + n4 + 2] = v[i][q].z; tl[k * 65 + n4 + 3] = v[i][q].w; } } }
        __syncthreads();
#pragma unroll
        for (int i = 0; i < 4; ++i) { const int vb = vb0 + i * G;
            if (vb < T_ALL) { TR_DECODE(vb) (void)W_; (void)N_; const float* tl = tile + i * (64 * 65); const int n = tid >> 3, kc = (tid & 7) * 8;
                u32x4 o; o.x = pg8::cvt_pk_bf16(tl[(kc + 0) * 65 + n], tl[(kc + 1) * 65 + n]); o.y = pg8::cvt_pk_bf16(tl[(kc + 2) * 65 + n], tl[(kc + 3) * 65 + n]);
                o.z = pg8::cvt_pk_bf16(tl[(kc + 4) * 65 + n], tl[(kc + 5) * 65 + n]); o.w = pg8::cvt_pk_bf16(tl[(kc + 6) * 65 + n], tl[(kc + 7) * 65 + n]);
                *(u32x4*)(Wt_ + (size_t)(n0_ + n) * D + k0_ + kc) = o; } }
        __syncthreads();
    }
#undef TR_DECODE
}
__device__ __forceinline__ void ph_wo_pool(const float* w_out_all, const float* pool_w_all, const float* pool_scale_all, bf16* Wo_t_all, float* sm) { const int tidx = otid();
    const int tid = tidx; float* P = sm; float* Ws = sm + 64 * 65;
    for (int vb = (int)gridDim.x - 1 - (int)blockIdx.x; vb < DEPTH * 4 * 16; vb += gridDim.x) {
        const int l = vb >> 6, g = (vb >> 4) & 3, n0 = (vb & 15) * 64;
        const float* w_out = w_out_all + (size_t)l * D * D; const float* pool_w = pool_w_all + (size_t)l * 4 * 64 * 64; const float* pool_scale = pool_scale_all + (size_t)l * PW; bf16* Wo_t = Wo_t_all + (size_t)l * D * D;
        for (int i = tid; i < 4096; i += NT) { const int r = i >> 6, cc = i & 63; P[r * 65 + cc] = pool_w[(g * 64 + r) * 64 + cc] * pool_scale[g * 64 + cc]; Ws[r * 65 + cc] = w_out[(size_t)(768 + g * 64 + r) * D + n0 + cc]; }
        __syncthreads();
        { const int i = tid & 63, nq = tid >> 6;
#pragma unroll 1
          for (int nn = nq * 8; nn < nq * 8 + 8; ++nn) { float s = 0.f;
#pragma unroll 16
              for (int j = 0; j < 64; ++j) s += P[i * 65 + j] * Ws[j * 65 + nn];
              Wo_t[(size_t)(n0 + nn) * D + 768 + g * 64 + i] = f2bf(s); } }
        __syncthreads();
    }
}
__device__ __forceinline__ void ph_cvt(const float* src, bf16* dst, size_t n4) { const int tidx = otid();
    for (size_t i = (size_t)blockIdx.x * NT + tidx; i < n4; i += (size_t)gridDim.x * NT) {
        const f32x4 v = ((const f32x4*)src)[i]; ushort4 o; o.x = f2bf(v.x); o.y = f2bf(v.y); o.z = f2bf(v.z); o.w = f2bf(v.w); ((ushort4*)dst)[i] = o; }
}

template <bool BF> __device__ __forceinline__ f32x4 ld4res(const void* p, size_t idx) {
    if (BF) { const ushort4 v = *(const ushort4*)((const bf16*)p + idx); return (f32x4){bf2f(v.x), bf2f(v.y), bf2f(v.z), bf2f(v.w)}; }
    else return *(const f32x4*)((const float*)p + idx);
}
__device__ __forceinline__ void st4res(bf16* p, size_t idx, f32x4 v) { pg8::u32x2 o; o.x = pg8::cvt_pk_bf16(v.x, v.y); o.y = pg8::cvt_pk_bf16(v.z, v.w); *(pg8::u32x2*)(p + idx) = o; }

template <bool XQOUT, bool INBF>
__device__ __forceinline__ void ph_norm(const void* xlat, const void* xctx, const float* nw, const float* modl, int off_sh, int off_sc, bf16* act  , unsigned char* xq, float* xs, int nrows) { const int tidx = otid();
    const int lane = tidx & 63, wave = tidx >> 6;
    for (int row0 = (blockIdx.x * 8 + wave) * 2; row0 < nrows; row0 += gridDim.x * 16) {
        f32x4 v[2][4];
#pragma unroll
        for (int r = 0; r < 2; ++r) { const int row = row0 + r; const void* src = row < M_LAT ? xlat : xctx; const size_t rb = (size_t)(row < M_LAT ? row : row - M_LAT) * D;
#pragma unroll
            for (int j = 0; j < 4; ++j) v[r][j] = ld4res<INBF>(src, rb + (size_t)(lane + 64 * j) * 4); }
#pragma unroll
        for (int r = 0; r < 2; ++r) { const int row = row0 + r; const int mi = row < M_LAT ? row / S : 4;
            const float* sh = modl + (size_t)mi * 6 * D + off_sh; const float* sc = modl + (size_t)mi * 6 * D + off_sc;
            float ss = 0.f;
#pragma unroll
            for (int j = 0; j < 4; ++j) ss += v[r][j].x * v[r][j].x + v[r][j].y * v[r][j].y + v[r][j].z * v[r][j].z + v[r][j].w * v[r][j].w;
            ss = wave_sum(ss);
            const float rs = rsqrtf(ss * (1.f / D) + EPS);
            f32x4 hv[4]; float am = 0.f;
#pragma unroll
            for (int j = 0; j < 4; ++j) { const int k = (lane + 64 * j) * 4;
                const f32x4 w = *(const f32x4*)(nw + k), a = *(const f32x4*)(sc + k), b = *(const f32x4*)(sh + k);
                hv[j].x = v[r][j].x * rs * w.x * (1.f + a.x) + b.x; hv[j].y = v[r][j].y * rs * w.y * (1.f + a.y) + b.y; hv[j].z = v[r][j].z * rs * w.z * (1.f + a.z) + b.z; hv[j].w = v[r][j].w * rs * w.w * (1.f + a.w) + b.w;
                if (act) { ushort4 o; o.x = f2bf(hv[j].x); o.y = f2bf(hv[j].y); o.z = f2bf(hv[j].z); o.w = f2bf(hv[j].w);
                *(ushort4*)(act + (size_t)row * D + k) = o; }
                am = fmaxf(am, fmaxf(fmaxf(fabsf(hv[j].x), fabsf(hv[j].y)), fmaxf(fabsf(hv[j].z), fabsf(hv[j].w)))); }
            if (XQOUT) { am = wave_max(am); const float sx = am > 0.f ? am * (1.f / 127.f) : 1.f, inv = 1.f / sx;
#pragma unroll
                for (int j = 0; j < 4; ++j) { const int q0 = (int)rintf(hv[j].x * inv), q1 = (int)rintf(hv[j].y * inv), q2 = (int)rintf(hv[j].z * inv), q3 = (int)rintf(hv[j].w * inv);
                    *(unsigned*)(xq + (size_t)row * D + (lane + 64 * j) * 4) = (unsigned)(q0 & 0xff) | ((unsigned)(q1 & 0xff) << 8) | ((unsigned)(q2 & 0xff) << 16) | ((unsigned)(q3 & 0xff) << 24); }
                if (lane == 0) xs[row] = sx; }
        }
    }
}

struct EpiBf16Out {
    static constexpr bool PERM = true, AFTER_DRAIN = false;
    bf16* O; int ldc; int ncols;
    __device__ __forceinline__ void operator()(const pg8::f32x4 (&acc)[2][2][4][2], const pg8::Unit& u, int wr, int wc, int fr, int fq) const {
        const int row0 = u.pm * 256 + wr * 64 + fr, col0 = u.pn * 256 + wc * 32 + 8 * fq;
#pragma unroll
        for (int ai = 0; ai < 2; ++ai)
#pragma unroll
            for (int m = 0; m < 4; ++m) { bf16* rowp = O + (size_t)(row0 + ai * 128 + m * 16) * ldc + col0;
#pragma unroll
                for (int bj = 0; bj < 2; ++bj) { if (col0 + bj * 128 < ncols) { const pg8::f32x4 v0 = acc[ai][bj][m][0], v1 = acc[ai][bj][m][1];
                    u32x4 w; w.x = pg8::cvt_pk_bf16(v0[0], v0[1]); w.y = pg8::cvt_pk_bf16(v0[2], v0[3]); w.z = pg8::cvt_pk_bf16(v1[0], v1[1]); w.w = pg8::cvt_pk_bf16(v1[2], v1[3]);
                    *(u32x4*)(rowp + bj * 128) = w; } } }
    }
};
#ifndef NT_STORE
#define NT_STORE 0
#endif
struct EpiI8Bf16Out {
    static constexpr bool PERM = true, AFTER_DRAIN = false;
    bf16* O; int ldc; int ncols; const float* sa; const float* sb;
    __device__ __forceinline__ void operator()(const pg8::i32x4 (&acc)[2][2][4][2], const pg8::Unit& u, int wr, int wc, int fr, int fq) const {
        const int row0 = u.pm * 256 + wr * 64 + fr, col0 = u.pn * 256 + wc * 32 + 8 * fq;
        f32x4 sbv[2][2];
#pragma unroll
        for (int bj = 0; bj < 2; ++bj) { sbv[bj][0] = *(const f32x4*)(sb + col0 + bj * 128); sbv[bj][1] = *(const f32x4*)(sb + col0 + bj * 128 + 4); }
        float srv[2][4];
#pragma unroll
        for (int ai = 0; ai < 2; ++ai)
#pragma unroll
            for (int m = 0; m < 4; ++m) srv[ai][m] = sa[row0 + ai * 128 + m * 16];
#pragma unroll
        for (int ai = 0; ai < 2; ++ai)
#pragma unroll
            for (int m = 0; m < 4; ++m) { const int row = row0 + ai * 128 + m * 16; const float sr = srv[ai][m]; bf16* rowp = O + (size_t)row * ldc + col0;
#pragma unroll
                for (int bj = 0; bj < 2; ++bj) { if (col0 + bj * 128 < ncols) { const pg8::i32x4 v0 = acc[ai][bj][m][0], v1 = acc[ai][bj][m][1]; const f32x4 s0 = sbv[bj][0] * sr, s1 = sbv[bj][1] * sr;
                    u32x4 w; w.x = pg8::cvt_pk_bf16((float)v0[0] * s0.x, (float)v0[1] * s0.y); w.y = pg8::cvt_pk_bf16((float)v0[2] * s0.z, (float)v0[3] * s0.w);
                    w.z = pg8::cvt_pk_bf16((float)v1[0] * s1.x, (float)v1[1] * s1.y); w.w = pg8::cvt_pk_bf16((float)v1[2] * s1.z, (float)v1[3] * s1.w);
                    if (NT_STORE) __builtin_nontemporal_store(w, (u32x4*)(rowp + bj * 128)); else *(u32x4*)(rowp + bj * 128) = w; } } }
    }
};
struct EpiI8QT {
    static constexpr bool PERM = true, AFTER_DRAIN = false;
    bf16* O; const float* sa; const float* sb;
    __device__ __forceinline__ void operator()(const pg8::i32x4 (&acc)[2][2][4][2], const pg8::Unit& u, int wr, int wc, int fr, int fq) const {
        const int row0 = u.pm * 256 + wr * 64 + fr, col0 = u.pn * 256 + wc * 32 + 8 * fq;
        f32x4 sbv[2][2];
#pragma unroll
        for (int bj = 0; bj < 2; ++bj) { sbv[bj][0] = *(const f32x4*)(sb + col0 + bj * 128); sbv[bj][1] = *(const f32x4*)(sb + col0 + bj * 128 + 4); }
        float srv[2][4];
#pragma unroll
        for (int ai = 0; ai < 2; ++ai)
#pragma unroll
            for (int m = 0; m < 4; ++m) srv[ai][m] = sa[row0 + ai * 128 + m * 16];
        const int sfrag = (2 * wc + (fq >> 1)) * 512 + (fq & 1) * 256;
#pragma unroll
        for (int ai = 0; ai < 2; ++ai)
#pragma unroll
            for (int m = 0; m < 4; ++m) { const int row = row0 + ai * 128 + m * 16; const float sr = srv[ai][m];
#pragma unroll
                for (int bj = 0; bj < 2; ++bj) { const pg8::i32x4 v0 = acc[ai][bj][m][0], v1 = acc[ai][bj][m][1]; const f32x4 s0 = sbv[bj][0] * sr, s1 = sbv[bj][1] * sr;
                    u32x4 w; w.x = pg8::cvt_pk_bf16((float)v0[0] * s0.x, (float)v0[1] * s0.y); w.y = pg8::cvt_pk_bf16((float)v0[2] * s0.z, (float)v0[3] * s0.w);
                    w.z = pg8::cvt_pk_bf16((float)v1[0] * s1.x, (float)v1[1] * s1.y); w.w = pg8::cvt_pk_bf16((float)v1[2] * s1.z, (float)v1[3] * s1.w);
                    *(u32x4*)(O + ((size_t)(((row >> 5) * PH + u.pn) * 2 + bj)) * 4096 + sfrag + (row & 31) * 8) = w; } }
    }
};
template <bool INBF>
struct EpiRes {
    static constexpr bool PERM = false, AFTER_DRAIN = false;
    const void* xin_lat; const void* xin_ctx; bf16* xout_lat; bf16* xout_ctx; const float* modl; int off_g;
    __device__ __forceinline__ void operator()(const pg8::f32x4 (&acc)[2][2][4][2], const pg8::Unit& u, int wr, int wc, int fr, int fq) const {
        const int r0 = u.pm * 256; const bool lat = r0 < M_LAT; const int mi = lat ? r0 / S : 4;
        const void* xin = lat ? xin_lat : xin_ctx; bf16* xout = lat ? xout_lat : xout_ctx;
        const size_t rbase = (size_t)(lat ? r0 : r0 - M_LAT) * D;
        const int col0 = u.pn * 256 + wc * 32 + 4 * fq;
        const float* gp = modl + (size_t)mi * 6 * D + off_g + col0;
        f32x4 gv[2][2];
#pragma unroll
        for (int bj = 0; bj < 2; ++bj)
#pragma unroll
            for (int n = 0; n < 2; ++n) gv[bj][n] = *(const f32x4*)(gp + bj * 128 + n * 16);
#pragma unroll
        for (int ai = 0; ai < 2; ++ai) {
            f32x4 xi[4][2][2];
#pragma unroll
            for (int mm = 0; mm < 4; ++mm) { const size_t off = rbase + (size_t)(ai * 128 + wr * 64 + mm * 16 + fr) * D + col0;
#pragma unroll
                for (int bj = 0; bj < 2; ++bj)
#pragma unroll
                    for (int n = 0; n < 2; ++n) xi[mm][bj][n] = ld4res<INBF>(xin, off + bj * 128 + n * 16); }
#pragma unroll
            for (int mm = 0; mm < 4; ++mm) { const size_t off = rbase + (size_t)(ai * 128 + wr * 64 + mm * 16 + fr) * D + col0;
#pragma unroll
                for (int bj = 0; bj < 2; ++bj)
#pragma unroll
                    for (int n = 0; n < 2; ++n) { const pg8::f32x4 a = acc[ai][bj][mm][n]; const f32x4 gq = gv[bj][n], x4 = xi[mm][bj][n]; f32x4 o;
                        o.x = x4.x + gq.x * a[0]; o.y = x4.y + gq.y * a[1]; o.z = x4.z + gq.z * a[2]; o.w = x4.w + gq.w * a[3];
                        st4res(xout, off + bj * 128 + n * 16, o); } }
            asm volatile("" ::: "memory");
        }
    }
};

template <int EPI>
__device__ __forceinline__ void ph_gemm_simple(const bf16* A, const bf16* Bt, int M, int N, int K, bf16* Cb, int ldc, int ncols,
                                               const float* xin_lat, const float* xin_ctx, float* xout_lat, float* xout_ctx, const float* modl, int off_g, bf16* sm  ) { const int tidx = otid();
    bf16 (*sA)[40] = (bf16 (*)[40])sm; bf16 (*sB)[40] = (bf16 (*)[40])(sm + 128 * 40);
    const int tid = tidx, w = tid >> 6, lane = tid & 63, fr = lane & 15, fq = lane >> 4;
    const int lr = tid >> 2, lc = (tid & 3) * 8;
    const int nbn = N / 64, nvb = (M / 128) * nbn;
    for (int vb = blockIdx.x; vb < nvb; vb += gridDim.x) {
        const int m0 = (vb / nbn) * 128, n0 = (vb % nbn) * 64;
        f32x4 acc[4];
#pragma unroll
        for (int j = 0; j < 4; ++j) acc[j] = (f32x4){0.f, 0.f, 0.f, 0.f};
        for (int k0 = 0; k0 < K; k0 += 32) {
            *(bf16x8*)&sA[lr][lc] = *(const bf16x8*)(A + (size_t)(m0 + lr) * K + k0 + lc);
            if (tid < 256) *(bf16x8*)&sB[lr][lc] = *(const bf16x8*)(Bt + (size_t)(n0 + lr) * K + k0 + lc);
            __syncthreads();
            const bf16x8 a = *(const bf16x8*)&sA[w * 16 + fr][fq * 8];
#pragma unroll
            for (int j = 0; j < 4; ++j) { const bf16x8 b = *(const bf16x8*)&sB[j * 16 + fr][fq * 8]; acc[j] = __builtin_amdgcn_mfma_f32_16x16x32_bf16(a, b, acc[j], 0, 0, 0); }
            __syncthreads();
        }
#pragma unroll
        for (int j = 0; j < 4; ++j)
#pragma unroll
            for (int i = 0; i < 4; ++i) {
                const int row = m0 + w * 16 + fq * 4 + i, col = n0 + j * 16 + fr;
                if (EPI == 0) { if (col < ncols) Cb[(size_t)row * ldc + col] = f2bf(acc[j][i]); }
                else { const int mi = row < M_LAT ? row / S : 4; const float g = modl[(size_t)mi * 6 * D + off_g + col];
                    if (row < M_LAT) xout_lat[(size_t)row * D + col] = xin_lat[(size_t)row * D + col] + g * acc[j][i];
                    else { const size_t o = (size_t)(row - M_LAT) * D + col; xout_ctx[o] = xin_ctx[o] + g * acc[j][i]; } }
            }
    }
}

__device__ __forceinline__ void ph_na(const bf16* px, const float* rpb  , bf16* act, int nrows) { const int tidx = otid();
    for (int gid = blockIdx.x * NT + tidx; gid < nrows * NAH; gid += gridDim.x * NT) {
        const int row = gid / NAH, h = gid % NAH;
        float q[64], o[64];
        const bf16* qp = px + (size_t)row * DPROJ + O_NA_Q + h * 64;
#pragma unroll
        for (int d = 0; d < 64; ++d) { q[d] = bf2f(qp[d]) * 0.125f; o[d] = 0.f; }
        float mx = -1e30f, den = 0.f;
        int b, nwin = 0, rr = 0, cq = 0, r_start = 0, c_start = 0;
        if (row < M_LAT) { b = row / S; const int t = row % S; rr = t / GW; cq = t % GW; r_start = min(max(rr - 4, 0), 128 - 8); c_start = min(max(cq - 8, 0), GW - 16); nwin = 128; }
        else b = (row - M_LAT) / CTX;
        for (int i = 0; i < nwin + CTX; ++i) {
            int krow; float bias = 0.f;
            if (i < nwin) { const int j = i / 16, kc = c_start + (i % 16), kr = r_start + j; krow = b * S + kr * GW + kc;
                bias = rpb[(h * 15 + (kr - rr + 7)) * 31 + (kc - cq + 15)]; }
            else krow = M_LAT + b * CTX + (i - nwin);
            const bf16* kp = px + (size_t)krow * DPROJ + O_NA_K + h * 64;
            float s = 0.f;
#pragma unroll
            for (int d = 0; d < 64; ++d) s += q[d] * bf2f(kp[d]);
            s += bias;
            const float nm = fmaxf(mx, s), corr = __expf(mx - nm), p = __expf(s - nm);
            den = den * corr + p; mx = nm;
            const bf16* vp = px + (size_t)krow * DPROJ + O_NA_V + h * 64;
#pragma unroll
            for (int d = 0; d < 64; ++d) o[d] = o[d] * corr + p * bf2f(vp[d]);
        }
        const float inv = 1.f / den;
        bf16* op = act + (size_t)row * D + h * 64;
#pragma unroll
        for (int d = 0; d < 64; ++d) op[d] = f2bf(o[d] * inv);
    }
}

typedef short s16x4 __attribute__((ext_vector_type(4)));
typedef __attribute__((address_space(3))) const unsigned char* lds_cp;
__device__ __forceinline__ s16x4 vtr(lds_cp p) { return __builtin_bit_cast(s16x4, __builtin_amdgcn_ds_read_tr16_b64_v4i16((__attribute__((address_space(3))) s16x4*)p)); }
__device__ __forceinline__ float xq_max(float x) {
    auto s = __builtin_amdgcn_permlane16_swap(__float_as_uint(x), __float_as_uint(x), false, false);
    x = fmaxf(__uint_as_float(s[0]), __uint_as_float(s[1]));
    auto t = __builtin_amdgcn_permlane32_swap(__float_as_uint(x), __float_as_uint(x), false, false);
    return fmaxf(__uint_as_float(t[0]), __uint_as_float(t[1]));
}
__device__ __forceinline__ float xq_sum(float x) {
    auto s = __builtin_amdgcn_permlane16_swap(__float_as_uint(x), __float_as_uint(x), false, false);
    x = __uint_as_float(s[0]) + __uint_as_float(s[1]);
    auto t = __builtin_amdgcn_permlane32_swap(__float_as_uint(x), __float_as_uint(x), false, false);
    return __uint_as_float(t[0]) + __uint_as_float(t[1]);
}
__device__ __forceinline__ void lds_barrier() { __builtin_amdgcn_s_waitcnt(0xC07F); __builtin_amdgcn_s_barrier(); }
constexpr int NA_ROWB = 160;
constexpr int NA_KOFF = 0, NA_VOFF = 2 * 64 * NA_ROWB, NA_BOFF = 4 * 64 * NA_ROWB;
__device__ __forceinline__ void ph_na_mfma(const bf16* px, const float* rpb  , bf16* act, int nunits, unsigned char* ldsg) { const int tidx = otid();
    const int lane = tidx & 63, w = __builtin_amdgcn_readfirstlane(tidx >> 6), fr = lane & 15, quad = lane >> 4;
    const lds_cp lds = (lds_cp)ldsg;
    float* sbias = (float*)(ldsg + NA_BOFF);
    constexpr float LOG2E = 1.4426950408889634f;
    const int skey = tidx >> 3, spiece = tidx & 7;
    const int G_ = gridDim.x, vcu = (G_ % 8 == 0) ? ((int)blockIdx.x % 8) * (G_ / 8) + (int)blockIdx.x / 8 : (int)blockIdx.x;
    for (int u = vcu; u < nunits; u += G_) {
        int b, h, wr0 = 0, nwin = 0, rq = 0, g = 0, rs_q = 0, qrow;
        const bool latent = u < 1536;
        if (latent) { b = u / 384; h = (u / 64) % 6; const int rp = u % 64;
            wr0 = min(max(2 * rp - 4, 0), 120); const int rs1 = min(max(2 * rp - 3, 0), 120); nwin = rs1 + 8 - wr0;
            rq = 2 * rp + (w >> 2); g = w & 3; rs_q = min(max(rq - 4, 0), 120); qrow = b * S + rq * GW + 16 * g + fr; }
        else { const int cu = u - 1536; b = cu / 12; h = (cu >> 1) % 6; qrow = M_LAT + b * CTX + (cu & 1) * 128 + 16 * w + fr; }
        const int nchunks = 4 + nwin;
        const int cq = 16 * g + fr, c_start = min(max(cq - 8, 0), 48);
        lds_barrier();
        for (int i = tidx; i < 480; i += NT) sbias[i] = (i & 31) < 31 ? rpb[h * 465 + (i >> 5) * 31 + (i & 31)] * LOG2E : -1e30f;
        bf16x8 qf[2];
        qf[0] = *(const bf16x8*)(px + (size_t)qrow * DPROJ + O_NA_Q + h * 64 + 8 * quad);
        qf[1] = *(const bf16x8*)(px + (size_t)qrow * DPROJ + O_NA_Q + h * 64 + 32 + 8 * quad);
        u32x4 kreg, vreg;
        { const size_t r = (size_t)(M_LAT + b * CTX + skey);
          kreg = *(const u32x4*)(px + r * DPROJ + O_NA_K + h * 64 + spiece * 8); vreg = *(const u32x4*)(px + r * DPROJ + O_NA_V + h * 64 + spiece * 8); }
        *(u32x4*)(ldsg + NA_KOFF + skey * NA_ROWB + spiece * 16) = kreg; *(u32x4*)(ldsg + NA_VOFF + skey * NA_ROWB + spiece * 16) = vreg;
        lds_barrier();
        f32x4 O[4];
#pragma unroll
        for (int dt = 0; dt < 4; ++dt) O[dt] = (f32x4){0.f, 0.f, 0.f, 0.f};
        float m = -1e30f, lsum = 0.f;
        const int cbase = 4 * quad - cq + 15;
        const int vbase = 4 * quad - c_start;
        const int c0 = min(max(16 * g - 8, 0), 32);
        int boff[8];
#pragma unroll
        for (int e = 0; e < 8; ++e) { const int ce = c0 + 16 * (e >> 2) + (e & 3); boff[e] = ((unsigned)(vbase + ce) < 16u) ? 4 * min(max(cbase + ce, 0), 30) : 4 * 31; }
        for (int c = 0; c < nchunks; ++c) {
            const int buf = c & 1;
            if (c + 1 < nchunks) { const int c1 = c + 1; const size_t r = c1 < 4 ? (size_t)(M_LAT + b * CTX + 64 * c1 + skey) : (size_t)(b * S + (wr0 + c1 - 4) * GW + skey);
                kreg = *(const u32x4*)(px + r * DPROJ + O_NA_K + h * 64 + spiece * 8); vreg = *(const u32x4*)(px + r * DPROJ + O_NA_V + h * 64 + spiece * 8); }
            const bool isctx = c < 4; const int kr = wr0 + c - 4;
            const bool use = isctx || (kr >= rs_q && kr < rs_q + 8);
            if (use) {
                const lds_cp kb = lds + NA_KOFF + buf * 64 * NA_ROWB, vb = lds + NA_VOFF + buf * 64 * NA_ROWB;
                const char* brow = (const char*)(sbias + (kr - rq + 7) * 32);
#pragma unroll
                for (int pair = 0; pair < 2; ++pair) {
                    if (!isctx && pair == 1) continue;
                    const int kofs = isctx ? 32 * pair : c0;
                    f32x4 a0 = (f32x4){0.f, 0.f, 0.f, 0.f}, a1 = a0;
#pragma unroll
                    for (int s = 0; s < 2; ++s) {
                        const bf16x8 k0 = *(const __attribute__((address_space(3))) bf16x8*)(kb + (kofs + fr) * NA_ROWB + 64 * s + 16 * quad);
                        const bf16x8 k1 = *(const __attribute__((address_space(3))) bf16x8*)(kb + (kofs + 16 + fr) * NA_ROWB + 64 * s + 16 * quad);
                        a0 = __builtin_amdgcn_mfma_f32_16x16x32_bf16(k0, qf[s], a0, 0, 0, 0);
                        a1 = __builtin_amdgcn_mfma_f32_16x16x32_bf16(k1, qf[s], a1, 0, 0, 0);
                    }
                    typedef float f32x2 __attribute__((ext_vector_type(2)));
                    f32x2 s2[4];
                    { float sc[8];
                      if (isctx) {
#pragma unroll
                          for (int i = 0; i < 4; ++i) { sc[i] = a0[i] * (0.125f * LOG2E); sc[4 + i] = a1[i] * (0.125f * LOG2E); }
                      } else {
#pragma unroll
                          for (int e = 0; e < 8; ++e) { const float bm = *(const float*)(brow + boff[e]);
                              sc[e] = __builtin_fmaf(e < 4 ? a0[e & 3] : a1[e & 3], 0.125f * LOG2E, bm); }
                      }
#pragma unroll
                      for (int k = 0; k < 4; ++k) s2[k] = (f32x2){sc[2 * k], sc[2 * k + 1]}; }
                    float mx = __builtin_fmaxf(__builtin_fmaxf(__builtin_fmaxf(s2[0].x, s2[0].y), __builtin_fmaxf(s2[1].x, s2[1].y)), __builtin_fmaxf(__builtin_fmaxf(s2[2].x, s2[2].y), __builtin_fmaxf(s2[3].x, s2[3].y)));
                    mx = xq_max(mx);
                    if (__any(mx > m + 6.f)) {
                        const float mn = fmaxf(m, mx), corr = __builtin_amdgcn_exp2f(m - mn); m = mn;
                        lsum *= corr;
#pragma unroll
                        for (int dt = 0; dt < 4; ++dt) O[dt] = O[dt] * corr;
                    }
                    float p[8];
                    { const f32x2 m2 = (f32x2){m, m}; f32x2 p2[4];
#pragma unroll
                      for (int k = 0; k < 4; ++k) { const f32x2 t = s2[k] - m2; p2[k] = (f32x2){__builtin_amdgcn_exp2f(t.x), __builtin_amdgcn_exp2f(t.y)}; p[2 * k] = p2[k].x; p[2 * k + 1] = p2[k].y; }
                      const f32x2 q2 = (p2[0] + p2[1]) + (p2[2] + p2[3]); lsum += q2.x + q2.y; }
                    u32x4 pk; pk.x = pg8::cvt_pk_bf16_n(p[0], p[1]); pk.y = pg8::cvt_pk_bf16_n(p[2], p[3]); pk.z = pg8::cvt_pk_bf16_n(p[4], p[5]); pk.w = pg8::cvt_pk_bf16_n(p[6], p[7]);
                    const bf16x8 pb = __builtin_bit_cast(bf16x8, pk);
#pragma unroll
                    for (int dt = 0; dt < 4; ++dt) {
                        const lds_cp va = vb + (kofs + 4 * quad + (fr >> 2)) * NA_ROWB + (16 * dt + 4 * (fr & 3)) * 2;
                        const s16x4 v0 = vtr(va), v1 = vtr(va + 16 * NA_ROWB);
                        bf16x8 A; A[0] = v0[0]; A[1] = v0[1]; A[2] = v0[2]; A[3] = v0[3]; A[4] = v1[0]; A[5] = v1[1]; A[6] = v1[2]; A[7] = v1[3];
                        O[dt] = __builtin_amdgcn_mfma_f32_16x16x32_bf16(A, pb, O[dt], 0, 0, 0);
                    }
                }
            }
            if (c + 1 < nchunks) { const int nb = (c + 1) & 1;
                *(u32x4*)(ldsg + NA_KOFF + nb * 64 * NA_ROWB + skey * NA_ROWB + spiece * 16) = kreg; *(u32x4*)(ldsg + NA_VOFF + nb * 64 * NA_ROWB + skey * NA_ROWB + spiece * 16) = vreg; }
            lds_barrier();
        }
        const float inv = 1.f / xq_sum(lsum);
        bf16* op = act + (size_t)qrow * D + h * 64 + 4 * quad;
#pragma unroll
        for (int dt = 0; dt < 4; ++dt) { pg8::u32x2 o; o.x = pg8::cvt_pk_bf16(O[dt][0] * inv, O[dt][1] * inv); o.y = pg8::cvt_pk_bf16(O[dt][2] * inv, O[dt][3] * inv); *(pg8::u32x2*)(op + 16 * dt) = o; }
    }
}
template <int W>
__device__ __forceinline__ void pool_item(const bf16* px, bf16* act, int row, int oc) {
    int t, T, base;
    if (row < M_LAT) { t = row % S; T = S; base = row - t; } else { t = (row - M_LAT) % CTX; T = CTX; base = row - t; }
    const int lo = max(t - W / 2, 0), hi = min(t + W / 2, T);
    bf16x8 tv[W];
#pragma unroll
    for (int i = 0; i < W; ++i) { const int tt = min(lo + i, hi - 1); tv[i] = *(const bf16x8*)(px + (size_t)(base + tt) * DPROJ + O_POOL + oc * 8); }
    const bf16x8 xv = *(const bf16x8*)(px + (size_t)row * DPROJ + O_POOL + oc * 8);
    float s[8];
#pragma unroll
    for (int j = 0; j < 8; ++j) s[j] = 0.f;
#pragma unroll
    for (int i = 0; i < W; ++i) { const float wgt = (lo + i < hi) ? 1.f : 0.f;
#pragma unroll
        for (int j = 0; j < 8; ++j) s[j] += wgt * bf2f((bf16)tv[i][j]); }
    const float inv = 1.f / (float)(hi - lo);
    u32x4 o; o.x = pg8::cvt_pk_bf16(s[0] * inv - bf2f((bf16)xv[0]), s[1] * inv - bf2f((bf16)xv[1])); o.y = pg8::cvt_pk_bf16(s[2] * inv - bf2f((bf16)xv[2]), s[3] * inv - bf2f((bf16)xv[3]));
    o.z = pg8::cvt_pk_bf16(s[4] * inv - bf2f((bf16)xv[4]), s[5] * inv - bf2f((bf16)xv[5])); o.w = pg8::cvt_pk_bf16(s[6] * inv - bf2f((bf16)xv[6]), s[7] * inv - bf2f((bf16)xv[7]));
    *(u32x4*)(act + (size_t)row * D + 768 + oc * 8) = o;
}
__device__ __forceinline__ void ph_pool(const bf16* px, bf16* act, int nrows) { const int tidx = otid();
    const int per = nrows * 8;
    for (int gid = blockIdx.x * NT + tidx; gid < 4 * per; gid += gridDim.x * NT) {
        const int g = gid / per, r = gid - g * per, row = r >> 3, oc = g * 8 + (r & 7);
        if (g == 0) pool_item<2>(px, act, row, oc); else if (g == 1) pool_item<4>(px, act, row, oc); else if (g == 2) pool_item<8>(px, act, row, oc); else pool_item<16>(px, act, row, oc);
    }
}
__device__ __forceinline__ float rope_elem(const bf16* p, int d, const float* cs, const float* sn, bool rope) {
    const float x = bf2f(p[d]);
    if (!rope) return x;
    const int half = d >> 5, dd = d & 31, j = dd & 15;
    const float c = cs[half * 16 + j], s = sn[half * 16 + j];
    if (dd < 16) { const float x2 = bf2f(p[d + 16]); return x * c - x2 * s; }
    else { const float x1 = bf2f(p[d - 16]); return x1 * s + x * c; }
}
__device__ __forceinline__ int chunk_row0(int b, int ci) { return ci < 64 ? b * S + ci * 128 : M_LAT + b * CTX + (ci - 64) * 128; }
__device__ __forceinline__ void load_kv_chunk(const bf16* px, const float* cosT, const float* sinT, int b, int h, int ci, float* sk, float* sv) { const int tidx = otid();
    const int row0 = chunk_row0(b, ci); const bool rope = ci < 64;
    for (int i = tidx; i < 128 * 64; i += NT) { const int m = i / 64, d = i % 64, row = row0 + m; const int t = rope ? (ci * 128 + m) : 0;
        sk[i] = rope_elem(px + (size_t)row * DPROJ + O_RET_K + h * 64, d, cosT + t * 32, sinT + t * 32, rope) * 0.125f;
        sv[i] = bf2f(px[(size_t)row * DPROJ + O_RET_V + h * 64 + d]); }
}
__device__ __forceinline__ void ph_ret_state(const bf16* px, const float* cosT, const float* sinT, const float* dec_f, const float* dec_b, float* ST, float* sm) { const int tidx = otid();
    float* sk = sm; float* sv = sm + 128 * 64;
    for (int vb = blockIdx.x; vb < NB * RH * NCH; vb += gridDim.x) {
        const int ci = vb % NCH, h = (vb / NCH) % RH, b = vb / (NCH * RH);
        load_kv_chunk(px, cosT, sinT, b, h, ci, sk, sv);
        __syncthreads();
        const float lgf = -log1pf(expf(-dec_f[h])), lgb = -log1pf(expf(-dec_b[h]));
        for (int i = tidx; i < 4096; i += NT) { const int d = i / 64, e = i % 64;
            float af = 0.f, ab = 0.f;
            for (int m = 0; m < 128; ++m) { const float kv = sk[m * 64 + d] * sv[m * 64 + e]; af += expf((127.f - m) * lgf) * kv; ab += expf((float)m * lgb) * kv; }
            ST[((((size_t)(b * RH + h) * 2 + 0) * NCH + ci) * 4096) + i] = af; ST[((((size_t)(b * RH + h) * 2 + 1) * NCH + ci) * 4096) + i] = ab; }
        __syncthreads();
    }
}
__device__ __forceinline__ void ph_ret_scan(const float* dec_f, const float* dec_b, float* ST) { const int tidx = otid();
    for (int gid = blockIdx.x * NT + tidx; gid < NB * RH * 2 * 4096; gid += gridDim.x * NT) {
        const int e = gid % 4096, dir = (gid / 4096) & 1, bh = gid / 8192, h = bh % RH;
        const float lg = -log1pf(expf(-(dir ? dec_b[h] : dec_f[h]))), gg = expf(128.f * lg);
        float* P = ST + ((size_t)bh * 2 + dir) * NCH * 4096 + e;
        float t[64];
#pragma unroll
        for (int c = 0; c < 64; ++c) t[c] = P[(size_t)c * 4096];
        const float k0 = P[(size_t)64 * 4096], k1 = P[(size_t)65 * 4096];
        if (dir == 0) { P[(size_t)64 * 4096] = 0.f; P[(size_t)65 * 4096] = k0; float R = gg * k0 + k1;
#pragma unroll
            for (int c = 0; c < 64; ++c) { const float v = t[c]; t[c] = R; R = gg * R + v; } }
        else { P[(size_t)65 * 4096] = 0.f; P[(size_t)64 * 4096] = k1; float R = k0 + gg * k1;
#pragma unroll
            for (int c = 63; c >= 0; --c) { const float v = t[c]; t[c] = R; R = gg * R + v; } }
#pragma unroll
        for (int c = 0; c < 64; ++c) P[(size_t)c * 4096] = t[c];
    }
}
__device__ __forceinline__ void ph_ret_scan_bf(const float* dec_f, const float* dec_b, bf16* ST) { const int tidx = otid();
    for (int gid = blockIdx.x * NT + tidx; gid < NB * RH * 2 * 2048; gid += gridDim.x * NT) {
        const int e2 = gid % 2048, dir = (gid / 2048) & 1, bh = gid / 4096, h = bh % RH;
        const float lg = -log1pf(expf(-(dir ? dec_b[h] : dec_f[h]))), gg = expf(128.f * lg);
        unsigned* P = (unsigned*)(ST + ((size_t)bh * 2 + dir) * NCH * 4096) + e2;
        unsigned t[64];
#pragma unroll
        for (int c = 0; c < 64; ++c) t[c] = P[(size_t)c * 2048];
        const unsigned k0 = P[(size_t)64 * 2048], k1 = P[(size_t)65 * 2048];
        const float k0x = __uint_as_float(k0 << 16), k0y = __uint_as_float(k0 & 0xffff0000u), k1x = __uint_as_float(k1 << 16), k1y = __uint_as_float(k1 & 0xffff0000u);
        if (dir == 0) { P[(size_t)64 * 2048] = 0u; P[(size_t)65 * 2048] = k0; float Rx = gg * k0x + k1x, Ry = gg * k0y + k1y;
#pragma unroll
            for (int c = 0; c < 64; ++c) { const unsigned v = t[c]; t[c] = pg8::cvt_pk_bf16(Rx, Ry); Rx = gg * Rx + __uint_as_float(v << 16); Ry = gg * Ry + __uint_as_float(v & 0xffff0000u); } }
        else { P[(size_t)65 * 2048] = 0u; P[(size_t)64 * 2048] = k1; float Rx = k0x + gg * k1x, Ry = k0y + gg * k1y;
#pragma unroll
            for (int c = 63; c >= 0; --c) { const unsigned v = t[c]; t[c] = pg8::cvt_pk_bf16(Rx, Ry); Rx = gg * Rx + __uint_as_float(v << 16); Ry = gg * Ry + __uint_as_float(v & 0xffff0000u); } }
#pragma unroll
        for (int c = 0; c < 64; ++c) P[(size_t)c * 2048] = t[c];
    }
}
__device__ __forceinline__ void ph_ret_out(const bf16* px, const float* cosT, const float* sinT, const float* dec_f, const float* dec_b, const float* ST, const float* gn_w, bf16* act, int nci, float* sm) { const int tidx = otid();
    float* sk = sm; float* sv = sm + 128 * 64; float* sy = sm + 2 * 128 * 64; float* sq = sy + 128 * 65;
    const int n = tidx & 127, eq = tidx >> 7;
    for (int vb = blockIdx.x; vb < NB * RH * nci; vb += gridDim.x) {
        const int ci = vb % nci, h = (vb / nci) % RH, b = vb / (nci * RH);
        const int row0 = chunk_row0(b, ci); const bool rope = ci < 64;
        load_kv_chunk(px, cosT, sinT, b, h, ci, sk, sv);
        __syncthreads();
        const int row = row0 + n; const int t = rope ? (ci * 128 + n) : 0;
        const float lgf = -log1pf(expf(-dec_f[h])), lgb = -log1pf(expf(-dec_b[h]));
        float q[64], y[16];
#pragma unroll
        for (int d = 0; d < 64; ++d) { q[d] = rope_elem(px + (size_t)row * DPROJ + O_RET_Q + h * 64, d, cosT + t * 32, sinT + t * 32, rope); if (eq == 0) sq[n * 65 + d] = q[d]; }
        __syncthreads();
#pragma unroll
        for (int e = 0; e < 16; ++e) y[e] = 0.f;
        for (int m = 0; m < 128; ++m) {
            float s = 0.f;
#pragma unroll
            for (int d = 0; d < 64; ++d) s += q[d] * sk[m * 64 + d];
            const float dm = m < n ? expf((float)(n - m) * lgf) : (m > n ? expf((float)(m - n) * lgb) : 2.f);
            s *= dm;
#pragma unroll
            for (int e = 0; e < 16; ++e) y[e] += s * sv[m * 64 + eq * 16 + e];
        }
        const float* Sf = ST + (((size_t)(b * RH + h) * 2 + 0) * NCH + ci) * 4096 + eq * 16; const float* Sb = ST + (((size_t)(b * RH + h) * 2 + 1) * NCH + ci) * 4096 + eq * 16;
        const float xf = expf((float)(n + 1) * lgf), xb = expf((float)(128 - n) * lgb);
#pragma unroll 1
        for (int d = 0; d < 64; ++d) { const float qd = sq[n * 65 + d]; const float qf = qd * xf, qb = qd * xb;
#pragma unroll
            for (int e = 0; e < 16; ++e) y[e] += qf * Sf[d * 64 + e] + qb * Sb[d * 64 + e]; }
#pragma unroll
        for (int e = 0; e < 16; ++e) sy[n * 65 + eq * 16 + e] = y[e];
        __syncthreads();
        float mu = 0.f;
        for (int e = 0; e < 64; ++e) mu += sy[n * 65 + e];
        mu *= (1.f / 64.f); float var = 0.f;
        for (int e = 0; e < 64; ++e) { const float dd = sy[n * 65 + e] - mu; var += dd * dd; }
        const float rs = rsqrtf(var * (1.f / 64.f) + EPS);
        const bf16* gp = px + (size_t)row * DPROJ + O_RET_G + h * 64 + eq * 16; bf16* op = act + (size_t)row * D + NAW + h * 64 + eq * 16;
#pragma unroll
        for (int e = 0; e < 16; ++e) { const float g = bf2f(gp[e]); op[e] = f2bf((y[e] - mu) * rs * gn_w[h * 64 + eq * 16 + e] * silu(g)); }
        __syncthreads();
    }
}


__device__ __forceinline__ void rope8(const bf16* hp, int piece, const float* cs, const float* sn, bool rope, float (&o)[8]) {
    const bf16x8 own = *(const bf16x8*)(hp + piece * 8);
    if (!rope) {
#pragma unroll
        for (int j = 0; j < 8; ++j) o[j] = bf2f((bf16)own[j]);
        return; }
    const bf16x8 par = *(const bf16x8*)(hp + (piece ^ 2) * 8);
    const int half = piece >> 2, pp = piece & 3, tb = half * 16 + 8 * (pp & 1);
    const f32x4 c0 = *(const f32x4*)(cs + tb), c1 = *(const f32x4*)(cs + tb + 4), s0 = *(const f32x4*)(sn + tb), s1 = *(const f32x4*)(sn + tb + 4);
    const float c[8] = {c0.x, c0.y, c0.z, c0.w, c1.x, c1.y, c1.z, c1.w}, s[8] = {s0.x, s0.y, s0.z, s0.w, s1.x, s1.y, s1.z, s1.w};
#pragma unroll
    for (int j = 0; j < 8; ++j) { const float a = bf2f((bf16)own[j]), b = bf2f((bf16)par[j]); o[j] = pp < 2 ? a * c[j] - b * s[j] : b * s[j] + a * c[j]; }
}
__device__ __forceinline__ u32x4 pack8(const float (&o)[8], float sc) {
    u32x4 r; r.x = pg8::cvt_pk_bf16(o[0] * sc, o[1] * sc); r.y = pg8::cvt_pk_bf16(o[2] * sc, o[3] * sc); r.z = pg8::cvt_pk_bf16(o[4] * sc, o[5] * sc); r.w = pg8::cvt_pk_bf16(o[6] * sc, o[7] * sc); return r;
}
__device__ __forceinline__ bf16x8 tr2(lds_cp a, int second_off) {
    const s16x4 v0 = vtr(a), v1 = vtr(a + second_off);
    bf16x8 A; A[0] = v0[0]; A[1] = v0[1]; A[2] = v0[2]; A[3] = v0[3]; A[4] = v1[0]; A[5] = v1[1]; A[6] = v1[2]; A[7] = v1[3]; return A;
}
constexpr int RT_P = 160;
__device__ __forceinline__ void rope_inv8(int odd, float (&inv8)[8]) {
#pragma unroll
    for (int k = 0; k < 8; ++k) inv8[k] = __builtin_amdgcn_exp2f(-(float)(8 * odd + k) * (13.287712379549449f / 16.f)) * 0.15915494309189535f;
}
__device__ __forceinline__ void rope8c(const bf16x8 own, const bf16x8 par, int piece, int t, const float (&inv8)[8], bool rope, float (&o)[8]) {
    if (!rope) {
#pragma unroll
        for (int j = 0; j < 8; ++j) o[j] = bf2f((bf16)own[j]);
        return; }
    const int half = piece >> 2, pp = piece & 3;
    const float pos = (float)(half ? (t % GW) : (t / GW));
#pragma unroll
    for (int j = 0; j < 8; ++j) { const float rev = pos * inv8[j], c = __builtin_amdgcn_cosf(rev), s = __builtin_amdgcn_sinf(rev);
        const float a = bf2f((bf16)own[j]), b = bf2f((bf16)par[j]); o[j] = pp < 2 ? a * c - b * s : b * s + a * c; }
}
__device__ __forceinline__ void rope8r(const bf16x8 own, const bf16x8 par, int piece, const float* cs, const float* sn, bool rope, float (&o)[8]) {
    if (!rope) {
#pragma unroll
        for (int j = 0; j < 8; ++j) o[j] = bf2f((bf16)own[j]);
        return; }
    const int half = piece >> 2, pp = piece & 3, tb = half * 16 + 8 * (pp & 1);
    const f32x4 c0 = *(const f32x4*)(cs + tb), c1 = *(const f32x4*)(cs + tb + 4), s0 = *(const f32x4*)(sn + tb), s1 = *(const f32x4*)(sn + tb + 4);
    const float c[8] = {c0.x, c0.y, c0.z, c0.w, c1.x, c1.y, c1.z, c1.w}, s[8] = {s0.x, s0.y, s0.z, s0.w, s1.x, s1.y, s1.z, s1.w};
#pragma unroll
    for (int j = 0; j < 8; ++j) { const float a = bf2f((bf16)own[j]), b = bf2f((bf16)par[j]); o[j] = pp < 2 ? a * c[j] - b * s[j] : b * s[j] + a * c[j]; }
}
__device__ __forceinline__ void ph_ret_state_mfma(const bf16* px, const float* cosT, const float* sinT, const float* dec_f, const float* dec_b, bf16* ST, unsigned char* ldsg) { const int tidx = otid();
    const int lane = tidx & 63, w = __builtin_amdgcn_readfirstlane(tidx >> 6), fr = lane & 15, quad = lane >> 4;
    const lds_cp lds = (lds_cp)ldsg;
    constexpr int KF = 0, KB = 128 * RT_P, VS = 2 * 128 * RT_P;
    constexpr int NU = NB * RH * NCH;
    bf16x8 kown[2], kpar[2]; u32x4 vv[2];
#define R1_ISSUE(vbx) do { const int ci_ = (vbx) % NCH, h_ = ((vbx) / NCH) % RH, b_ = (vbx) / (NCH * RH); const int row0_ = chunk_row0(b_, ci_); \
        _Pragma("unroll") for (int it = 0; it < 2; ++it) { const int item = tidx + NT * it, m = item >> 3, piece = item & 7; const bf16* rp = px + (size_t)(row0_ + m) * DPROJ; \
            kown[it] = *(const bf16x8*)(rp + O_RET_K + h_ * 64 + piece * 8); kpar[it] = *(const bf16x8*)(rp + O_RET_K + h_ * 64 + (piece ^ 2) * 8); vv[it] = *(const u32x4*)(rp + O_RET_V + h_ * 64 + piece * 8); } } while (0)
    float invk[8]; rope_inv8(tidx & 1, invk);
    int vb = blockIdx.x;
    if (vb < NU) R1_ISSUE(vb);
    for (; vb < NU; vb += gridDim.x) {
        const int ci = vb % NCH, h = (vb / NCH) % RH, b = vb / (NCH * RH);
        const bool rope = ci < 64;
        const float lgf = -log1pf(expf(-dec_f[h])), lgb = -log1pf(expf(-dec_b[h]));
        lds_barrier();
#pragma unroll
        for (int it = 0; it < 2; ++it) { const int item = tidx + NT * it, m = item >> 3, piece = item & 7; const int t = rope ? (ci * 128 + m) : 0;
            float o[8]; rope8c(kown[it], kpar[it], piece, t, invk, rope, o);
            *(u32x4*)(ldsg + KF + m * RT_P + piece * 16) = pack8(o, 0.125f * expf((127.f - (float)m) * lgf));
            *(u32x4*)(ldsg + KB + m * RT_P + piece * 16) = pack8(o, 0.125f * expf((float)m * lgb));
            *(u32x4*)(ldsg + VS + m * RT_P + piece * 16) = vv[it]; }
        R1_ISSUE(min(vb + (int)gridDim.x, NU - 1));
        lds_barrier();
        const int dir = w >> 2, dt = w & 3;
        const lds_cp kb = lds + (dir ? KB : KF);
        bf16x8 A[4];
#pragma unroll
        for (int ks = 0; ks < 4; ++ks) A[ks] = tr2(kb + (32 * ks + 8 * quad + (fr >> 2)) * RT_P + (16 * dt + 4 * (fr & 3)) * 2, 4 * RT_P);
        bf16* outp = ST + ((((size_t)(b * RH + h) * 2 + dir) * NCH + ci) * 4096);
#pragma unroll
        for (int et = 0; et < 4; ++et) {
            f32x4 acc = (f32x4){0.f, 0.f, 0.f, 0.f};
#pragma unroll
            for (int ks = 0; ks < 4; ++ks) { const bf16x8 Bv = tr2(lds + VS + (32 * ks + 8 * quad + (fr >> 2)) * RT_P + (16 * et + 4 * (fr & 3)) * 2, 4 * RT_P);
                acc = __builtin_amdgcn_mfma_f32_16x16x32_bf16(A[ks], Bv, acc, 0, 0, 0); }
#pragma unroll
            for (int i = 0; i < 4; ++i) outp[(16 * dt + 4 * quad + i) * 64 + 16 * et + fr] = f2bf(acc[i]);
        }
    }
#undef R1_ISSUE
}
__device__ __forceinline__ void ph_ret_out_mfma(const bf16* px, const float* cosT, const float* sinT, const float* dec_f, const float* dec_b, const bf16* ST, const float* gn_w, bf16* act, int nci, unsigned char* ldsg) { const int tidx = otid();
    const int lane = tidx & 63, w = __builtin_amdgcn_readfirstlane(tidx >> 6), fr = lane & 15, quad = lane >> 4;
    const lds_cp lds = (lds_cp)ldsg;
    constexpr int KS = 0, VS = 128 * RT_P, SF = 2 * 128 * RT_P, SB = SF + 64 * RT_P;
    constexpr float LOG2E = 1.4426950408889634f;
    const int NU = NB * RH * nci;
    bf16x8 kown[2], kpar[2], qown[2], qpar[2]; u32x4 vv[2]; u32x4 sfu, sbu;
#define R3_ISSUE(vbx) do { const int ci_ = (vbx) % nci, h_ = ((vbx) / nci) % RH, b_ = (vbx) / (nci * RH); const int row0_ = chunk_row0(b_, ci_); \
        _Pragma("unroll") for (int it = 0; it < 2; ++it) { const int item = tidx + NT * it, m = item >> 3, piece = item & 7; const bf16* rp = px + (size_t)(row0_ + m) * DPROJ; \
            kown[it] = *(const bf16x8*)(rp + O_RET_K + h_ * 64 + piece * 8); kpar[it] = *(const bf16x8*)(rp + O_RET_K + h_ * 64 + (piece ^ 2) * 8); vv[it] = *(const u32x4*)(rp + O_RET_V + h_ * 64 + piece * 8); } \
        { const bf16* Sf_ = ST + (((size_t)(b_ * RH + h_) * 2 + 0) * NCH + ci_) * 4096; const bf16* Sb_ = ST + (((size_t)(b_ * RH + h_) * 2 + 1) * NCH + ci_) * 4096; const int d_ = tidx >> 3, e0_ = (tidx & 7) * 8; \
          sfu = *(const u32x4*)(Sf_ + d_ * 64 + e0_); sbu = *(const u32x4*)(Sb_ + d_ * 64 + e0_); } \
        { const bf16* qp = px + (size_t)(row0_ + 16 * w + fr) * DPROJ + O_RET_Q + h_ * 64; \
          _Pragma("unroll") for (int s = 0; s < 2; ++s) { qown[s] = *(const bf16x8*)(qp + (4 * s + quad) * 8); qpar[s] = *(const bf16x8*)(qp + ((4 * s + quad) ^ 2) * 8); } } } while (0)
    float invk[8], invq[8]; rope_inv8(tidx & 1, invk); rope_inv8(quad & 1, invq);
    int vb = blockIdx.x;
    if (vb < NU) R3_ISSUE(vb);
    for (; vb < NU; vb += gridDim.x) {
        const int ci = vb % nci, h = (vb / nci) % RH, b = vb / (nci * RH);
        const int row0 = chunk_row0(b, ci); const bool rope = ci < 64;
        const float lgf2 = -log1pf(expf(-dec_f[h])) * LOG2E, lgb2 = -log1pf(expf(-dec_b[h])) * LOG2E;
        lds_barrier();
#pragma unroll
        for (int it = 0; it < 2; ++it) { const int item = tidx + NT * it, m = item >> 3, piece = item & 7; const int t = rope ? (ci * 128 + m) : 0;
            float o[8]; rope8c(kown[it], kpar[it], piece, t, invk, rope, o);
            *(u32x4*)(ldsg + KS + m * RT_P + piece * 16) = pack8(o, 0.125f);
            *(u32x4*)(ldsg + VS + m * RT_P + piece * 16) = vv[it]; }
        { const int d = tidx >> 3, e0 = (tidx & 7) * 8;
          *(u32x4*)(ldsg + SF + d * RT_P + e0 * 2) = sfu; *(u32x4*)(ldsg + SB + d * RT_P + e0 * 2) = sbu; }
        const int nloc = 16 * w + fr, row = row0 + nloc; const int tq = rope ? (ci * 128 + nloc) : 0;
        bf16x8 qf[2];
#pragma unroll
        for (int s = 0; s < 2; ++s) { float o[8]; rope8c(qown[s], qpar[s], 4 * s + quad, tq, invq, rope, o); qf[s] = __builtin_bit_cast(bf16x8, pack8(o, 1.f)); }
        ushort4 gvp[4]; f32x4 wvp[4];
        { const bf16* gp = px + (size_t)row * DPROJ + O_RET_G + h * 64 + 4 * quad; const float* gw = gn_w + h * 64 + 4 * quad;
#pragma unroll
          for (int et = 0; et < 4; ++et) { gvp[et] = *(const ushort4*)(gp + 16 * et); wvp[et] = *(const f32x4*)(gw + 16 * et); } }
        R3_ISSUE(min(vb + (int)gridDim.x, NU - 1));
        lds_barrier();
        f32x4 Y[4];
#pragma unroll
        for (int et = 0; et < 4; ++et) Y[et] = (f32x4){0.f, 0.f, 0.f, 0.f};
        float lf[4], lb[4];
#pragma unroll
        for (int i = 0; i < 4; ++i) { const float dl = (float)(fr - 4 * quad - i); lf[i] = __builtin_amdgcn_exp2f(dl * lgf2); lb[i] = __builtin_amdgcn_exp2f(-dl * lgb2); }
#pragma unroll
        for (int mp = 0; mp < 4; ++mp) {
            float p[8];
#pragma unroll
            for (int t2 = 0; t2 < 2; ++t2) { const int mt = 2 * mp + t2;
                f32x4 acc = (f32x4){0.f, 0.f, 0.f, 0.f};
#pragma unroll
                for (int s = 0; s < 2; ++s) { const bf16x8 kf = *(const __attribute__((address_space(3))) bf16x8*)(lds + KS + (16 * mt + fr) * RT_P + 64 * s + 16 * quad);
                    acc = __builtin_amdgcn_mfma_f32_16x16x32_bf16(kf, qf[s], acc, 0, 0, 0); }
                if (mt == w) {
#pragma unroll
                    for (int i = 0; i < 4; ++i) { const int df = fr - 4 * quad - i;
                        const float dm = df > 0 ? lf[i] : (df < 0 ? lb[i] : 2.f);
                        p[4 * t2 + i] = acc[i] * dm; }
                } else {
                    const float tf = mt < w ? __builtin_amdgcn_exp2f((float)(16 * (w - mt)) * lgf2) : __builtin_amdgcn_exp2f((float)(16 * (mt - w)) * lgb2);
#pragma unroll
                    for (int i = 0; i < 4; ++i) p[4 * t2 + i] = acc[i] * ((mt < w ? lf[i] : lb[i]) * tf);
                } }
            u32x4 pk; pk.x = pg8::cvt_pk_bf16(p[0], p[1]); pk.y = pg8::cvt_pk_bf16(p[2], p[3]); pk.z = pg8::cvt_pk_bf16(p[4], p[5]); pk.w = pg8::cvt_pk_bf16(p[6], p[7]);
            const bf16x8 pb = __builtin_bit_cast(bf16x8, pk);
#pragma unroll
            for (int et = 0; et < 4; ++et) { const bf16x8 A = tr2(lds + VS + (32 * mp + 4 * quad + (fr >> 2)) * RT_P + (16 * et + 4 * (fr & 3)) * 2, 16 * RT_P);
                Y[et] = __builtin_amdgcn_mfma_f32_16x16x32_bf16(A, pb, Y[et], 0, 0, 0); }
        }
        const float xf = __builtin_amdgcn_exp2f((float)(nloc + 1) * lgf2), xb = __builtin_amdgcn_exp2f((float)(128 - nloc) * lgb2);
#pragma unroll
        for (int et = 0; et < 4; ++et) {
            f32x4 cf = (f32x4){0.f, 0.f, 0.f, 0.f}, cb = cf;
#pragma unroll
            for (int ks = 0; ks < 2; ++ks) { const int ro = (32 * ks + 8 * quad + (fr >> 2)) * RT_P + (16 * et + 4 * (fr & 3)) * 2;
                cf = __builtin_amdgcn_mfma_f32_16x16x32_bf16(tr2(lds + SF + ro, 4 * RT_P), qf[ks], cf, 0, 0, 0);
                cb = __builtin_amdgcn_mfma_f32_16x16x32_bf16(tr2(lds + SB + ro, 4 * RT_P), qf[ks], cb, 0, 0, 0); }
            Y[et] = Y[et] + cf * xf + cb * xb;
        }
        float s1 = 0.f;
#pragma unroll
        for (int et = 0; et < 4; ++et) s1 += (Y[et][0] + Y[et][1]) + (Y[et][2] + Y[et][3]);
        const float mu = xq_sum(s1) * (1.f / 64.f);
        float s2 = 0.f;
#pragma unroll
        for (int et = 0; et < 4; ++et)
#pragma unroll
            for (int i = 0; i < 4; ++i) { const float dd = Y[et][i] - mu; s2 += dd * dd; }
        const float rs = rsqrtf(xq_sum(s2) * (1.f / 64.f) + EPS);
        bf16* op = act + (size_t)row * D + NAW + h * 64 + 4 * quad;
#pragma unroll
        for (int et = 0; et < 4; ++et) { const ushort4 gv = gvp[et]; const f32x4 wv = wvp[et];
            const float o0 = (Y[et][0] - mu) * rs * wv.x * silu(bf2f(gv.x)), o1 = (Y[et][1] - mu) * rs * wv.y * silu(bf2f(gv.y)), o2 = (Y[et][2] - mu) * rs * wv.z * silu(bf2f(gv.z)), o3 = (Y[et][3] - mu) * rs * wv.w * silu(bf2f(gv.w));
            pg8::u32x2 o; o.x = pg8::cvt_pk_bf16(o0, o1); o.y = pg8::cvt_pk_bf16(o2, o3); *(pg8::u32x2*)(op + 16 * et) = o; }
    }
#undef R3_ISSUE
}
__device__ __forceinline__ void ph_topk1(const bf16* Q, const bf16* keysl, float* topv, int* topi, int nrows, bf16* sm) { const int tidx = otid();
    bf16 (*sk)[136] = (bf16 (*)[136])sm;
    const int nrt = nrows / NT;
    for (int vb = blockIdx.x; vb < nrt * 16; vb += gridDim.x) {
        const int hs = vb % 16, side = hs & 1, h = hs >> 1, row = (vb / 16) * NT + tidx;
        const bf16* kp = keysl + ((size_t)(side * PH + h) * PNK) * PKD;
        for (int i = tidx; i < 128 * 128; i += NT) sk[i / 128][i % 128] = kp[i];
        __syncthreads();
        float q[128];
        const bf16* qp = Q + (size_t)row * DQ + h * 256 + side * 128;
#pragma unroll
        for (int d = 0; d < 128; ++d) q[d] = bf2f(qp[d]);
        float tv[16]; int ti[16];
#pragma unroll
        for (int j = 0; j < 16; ++j) { tv[j] = -3e38f; ti[j] = 0; }
        for (int kk = 0; kk < 128; ++kk) {
            float s = 0.f;
#pragma unroll
            for (int d = 0; d < 128; ++d) s += q[d] * bf2f(sk[kk][d]);
            int si = kk;
#pragma unroll
            for (int j = 0; j < 16; ++j) { if (s > tv[j]) { const float tvv = tv[j]; const int tii = ti[j]; tv[j] = s; ti[j] = si; s = tvv; si = tii; } }
        }
        const size_t o = (((size_t)row * PH + h) * 2 + side) * 16;
#pragma unroll
        for (int j = 0; j < 16; ++j) { topv[o + j] = tv[j]; topi[o + j] = ti[j]; }
        __syncthreads();
    }
}
__device__ __forceinline__ void ph_topk2(const float* topv, const int* topi, int* idx, float* gate, int nrows) { const int tidx = otid();
    for (int gid = blockIdx.x * NT + tidx; gid < nrows * PH; gid += gridDim.x * NT) {
        const size_t o = (size_t)gid * 32;
        float vb[16];
#pragma unroll
        for (int j = 0; j < 16; ++j) vb[j] = topv[o + 16 + j];
        float tv[16]; int ti[16];
#pragma unroll
        for (int j = 0; j < 16; ++j) { tv[j] = -3e38f; ti[j] = 0; }
#pragma unroll 1
        for (int i = 0; i < 16; ++i) { const float vai = topv[o + i];
#pragma unroll
            for (int jb = 0; jb < 16; ++jb) { float s = vai + vb[jb]; int si = i * 16 + jb;
#pragma unroll
                for (int j = 0; j < 16; ++j) { if (s > tv[j]) { const float tvv = tv[j]; const int tii = ti[j]; tv[j] = s; ti[j] = si; s = tvv; si = tii; } } } }
        const float mx = tv[0]; float den = 0.f, p[16];
#pragma unroll
        for (int j = 0; j < 16; ++j) { p[j] = __expf(tv[j] - mx); den += p[j]; }
        const float inv = 1.f / den;
        const size_t oo = (size_t)gid * 16;
#pragma unroll
        for (int j = 0; j < 16; ++j) { const int ia = topi[o + (ti[j] >> 4)], ib = topi[o + 16 + (ti[j] & 15)]; idx[oo + j] = ia * PNK + ib; gate[oo + j] = p[j] * inv; }
    }
}


__device__ __forceinline__ void ins16(float (&L)[16], float v) {
#pragma unroll
    for (int j = 15; j >= 1; --j) L[j] = __builtin_amdgcn_fmed3f(L[j - 1], v, L[j]);
    L[0] = fmaxf(L[0], v);
}
__device__ __forceinline__ void bitonic_merge16(float (&L)[16], const float (&A)[16], const float (&B)[16]) {
#pragma unroll
    for (int j = 0; j < 16; ++j) L[j] = fmaxf(A[j], B[15 - j]);
#pragma unroll
    for (int st = 8; st >= 1; st >>= 1)
#pragma unroll
        for (int j = 0; j < 16; ++j) if ((j & st) == 0) { const float hi = fmaxf(L[j], L[j + st]), lo = fminf(L[j], L[j + st]); L[j] = hi; L[j + st] = lo; }
}
__device__ __forceinline__ void top16of32(float (&v)[32]) {
#define CE(i, j) { const float hi_ = fmaxf(v[i], v[j]), lo_ = fminf(v[i], v[j]); v[i] = hi_; v[j] = lo_; }
#define CMAX(i, j) { v[i] = fmaxf(v[i], v[j]); }
#define CMIN(i, j) { v[j] = fminf(v[i], v[j]); }
    CE(0,1) CE(2,3) CE(0,2) CE(1,3) CE(1,2) CE(4,5) CE(6,7) CE(4,6) CE(5,7) CE(5,6) CE(0,4) CE(2,6) CE(2,4) CE(1,5) CE(3,7) CE(3,5) CE(1,2) CE(3,4) CE(5,6) CE(8,9) CE(10,11) CE(8,10) CE(9,11) CE(9,10) CE(12,13) CE(14,15) CE(12,14) CE(13,15) CE(13,14) CE(8,12) CE(10,14) CE(10,12) CE(9,13) CE(11,15) CE(11,13) CE(9,10) CE(11,12) CE(13,14) CE(0,8) CE(4,12) CE(4,8) CE(2,10) CE(6,14) CE(6,10) CE(2,4) CE(6,8) CE(10,12) CE(1,9) CE(5,13) CE(5,9) CE(3,11) CE(7,15) CE(7,11) CE(3,5) CE(7,9) CE(11,13) CE(1,2) CE(3,4) CE(5,6) CE(7,8) CE(9,10) CE(11,12) CE(13,14) CE(16,17) CE(18,19) CE(16,18) CE(17,19) CE(17,18) CE(20,21) CE(22,23) CE(20,22) CE(21,23) CE(21,22) CE(16,20) CE(18,22) CE(18,20) CE(17,21) CE(19,23) CE(19,21) CE(17,18) CE(19,20) CE(21,22) CE(24,25) CE(26,27) CE(24,26) CE(25,27) CE(25,26) CE(28,29) CE(30,31) CE(28,30) CE(29,31) CE(29,30) CE(24,28) CE(26,30) CE(26,28) CE(25,29) CE(27,31) CE(27,29) CE(25,26) CE(27,28) CE(29,30) CE(16,24) CE(20,28) CE(20,24) CE(18,26) CE(22,30) CE(22,26) CE(18,20) CE(22,24) CE(26,28) CE(17,25) CE(21,29) CE(21,25) CE(19,27) CE(23,31) CE(23,27) CE(19,21) CE(23,25) CE(27,29) CE(17,18) CE(19,20) CE(21,22) CE(23,24) CE(25,26) CE(27,28) CE(29,30) CE(0,16) CMAX(8,24) CE(8,16) CE(4,20) CMAX(12,28) CMAX(12,20) CE(4,8) CE(12,16) CE(2,18) CMAX(10,26) CE(10,18) CE(6,22) CMAX(14,30) CMAX(14,22) CE(6,10) CMAX(14,18) CE(2,4) CE(6,8) CE(10,12) CE(14,16) CE(1,17) CMAX(9,25) CE(9,17) CE(5,21) CMAX(13,29) CMAX(13,21) CE(5,9) CE(13,17) CE(3,19) CMAX(11,27) CE(11,19) CE(7,23) CMAX(15,31) CMAX(15,23) CE(7,11) CMAX(15,19) CE(3,5) CE(7,9) CE(11,13) CMAX(15,17) CE(1,2) CE(3,4) CE(5,6) CE(7,8) CE(9,10) CE(11,12) CE(13,14) CMAX(15,16)
#undef CE
#undef CMAX
#undef CMIN
}
constexpr int TK_KROW = 272;
constexpr int TK_LIST = 2 * 128 * TK_KROW;
__device__ __forceinline__ void ph_tk_mfma(const bf16* Q, const bf16* keysl, int* idx, float* gate, int nrows, unsigned char* ldsg) { const int tidx = otid();
    const int lane = tidx & 63, w = __builtin_amdgcn_readfirstlane(tidx >> 6), fr = lane & 15, quad = lane >> 4;
    const lds_cp lds = (lds_cp)ldsg;
    unsigned* lists = (unsigned*)(ldsg + TK_LIST) + (w * 16 + fr) * 32;
    const int nunits = (nrows / 128) * PH;
    int hcur = -1;
    for (int u = blockIdx.x; u < nunits; u += gridDim.x) {
        const int h = u % PH, tile = u / PH;
        __syncthreads();
        if (h != hcur) {
            for (int i = tidx; i < 2 * 128 * 16; i += NT) { const int side = i >> 11, r = (i >> 4) & 127, pc = i & 15;
                *(u32x4*)(ldsg + (side * 128 + r) * TK_KROW + pc * 16) = *(const u32x4*)(keysl + ((size_t)(side * PH + h) * PNK + r) * PKD + pc * 8); }
            hcur = h;
        }
        __syncthreads();
        const int row = tile * 128 + 16 * w + fr;
        float Lb[16];
#pragma unroll
        for (int side = 0; side < 2; ++side) {
            bf16x8 qf[4];
#pragma unroll
            for (int s = 0; s < 4; ++s) qf[s] = *(const bf16x8*)(Q + (size_t)row * DQ + h * 256 + side * 128 + 32 * s + 8 * quad);
            float L[16];
            { float pv[32];
#pragma unroll
              for (int t = 0; t < 8; ++t) {
                f32x4 acc = (f32x4){0.f, 0.f, 0.f, 0.f};
#pragma unroll
                for (int s = 0; s < 4; ++s) { const bf16x8 kf = *(const __attribute__((address_space(3))) bf16x8*)(lds + (side * 128 + 16 * t + fr) * TK_KROW + 64 * s + 16 * quad);
                    acc = __builtin_amdgcn_mfma_f32_16x16x32_bf16(kf, qf[s], acc, 0, 0, 0); }
#pragma unroll
                for (int i = 0; i < 4; ++i) { const unsigned key = 16 * t + 4 * quad + i; pv[4 * t + i] = __uint_as_float((__float_as_uint(acc[i]) & ~0x7fu) | key); }
              }
              top16of32(pv);
#pragma unroll
              for (int j = 0; j < 16; ++j) L[j] = pv[j]; }
            { float A[16], B[16];
#pragma unroll
              for (int j = 0; j < 16; ++j) { auto s = __builtin_amdgcn_permlane16_swap(__float_as_uint(L[j]), __float_as_uint(L[j]), false, false); A[j] = __uint_as_float(s[0]); B[j] = __uint_as_float(s[1]); }
              bitonic_merge16(L, A, B);
#pragma unroll
              for (int j = 0; j < 16; ++j) { auto s = __builtin_amdgcn_permlane32_swap(__float_as_uint(L[j]), __float_as_uint(L[j]), false, false); A[j] = __uint_as_float(s[0]); B[j] = __uint_as_float(s[1]); }
              bitonic_merge16(L, A, B); }
            if (side == 0) {
                if (quad == 0) {
#pragma unroll
                    for (int j = 0; j < 16; ++j) lists[j] = __float_as_uint(L[j]); }
            } else {
#pragma unroll
                for (int j = 0; j < 16; ++j) Lb[j] = L[j];
                if (quad == 0) {
#pragma unroll
                    for (int j = 0; j < 16; ++j) lists[16 + j] = __float_as_uint(L[j]); }
            }
        }

        float C[16];
#pragma unroll
        for (int j = 0; j < 16; ++j) C[j] = -3.0e38f;
#pragma unroll
        for (int r = 0; r < 4; ++r) {
            const float vai = __uint_as_float(lists[4 * r + quad] & ~0x7fu);
            const int irow = 4 * r + quad, len = 16 / (irow + 1);
            constexpr int maxlen[4] = {16, 3, 1, 1};
#pragma unroll
            for (int j = 0; j < maxlen[r]; ++j) { const float s = vai + __uint_as_float(__float_as_uint(Lb[j]) & ~0x7fu);
                const float pkv = __uint_as_float((__float_as_uint(s) & ~0xffu) | (unsigned)(irow * 16 + j));
                ins16(C, j < len ? pkv : -3.0e38f); }
        }
        { float A[16], B[16];
#pragma unroll
          for (int j = 0; j < 16; ++j) { auto s = __builtin_amdgcn_permlane16_swap(__float_as_uint(C[j]), __float_as_uint(C[j]), false, false); A[j] = __uint_as_float(s[0]); B[j] = __uint_as_float(s[1]); }
          bitonic_merge16(C, A, B);
#pragma unroll
          for (int j = 0; j < 16; ++j) { auto s = __builtin_amdgcn_permlane32_swap(__float_as_uint(C[j]), __float_as_uint(C[j]), false, false); A[j] = __uint_as_float(s[0]); B[j] = __uint_as_float(s[1]); }
          bitonic_merge16(C, A, B); }
        const float mx = __uint_as_float(__float_as_uint(C[0]) & ~0xffu);
        float p[16], den = 0.f; int ex[16];
#pragma unroll
        for (int k = 0; k < 16; ++k) { const unsigned cb = __float_as_uint(C[k]); const float sv = __uint_as_float(cb & ~0xffu); p[k] = __expf(sv - mx); den += p[k];
            const unsigned ka = lists[(cb >> 4) & 15] & 0x7fu, kb = lists[16 + (cb & 15)] & 0x7fu; ex[k] = (int)(ka * PNK + kb); }
        const float inv = 1.f / den;
        if (quad == 0) {
            int* ip = idx + (size_t)row * 128 + h * 16; float* gp = gate + (size_t)row * 128 + h * 16;
#pragma unroll
            for (int k = 0; k < 16; k += 4) { *(int4*)(ip + k) = make_int4(ex[k], ex[k + 1], ex[k + 2], ex[k + 3]); *(f32x4*)(gp + k) = (f32x4){p[k] * inv, p[k + 1] * inv, p[k + 2] * inv, p[k + 3] * inv}; }
        }
    }
}
template <int B>
__device__ __forceinline__ void sort16at(float (&v)[64]) {
#define CE(i, j) { const float hi_ = fmaxf(v[B + i], v[B + j]), lo_ = fminf(v[B + i], v[B + j]); v[B + i] = hi_; v[B + j] = lo_; }
    CE(0,1) CE(2,3) CE(0,2) CE(1,3) CE(1,2) CE(4,5) CE(6,7) CE(4,6) CE(5,7) CE(5,6) CE(0,4) CE(2,6) CE(2,4) CE(1,5) CE(3,7) CE(3,5) CE(1,2) CE(3,4) CE(5,6) CE(8,9) CE(10,11) CE(8,10) CE(9,11) CE(9,10) CE(12,13) CE(14,15) CE(12,14) CE(13,15) CE(13,14) CE(8,12) CE(10,14) CE(10,12) CE(9,13) CE(11,15) CE(11,13) CE(9,10) CE(11,12) CE(13,14) CE(0,8) CE(4,12) CE(4,8) CE(2,10) CE(6,14) CE(6,10) CE(2,4) CE(6,8) CE(10,12) CE(1,9) CE(5,13) CE(5,9) CE(3,11) CE(7,15) CE(7,11) CE(3,5) CE(7,9) CE(11,13) CE(1,2) CE(3,4) CE(5,6) CE(7,8) CE(9,10) CE(11,12) CE(13,14)
#undef CE
}
__device__ __forceinline__ void top16of64(float (&v)[64], float (&L)[16]) {
    sort16at<0>(v); sort16at<16>(v); sort16at<32>(v); sort16at<48>(v);
    float A[16], Bv[16], M0[16], M1[16];
#pragma unroll
    for (int j = 0; j < 16; ++j) { A[j] = v[j]; Bv[j] = v[16 + j]; }
    bitonic_merge16(M0, A, Bv);
#pragma unroll
    for (int j = 0; j < 16; ++j) { A[j] = v[32 + j]; Bv[j] = v[48 + j]; }
    bitonic_merge16(M1, A, Bv);
    bitonic_merge16(L, M0, M1);
}
typedef float f32x16 __attribute__((ext_vector_type(16)));
__device__ __forceinline__ void ph_tk32(const bf16* Q, const bf16* keysl, int* idx, float* gate, int nrows, unsigned char* ldsg) { const int tidx = otid();
    const int lane = tidx & 63, w = __builtin_amdgcn_readfirstlane(tidx >> 6), r32 = lane & 31, hh = lane >> 5;
    const lds_cp lds = (lds_cp)ldsg;
    unsigned* lists = (unsigned*)(ldsg + TK_LIST) + (w * 32 + r32) * 32;
    const int nunits = (nrows / 256) * PH;
    int hcur = -1;
    for (int u = blockIdx.x; u < nunits; u += gridDim.x) {
        const int h = u % PH, tile = u / PH;
        __syncthreads();
        if (h != hcur) {
            for (int i = tidx; i < 2 * 128 * 16; i += NT) { const int side = i >> 11, r = (i >> 4) & 127, pc = i & 15;
                *(u32x4*)(ldsg + (side * 128 + r) * TK_KROW + pc * 16) = *(const u32x4*)(keysl + ((size_t)(side * PH + h) * PNK + r) * PKD + pc * 8); }
            hcur = h;
        }
        __syncthreads();
        const int row = tile * 256 + 32 * w + r32;
        float Lb[16];
#pragma unroll
        for (int side = 0; side < 2; ++side) {
            bf16x8 qf[8];
#pragma unroll
            for (int s = 0; s < 8; ++s) qf[s] = *(const bf16x8*)(Q + ((size_t)(((tile * 8 + w) * PH + h) * 2 + side)) * 4096 + s * 512 + hh * 256 + r32 * 8);
            float pv[64];
#pragma unroll
            for (int t = 0; t < 4; ++t) {
                f32x16 acc;
#pragma unroll
                for (int i = 0; i < 16; ++i) acc[i] = 0.f;
#pragma unroll
                for (int s = 0; s < 8; ++s) { const bf16x8 kf = *(const __attribute__((address_space(3))) bf16x8*)(lds + (side * 128 + 32 * t + r32) * TK_KROW + 32 * s + 16 * hh);
                    acc = __builtin_amdgcn_mfma_f32_32x32x16_bf16(kf, qf[s], acc, 0, 0, 0); }
#pragma unroll
                for (int i = 0; i < 16; ++i) { const unsigned key = 32 * t + (i & 3) + 8 * (i >> 2) + 4 * hh; pv[16 * t + i] = __uint_as_float((__float_as_uint(acc[i]) & ~0x7fu) | key); }
            }
            float L[16];
            top16of64(pv, L);
            { float A[16], B[16];
#pragma unroll
              for (int j = 0; j < 16; ++j) { auto s = __builtin_amdgcn_permlane32_swap(__float_as_uint(L[j]), __float_as_uint(L[j]), false, false); A[j] = __uint_as_float(s[0]); B[j] = __uint_as_float(s[1]); }
              bitonic_merge16(L, A, B); }
            if (side == 0) { if (hh == 0) {
#pragma unroll
                    for (int j = 0; j < 16; ++j) lists[j] = __float_as_uint(L[j]); } }
            else {
#pragma unroll
                for (int j = 0; j < 16; ++j) Lb[j] = L[j];
                if (hh == 0) {
#pragma unroll
                    for (int j = 0; j < 16; ++j) lists[16 + j] = __float_as_uint(L[j]); } }
        }
        float C[16];
#pragma unroll
        for (int j = 0; j < 16; ++j) C[j] = -3.0e38f;
#pragma unroll
        for (int r = 0; r < 8; ++r) {
            const float vai = __uint_as_float(lists[2 * r + hh] & ~0x7fu);
            const int irow = 2 * r + hh, len = 16 / (irow + 1);
            constexpr int maxlen[8] = {16, 5, 3, 2, 1, 1, 1, 1};
#pragma unroll
            for (int j = 0; j < maxlen[r]; ++j) { const float s = vai + __uint_as_float(__float_as_uint(Lb[j]) & ~0x7fu);
                const float pkv = __uint_as_float((__float_as_uint(s) & ~0xffu) | (unsigned)(irow * 16 + j));
                ins16(C, j < len ? pkv : -3.0e38f); }
        }
        { float A[16], B[16];
#pragma unroll
          for (int j = 0; j < 16; ++j) { auto s = __builtin_amdgcn_permlane32_swap(__float_as_uint(C[j]), __float_as_uint(C[j]), false, false); A[j] = __uint_as_float(s[0]); B[j] = __uint_as_float(s[1]); }
          bitonic_merge16(C, A, B); }
        const float mx = __uint_as_float(__float_as_uint(C[0]) & ~0xffu);
        float p[16], den = 0.f; int ex[16];
#pragma unroll
        for (int k = 0; k < 16; ++k) { const unsigned cb = __float_as_uint(C[k]); const float sv = __uint_as_float(cb & ~0xffu); p[k] = __expf(sv - mx); den += p[k];
            const unsigned ka = lists[(cb >> 4) & 15] & 0x7fu, kb = lists[16 + (cb & 15)] & 0x7fu; ex[k] = (int)(ka * PNK + kb); }
        const float inv = 1.f / den;
        if (hh == 0) {
            int* ip = idx + (size_t)row * 128 + h * 16; float* gp = gate + (size_t)row * 128 + h * 16;
#pragma unroll
            for (int k = 0; k < 16; k += 4) { *(int4*)(ip + k) = make_int4(ex[k], ex[k + 1], ex[k + 2], ex[k + 3]); *(f32x4*)(gp + k) = (f32x4){p[k] * inv, p[k + 1] * inv, p[k + 2] * inv, p[k + 3] * inv}; }
        }
    }
}
__device__ __forceinline__ float dot16(const float (&hx)[16], const bf16x8 a, const bf16x8 b) {
    float s = 0.f;
#pragma unroll
    for (int j = 0; j < 8; ++j) s += hx[j] * bf2f((bf16)a[j]) + hx[8 + j] * bf2f((bf16)b[j]);
    return s;
}
template <bool FINAL>
__device__ __forceinline__ void ph_peer(const bf16* act, const int* idx, const float* gate, const bf16* U, const bf16* V, const float* modl, int off_g,
                                        float* xlat, float* xctx, const float* fw, int nrows) { const int tidx = otid();
    const int lane = tidx & 63, wave = tidx >> 6;
    for (int row = blockIdx.x * 8 + wave; row < nrows; row += gridDim.x * 8) {
        float hx[16];
        { const bf16x8 a = *(const bf16x8*)(act + (size_t)row * D + lane * 8), b = *(const bf16x8*)(act + (size_t)row * D + 512 + lane * 8);
#pragma unroll
          for (int j = 0; j < 8; ++j) { hx[j] = bf2f((bf16)a[j]); hx[8 + j] = bf2f((bf16)b[j]); } }
        const int myi0 = idx[(size_t)row * 128 + lane], myi1 = idx[(size_t)row * 128 + 64 + lane];
        const float myg0 = gate[(size_t)row * 128 + lane], myg1 = gate[(size_t)row * 128 + 64 + lane];
        float a0 = 0.f, a1 = 0.f;
        for (int base = 0; base < 128; base += 8) {
            bf16x8 ua[8], ub[8];
#pragma unroll
            for (int j = 0; j < 8; ++j) { const int e = rl_i(base < 64 ? myi0 : myi1, (base + j) & 63); const bf16* up = U + (size_t)e * D; ua[j] = *(const bf16x8*)(up + lane * 8); ub[j] = *(const bf16x8*)(up + 512 + lane * 8); }
#pragma unroll
            for (int j = 0; j < 8; ++j) { const float s = wave_sum(dot16(hx, ua[j], ub[j])); if (lane == ((base + j) & 63)) { if (base < 64) a0 = s; else a1 = s; } }
        }
        const float w0 = myg0 * 0.5f * a0 * (1.f + erff(a0 * 0.70710678f)), w1 = myg1 * 0.5f * a1 * (1.f + erff(a1 * 0.70710678f));
        float out[16];
#pragma unroll
        for (int j = 0; j < 16; ++j) out[j] = 0.f;
        for (int base = 0; base < 128; base += 8) {
            bf16x8 va[8], vb[8];
#pragma unroll
            for (int j = 0; j < 8; ++j) { const int e = rl_i(base < 64 ? myi0 : myi1, (base + j) & 63); const bf16* vp = V + (size_t)e * D; va[j] = *(const bf16x8*)(vp + lane * 8); vb[j] = *(const bf16x8*)(vp + 512 + lane * 8); }
#pragma unroll
            for (int j = 0; j < 8; ++j) { const float w = rl_f(base < 64 ? w0 : w1, (base + j) & 63);
#pragma unroll
                for (int q = 0; q < 8; ++q) { out[q] += w * bf2f((bf16)va[j][q]); out[8 + q] += w * bf2f((bf16)vb[j][q]); } }
        }
        const int mi = row < M_LAT ? row / S : 4;
        float* xr = row < M_LAT ? xlat + (size_t)row * D : xctx + (size_t)(row - M_LAT) * D;
        const float* g2 = modl + (size_t)mi * 6 * D + off_g;
        float xn[16]; float ss = 0.f;
#pragma unroll
        for (int hlf = 0; hlf < 2; ++hlf) { const int k = hlf * 512 + lane * 8;
            const f32x4 x0 = *(const f32x4*)(xr + k), x1 = *(const f32x4*)(xr + k + 4), g0 = *(const f32x4*)(g2 + k), g1 = *(const f32x4*)(g2 + k + 4);
            xn[hlf * 8 + 0] = x0.x + g0.x * out[hlf * 8 + 0]; xn[hlf * 8 + 1] = x0.y + g0.y * out[hlf * 8 + 1]; xn[hlf * 8 + 2] = x0.z + g0.z * out[hlf * 8 + 2]; xn[hlf * 8 + 3] = x0.w + g0.w * out[hlf * 8 + 3];
            xn[hlf * 8 + 4] = x1.x + g1.x * out[hlf * 8 + 4]; xn[hlf * 8 + 5] = x1.y + g1.y * out[hlf * 8 + 5]; xn[hlf * 8 + 6] = x1.z + g1.z * out[hlf * 8 + 6]; xn[hlf * 8 + 7] = x1.w + g1.w * out[hlf * 8 + 7]; }
#pragma unroll
        for (int j = 0; j < 16; ++j) ss += xn[j] * xn[j];
        float rs = 1.f;
        if (FINAL) { ss = wave_sum(ss); rs = rsqrtf(ss * (1.f / D) + EPS); }
#pragma unroll
        for (int hlf = 0; hlf < 2; ++hlf) { const int k = hlf * 512 + lane * 8;
            f32x4 o0, o1;
            if (FINAL) { const f32x4 f0 = *(const f32x4*)(fw + k), f1 = *(const f32x4*)(fw + k + 4);
                o0 = (f32x4){xn[hlf * 8 + 0] * rs * f0.x, xn[hlf * 8 + 1] * rs * f0.y, xn[hlf * 8 + 2] * rs * f0.z, xn[hlf * 8 + 3] * rs * f0.w};
                o1 = (f32x4){xn[hlf * 8 + 4] * rs * f1.x, xn[hlf * 8 + 5] * rs * f1.y, xn[hlf * 8 + 6] * rs * f1.z, xn[hlf * 8 + 7] * rs * f1.w}; }
            else { o0 = (f32x4){xn[hlf * 8 + 0], xn[hlf * 8 + 1], xn[hlf * 8 + 2], xn[hlf * 8 + 3]}; o1 = (f32x4){xn[hlf * 8 + 4], xn[hlf * 8 + 5], xn[hlf * 8 + 6], xn[hlf * 8 + 7]}; }
            *(f32x4*)(xr + k) = o0; *(f32x4*)(xr + k + 4) = o1; }
    }
}


__device__ __forceinline__ void ph_quant(const float* src, unsigned char* dst, float* scl, int nrows, int offs  ) { const int tidx = otid();
    const int lane = tidx & 63, wave = tidx >> 6;
    for (int row0 = (blockIdx.x * 8 + wave) * 4; row0 < nrows; row0 += gridDim.x * 8 * 4) {
        f32x4 v[4][4];
#pragma unroll
        for (int r = 0; r < 4; ++r)
#pragma unroll
            for (int j = 0; j < 4; ++j) v[r][j] = *(const f32x4*)(src + (size_t)(row0 + r) * D + lane * 16 + 4 * j);
#pragma unroll
        for (int r = 0; r < 4; ++r) {
            float am = 0.f;
#pragma unroll
            for (int j = 0; j < 4; ++j) am = fmaxf(am, fmaxf(fmaxf(fabsf(v[r][j].x), fabsf(v[r][j].y)), fmaxf(fabsf(v[r][j].z), fabsf(v[r][j].w))));
            am = wave_max(am);
            const float sc = am > 0.f ? am * (1.f / 127.f) : 1.f, inv = 1.f / sc;
            u32x4 o;
#pragma unroll
            for (int j = 0; j < 4; ++j) { const int q0 = (int)rintf(v[r][j].x * inv) + offs, q1 = (int)rintf(v[r][j].y * inv) + offs, q2 = (int)rintf(v[r][j].z * inv) + offs, q3 = (int)rintf(v[r][j].w * inv) + offs;
                o[j] = (unsigned)(q0 & 0xff) | ((unsigned)(q1 & 0xff) << 8) | ((unsigned)(q2 & 0xff) << 16) | ((unsigned)(q3 & 0xff) << 24); }
            *(u32x4*)(dst + (size_t)(row0 + r) * D + lane * 16) = o;
            if (lane == 0) scl[row0 + r] = sc;
        }
    }
}
__device__ __forceinline__ void ph_quant_w(const bf16* src, unsigned char* dst, float* scl, int nrows) { const int tidx = otid();
    const int lane = tidx & 63, wave = tidx >> 6;
    for (int row0 = (blockIdx.x * 8 + wave) * 2; row0 < nrows; row0 += gridDim.x * 16) {
        bf16x8 a[2][2];
#pragma unroll
        for (int r = 0; r < 2; ++r) { a[r][0] = *(const bf16x8*)(src + (size_t)(row0 + r) * D + lane * 16); a[r][1] = *(const bf16x8*)(src + (size_t)(row0 + r) * D + lane * 16 + 8); }
#pragma unroll
        for (int r = 0; r < 2; ++r) { float f[16]; float am = 0.f;
#pragma unroll
            for (int j = 0; j < 8; ++j) { f[j] = bf2f((bf16)a[r][0][j]); f[8 + j] = bf2f((bf16)a[r][1][j]); am = fmaxf(am, fmaxf(fabsf(f[j]), fabsf(f[8 + j]))); }
            am = wave_max(am); const float sc = am > 0.f ? am * (1.f / 127.f) : 1.f, inv = 1.f / sc;
            u32x4 o;
#pragma unroll
            for (int j = 0; j < 4; ++j) { const int q0 = (int)rintf(f[4 * j] * inv), q1 = (int)rintf(f[4 * j + 1] * inv), q2 = (int)rintf(f[4 * j + 2] * inv), q3 = (int)rintf(f[4 * j + 3] * inv);
                o[j] = (unsigned)(q0 & 0xff) | ((unsigned)(q1 & 0xff) << 8) | ((unsigned)(q2 & 0xff) << 16) | ((unsigned)(q3 & 0xff) << 24); }
            *(u32x4*)(dst + (size_t)(row0 + r) * D + lane * 16) = o;
            if (lane == 0) scl[row0 + r] = sc; }
    }
}
__device__ __forceinline__ int xreduce64(int (&p)[64], int lane) {
#pragma unroll
    for (int k = 0; k < 32; ++k) { auto r = __builtin_amdgcn_permlane32_swap((unsigned)p[k], (unsigned)p[k + 32], false, false); p[k] = (int)(r[0] + r[1]); }
#pragma unroll
    for (int k = 0; k < 16; ++k) { auto r = __builtin_amdgcn_permlane16_swap((unsigned)p[k], (unsigned)p[k + 16], false, false); p[k] = (int)(r[0] + r[1]); }
#define XR_STEP(n, M) _Pragma("unroll") for (int k = 0; k < (n) / 2; ++k) { const bool up = (lane & (M)) != 0; const int send = up ? p[k] : p[k + (n) / 2], keep = up ? p[k + (n) / 2] : p[k]; \
        p[k] = keep + __builtin_amdgcn_ds_swizzle(send, ((M) << 10) | 0x1f); }
    XR_STEP(16, 8) XR_STEP(8, 4) XR_STEP(4, 2) XR_STEP(2, 1)
#undef XR_STEP
    return p[0];
}
template <int MODE  >
__device__ __forceinline__ void ph_peer8(bf16* act, const int* idx, const float* gate, const unsigned char* U8, const unsigned char* V8, const float* SU, const float* SV,
                                         const float* modl, int off_g, bf16* xlat, bf16* xctx, float* outf, const float* fw, const float* modn, int nrows) { const int tidx = otid();
    constexpr bool FINAL = (MODE == 2);
    const int lane = tidx & 63, wave = tidx >> 6;
    for (int row = blockIdx.x * 8 + wave; row < nrows; row += gridDim.x * 8) {
        int xq[4]; float sx;
        { const bf16x8 a = *(const bf16x8*)(act + (size_t)row * D + lane * 16), b = *(const bf16x8*)(act + (size_t)row * D + lane * 16 + 8);
          float hx[16]; float am = 0.f;
#pragma unroll
          for (int j = 0; j < 8; ++j) { hx[j] = bf2f((bf16)a[j]); hx[8 + j] = bf2f((bf16)b[j]); am = fmaxf(am, fmaxf(fabsf(hx[j]), fabsf(hx[8 + j]))); }
          am = wave_max(am); sx = am > 0.f ? am * (1.f / 127.f) : 1.f; const float inv = 1.f / sx;
#pragma unroll
          for (int j = 0; j < 4; ++j) { const int q0 = (int)rintf(hx[4 * j] * inv), q1 = (int)rintf(hx[4 * j + 1] * inv), q2 = (int)rintf(hx[4 * j + 2] * inv), q3 = (int)rintf(hx[4 * j + 3] * inv);
              xq[j] = (int)((unsigned)(q0 & 0xff) | ((unsigned)(q1 & 0xff) << 8) | ((unsigned)(q2 & 0xff) << 16) | ((unsigned)(q3 & 0xff) << 24)); } }
        const int myi0 = idx[(size_t)row * 128 + lane], myi1 = idx[(size_t)row * 128 + 64 + lane];
        const float myg0 = gate[(size_t)row * 128 + lane], myg1 = gate[(size_t)row * 128 + 64 + lane];
        const float su0 = SU[myi0], su1 = SU[myi1], sv0 = SV[myi0], sv1 = SV[myi1];
        float wgt[2];
#pragma unroll
        for (int hf = 0; hf < 2; ++hf) {
            int p[64];
#pragma unroll
            for (int base = 0; base < 64; base += 16) {
                u32x4 ub[16];
#pragma unroll
                for (int j = 0; j < 16; ++j) { const int e = rl_i(hf ? myi1 : myi0, base + j); ub[j] = *(const u32x4*)(U8 + (size_t)e * D + lane * 16); }
#pragma unroll
                for (int j = 0; j < 16; ++j) { int s = __builtin_amdgcn_sdot4((int)ub[j].x, xq[0], 0, false); s = __builtin_amdgcn_sdot4((int)ub[j].y, xq[1], s, false);
                    s = __builtin_amdgcn_sdot4((int)ub[j].z, xq[2], s, false); p[base + j] = __builtin_amdgcn_sdot4((int)ub[j].w, xq[3], s, false); }
            }
            const float a = (float)xreduce64(p, lane) * sx * (hf ? su1 : su0);
            wgt[hf] = (hf ? myg1 * sv1 : myg0 * sv0) * 0.5f * a * (1.f + erff(a * 0.70710678f));
        }
        float out[16];
#pragma unroll
        for (int j = 0; j < 16; ++j) out[j] = 0.f;
#pragma unroll 1
        for (int base = 0; base < 128; base += 16) {
            u32x4 vb[16];
#pragma unroll
            for (int j = 0; j < 16; ++j) { const int e = rl_i(base < 64 ? myi0 : myi1, (base + j) & 63); vb[j] = *(const u32x4*)(V8 + (size_t)e * D + lane * 16); }
#pragma unroll
            for (int j = 0; j < 16; ++j) { const float wv = rl_f(base < 64 ? wgt[0] : wgt[1], (base + j) & 63);
#pragma unroll
                for (int q = 0; q < 4; ++q) { const unsigned dw = vb[j][q];
                    out[4 * q + 0] += wv * (float)((int)(dw << 24) >> 24); out[4 * q + 1] += wv * (float)((int)(dw << 16) >> 24); out[4 * q + 2] += wv * (float)((int)(dw << 8) >> 24); out[4 * q + 3] += wv * (float)((int)dw >> 24); } }
        }
        const int mi = row < M_LAT ? row / S : 4;
        bf16* xr = (row < M_LAT ? xlat + (size_t)row * D : xctx + (size_t)(row - M_LAT) * D) + lane * 16;
        const float* g2 = modl + (size_t)mi * 6 * D + off_g + lane * 16;
        float xn[16]; float ss = 0.f;
#pragma unroll
        for (int q = 0; q < 4; ++q) { const f32x4 x0 = ld4res<true>(xr, 4 * q), g0 = *(const f32x4*)(g2 + 4 * q);
            xn[4 * q + 0] = bf2f(f2bf(x0.x + g0.x * out[4 * q + 0])); xn[4 * q + 1] = bf2f(f2bf(x0.y + g0.y * out[4 * q + 1]));
            xn[4 * q + 2] = bf2f(f2bf(x0.z + g0.z * out[4 * q + 2])); xn[4 * q + 3] = bf2f(f2bf(x0.w + g0.w * out[4 * q + 3])); }
#pragma unroll
        for (int j = 0; j < 16; ++j) ss += xn[j] * xn[j];
        float rs = 1.f;
        if (MODE != 0) { ss = wave_sum(ss); rs = rsqrtf(ss * (1.f / D) + EPS); }
#pragma unroll
        for (int q = 0; q < 4; ++q) {
            if (FINAL) { const f32x4 f0 = *(const f32x4*)(fw + lane * 16 + 4 * q); *(f32x4*)(outf + (size_t)row * D + lane * 16 + 4 * q) = (f32x4){xn[4 * q] * rs * f0.x, xn[4 * q + 1] * rs * f0.y, xn[4 * q + 2] * rs * f0.z, xn[4 * q + 3] * rs * f0.w}; }
            else st4res(xr, 4 * q, (f32x4){xn[4 * q], xn[4 * q + 1], xn[4 * q + 2], xn[4 * q + 3]}); }
        if (MODE == 1) {
            const float* sh = modn + (size_t)mi * 6 * D + lane * 16; const float* sc = sh + D; const float* nw = fw + lane * 16;
            u32x4 o0, o1; unsigned pk[8];
#pragma unroll
            for (int q = 0; q < 4; ++q) { const f32x4 w4 = *(const f32x4*)(nw + 4 * q), a4 = *(const f32x4*)(sc + 4 * q), b4 = *(const f32x4*)(sh + 4 * q);
                pk[2 * q] = pg8::cvt_pk_bf16(xn[4 * q] * rs * w4.x * (1.f + a4.x) + b4.x, xn[4 * q + 1] * rs * w4.y * (1.f + a4.y) + b4.y);
                pk[2 * q + 1] = pg8::cvt_pk_bf16(xn[4 * q + 2] * rs * w4.z * (1.f + a4.z) + b4.z, xn[4 * q + 3] * rs * w4.w * (1.f + a4.w) + b4.w); }
            o0 = (u32x4){pk[0], pk[1], pk[2], pk[3]}; o1 = (u32x4){pk[4], pk[5], pk[6], pk[7]};
            *(u32x4*)(act + (size_t)row * D + lane * 16) = o0; *(u32x4*)(act + (size_t)row * D + lane * 16 + 8) = o1;
        }
    }
}

constexpr int PSA_ENT_MAX = 512;
constexpr int PSA_XQ = 0, PSA_ENT = 135168, PSA_ENT_BYTES = 2048, PSA_SX = PSA_ENT + 8 * PSA_ENT_BYTES;
constexpr int PSA_HIST = 152576, PSA_WTOT = PSA_HIST + 8192, PSA_SORT_MAX = 4096;
static_assert(PSA_SX + 132 * 4 <= PSA_HIST && PSA_WTOT + 64 <= LDS_BYTES - 64, "sweep A LDS map");
constexpr int PSB_IDX = 0, PSB_WQ = 33792, PSB_SW = PSB_WQ + 132 * 128, PSB_SS = PSB_SW + 1024;
#ifndef PEER_NSLAB
#define PEER_NSLAB 8
#endif
#ifndef PEER_PSH
static_assert(true, "");
#define PEER_SORTA 1
#define PEER_PSH 11
#endif
__device__ __forceinline__ int reduce32i(int (&p)[32], int lane) {
#pragma unroll
    for (int k = 0; k < 16; ++k) { auto r = __builtin_amdgcn_permlane32_swap((unsigned)p[k], (unsigned)p[k + 16], false, false); p[k] = (int)(r[0] + r[1]); }
#pragma unroll
    for (int k = 0; k < 8; ++k) { auto r = __builtin_amdgcn_permlane16_swap((unsigned)p[k], (unsigned)p[k + 8], false, false); p[k] = (int)(r[0] + r[1]); }
    { const bool up = (lane & 8) != 0;
#pragma unroll
      for (int k = 0; k < 4; ++k) { const int send = up ? p[k] : p[k + 4], keep = up ? p[k + 4] : p[k]; p[k] = keep + __builtin_amdgcn_ds_swizzle(send, (8 << 10) | 0x1f); } }
    { const bool up = (lane & 4) != 0;
#pragma unroll
      for (int k = 0; k < 2; ++k) { const int send = up ? p[k] : p[k + 2], keep = up ? p[k + 2] : p[k]; p[k] = keep + __builtin_amdgcn_ds_swizzle(send, (4 << 10) | 0x1f); } }
    { const bool up = (lane & 2) != 0; const int send = up ? p[0] : p[1], keep = up ? p[1] : p[0]; p[0] = keep + __builtin_amdgcn_ds_swizzle(send, (2 << 10) | 0x1f); }
    p[0] += __builtin_amdgcn_ds_swizzle(p[0], (1 << 10) | 0x1f);
    return p[0];
}
template <int LPS>
__device__ __forceinline__ void reduce16r(int (&p)[16], int lane) {
#pragma unroll
    for (int k = 0; k < 8; ++k) { auto r = __builtin_amdgcn_permlane32_swap((unsigned)p[k], (unsigned)p[k + 8], false, false); p[k] = (int)(r[0] + r[1]); }
#pragma unroll
    for (int k = 0; k < 4; ++k) { auto r = __builtin_amdgcn_permlane16_swap((unsigned)p[k], (unsigned)p[k + 4], false, false); p[k] = (int)(r[0] + r[1]); }
    { const bool up = (lane & 8) != 0;
#pragma unroll
      for (int k = 0; k < 2; ++k) { const int send = up ? p[k] : p[k + 2], keep = up ? p[k + 2] : p[k]; p[k] = keep + __builtin_amdgcn_ds_swizzle(send, (8 << 10) | 0x1f); } }
    if (LPS == 4) { const bool up = (lane & 4) != 0; const int send = up ? p[0] : p[1], keep = up ? p[1] : p[0]; p[0] = keep + __builtin_amdgcn_ds_swizzle(send, (4 << 10) | 0x1f); }
}
template <int MODE  >
__device__ __forceinline__ void ph_peer_sweep(const int* idx, const float* gate, const unsigned char* U8, const unsigned char* V8, const float* SU, const float* SV, const unsigned char* XQ, const float* XS,
                                              float* AW  , const float* modl, int off_g, bf16* xlat, bf16* xctx, float* outf  , const float* nw, const float* modn, unsigned char* xqo, float* xso, int nrows, unsigned char* ldsg) { const int tidx = otid();
    const int lane = tidx & 63, wave = __builtin_amdgcn_readfirstlane(tidx >> 6);
    const int TPW = nrows / (int)gridDim.x, row0 = (int)blockIdx.x * TPW;
    const int J = (TPW - wave + 7) / 8;
    __syncthreads();
    unsigned* ent = (unsigned*)(ldsg + PSA_ENT + wave * PSA_ENT_BYTES); float* sxs = (float*)(ldsg + PSA_SX);
    for (int j = 0; j < J; ++j) { const int tl = wave + 8 * j; *(u32x4*)(ldsg + PSA_XQ + tl * 1024 + lane * 16) = *(const u32x4*)(XQ + (size_t)(row0 + tl) * D + lane * 16); if (lane == 0) sxs[tl] = XS[row0 + tl]; }
    unsigned iab[17];
#pragma unroll
    for (int j = 0; j < 17; ++j) { if (j < J) { const size_t r = (size_t)(row0 + wave + 8 * j) * 128; iab[j] = (unsigned)idx[r + lane] | ((unsigned)idx[r + 64 + lane] << 16); } else iab[j] = 0xffffffffu; }
#if PEER_SORTA
    unsigned* hist = (unsigned*)(ldsg + PSA_HIST); unsigned* srt = (unsigned*)(ldsg + PSA_ENT); unsigned* wtot = (unsigned*)(ldsg + PSA_WTOT);
    ((u32x4*)hist)[tidx] = (u32x4){0u, 0u, 0u, 0u};
    __syncthreads();
#endif
#define IA(j) ((int)(iab[j] & 0xffffu))
#define IB(j) ((int)(iab[j] >> 16))
#pragma unroll 1
    for (int p = 0; p < (NEXP >> PEER_PSH); ++p) {
        const unsigned* lst = ent; int n = 0, cstart = 0, cstride = 32, nov = 0;
#pragma unroll
        for (int j = 0; j < 17; ++j) asm volatile("" : "+v"(iab[j]));
        unsigned lane_o = (unsigned)lane; asm volatile("" : "+v"(lane_o));
#if PEER_SORTA
#pragma unroll
        for (int j = 0; j < 17; ++j) {
            if ((IA(j) >> PEER_PSH) == p) atomicAdd(&hist[IA(j) & 2047], 1u);
            if ((IB(j) >> PEER_PSH) == p) atomicAdd(&hist[IB(j) & 2047], 1u);
        }
        __syncthreads();
        const u32x4 hh4 = ((const u32x4*)hist)[tidx];
        const unsigned hs = hh4.x + hh4.y + hh4.z + hh4.w; unsigned inc = hs;
#pragma unroll
        for (int d = 1; d < 64; d <<= 1) { const unsigned t = (unsigned)__shfl_up((int)inc, d); if (lane >= d) inc += t; }
        if (lane == 63) wtot[wave] = inc;
        __syncthreads();
        unsigned wbase = 0, NS = 0;
#pragma unroll
        for (int w2 = 0; w2 < 8; ++w2) { const unsigned t = wtot[w2]; NS += t; if (w2 < wave) wbase += t; }
        NS = (unsigned)__builtin_amdgcn_readfirstlane((int)NS); wbase = (unsigned)__builtin_amdgcn_readfirstlane((int)wbase);
        { const unsigned ex = wbase + inc - hs; u32x4 o; o.x = ex; o.y = ex + hh4.x; o.z = o.y + hh4.y; o.w = o.z + hh4.z; ((u32x4*)hist)[tidx] = o; }
        __syncthreads();
        if (NS <= (unsigned)PSA_SORT_MAX) {
#pragma unroll
            for (int j = 0; j < 17; ++j) {
                if ((IA(j) >> PEER_PSH) == p) { const unsigned pos = atomicAdd(&hist[IA(j) & 2047], 1u); srt[pos] = (unsigned)IA(j) | (lane_o << 14) | ((unsigned)(wave + 8 * j) << 21); }
                if ((IB(j) >> PEER_PSH) == p) { const unsigned pos = atomicAdd(&hist[IB(j) & 2047], 1u); srt[pos] = (unsigned)IB(j) | ((64u + lane_o) << 14) | ((unsigned)(wave + 8 * j) << 21); }
            }
            __syncthreads();
            ((u32x4*)hist)[tidx] = (u32x4){0u, 0u, 0u, 0u};
            lst = srt; n = (int)NS; cstart = wave * 32; cstride = 256;
        } else {
        ((u32x4*)hist)[tidx] = (u32x4){0u, 0u, 0u, 0u};
#endif
#pragma unroll
        for (int j = 0; j < 17; ++j) {
            const bool in0 = (IA(j) >> PEER_PSH) == p, in1 = (IB(j) >> PEER_PSH) == p;
            const unsigned long long m0 = __ballot(in0), m1 = __ballot(in1);
            const int c0 = __popcll(m0), c1 = __popcll(m1);
            const int r0 = n + (int)__builtin_amdgcn_mbcnt_hi((unsigned)(m0 >> 32), __builtin_amdgcn_mbcnt_lo((unsigned)m0, 0u));
            const int r1 = n + c0 + (int)__builtin_amdgcn_mbcnt_hi((unsigned)(m1 >> 32), __builtin_amdgcn_mbcnt_lo((unsigned)m1, 0u));
            if (in0 && r0 < PSA_ENT_MAX) ent[r0] = (unsigned)IA(j) | (lane_o << 14) | ((unsigned)(wave + 8 * j) << 21);
            if (in1 && r1 < PSA_ENT_MAX) ent[r1] = (unsigned)IB(j) | ((64u + lane_o) << 14) | ((unsigned)(wave + 8 * j) << 21);
            n += c0 + c1;
        }
        nov = n;
        n = min(n, PSA_ENT_MAX);
#if PEER_SORTA
        }
#endif
        {
#pragma unroll 1
            for (int base = cstart; base < n; base += cstride) {
                const unsigned myent = lst[min(base + (lane & 31), n - 1)];
                u32x4 ub[32];
#pragma unroll
                for (int q = 0; q < 32; ++q) { const unsigned ej = (unsigned)rl_i((int)myent, q); ub[q] = *(const u32x4*)(U8 + (size_t)(ej & 0x3fffu) * D + lane * 16); }
                int ps[32];
#pragma unroll
                for (int q = 0; q < 32; ++q) { const int tq = (int)((unsigned)rl_i((int)myent, q) >> 21); const u32x4 xv = *(const u32x4*)(ldsg + PSA_XQ + tq * 1024 + lane * 16);
                    int s = __builtin_amdgcn_sdot4((int)ub[q].x, (int)xv.x, 0, false); s = __builtin_amdgcn_sdot4((int)ub[q].y, (int)xv.y, s, false);
                    s = __builtin_amdgcn_sdot4((int)ub[q].z, (int)xv.z, s, false); ps[q] = __builtin_amdgcn_sdot4((int)ub[q].w, (int)xv.w, s, false); }
                const int tot = reduce32i(ps, lane);
                const int slot = lane >> 1;
                if ((lane & 1) == 0 && base + slot < n) { const unsigned en = lst[base + slot]; const int tl = (int)(en >> 21), pos = (int)((en >> 14) & 127u);
                    AW[(size_t)(row0 + tl) * 128 + pos] = (float)tot * sxs[tl]; }
            }
        }
        if (nov > PSA_ENT_MAX) {
            int cnt = 0;
#pragma unroll 1
            for (int j = 0; j < J; ++j) { const size_t r = (size_t)(row0 + wave + 8 * j) * 128;
#pragma unroll 1
                for (int pos = 0; pos < 128; ++pos) { const int e = idx[r + pos];
                    if ((e >> PEER_PSH) == p) { if (cnt >= PSA_ENT_MAX) { const u32x4 uv = *(const u32x4*)(U8 + (size_t)e * D + lane * 16), xv = *(const u32x4*)(ldsg + PSA_XQ + (wave + 8 * j) * 1024 + lane * 16);
                            int s = __builtin_amdgcn_sdot4((int)uv.x, (int)xv.x, 0, false); s = __builtin_amdgcn_sdot4((int)uv.y, (int)xv.y, s, false); s = __builtin_amdgcn_sdot4((int)uv.z, (int)xv.z, s, false); s = __builtin_amdgcn_sdot4((int)uv.w, (int)xv.w, s, false);
                            const float a = wave_sum((float)s); if (lane == 0) AW[r + pos] = a * sxs[wave + 8 * j]; }
                        ++cnt; } } }
        }
        __syncthreads();
    }
    unsigned short* idxs = (unsigned short*)(ldsg + PSB_IDX); unsigned char* wqb = ldsg + PSB_WQ; float* sws = (float*)(ldsg + PSB_SW); float* ssl = (float*)(ldsg + PSB_SS);
    constexpr int LPS = 64 / PEER_NSLAB, RR = 64 / LPS, NK = 128 / RR, NG = NK / 4;
#pragma unroll
    for (int jb = 0; jb < 18; jb += 3) {
        float aw0[3], aw1[3], g0[3], g1[3], su0[3], su1[3], sv0[3], sv1[3];
#pragma unroll
        for (int q = 0; q < 3; ++q) { const int j = jb + q; if (j < 17 && j < J) { const size_t r = (size_t)(row0 + wave + 8 * j) * 128;
            aw0[q] = AW[r + lane]; aw1[q] = AW[r + 64 + lane]; g0[q] = gate[r + lane]; g1[q] = gate[r + 64 + lane];
            su0[q] = SU[IA(j)]; su1[q] = SU[IB(j)]; sv0[q] = SV[IA(j)]; sv1[q] = SV[IB(j)]; } }
#pragma unroll
        for (int q = 0; q < 3; ++q) { const int j = jb + q; if (j < 17 && j < J) { const int tl = wave + 8 * j;
            const float a0 = aw0[q] * su0[q], a1 = aw1[q] * su1[q];
            const float w0 = g0[q] * sv0[q] * 0.5f * a0 * (1.f + erff(a0 * 0.70710678f)), w1 = g1[q] * sv1[q] * 0.5f * a1 * (1.f + erff(a1 * 0.70710678f));
            const float wm = wave_max(fmaxf(fabsf(w0), fabsf(w1))); const float sw = wm > 0.f ? wm * (1.f / 127.f) : 1.f, inv = 1.f / sw;
            const int q0 = (int)rintf(w0 * inv), q1 = (int)rintf(w1 * inv);
            { const int pos = lane, k = pos / RR, rr = pos % RR; wqb[tl * 128 + ((k >> 2) * RR + rr) * 4 + (k & 3)] = (unsigned char)(q0 & 0xff); }
            { const int pos = 64 + lane, k = pos / RR, rr = pos % RR; wqb[tl * 128 + ((k >> 2) * RR + rr) * 4 + (k & 3)] = (unsigned char)(q1 & 0xff); }
            idxs[tl * 128 + lane] = (unsigned short)IA(j); idxs[tl * 128 + 64 + lane] = (unsigned short)IB(j);
            if (lane == 0) sws[tl] = sw; ssl[tl * 64 + lane] = 0.f; } }
    }
    __syncthreads();
    const int rr = lane / LPS, cc = lane % LPS;
    constexpr int NREPB = ((DUP_MASK >> 10) & 1) ? 2 : 1; constexpr float WSC = 1.f / NREPB;
    constexpr int TB = (NK == 8) ? 4 : 2;
    for (int repB = 0; repB < NREPB; ++repB)
#pragma unroll 1
    for (int s = 0; s < PEER_NSLAB; ++s) {
#pragma unroll 1
        for (int jg = 0; jg < J; jg += TB) {
            u32x4 vb[TB][NK];
#pragma unroll
            for (int q = 0; q < TB; ++q) if (jg + q < J) { const int tl = wave + 8 * (jg + q);
#pragma unroll
                for (int k = 0; k < NK; ++k) { const int e = idxs[tl * 128 + RR * k + rr]; vb[q][k] = *(const u32x4*)(V8 + (size_t)e * D + s * (LPS * 16) + cc * 16); } }
#pragma unroll
            for (int q = 0; q < TB; ++q) if (jg + q < J) { const int tl = wave + 8 * (jg + q), row = row0 + tl;
                int acc[16];
#pragma unroll
                for (int c = 0; c < 16; ++c) acc[c] = 0;
#pragma unroll
                for (int gq = 0; gq < NG; ++gq) { const int wq = *(const int*)(wqb + tl * 128 + (gq * RR + rr) * 4);
#pragma unroll
                    for (int d4 = 0; d4 < 4; ++d4) { const unsigned a = vb[q][4 * gq][d4], b = vb[q][4 * gq + 1][d4], c = vb[q][4 * gq + 2][d4], d = vb[q][4 * gq + 3][d4];
                        const unsigned x0 = __builtin_amdgcn_perm(b, a, 0x05010400u), x1 = __builtin_amdgcn_perm(b, a, 0x07030602u), y0 = __builtin_amdgcn_perm(d, c, 0x05010400u), y1 = __builtin_amdgcn_perm(d, c, 0x07030602u);
                        acc[4 * d4 + 0] = __builtin_amdgcn_sdot4((int)__builtin_amdgcn_perm(y0, x0, 0x05040100u), wq, acc[4 * d4 + 0], false);
                        acc[4 * d4 + 1] = __builtin_amdgcn_sdot4((int)__builtin_amdgcn_perm(y0, x0, 0x07060302u), wq, acc[4 * d4 + 1], false);
                        acc[4 * d4 + 2] = __builtin_amdgcn_sdot4((int)__builtin_amdgcn_perm(y1, x1, 0x05040100u), wq, acc[4 * d4 + 2], false);
                        acc[4 * d4 + 3] = __builtin_amdgcn_sdot4((int)__builtin_amdgcn_perm(y1, x1, 0x07060302u), wq, acc[4 * d4 + 3], false); } }
                reduce16r<LPS>(acc, lane);
                const float sc = sws[tl] * WSC;
                const int mi = row < M_LAT ? row / S : 4;
                bf16* xrow = row < M_LAT ? xlat + (size_t)row * D : xctx + (size_t)(row - M_LAT) * D;
                const float* g2 = modl + (size_t)mi * 6 * D + off_g;
                if (LPS == 4) { const int col = s * 64 + cc * 16 + rr; const bf16 vb = f2bf(bf2f(xrow[col]) + g2[col] * ((float)acc[0] * sc)); xrow[col] = vb; const float v0 = bf2f(vb); if (repB == NREPB - 1) ssl[tl * 64 + lane] += v0 * v0; }
                else { const int col = s * 128 + cc * 16 + 2 * rr; const unsigned xb = *(const unsigned*)(xrow + col); const float2 gg = *(const float2*)(g2 + col);
                    const unsigned ob = pg8::cvt_pk_bf16(__uint_as_float(xb << 16) + gg.x * ((float)acc[0] * sc), __uint_as_float(xb & 0xffff0000u) + gg.y * ((float)acc[1] * sc));
                    *(unsigned*)(xrow + col) = ob; const float v0 = __uint_as_float(ob << 16), v1 = __uint_as_float(ob & 0xffff0000u);
                    if (repB == NREPB - 1) ssl[tl * 64 + lane] += v0 * v0 + v1 * v1; }
            }
        }
        __syncthreads();
    }
    asm volatile("s_waitcnt vmcnt(0)" ::: "memory");
    __builtin_amdgcn_fence(__ATOMIC_ACQUIRE, "agent");
    asm volatile("s_waitcnt vmcnt(0)" ::: "memory");
#pragma unroll 1
    for (int j0 = 0; j0 < J; j0 += 2) {
        f32x4 v[2][4];
#pragma unroll
        for (int t = 0; t < 2; ++t) if (j0 + t < J) { const int row = row0 + wave + 8 * (j0 + t); const bf16* xrow = row < M_LAT ? xlat + (size_t)row * D : xctx + (size_t)(row - M_LAT) * D;
#pragma unroll
            for (int q = 0; q < 4; ++q) v[t][q] = ld4res<true>(xrow, (size_t)(lane + 64 * q) * 4); }
#pragma unroll
        for (int t = 0; t < 2; ++t) if (j0 + t < J) { const int tl = wave + 8 * (j0 + t), row = row0 + tl; const int mi = row < M_LAT ? row / S : 4;
            float* xrow = outf + (size_t)row * D;
            const float rs = rsqrtf(wave_sum(ssl[tl * 64 + lane]) * (1.f / D) + EPS);
            float am = 0.f;
#pragma unroll
            for (int q = 0; q < 4; ++q) { const int k = (lane + 64 * q) * 4; const f32x4 w = *(const f32x4*)(nw + k);
                if (MODE == 2) { f32x4 o; o.x = v[t][q].x * rs * w.x; o.y = v[t][q].y * rs * w.y; o.z = v[t][q].z * rs * w.z; o.w = v[t][q].w * rs * w.w; ((f32x4*)xrow)[lane + 64 * q] = o; }
                else { const f32x4 b = *(const f32x4*)(modn + (size_t)mi * 6 * D + k), a = *(const f32x4*)(modn + (size_t)mi * 6 * D + D + k);
                    v[t][q].x = v[t][q].x * rs * w.x * (1.f + a.x) + b.x; v[t][q].y = v[t][q].y * rs * w.y * (1.f + a.y) + b.y; v[t][q].z = v[t][q].z * rs * w.z * (1.f + a.z) + b.z; v[t][q].w = v[t][q].w * rs * w.w * (1.f + a.w) + b.w;
                    am = fmaxf(am, fmaxf(fmaxf(fabsf(v[t][q].x), fabsf(v[t][q].y)), fmaxf(fabsf(v[t][q].z), fabsf(v[t][q].w)))); } }
            if (MODE == 1) {
                am = wave_max(am); const float sx = am > 0.f ? am * (1.f / 127.f) : 1.f, inv = 1.f / sx;
#pragma unroll
                for (int q = 0; q < 4; ++q) { const int q0 = (int)rintf(v[t][q].x * inv), q1 = (int)rintf(v[t][q].y * inv), q2 = (int)rintf(v[t][q].z * inv), q3 = (int)rintf(v[t][q].w * inv);
                    *(unsigned*)(xqo + (size_t)row * D + (lane + 64 * q) * 4) = (unsigned)(q0 & 0xff) | ((unsigned)(q1 & 0xff) << 8) | ((unsigned)(q2 & 0xff) << 16) | ((unsigned)(q3 & 0xff) << 24); }
                if (lane == 0) xso[row] = sx; }
        }
    }
}
__device__ __forceinline__ void ph_final_norm(float* x, const float* fw, int nrows) { const int tidx = otid();
    const int lane = tidx & 63, wave = tidx >> 6;
    for (int row0 = (blockIdx.x * 8 + wave) * 2; row0 < nrows; row0 += gridDim.x * 16) {
        f32x4 v[2][4];
#pragma unroll
        for (int r = 0; r < 2; ++r)
#pragma unroll
            for (int j = 0; j < 4; ++j) v[r][j] = ((const f32x4*)(x + (size_t)(row0 + r) * D))[lane + 64 * j];
#pragma unroll
        for (int r = 0; r < 2; ++r) { float ss = 0.f;
#pragma unroll
            for (int j = 0; j < 4; ++j) ss += v[r][j].x * v[r][j].x + v[r][j].y * v[r][j].y + v[r][j].z * v[r][j].z + v[r][j].w * v[r][j].w;
            ss = wave_sum(ss); const float rs = rsqrtf(ss * (1.f / D) + EPS);
#pragma unroll
            for (int j = 0; j < 4; ++j) { const f32x4 w = *(const f32x4*)(fw + (lane + 64 * j) * 4); f32x4 o = v[r][j] * rs; o.x *= w.x; o.y *= w.y; o.z *= w.z; o.w *= w.w; ((f32x4*)(x + (size_t)(row0 + r) * D))[lane + 64 * j] = o; } }
    }
}
#define DEFINE_PTRS \
    const float* x = p.in[0]; const float* c = p.in[1]; const float* ctx = p.in[2]; const float* c_ctx = p.in[3]; \
    const float* norm1_w = p.in[4]; const float* norm2_w = p.in[5]; const float* w_ada = p.in[6]; const float* b_ada = p.in[7]; \
    const float* w_in = p.in[8]; const float* w_out = p.in[9]; const float* na_rpb = p.in[10]; \
    const float* dec_f = p.in[11]; const float* dec_b = p.in[12]; const float* gn_w = p.in[13]; \
    const float* pool_w = p.in[14]; const float* pool_scale = p.in[15]; const float* peer_wq = p.in[16]; \
    const float* peer_keys = p.in[17]; const float* peer_u = p.in[18]; const float* peer_v = p.in[19]; const float* final_w = p.in[20]; \
    unsigned char* ws = p.ws; float* out = p.out; \
    float* MOD = (float*)(ws + WS_MOD); float* cosT = (float*)(ws + WS_ROPE); float* sinT = cosT + S * 32; \
    bf16* WI = (bf16*)(ws + WS_WI); bf16* WO = (bf16*)(ws + WS_WO); bf16* WQ = (bf16*)(ws + WS_WQ); bf16* KEYS = (bf16*)(ws + WS_KEYS); \
    bf16* XR = (bf16*)(ws + WS_XR); bf16* XRC = (bf16*)(ws + WS_XRC); bf16* U = (bf16*)(ws + WS_U); bf16* V = (bf16*)(ws + WS_V); bf16* ACT = (bf16*)(ws + WS_ACT); \
    bf16* PX = (bf16*)(ws + WS_PX); bf16* Q = PX; float* ST = (float*)(ws + WS_ST); bf16* STB = (bf16*)(ws + WS_ST); int* IDX = (int*)(ws + WS_IDX); float* GATE = (float*)(ws + WS_GATE); \
    float* TOPV = (float*)(ws + WS_TOPV); int* TOPI = (int*)(ws + WS_TOPI); \
    float* AW = (float*)(ws + WS_AW); (void)AW; \
    unsigned char* WI8 = ws + WS_WI8; unsigned char* WQ8 = ws + WS_WQ8; float* SWI = (float*)(ws + WS_SWI); float* SWQ = (float*)(ws + WS_SWQ); (void)WI8; (void)WQ8; (void)SWI; (void)SWQ; \
    unsigned char* XQ = ws + WS_XQ; float* XS = (float*)(ws + WS_XS); (void)XQ; (void)XS; \
    unsigned char* U8 = ws + WS_U; unsigned char* V8 = ws + WS_V; float* SU = (float*)(ws + WS_SU); float* SV = (float*)(ws + WS_SV); (void)U8; (void)V8; (void)SU; (void)SV; \
    (void)x; (void)c; (void)ctx; (void)c_ctx; (void)norm1_w; (void)norm2_w; (void)w_ada; (void)b_ada; (void)w_in; (void)w_out; (void)na_rpb; (void)dec_f; (void)dec_b; (void)gn_w; \
    (void)pool_w; (void)pool_scale; (void)peer_wq; (void)peer_keys; (void)peer_u; (void)peer_v; (void)final_w; (void)out; (void)MOD; (void)cosT; (void)sinT; (void)WI; (void)WO; (void)WQ; \
    (void)KEYS; (void)XR; (void)XRC; (void)U; (void)V; (void)ACT; (void)PX; (void)Q; (void)ST; (void)IDX; (void)GATE; (void)TOPV; (void)TOPI;
#define GRID_SYNC() xcd_barrier(bar)

template <int l>
__device__ __forceinline__ void layer(const Params& p, unsigned char* lds, const XcdBarrier& bar) {
    DEFINE_PTRS
    constexpr bool last = (l == DEPTH - 1);
    const float* modl = MOD + (size_t)l * 5 * 6 * D;
    constexpr int mrows = last ? M_LAT : M_ALL;
    if (l == 0) { ph_quant_w(WI, WI8, SWI, DEPTH * DPROJ_PAD); ph_quant_w(WQ, WQ8, SWQ, DEPTH * DQ); }
    if (l == 0) { DUP(1) ph_norm<true, false>(x, ctx, norm1_w + l * D, modl, 0, D, nullptr, XQ, XS, M_ALL);
    GRID_SYNC(); }
    else if (gridDim.x != 256) { ph_norm<true, true>(XR, XRC, norm1_w + l * D, modl, 0, D, nullptr, XQ, XS, M_ALL);
    GRID_SYNC(); }
#if USE_PG8
    DUP(2) { pg8::Gemm g{(const pg8::bf16_t*)XQ, (const pg8::bf16_t*)(WI8 + (size_t)l * DPROJ_PAD * D), M_ALL, DPROJ_PAD, D / 2}; pg8::StaticOrder So; So.init(M_ALL, DPROJ_PAD, (int)gridDim.x, (int)blockIdx.x);
      EpiI8Bf16Out E{PX, DPROJ, DPROJ, XS, SWI + l * DPROJ_PAD}; pg8::gemm_phase_i8<EpiI8Bf16Out, pg8::StaticOrder>((PG8_LAS unsigned char*)lds, g, So, E, nullptr); }
#else
    ph_gemm_simple<0>(ACT, WI + (size_t)l * DPROJ_PAD * D, M_ALL, DPROJ_PAD, D, PX, DPROJ, DPROJ, nullptr, nullptr, nullptr, nullptr, nullptr, 0, (bf16*)lds);
#endif
    GRID_SYNC();
#if NA_NAIVE
    ph_na(PX, na_rpb + (size_t)l * NAH * 15 * 31, ACT, mrows);
#else
    DUP(4) { ph_na_mfma(PX, na_rpb + (size_t)l * NAH * 15 * 31, ACT, last ? 1536 : 1584, lds);
    __syncthreads(); }
#endif
    DUP(5) ph_pool(PX, ACT, mrows);
#if RET_NAIVE
    ph_ret_state(PX, cosT, sinT, dec_f + l * RH, dec_b + l * RH, ST, (float*)lds);
#else
    DUP(6) ph_ret_state_mfma(PX, cosT, sinT, dec_f + l * RH, dec_b + l * RH, STB, lds);
#endif
    GRID_SYNC();
#if RET_NAIVE
    ph_ret_scan(dec_f + l * RH, dec_b + l * RH, ST);
#else
    ph_ret_scan_bf(dec_f + l * RH, dec_b + l * RH, STB);
#endif
    GRID_SYNC();
#if RET_NAIVE
    ph_ret_out(PX, cosT, sinT, dec_f + l * RH, dec_b + l * RH, ST, gn_w + l * RW, ACT, last ? 64 : NCH, (float*)lds);
#else
    DUP(7) ph_ret_out_mfma(PX, cosT, sinT, dec_f + l * RH, dec_b + l * RH, STB, gn_w + l * RW, ACT, last ? 64 : NCH, lds);
#endif
    GRID_SYNC();
#if USE_PG8
    DUP(l == 0 ? 11 : 31) { pg8::Gemm g{ACT, WO + (size_t)l * D * D, mrows, D, D}; pg8::StaticOrder So; So.init(mrows, D, (int)gridDim.x, (int)blockIdx.x);
      if (l == 0) { EpiRes<false> E{x, ctx, XR, XRC, modl, 2 * D}; pg8::gemm_phase<EpiRes<false>, pg8::StaticOrder>((PG8_LAS unsigned char*)lds, g, So, E, nullptr); }
      else { EpiRes<true> E{XR, XRC, XR, XRC, modl, 2 * D}; pg8::gemm_phase<EpiRes<true>, pg8::StaticOrder>((PG8_LAS unsigned char*)lds, g, So, E, nullptr); } }
#else
    ph_gemm_simple<1>(ACT, WO + (size_t)l * D * D, mrows, D, D, nullptr, 0, 0, xl, xc, out, XCTX, modl, 2 * D, (bf16*)lds);
#endif
    GRID_SYNC();
    DUP(1) ph_norm<true, true>(XR, XRC, norm2_w + l * D, modl, 3 * D, 4 * D, gridDim.x != 256 ? ACT : nullptr, XQ, XS, mrows);
    GRID_SYNC();
#if USE_PG8
    DUP(3) { pg8::Gemm g{(const pg8::bf16_t*)XQ, (const pg8::bf16_t*)(WQ8 + (size_t)l * DQ * D), mrows, DQ, D / 2}; pg8::StaticOrder So; So.init(mrows, DQ, (int)gridDim.x, (int)blockIdx.x);
#if TK32
      EpiI8QT E{Q, XS, SWQ + l * DQ}; pg8::gemm_phase_i8<EpiI8QT, pg8::StaticOrder>((PG8_LAS unsigned char*)lds, g, So, E, nullptr); }
#else
      EpiI8Bf16Out E{Q, DQ, DQ, XS, SWQ + l * DQ}; pg8::gemm_phase_i8<EpiI8Bf16Out, pg8::StaticOrder>((PG8_LAS unsigned char*)lds, g, So, E, nullptr); }
#endif
#else
    ph_gemm_simple<0>(ACT, WQ + (size_t)l * DQ * D, mrows, DQ, D, Q, DQ, DQ, nullptr, nullptr, nullptr, nullptr, nullptr, 0, (bf16*)lds);
#endif
    GRID_SYNC();
#if 1
#if TK32
    DUP(8) ph_tk32(Q, KEYS + (size_t)l * 2 * PH * PNK * PKD, IDX, GATE, mrows, lds);
#else
    DUP(8) ph_tk_mfma(Q, KEYS + (size_t)l * 2 * PH * PNK * PKD, IDX, GATE, mrows, lds);
#endif
#endif
    GRID_SYNC();
#if PEER_BF16
    ph_peer<last>(ACT, IDX, GATE, U + (size_t)l * NEXP * D, V + (size_t)l * NEXP * D, modl, 5 * D, out, XCTX, final_w, mrows);
#else
    if (gridDim.x == 256) {
        ph_peer_sweep<last ? 2 : 1>(IDX, GATE, U8 + (size_t)l * NEXP * D, V8 + (size_t)l * NEXP * D, SU + l * NEXP, SV + l * NEXP, XQ, XS, AW, modl, 5 * D, XR, XRC, out,
                                    last ? final_w : norm1_w + (l + 1) * D, MOD + (size_t)(l + 1 < DEPTH ? l + 1 : l) * 5 * 6 * D, XQ, XS, mrows, lds);
        if (!last) GRID_SYNC();
    } else {
        ph_peer8<last ? 2 : 0>(ACT, IDX, GATE, U8 + (size_t)l * NEXP * D, V8 + (size_t)l * NEXP * D, SU + l * NEXP, SV + l * NEXP, modl, 5 * D, XR, XRC, out, final_w, nullptr, mrows);
        if (!last) GRID_SYNC();
    }
    return;
#endif
    if (!last) GRID_SYNC();
}

__global__ void __launch_bounds__(NT, 2) mega(Params p) {
    extern __shared__ __attribute__((aligned(16))) unsigned char lds[];
    volatile LAS unsigned* bst = (volatile LAS unsigned*)((LAS unsigned char*)lds + LDS_BYTES - 64);
    if (threadIdx.x < 16) bst[threadIdx.x] = 0u;
    __syncthreads();
    const XcdBarrier bar = xcd_barrier_post((unsigned*)(p.ws + WS_CTL), bst);
    DUP(0) {
        DEFINE_PTRS
        DUP(20) { ph_mods(c, c_ctx, w_ada, b_ada, MOD, (float*)lds);
        __syncthreads();
#if RET_NAIVE
        ph_rope(cosT, sinT);
#endif
        }
        DUP(21)
        { ph_transpose_all(w_in, peer_wq, w_out, WI, WQ, WO, (float*)lds);
          ph_wo_pool(w_out, pool_w, pool_scale, WO, (float*)lds); }
        ph_cvt(peer_keys, KEYS, (size_t)DEPTH * 2 * PH * PNK * PKD / 4);
#if PEER_BF16
        ph_cvt(peer_u, U, (size_t)DEPTH * NEXP * D / 4);
        ph_cvt(peer_v, V, (size_t)DEPTH * NEXP * D / 4);
#else
        DUP(22) { ph_quant(peer_u, U8, SU, DEPTH * NEXP, 0);
        ph_quant(peer_v, V8, SV, DEPTH * NEXP, 0); }
#endif
    }
    GRID_SYNC();
    layer<0>(p, lds, bar);
    layer<1>(p, lds, bar);
}
}

extern "C" void kernel_launch(void* const* d_in, const int* in_sizes, int n_in, void* d_out, int out_size, void* d_ws, size_t ws_size, hipStream_t stream) {
    static int grid = 0;
    if (grid == 0) {
        if (n_in != 21 || out_size != M_LAT * D || ws_size < WS_END) { fprintf(stderr, "kernel_launch: unexpected sizes n_in %d out %d ws %zu (need %zu)\n", n_in, out_size, ws_size, (size_t)WS_END); grid = -1; return; }
        int dev = 0, cus = 0, per_cu = 0;
        if (hipGetDevice(&dev) != hipSuccess || hipDeviceGetAttribute(&cus, hipDeviceAttributeMultiprocessorCount, dev) != hipSuccess) { fprintf(stderr, "kernel_launch: device query failed\n"); grid = -1; return; }
        if (hipFuncSetAttribute((const void*)mega, hipFuncAttributeMaxDynamicSharedMemorySize, LDS_BYTES) != hipSuccess) { fprintf(stderr, "kernel_launch: hipFuncSetAttribute failed\n"); grid = -1; return; }
        if (hipOccupancyMaxActiveBlocksPerMultiprocessor(&per_cu, (const void*)mega, NT, LDS_BYTES) != hipSuccess || per_cu < 1) { fprintf(stderr, "kernel_launch: occupancy query says %d\n", per_cu); grid = -1; (void)hipGetLastError(); return; }
        grid = cus;
    }
    if (grid < 0) return;
    Params p{};
    for (int i = 0; i < 21; ++i) p.in[i] = (const float*)d_in[i];
    p.out = (float*)d_out; p.ws = (unsigned char*)d_ws;
    if (hipMemsetAsync((char*)d_ws + WS_CTL, 0, 65536, stream) != hipSuccess) { fprintf(stderr, "kernel_launch: memset failed\n"); return; }
    hipLaunchKernelGGL(mega, dim3(grid), dim3(NT), LDS_BYTES, stream, p);
    hipError_t e = hipPeekAtLastError();
    if (e != hipSuccess) fprintf(stderr, "kernel_launch: launch failed: %s (grid %d)\n", hipGetErrorString(e), grid);
}
```

```cpp
#include <hip/hip_runtime.h>
#include <cstdio>
#include <cstdint>

#ifndef DUP_MASK
#define DUP_MASK 0
#endif
#ifndef USE_PG8
#define USE_PG8 1
#endif
#ifndef NA_NAIVE
#define NA_NAIVE 0
#endif
#ifndef TK_NAIVE
#define TK_NAIVE 0
#endif
#ifndef RET_NAIVE
#define RET_NAIVE 0
#endif
#ifndef TK32
#define TK32 1
#endif
#ifndef PEER_BF16
#define PEER_BF16 0
#endif
#define DUP(bit) for (int _r = 0; _r < ((((unsigned)DUP_MASK >> (bit)) & 1u) ? 2 : 1); ++_r)

__device__ __forceinline__ int otid() { int t = threadIdx.x; asm volatile("" : "+v"(t)); return t; }

namespace pg8 {

#define PG8_LAS __attribute__((address_space(3)))
typedef unsigned short bf16_t;
typedef short bf16x8 __attribute__((ext_vector_type(8)));
typedef float f32x4 __attribute__((ext_vector_type(4)));
typedef unsigned u32x4 __attribute__((ext_vector_type(4)));
constexpr int BM = 256, BK = 64, HALF = 128, HTB = HALF * BK * 2  , STAGE_BYTES = 8 * HTB, NXCD = 8, WGM = 8;

__host__ __device__ __forceinline__ int lds_byte(int r, int c) { const int st = (r >> 4) * 2 + (c >> 5), rr = r & 15, cc = c & 31, ob = rr * 64 + cc * 2; return st * 1024 + (ob ^ (((ob >> 9) & 1) << 5)); }
__host__ __device__ __forceinline__ void stage_rc(int b, int& R, int& C) { const int st = b / 1024, sb = b % 1024, swz = sb ^ (((sb >> 9) & 1) << 5); R = (st >> 1) * 16 + swz / 64; C = (st & 1) * 32 + (swz % 64) / 2; }
__host__ __device__ __forceinline__ int perm32(int rho) { const int n = rho >> 4, i = rho & 15; return 8 * (i >> 2) + 4 * n + (i & 3); }

struct Unit { int pm, pn; };
struct Gemm { const bf16_t* A; const bf16_t* Bt; int M, N, K; };

struct StaticOrder {
    int nM, nN, nwg, G, c;
    __host__ __device__ __forceinline__ void init(int M, int N, int G_, int c_) { nM = M / BM; nN = N / BM; nwg = nM * nN; G = G_; c = c_; }
    __host__ __device__ __forceinline__ bool next(int i, Unit& u) const {
        const long L = (long)i * G + c; if (L >= nwg) return false;
        int wgid = (int)L; { const int q = nwg / NXCD, r = nwg % NXCD, xcd = wgid % NXCD, off = wgid / NXCD; wgid = (xcd < r ? xcd * (q + 1) : r * (q + 1) + (xcd - r) * q) + off; }
        const int nig = WGM * nN, gid = wgid / nig, fm = gid * WGM, gsz = (nM - fm) < WGM ? (nM - fm) : WGM;
        u.pm = fm + ((wgid % nig) % gsz); u.pn = (wgid % nig) / gsz; return true;
    }
    __device__ __forceinline__ void a_ready(const Unit&) const {}
    __device__ __forceinline__ void done(const Unit&) const {}
};
struct HeadOrder {
    int nM, c;
    __device__ __forceinline__ void init(int M, int c_) { nM = M / BM; c = c_; }
    __device__ __forceinline__ bool next(int i, Unit& u) const { const int k = c >> 3, pm = 4 * (c & 7) + (k >> 3) + 32 * i; if (pm >= nM) return false; u.pm = pm; u.pn = k & 7; return true; }
    __device__ __forceinline__ void a_ready(const Unit&) const {} __device__ __forceinline__ void done(const Unit&) const {}
};
struct OneUnit { Unit u; __device__ __forceinline__ bool next(int i, Unit& o) const { if (i != 0) return false; o = u; return true; }
    __device__ __forceinline__ void a_ready(const Unit&) const {} __device__ __forceinline__ void done(const Unit&) const {} };

typedef unsigned u32x2 __attribute__((ext_vector_type(2)));
__device__ __forceinline__ unsigned cvt_pk_bf16(float lo, float hi) { unsigned r; asm volatile("v_cvt_pk_bf16_f32 %0, %1, %2" : "=v"(r) : "v"(lo), "v"(hi)); return r; }
typedef __bf16 bf16x2v_t __attribute__((ext_vector_type(2)));
typedef float f32x2v_t __attribute__((ext_vector_type(2)));
__device__ __forceinline__ unsigned cvt_pk_bf16_n(float lo, float hi) { const bf16x2v_t r = __builtin_convertvector((f32x2v_t){lo, hi}, bf16x2v_t); return __builtin_bit_cast(unsigned, r); }
template <class Epi, class Sched, bool STAMP = false>
__device__ __forceinline__ void gemm_phase(PG8_LAS unsigned char* lds, const Gemm g, const Sched& S, const Epi& E, unsigned long long* stamps) {
    const int tid = otid(), wid = __builtin_amdgcn_readfirstlane(tid >> 6), lane = tid & 63, wr = wid >> 2, wc = wid & 3, fr = lane & 15, fq = lane >> 4;
    const int K = g.K, nt = K / BK;
    int ts_lo = 0, ts_hi = 0, nts = 0; const unsigned long long rt_entry = STAMP ? (unsigned long long)wall_clock64() : 0ull;
#define PG8_STAMP() do { if (STAMP && wid == 0 && nts < 64) { const unsigned long long _c = (unsigned long long)clock64(); \
        ts_lo = (lane == nts) ? (int)(unsigned)_c : ts_lo; ts_hi = (lane == nts) ? (int)(unsigned)(_c >> 32) : ts_hi; ++nts; } } while (0)
    PG8_STAMP();
    unsigned voffA[2], voffB[2];
#pragma unroll
    for (int i = 0; i < 2; ++i) { int R, C; stage_rc(tid * 16 + i * 8192, R, C); const int Rb = Epi::PERM ? ((R & ~31) + perm32(R & 31)) : R;
        voffA[i] = (unsigned)(R * K + C) * 2u; voffB[i] = (unsigned)(Rb * K + C) * 2u; }
    const size_t kstep = (size_t)(BK * 2);
    const size_t hstep = (size_t)HALF * K * 2;
    const size_t tstep = 2 * hstep;
    const unsigned ldsw = (unsigned)wid * 1024u;
    const int aoff = lds_byte(wr * 64 + fr, fq * 8), boff = lds_byte(wc * 32 + fr, fq * 8);
#define PG8_SA(b, h) (((b) * 2 + (h)) * HTB)
#define PG8_SB(b, h) ((4 + (b) * 2 + (h)) * HTB)
#define PG8_STAGE(bufoff, gbase, voff) do { _Pragma("unroll") for (int _i = 0; _i < 2; ++_i) \
        __builtin_amdgcn_global_load_lds((const unsigned*)((const char*)(gbase) + (voff)[_i]), (PG8_LAS unsigned*)(lds + (bufoff) + ldsw + _i * 8192), 16, 0, 0); } while (0)
#define PG8_LDA(dst, b, h) do { _Pragma("unroll") for (int m = 0; m < 4; ++m) _Pragma("unroll") for (int k = 0; k < 2; ++k) dst[m][k] = *(const PG8_LAS bf16x8*)(lds + PG8_SA(b, h) + aoff + m * 2048 + k * 1024); } while (0)
#define PG8_LDB(dst, b, h) do { _Pragma("unroll") for (int n = 0; n < 2; ++n) _Pragma("unroll") for (int k = 0; k < 2; ++k) dst[n][k] = *(const PG8_LAS bf16x8*)(lds + PG8_SB(b, h) + boff + n * 2048 + k * 1024); } while (0)
#define PG8_MMA(ai, bj, At, Bt) do { __builtin_amdgcn_s_setprio(1); _Pragma("unroll") for (int m = 0; m < 4; ++m) _Pragma("unroll") for (int n = 0; n < 2; ++n) _Pragma("unroll") for (int k = 0; k < 2; ++k) \
        acc[ai][bj][m][n] = __builtin_amdgcn_mfma_f32_16x16x32_bf16(Bt[n][k], At[m][k], acc[ai][bj][m][n], 0, 0, 0); __builtin_amdgcn_s_setprio(0); } while (0)
#define PG8_WAIT_V(n) asm volatile("s_waitcnt vmcnt(" #n ")" ::: "memory")
#define PG8_WAIT_L(n) asm volatile("s_waitcnt lgkmcnt(" #n ")" ::: "memory")
#define PG8_BAR __builtin_amdgcn_s_barrier()
#define PG8_SCHED __builtin_amdgcn_sched_barrier(0)
    Unit cur, nxt; int ui = 0;
    if (!S.next(0, cur)) return;
    f32x4 acc[2][2][4][2];
#pragma unroll
    for (int a = 0; a < 2; ++a)
#pragma unroll
        for (int b = 0; b < 2; ++b)
#pragma unroll
            for (int m = 0; m < 4; ++m)
#pragma unroll
                for (int n = 0; n < 2; ++n) acc[a][b][m][n] = (f32x4){0.f, 0.f, 0.f, 0.f};
    bf16x8 At[4][2], B0[2][2], B1[2][2];
    const char* cA = (const char*)g.A + (size_t)cur.pm * tstep; const char* cB = (const char*)g.Bt + (size_t)cur.pn * tstep;
    S.a_ready(cur);
    PG8_STAGE(PG8_SB(0, 0), cB, voffB); PG8_STAGE(PG8_SA(0, 0), cA, voffA); PG8_STAGE(PG8_SB(0, 1), cB + hstep, voffB); PG8_STAGE(PG8_SA(0, 1), cA + hstep, voffA);
    if (wr == 1) PG8_BAR;
    PG8_WAIT_V(4); PG8_BAR;
    PG8_STAGE(PG8_SB(1, 0), cB + kstep, voffB); PG8_STAGE(PG8_SA(1, 0), cA + kstep, voffA); PG8_STAGE(PG8_SB(1, 1), cB + hstep + kstep, voffB);
    PG8_WAIT_V(6); PG8_BAR;
    PG8_STAMP();
    for (;;) {
        const bool has_next = S.next(ui + 1, nxt);
        const char* nA = has_next ? (const char*)g.A + (size_t)nxt.pm * tstep : cA; const char* nB = has_next ? (const char*)g.Bt + (size_t)nxt.pn * tstep : cB;
        for (int t = 0; t < nt; t += 2) {
            const bool last = (t == nt - 2);
            const char* a1 = cA + (size_t)(t + 1) * kstep;
            const char* a2 = last ? nA : cA + (size_t)(t + 2) * kstep; const char* b2 = last ? nB : cB + (size_t)(t + 2) * kstep;
            const char* a3 = a2 + kstep; const char* b3 = b2 + kstep;
            if (last && has_next) S.a_ready(nxt);
            PG8_LDB(B0, 0, 0); PG8_SCHED; PG8_LDA(At, 0, 0); PG8_STAGE(PG8_SA(1, 1), a1 + hstep, voffA);
            PG8_WAIT_L(8); PG8_BAR; PG8_WAIT_L(0); PG8_MMA(0, 0, At, B0); PG8_BAR; PG8_SCHED;
            PG8_LDB(B1, 0, 1); PG8_STAGE(PG8_SB(0, 0), b2, voffB);
            PG8_BAR; PG8_WAIT_L(0); PG8_MMA(0, 1, At, B1); PG8_BAR;
            PG8_LDA(At, 0, 1); PG8_STAGE(PG8_SA(0, 0), a2, voffA);
            PG8_BAR; PG8_WAIT_L(0); PG8_MMA(1, 0, At, B0); PG8_BAR; PG8_SCHED;
            PG8_STAGE(PG8_SB(0, 1), b2 + hstep, voffB);
            PG8_WAIT_V(6); PG8_BAR; PG8_MMA(1, 1, At, B1); PG8_BAR;
            PG8_LDB(B0, 1, 0); PG8_SCHED; PG8_LDA(At, 1, 0); PG8_STAGE(PG8_SA(0, 1), a2 + hstep, voffA);
            PG8_WAIT_L(8); PG8_BAR; PG8_WAIT_L(0); PG8_MMA(0, 0, At, B0); PG8_BAR; PG8_SCHED;
            PG8_LDB(B1, 1, 1); PG8_STAGE(PG8_SB(1, 0), b3, voffB);
            PG8_BAR; PG8_WAIT_L(0); PG8_MMA(0, 1, At, B1); PG8_BAR;
            PG8_LDA(At, 1, 1); PG8_STAGE(PG8_SA(1, 0), a3, voffA);
            PG8_BAR; PG8_WAIT_L(0); PG8_MMA(1, 0, At, B0); PG8_BAR; PG8_SCHED;
            PG8_STAGE(PG8_SB(1, 1), b3 + hstep, voffB);
            PG8_WAIT_V(6); PG8_BAR; PG8_MMA(1, 1, At, B1); PG8_BAR;
        }
        PG8_STAMP();
        if constexpr (!Epi::AFTER_DRAIN) { E(acc, cur, wr, wc, fr, fq); S.done(cur); }
        PG8_STAMP();
        if (!has_next) break;
#pragma unroll
        for (int a = 0; a < 2; ++a)
#pragma unroll
            for (int b = 0; b < 2; ++b)
#pragma unroll
                for (int m = 0; m < 4; ++m)
#pragma unroll
                    for (int n = 0; n < 2; ++n) acc[a][b][m][n] = (f32x4){0.f, 0.f, 0.f, 0.f};
        cur = nxt; cA = nA; cB = nB; ++ui;
    }
    PG8_WAIT_V(0);
    if (wr == 0) PG8_BAR;
    PG8_BAR;
    if constexpr (Epi::AFTER_DRAIN) { E.fused(acc, cur, wr, wc, fr, fq, lds, wid, lane); S.done(cur); }
    PG8_STAMP();
    if (STAMP && wid == 0) { stamps[lane] = lane < nts ? (((unsigned long long)(unsigned)ts_hi << 32) | (unsigned)ts_lo) : 0ull;
        if (lane == 62) stamps[62] = rt_entry; if (lane == 63) stamps[63] = (unsigned long long)wall_clock64(); }
#undef PG8_STAMP
#undef PG8_SA
#undef PG8_SB
#undef PG8_STAGE
#undef PG8_LDA
#undef PG8_LDB
#undef PG8_MMA
#undef PG8_WAIT_V
#undef PG8_WAIT_L
#undef PG8_BAR
#undef PG8_SCHED
}

typedef int i32x4 __attribute__((ext_vector_type(4)));
template <class Epi, class Sched, bool STAMP = false>
__device__ __forceinline__ void gemm_phase_i8(PG8_LAS unsigned char* lds, const Gemm g, const Sched& S, const Epi& E, unsigned long long* stamps) {
    const int tid = otid(), wid = __builtin_amdgcn_readfirstlane(tid >> 6), lane = tid & 63, wr = wid >> 2, wc = wid & 3, fr = lane & 15, fq = lane >> 4;
    const int K = g.K, nt = K / BK;
    int ts_lo = 0, ts_hi = 0, nts = 0; const unsigned long long rt_entry = STAMP ? (unsigned long long)wall_clock64() : 0ull;
#define PG8_STAMP() do { if (STAMP && wid == 0 && nts < 64) { const unsigned long long _c = (unsigned long long)clock64(); \
        ts_lo = (lane == nts) ? (int)(unsigned)_c : ts_lo; ts_hi = (lane == nts) ? (int)(unsigned)(_c >> 32) : ts_hi; ++nts; } } while (0)
    PG8_STAMP();
    unsigned voffA[2], voffB[2];
#pragma unroll
    for (int i = 0; i < 2; ++i) { int R, C; stage_rc(tid * 16 + i * 8192, R, C); const int Rb = Epi::PERM ? ((R & ~31) + perm32(R & 31)) : R;
        voffA[i] = (unsigned)(R * K + C) * 2u; voffB[i] = (unsigned)(Rb * K + C) * 2u; }
    const size_t kstep = (size_t)(BK * 2);
    const size_t hstep = (size_t)HALF * K * 2;
    const size_t tstep = 2 * hstep;
    const unsigned ldsw = (unsigned)wid * 1024u;
    const int aoff = lds_byte(wr * 64 + fr, fq * 8), boff = lds_byte(wc * 32 + fr, fq * 8);
#define PG8_SA(b, h) (((b) * 2 + (h)) * HTB)
#define PG8_SB(b, h) ((4 + (b) * 2 + (h)) * HTB)
#define PG8_STAGE(bufoff, gbase, voff) do { _Pragma("unroll") for (int _i = 0; _i < 2; ++_i) \
        __builtin_amdgcn_global_load_lds((const unsigned*)((const char*)(gbase) + (voff)[_i]), (PG8_LAS unsigned*)(lds + (bufoff) + ldsw + _i * 8192), 16, 0, 0); } while (0)
#define PG8_LDA(dst, b, h) do { _Pragma("unroll") for (int m = 0; m < 4; ++m) _Pragma("unroll") for (int k = 0; k < 2; ++k) dst[m][k] = *(const PG8_LAS i32x4*)(lds + PG8_SA(b, h) + aoff + m * 2048 + k * 1024); } while (0)
#define PG8_LDB(dst, b, h) do { _Pragma("unroll") for (int n = 0; n < 2; ++n) _Pragma("unroll") for (int k = 0; k < 2; ++k) dst[n][k] = *(const PG8_LAS i32x4*)(lds + PG8_SB(b, h) + boff + n * 2048 + k * 1024); } while (0)
#define PG8_MMA(ai, bj, At, Bt) do { __builtin_amdgcn_s_setprio(1); _Pragma("unroll") for (int m = 0; m < 4; ++m) _Pragma("unroll") for (int n = 0; n < 2; ++n) _Pragma("unroll") for (int k = 0; k < 2; ++k) \
        acc[ai][bj][m][n] = __builtin_amdgcn_mfma_i32_16x16x64_i8(Bt[n][k], At[m][k], acc[ai][bj][m][n], 0, 0, 0); __builtin_amdgcn_s_setprio(0); } while (0)
#define PG8_WAIT_V(n) asm volatile("s_waitcnt vmcnt(" #n ")" ::: "memory")
#define PG8_WAIT_L(n) asm volatile("s_waitcnt lgkmcnt(" #n ")" ::: "memory")
#define PG8_BAR __builtin_amdgcn_s_barrier()
#define PG8_SCHED __builtin_amdgcn_sched_barrier(0)
    Unit cur, nxt; int ui = 0;
    if (!S.next(0, cur)) return;
    i32x4 acc[2][2][4][2];
#pragma unroll
    for (int a = 0; a < 2; ++a)
#pragma unroll
        for (int b = 0; b < 2; ++b)
#pragma unroll
            for (int m = 0; m < 4; ++m)
#pragma unroll
                for (int n = 0; n < 2; ++n) acc[a][b][m][n] = (i32x4){0, 0, 0, 0};
    i32x4 At[4][2], B0[2][2], B1[2][2];
    const char* cA = (const char*)g.A + (size_t)cur.pm * tstep; const char* cB = (const char*)g.Bt + (size_t)cur.pn * tstep;
    S.a_ready(cur);
    PG8_STAGE(PG8_SB(0, 0), cB, voffB); PG8_STAGE(PG8_SA(0, 0), cA, voffA); PG8_STAGE(PG8_SB(0, 1), cB + hstep, voffB); PG8_STAGE(PG8_SA(0, 1), cA + hstep, voffA);
    if (wr == 1) PG8_BAR;
    PG8_WAIT_V(4); PG8_BAR;
    PG8_STAGE(PG8_SB(1, 0), cB + kstep, voffB); PG8_STAGE(PG8_SA(1, 0), cA + kstep, voffA); PG8_STAGE(PG8_SB(1, 1), cB + hstep + kstep, voffB);
    PG8_WAIT_V(6); PG8_BAR;
    PG8_STAMP();
    for (;;) {
        const bool has_next = S.next(ui + 1, nxt);
        const char* nA = has_next ? (const char*)g.A + (size_t)nxt.pm * tstep : cA; const char* nB = has_next ? (const char*)g.Bt + (size_t)nxt.pn * tstep : cB;
        for (int t = 0; t < nt; t += 2) {
            const bool last = (t == nt - 2);
            const char* a1 = cA + (size_t)(t + 1) * kstep;
            const char* a2 = last ? nA : cA + (size_t)(t + 2) * kstep; const char* b2 = last ? nB : cB + (size_t)(t + 2) * kstep;
            const char* a3 = a2 + kstep; const char* b3 = b2 + kstep;
            if (last && has_next) S.a_ready(nxt);
            PG8_LDB(B0, 0, 0); PG8_SCHED; PG8_LDA(At, 0, 0); PG8_STAGE(PG8_SA(1, 1), a1 + hstep, voffA);
            PG8_WAIT_L(8); PG8_BAR; PG8_WAIT_L(0); PG8_MMA(0, 0, At, B0); PG8_BAR; PG8_SCHED;
            PG8_LDB(B1, 0, 1); PG8_STAGE(PG8_SB(0, 0), b2, voffB);
            PG8_BAR; PG8_WAIT_L(0); PG8_MMA(0, 1, At, B1); PG8_BAR;
            PG8_LDA(At, 0, 1); PG8_STAGE(PG8_SA(0, 0), a2, voffA);
            PG8_BAR; PG8_WAIT_L(0); PG8_MMA(1, 0, At, B0); PG8_BAR; PG8_SCHED;
            PG8_STAGE(PG8_SB(0, 1), b2 + hstep, voffB);
            PG8_WAIT_V(6); PG8_BAR; PG8_MMA(1, 1, At, B1); PG8_BAR;
            PG8_LDB(B0, 1, 0); PG8_SCHED; PG8_LDA(At, 1, 0); PG8_STAGE(PG8_SA(0, 1), a2 + hstep, voffA);
            PG8_WAIT_L(8); PG8_BAR; PG8_WAIT_L(0); PG8_MMA(0, 0, At, B0); PG8_BAR; PG8_SCHED;
            PG8_LDB(B1, 1, 1); PG8_STAGE(PG8_SB(1, 0), b3, voffB);
            PG8_BAR; PG8_WAIT_L(0); PG8_MMA(0, 1, At, B1); PG8_BAR;
            PG8_LDA(At, 1, 1); PG8_STAGE(PG8_SA(1, 0), a3, voffA);
            PG8_BAR; PG8_WAIT_L(0); PG8_MMA(1, 0, At, B0); PG8_BAR; PG8_SCHED;
            PG8_STAGE(PG8_SB(1, 1), b3 + hstep, voffB);
            PG8_WAIT_V(6); PG8_BAR; PG8_MMA(1, 1, At, B1); PG8_BAR;
        }
        PG8_STAMP();
        if constexpr (!Epi::AFTER_DRAIN) { for (int _e = 0; _e < ((((unsigned)DUP_MASK >> 14) & 1u) ? 2 : 1); ++_e) E(acc, cur, wr, wc, fr, fq); S.done(cur); }
        PG8_STAMP();
        if (!has_next) break;
#pragma unroll
        for (int a = 0; a < 2; ++a)
#pragma unroll
            for (int b = 0; b < 2; ++b)
#pragma unroll
                for (int m = 0; m < 4; ++m)
#pragma unroll
                    for (int n = 0; n < 2; ++n) acc[a][b][m][n] = (i32x4){0, 0, 0, 0};
        cur = nxt; cA = nA; cB = nB; ++ui;
    }
    PG8_WAIT_V(0);
    if (wr == 0) PG8_BAR;
    PG8_BAR;
    if constexpr (Epi::AFTER_DRAIN) { E.fused(acc, cur, wr, wc, fr, fq, lds, wid, lane); S.done(cur); }
    PG8_STAMP();
    if (STAMP && wid == 0) { stamps[lane] = lane < nts ? (((unsigned long long)(unsigned)ts_hi << 32) | (unsigned)ts_lo) : 0ull;
        if (lane == 62) stamps[62] = rt_entry; if (lane == 63) stamps[63] = (unsigned long long)wall_clock64(); }
#undef PG8_STAMP
#undef PG8_SA
#undef PG8_SB
#undef PG8_STAGE
#undef PG8_LDA
#undef PG8_LDB
#undef PG8_MMA
#undef PG8_WAIT_V
#undef PG8_WAIT_L
#undef PG8_BAR
#undef PG8_SCHED
}
}

#define XB_TMO      128
#define XB_XCNT(j)  (256  + 64 * (j))
#define XB_XSUB(j)  (1280 + 64 * (j))
#define XB_XGEN(j)  (2304 + 64 * (j))
#define XB_TOP      3328
#define XB_TOPGEN   3392
#define XCD_BAR_WORDS 3456
#define XB_SPIN_CAP (1u << 18)
#define LAS __attribute__((address_space(3)))

__device__ __forceinline__ unsigned xb_ld(unsigned* p)              { return __hip_atomic_load(p, __ATOMIC_RELAXED, __HIP_MEMORY_SCOPE_AGENT); }
__device__ __forceinline__ unsigned xb_add(unsigned* p, unsigned v) { return __hip_atomic_fetch_add(p, v, __ATOMIC_RELAXED, __HIP_MEMORY_SCOPE_AGENT); }
__device__ __forceinline__ unsigned xb_xcc_id() { return (unsigned)__builtin_amdgcn_s_getreg((3 << 11) | 20) & 0xFu; }
#define XB_SPIN(cond, bar) do { unsigned _sp = 0; while (cond) { __builtin_amdgcn_s_sleep(1); \
    if ((++_sp & 255u) == 0u) { if (xb_ld(&(bar)[XB_TMO])) break; if (_sp > XB_SPIN_CAP) { atomicAdd(&(bar)[XB_TMO], 1u); break; } } } } while (0)

struct XcdBarrier {
    unsigned* bar; unsigned x;
    volatile LAS unsigned* st;
};

__device__ __forceinline__ XcdBarrier xcd_barrier_post(unsigned* bar, volatile LAS unsigned* st) {
    XcdBarrier b; b.bar = bar; b.x = xb_xcc_id(); b.st = st;
    if (threadIdx.x == 0) (void)xb_add(&bar[XB_XCNT(b.x)], 1u);
    return b;
}
__device__ __forceinline__ void xcd_barrier_complete(unsigned* bar, unsigned x, unsigned& nloc, unsigned& nx) {
    const unsigned G = gridDim.x * gridDim.y * gridDim.z;
    unsigned sum, cnt, mine, sp = 0u;
    for (;;) {
        sum = 0u; cnt = 0u; mine = 0u;
#pragma unroll
        for (unsigned j = 0; j < 16; ++j) { const unsigned c = xb_ld(&bar[XB_XCNT(j)]); sum += c; cnt += (c > 0u) ? 1u : 0u; mine = (j == x) ? c : mine; }
        if (sum == G) break;
        __builtin_amdgcn_s_sleep(1);
        if ((++sp & 255u) == 0u) { if (xb_ld(&bar[XB_TMO])) break; if (sp > XB_SPIN_CAP) { atomicAdd(&bar[XB_TMO], 1u); break; } }
    }
    nloc = mine > 0u ? mine : 1u; nx = cnt > 0u ? cnt : 1u;
}

__device__ __forceinline__ void xcd_barrier(const XcdBarrier& b) {
    asm volatile("s_waitcnt vmcnt(0)" ::: "memory");
    __syncthreads();
    if (threadIdx.x == 0) {
        unsigned* bar = b.bar;
        __builtin_amdgcn_s_waitcnt(0);
        unsigned nloc = b.st[0], nx = b.st[1];
        if (nloc == 0u) { xcd_barrier_complete(bar, b.x, nloc, nx); b.st[0] = nloc; b.st[1] = nx; }
        const unsigned old = xb_add(&bar[XB_XSUB(b.x)], 1u);
        const unsigned gen = old / nloc;
        if (old + 1u == (gen + 1u) * nloc) {
            __builtin_amdgcn_fence(__ATOMIC_RELEASE, "agent");
            asm volatile("s_waitcnt vmcnt(0)" ::: "memory");
            const unsigned og = xb_add(&bar[XB_TOP], 1u);
            const unsigned tg = og / nx;
            if (og + 1u == (tg + 1u) * nx) xb_add(&bar[XB_TOPGEN], 1u);
            else XB_SPIN(xb_ld(&bar[XB_TOPGEN]) == tg, bar);
            __builtin_amdgcn_fence(__ATOMIC_ACQUIRE, "agent");
            xb_add(&bar[XB_XGEN(b.x)], 1u);
            asm volatile("s_waitcnt vmcnt(0)" ::: "memory");
        } else {
            XB_SPIN(xb_ld(&bar[XB_XGEN(b.x)]) == gen, bar);
            __builtin_amdgcn_fence(__ATOMIC_ACQUIRE, "agent");
            asm volatile("s_waitcnt vmcnt(0)" ::: "memory");
        }
    }
    __syncthreads();
}


namespace {
constexpr int D = 1024, NB = 4, S = 8192, DEPTH = 2, GW = 64, CTX = 256, HD = 64;
constexpr int NAH = 6, RH = 6, NAW = 384, RW = 384, PW = 256;
constexpr int M_LAT = NB * S, M_CTX = NB * CTX, M_ALL = M_LAT + M_CTX;
constexpr int O_NA_Q = 0, O_NA_K = 384, O_NA_V = 768, O_RET_Q = 1152, O_RET_K = 1536, O_RET_V = 1920, O_RET_G = 2304, O_POOL = 2688;
constexpr int DPROJ = 2944, DPROJ_PAD = 3072;
constexpr int PH = 8, PNK = 128, PKD = 128, PTOP = 16, NEXP = 16384, DQ = 2048;
constexpr float EPS = 1e-6f;
constexpr int NCH = S / 128 + 2;
constexpr int NT = 512;
constexpr int LDS_BYTES = 163840;

typedef unsigned short bf16;
typedef short bf16x8 __attribute__((ext_vector_type(8)));
typedef float f32x4 __attribute__((ext_vector_type(4)));
typedef unsigned u32x4 __attribute__((ext_vector_type(4)));

__device__ __forceinline__ float bf2f(bf16 v) { return __uint_as_float(((unsigned)v) << 16); }
__device__ __forceinline__ bf16 f2bf(float f) { unsigned u = __float_as_uint(f); return (bf16)((u + 0x7fffu + ((u >> 16) & 1u)) >> 16); }
__device__ __forceinline__ float silu(float x) { return x / (1.f + __expf(-x)); }
#define SWZ_XOR(v, m) __int_as_float(__builtin_amdgcn_ds_swizzle(__float_as_int(v), ((m) << 10) | 0x1f))
__device__ __forceinline__ float wave_sum(float v) {
    v += SWZ_XOR(v, 1); v += SWZ_XOR(v, 2); v += SWZ_XOR(v, 4); v += SWZ_XOR(v, 8); v += SWZ_XOR(v, 16);
    return __int_as_float(__builtin_amdgcn_readlane(__float_as_int(v), 0)) + __int_as_float(__builtin_amdgcn_readlane(__float_as_int(v), 32));
}
__device__ __forceinline__ float wave_max(float v) {
    v = fmaxf(v, SWZ_XOR(v, 1)); v = fmaxf(v, SWZ_XOR(v, 2)); v = fmaxf(v, SWZ_XOR(v, 4)); v = fmaxf(v, SWZ_XOR(v, 8)); v = fmaxf(v, SWZ_XOR(v, 16));
    return fmaxf(__int_as_float(__builtin_amdgcn_readlane(__float_as_int(v), 0)), __int_as_float(__builtin_amdgcn_readlane(__float_as_int(v), 32)));
}
__device__ __forceinline__ int rl_i(int v, int lane) { return __builtin_amdgcn_readlane(v, lane); }
__device__ __forceinline__ float rl_f(float v, int lane) { return __int_as_float(__builtin_amdgcn_readlane(__float_as_int(v), lane)); }

constexpr size_t MiB = 1u << 20;
constexpr size_t WS_CTL = 0;
constexpr size_t WS_MOD = 1 * MiB;
constexpr size_t WS_ROPE = WS_MOD + 512 * 1024;
constexpr size_t WS_KEYS = 3 * MiB + 512 * 1024;
constexpr size_t WS_SU = 4 * MiB + 512 * 1024, WS_SV = WS_SU + 256 * 1024;
constexpr size_t WS_XS = 5 * MiB;
constexpr size_t WS_SWI = 5 * MiB + 512 * 1024, WS_SWQ = WS_SWI + 65536;
constexpr size_t WS_WO = 6 * MiB;
constexpr size_t WS_WI8 = 10 * MiB, WS_WQ8 = 16 * MiB;
constexpr size_t WS_WI = 20 * MiB;
constexpr size_t WS_WQ = 32 * MiB;
constexpr size_t WS_U = 40 * MiB;
constexpr size_t WS_V = 72 * MiB;
constexpr size_t WS_XQ = 104 * MiB;
constexpr size_t WS_ACT = 137 * MiB;
constexpr size_t WS_PX = 203 * MiB;
constexpr size_t WS_AW = WS_PX + 160 * MiB;
constexpr size_t WS_ST = 393 * MiB;
constexpr size_t WS_XR = 443 * MiB;
constexpr size_t WS_XRC = 507 * MiB;
constexpr size_t WS_END = 509 * MiB;
constexpr size_t WS_IDX = WS_ST, WS_GATE = WS_ST + 17 * MiB;
constexpr size_t WS_TOPV = WS_PX + 133 * MiB, WS_TOPI = WS_ACT;

struct Params { const float* in[21]; float* out; unsigned char* ws; };

__device__ __forceinline__ void ph_mods(const float* c, const float* c_ctx, const float* w_ada, const float* b_ada, float* mod, float* sm  ) { const int tidx = otid();
    const int tid = tidx, ks = tid >> 6, jj = tid & 63;
    float* act = sm; float* red = sm + 5 * D;
    if ((int)blockIdx.x >= DEPTH * 96) return;
    for (int i = tid; i < 5 * D; i += NT) { const float v = i < 4 * D ? c[i] : c_ctx[i - 4 * D]; act[i] = silu(v); }
    __syncthreads();
    for (int vb = blockIdx.x; vb < DEPTH * 96; vb += gridDim.x) {
        const int l = vb / 96, j = (vb % 96) * 64 + jj;
        const float* w = w_ada + (size_t)l * D * 6 * D + (size_t)(ks * 128) * 6 * D + j;
        const float* ap = act + ks * 128;
        float a0 = 0, a1 = 0, a2 = 0, a3 = 0, a4 = 0;
#pragma unroll 32
        for (int k = 0; k < 128; ++k) { const float wv = w[(size_t)k * 6 * D];
            a0 += ap[k] * wv; a1 += ap[D + k] * wv; a2 += ap[2 * D + k] * wv; a3 += ap[3 * D + k] * wv; a4 += ap[4 * D + k] * wv; }
        red[(ks * 5 + 0) * 64 + jj] = a0; red[(ks * 5 + 1) * 64 + jj] = a1; red[(ks * 5 + 2) * 64 + jj] = a2; red[(ks * 5 + 3) * 64 + jj] = a3; red[(ks * 5 + 4) * 64 + jj] = a4;
        __syncthreads();
        if (tid < 320) { const int r = tid >> 6; float s = 0.f;
#pragma unroll
            for (int q = 0; q < 8; ++q) s += red[(q * 5 + r) * 64 + jj];
            mod[((size_t)l * 5 + r) * 6 * D + j] = s + b_ada[l * 6 * D + j]; }
        __syncthreads();
    }
}
__device__ __forceinline__ void ph_rope(float* cosT, float* sinT) { const int tidx = otid();
    for (int gid = blockIdx.x * NT + tidx; gid < S * 32; gid += gridDim.x * NT) {
        const int t = gid / 32, j = gid % 32, jj = j & 15;
        const float inv = powf(10000.f, -(float)jj / 16.f);
        const float pos = j < 16 ? (float)(t / GW) : (float)(t % GW);
        const float ang = pos * inv;
        cosT[gid] = cosf(ang); sinT[gid] = sinf(ang);
    }
}
__device__ __forceinline__ void ph_transpose(const float* W, int K, int N, int Npad, int ldk, bf16* Wt, float* tile  ) { const int tidx = otid();
    const int tid = tidx, nbn = Npad / 64, nvb = nbn * (K / 64);
    for (int vb = blockIdx.x; vb < nvb; vb += gridDim.x) {
        const int n0 = (vb % nbn) * 64, k0 = (vb / nbn) * 64;
        { const int kk = tid >> 4, n4 = (tid & 15) * 4;
#pragma unroll
          for (int i = 0; i < 2; ++i) { const int k = kk + 32 * i; const int n = n0 + n4;
              const f32x4 v = (n < N) ? *(const f32x4*)(W + (size_t)(k0 + k) * N + n) : (f32x4){0.f, 0.f, 0.f, 0.f};
              tile[k * 65 + n4] = v.x; tile[k * 65 + n4 + 1] = v.y; tile[k * 65 + n4 + 2] = v.z; tile[k * 65 + n4 + 3] = v.w; } }
        __syncthreads();
        { const int n = tid >> 3, kc = (tid & 7) * 8;
          u32x4 o; o.x = pg8::cvt_pk_bf16(tile[(kc + 0) * 65 + n], tile[(kc + 1) * 65 + n]); o.y = pg8::cvt_pk_bf16(tile[(kc + 2) * 65 + n], tile[(kc + 3) * 65 + n]);
          o.z = pg8::cvt_pk_bf16(tile[(kc + 4) * 65 + n], tile[(kc + 5) * 65 + n]); o.w = pg8::cvt_pk_bf16(tile[(kc + 6) * 65 + n], tile[(kc + 7) * 65 + n]);
          *(u32x4*)(Wt + (size_t)(n0 + n) * ldk + k0 + kc) = o; }
        __syncthreads();
    }
}
__device__ __forceinline__ void ph_transpose_all(const float* w_in, const float* peer_wq, const float* w_out, bf16* WI, bf16* WQ, bf16* WO, float* tile) { const int tidx = otid();
    constexpr int T_IN = (DPROJ_PAD / 64) * (D / 64), T_Q = (DQ / 64) * (D / 64), T_O = (D / 64) * (768 / 64), T_L = T_IN + T_Q + T_O, T_ALL = DEPTH * T_L;
    const int tid = tidx, G = (int)gridDim.x, c = G - 1 - (int)blockIdx.x;
#define TR_DECODE(vb) const int l_ = (vb) / T_L, r0_ = (vb) % T_L; const int which_ = r0_ < T_IN ? 0 : (r0_ < T_IN + T_Q ? 1 : 2); const int r_ = r0_ - (which_ == 0 ? 0 : (which_ == 1 ? T_IN : T_IN + T_Q)); \
        const int N_ = which_ == 0 ? DPROJ : (which_ == 1 ? DQ : D), nbn_ = which_ == 0 ? DPROJ_PAD / 64 : (which_ == 1 ? DQ / 64 : D / 64); \
        const float* W_ = which_ == 0 ? w_in + (size_t)l_ * D * DPROJ : (which_ == 1 ? peer_wq + (size_t)l_ * D * DQ : w_out + (size_t)l_ * D * D); \
        bf16* Wt_ = which_ == 0 ? WI + (size_t)l_ * DPROJ_PAD * D : (which_ == 1 ? WQ + (size_t)l_ * DQ * D : WO + (size_t)l_ * D * D); \
        const int n0_ = (r_ % nbn_) * 64, k0_ = (r_ / nbn_) * 64;
    for (int vb0 = c; vb0 < T_ALL; vb0 += 4 * G) {
        f32x4 v[4][2];
#pragma unroll
        for (int i = 0; i < 4; ++i) { const int vb = vb0 + i * G;
            if (vb < T_ALL) { TR_DECODE(vb) (void)Wt_; const int kk = tid >> 4, n = n0_ + (tid & 15) * 4;
#pragma unroll
                for (int q = 0; q < 2; ++q) v[i][q] = (n < N_) ? *(const f32x4*)(W_ + (size_t)(k0_ + kk + 32 * q) * N_ + n) : (f32x4){0.f, 0.f, 0.f, 0.f}; } }
#pragma unroll
        for (int i = 0; i < 4; ++i) { const int vb = vb0 + i * G;
            if (vb < T_ALL) { float* tl = tile + i * (64 * 65); const int kk = tid >> 4, n4 = (tid & 15) * 4;
#pragma unroll
                for (int q = 0; q < 2; ++q) { const int k = kk + 32 * q; tl[k * 65 + n4] = v[i][q].x; tl[k * 65 + n4 + 1] = v[i][q].y; tl[k * 65 + n4 + 2] = v[i][q].z; tl[k * 65 + n4 + 3] = v[i][q].w; } } }
        __syncthreads();
#pragma unroll
        for (int i = 0; i < 4; ++i) { const int vb = vb0 + i * G;
            if (vb < T_ALL) { TR_DECODE(vb) (void)W_; (void)N_; const float* tl = tile + i * (64 * 65); const int n = tid >> 3, kc = (tid & 7) * 8;
                u32x4 o; o.x = pg8::cvt_pk_bf16(tl[(kc + 0) * 65 + n], tl[(kc + 1) * 65 + n]); o.y = pg8::cvt_pk_bf16(tl[(kc + 2) * 65 + n], tl[(kc + 3) * 65 + n]);
                o.z = pg8::cvt_pk_bf16(tl[(kc + 4) * 65 + n], tl[(kc + 5) * 65 + n]); o.w = pg8::cvt_pk_bf16(tl[(kc + 6) * 65 + n], tl[(kc + 7) * 65 + n]);
                *(u32x4*)(Wt_ + (size_t)(n0_ + n) * D + k0_ + kc) = o; } }
        __syncthreads();
    }
#undef TR_DECODE
}
__device__ __forceinline__ void ph_wo_pool(const float* w_out_all, const float* pool_w_all, const float* pool_scale_all, bf16* Wo_t_all, float* sm) { const int tidx = otid();
    const int tid = tidx; float* P = sm; float* Ws = sm + 64 * 65;
    for (int vb = (int)gridDim.x - 1 - (int)blockIdx.x; vb < DEPTH * 4 * 16; vb += gridDim.x) {
        const int l = vb >> 6, g = (vb >> 4) & 3, n0 = (vb & 15) * 64;
        const float* w_out = w_out_all + (size_t)l * D * D; const float* pool_w = pool_w_all + (size_t)l * 4 * 64 * 64; const float* pool_scale = pool_scale_all + (size_t)l * PW; bf16* Wo_t = Wo_t_all + (size_t)l * D * D;
        for (int i = tid; i < 4096; i += NT) { const int r = i >> 6, cc = i & 63; P[r * 65 + cc] = pool_w[(g * 64 + r) * 64 + cc] * pool_scale[g * 64 + cc]; Ws[r * 65 + cc] = w_out[(size_t)(768 + g * 64 + r) * D + n0 + cc]; }
        __syncthreads();
        { const int i = tid & 63, nq = tid >> 6;
#pragma unroll 1
          for (int nn = nq * 8; nn < nq * 8 + 8; ++nn) { float s = 0.f;
#pragma unroll 16
              for (int j = 0; j < 64; ++j) s += P[i * 65 + j] * Ws[j * 65 + nn];
              Wo_t[(size_t)(n0 + nn) * D + 768 + g * 64 + i] = f2bf(s); } }
        __syncthreads();
    }
}
__device__ __forceinline__ void ph_cvt(const float* src, bf16* dst, size_t n4) { const int tidx = otid();
    for (size_t i = (size_t)blockIdx.x * NT + tidx; i < n4; i += (size_t)gridDim.x * NT) {
        const f32x4 v = ((const f32x4*)src)[i]; ushort4 o; o.x = f2bf(v.x); o.y = f2bf(v.y); o.z = f2bf(v.z); o.w = f2bf(v.w); ((ushort4*)dst)[i] = o; }
}

template <bool BF> __device__ __forceinline__ f32x4 ld4res(const void* p, size_t idx) {
    if (BF) { const ushort4 v = *(const ushort4*)((const bf16*)p + idx); return (f32x4){bf2f(v.x), bf2f(v.y), bf2f(v.z), bf2f(v.w)}; }
    else return *(const f32x4*)((const float*)p + idx);
}
__device__ __forceinline__ void st4res(bf16* p, size_t idx, f32x4 v) { pg8::u32x2 o; o.x = pg8::cvt_pk_bf16(v.x, v.y); o.y = pg8::cvt_pk_bf16(v.z, v.w); *(pg8::u32x2*)(p + idx) = o; }

template <bool XQOUT, bool INBF>
__device__ __forceinline__ void ph_norm(const void* xlat, const void* xctx, const float* nw, const float* modl, int off_sh, int off_sc, bf16* act  , unsigned char* xq, float* xs, int nrows) { const int tidx = otid();
    const int lane = tidx & 63, wave = tidx >> 6;
    for (int row0 = (blockIdx.x * 8 + wave) * 2; row0 < nrows; row0 += gridDim.x * 16) {
        f32x4 v[2][4];
#pragma unroll
        for (int r = 0; r < 2; ++r) { const int row = row0 + r; const void* src = row < M_LAT ? xlat : xctx; const size_t rb = (size_t)(row < M_LAT ? row : row - M_LAT) * D;
#pragma unroll
            for (int j = 0; j < 4; ++j) v[r][j] = ld4res<INBF>(src, rb + (size_t)(lane + 64 * j) * 4); }
#pragma unroll
        for (int r = 0; r < 2; ++r) { const int row = row0 + r; const int mi = row < M_LAT ? row / S : 4;
            const float* sh = modl + (size_t)mi * 6 * D + off_sh; const float* sc = modl + (size_t)mi * 6 * D + off_sc;
            float ss = 0.f;
#pragma unroll
            for (int j = 0; j < 4; ++j) ss += v[r][j].x * v[r][j].x + v[r][j].y * v[r][j].y + v[r][j].z * v[r][j].z + v[r][j].w * v[r][j].w;
            ss = wave_sum(ss);
            const float rs = rsqrtf(ss * (1.f / D) + EPS);
            f32x4 hv[4]; float am = 0.f;
#pragma unroll
            for (int j = 0; j < 4; ++j) { const int k = (lane + 64 * j) * 4;
                const f32x4 w = *(const f32x4*)(nw + k), a = *(const f32x4*)(sc + k), b = *(const f32x4*)(sh + k);
                hv[j].x = v[r][j].x * rs * w.x * (1.f + a.x) + b.x; hv[j].y = v[r][j].y * rs * w.y * (1.f + a.y) + b.y; hv[j].z = v[r][j].z * rs * w.z * (1.f + a.z) + b.z; hv[j].w = v[r][j].w * rs * w.w * (1.f + a.w) + b.w;
                if (act) { ushort4 o; o.x = f2bf(hv[j].x); o.y = f2bf(hv[j].y); o.z = f2bf(hv[j].z); o.w = f2bf(hv[j].w);
                *(ushort4*)(act + (size_t)row * D + k) = o; }
                am = fmaxf(am, fmaxf(fmaxf(fabsf(hv[j].x), fabsf(hv[j].y)), fmaxf(fabsf(hv[j].z), fabsf(hv[j].w)))); }
            if (XQOUT) { am = wave_max(am); const float sx = am > 0.f ? am * (1.f / 127.f) : 1.f, inv = 1.f / sx;
#pragma unroll
                for (int j = 0; j < 4; ++j) { const int q0 = (int)rintf(hv[j].x * inv), q1 = (int)rintf(hv[j].y * inv), q2 = (int)rintf(hv[j].z * inv), q3 = (int)rintf(hv[j].w * inv);
                    *(unsigned*)(xq + (size_t)row * D + (lane + 64 * j) * 4) = (unsigned)(q0 & 0xff) | ((unsigned)(q1 & 0xff) << 8) | ((unsigned)(q2 & 0xff) << 16) | ((unsigned)(q3 & 0xff) << 24); }
                if (lane == 0) xs[row] = sx; }
        }
    }
}

struct EpiBf16Out {
    static constexpr bool PERM = true, AFTER_DRAIN = false;
    bf16* O; int ldc; int ncols;
    __device__ __forceinline__ void operator()(const pg8::f32x4 (&acc)[2][2][4][2], const pg8::Unit& u, int wr, int wc, int fr, int fq) const {
        const int row0 = u.pm * 256 + wr * 64 + fr, col0 = u.pn * 256 + wc * 32 + 8 * fq;
#pragma unroll
        for (int ai = 0; ai < 2; ++ai)
#pragma unroll
            for (int m = 0; m < 4; ++m) { bf16* rowp = O + (size_t)(row0 + ai * 128 + m * 16) * ldc + col0;
#pragma unroll
                for (int bj = 0; bj < 2; ++bj) { if (col0 + bj * 128 < ncols) { const pg8::f32x4 v0 = acc[ai][bj][m][0], v1 = acc[ai][bj][m][1];
                    u32x4 w; w.x = pg8::cvt_pk_bf16(v0[0], v0[1]); w.y = pg8::cvt_pk_bf16(v0[2], v0[3]); w.z = pg8::cvt_pk_bf16(v1[0], v1[1]); w.w = pg8::cvt_pk_bf16(v1[2], v1[3]);
                    *(u32x4*)(rowp + bj * 128) = w; } } }
    }
};
#ifndef NT_STORE
#define NT_STORE 0
#endif
struct EpiI8Bf16Out {
    static constexpr bool PERM = true, AFTER_DRAIN = false;
    bf16* O; int ldc; int ncols; const float* sa; const float* sb;
    __device__ __forceinline__ void operator()(const pg8::i32x4 (&acc)[2][2][4][2], const pg8::Unit& u, int wr, int wc, int fr, int fq) const {
        const int row0 = u.pm * 256 + wr * 64 + fr, col0 = u.pn * 256 + wc * 32 + 8 * fq;
        f32x4 sbv[2][2];
#pragma unroll
        for (int bj = 0; bj < 2; ++bj) { sbv[bj][0] = *(const f32x4*)(sb + col0 + bj * 128); sbv[bj][1] = *(const f32x4*)(sb + col0 + bj * 128 + 4); }
        float srv[2][4];
#pragma unroll
        for (int ai = 0; ai < 2; ++ai)
#pragma unroll
            for (int m = 0; m < 4; ++m) srv[ai][m] = sa[row0 + ai * 128 + m * 16];
#pragma unroll
        for (int ai = 0; ai < 2; ++ai)
#pragma unroll
            for (int m = 0; m < 4; ++m) { const int row = row0 + ai * 128 + m * 16; const float sr = srv[ai][m]; bf16* rowp = O + (size_t)row * ldc + col0;
#pragma unroll
                for (int bj = 0; bj < 2; ++bj) { if (col0 + bj * 128 < ncols) { const pg8::i32x4 v0 = acc[ai][bj][m][0], v1 = acc[ai][bj][m][1]; const f32x4 s0 = sbv[bj][0] * sr, s1 = sbv[bj][1] * sr;
                    u32x4 w; w.x = pg8::cvt_pk_bf16((float)v0[0] * s0.x, (float)v0[1] * s0.y); w.y = pg8::cvt_pk_bf16((float)v0[2] * s0.z, (float)v0[3] * s0.w);
                    w.z = pg8::cvt_pk_bf16((float)v1[0] * s1.x, (float)v1[1] * s1.y); w.w = pg8::cvt_pk_bf16((float)v1[2] * s1.z, (float)v1[3] * s1.w);
                    if (NT_STORE) __builtin_nontemporal_store(w, (u32x4*)(rowp + bj * 128)); else *(u32x4*)(rowp + bj * 128) = w; } } }
    }
};
struct EpiI8QT {
    static constexpr bool PERM = true, AFTER_DRAIN = false;
    bf16* O; const float* sa; const float* sb;
    __device__ __forceinline__ void operator()(const pg8::i32x4 (&acc)[2][2][4][2], const pg8::Unit& u, int wr, int wc, int fr, int fq) const {
        const int row0 = u.pm * 256 + wr * 64 + fr, col0 = u.pn * 256 + wc * 32 + 8 * fq;
        f32x4 sbv[2][2];
#pragma unroll
        for (int bj = 0; bj < 2; ++bj) { sbv[bj][0] = *(const f32x4*)(sb + col0 + bj * 128); sbv[bj][1] = *(const f32x4*)(sb + col0 + bj * 128 + 4); }
        float srv[2][4];
#pragma unroll
        for (int ai = 0; ai < 2; ++ai)
#pragma unroll
            for (int m = 0; m < 4; ++m) srv[ai][m] = sa[row0 + ai * 128 + m * 16];
        const int sfrag = (2 * wc + (fq >> 1)) * 512 + (fq & 1) * 256;
#pragma unroll
        for (int ai = 0; ai < 2; ++ai)
#pragma unroll
            for (int m = 0; m < 4; ++m) { const int row = row0 + ai * 128 + m * 16; const float sr = srv[ai][m];
#pragma unroll
                for (int bj = 0; bj < 2; ++bj) { const pg8::i32x4 v0 = acc[ai][bj][m][0], v1 = acc[ai][bj][m][1]; const f32x4 s0 = sbv[bj][0] * sr, s1 = sbv[bj][1] * sr;
                    u32x4 w; w.x = pg8::cvt_pk_bf16((float)v0[0] * s0.x, (float)v0[1] * s0.y); w.y = pg8::cvt_pk_bf16((float)v0[2] * s0.z, (float)v0[3] * s0.w);
                    w.z = pg8::cvt_pk_bf16((float)v1[0] * s1.x, (float)v1[1] * s1.y); w.w = pg8::cvt_pk_bf16((float)v1[2] * s1.z, (float)v1[3] * s1.w);
                    *(u32x4*)(O + ((size_t)(((row >> 5) * PH + u.pn) * 2 + bj)) * 4096 + sfrag + (row & 31) * 8) = w; } }
    }
};
template <bool INBF>
struct EpiRes {
    static constexpr bool PERM = false, AFTER_DRAIN = false;
    const void* xin_lat; const void* xin_ctx; bf16* xout_lat; bf16* xout_ctx; const float* modl; int off_g;
    __device__ __forceinline__ void operator()(const pg8::f32x4 (&acc)[2][2][4][2], const pg8::Unit& u, int wr, int wc, int fr, int fq) const {
        const int r0 = u.pm * 256; const bool lat = r0 < M_LAT; const int mi = lat ? r0 / S : 4;
        const void* xin = lat ? xin_lat : xin_ctx; bf16* xout = lat ? xout_lat : xout_ctx;
        const size_t rbase = (size_t)(lat ? r0 : r0 - M_LAT) * D;
        const int col0 = u.pn * 256 + wc * 32 + 4 * fq;
        const float* gp = modl + (size_t)mi * 6 * D + off_g + col0;
        f32x4 gv[2][2];
#pragma unroll
        for (int bj = 0; bj < 2; ++bj)
#pragma unroll
            for (int n = 0; n < 2; ++n) gv[bj][n] = *(const f32x4*)(gp + bj * 128 + n * 16);
#pragma unroll
        for (int ai = 0; ai < 2; ++ai) {
            f32x4 xi[4][2][2];
#pragma unroll
            for (int mm = 0; mm < 4; ++mm) { const size_t off = rbase + (size_t)(ai * 128 + wr * 64 + mm * 16 + fr) * D + col0;
#pragma unroll
                for (int bj = 0; bj < 2; ++bj)
#pragma unroll
                    for (int n = 0; n < 2; ++n) xi[mm][bj][n] = ld4res<INBF>(xin, off + bj * 128 + n * 16); }
#pragma unroll
            for (int mm = 0; mm < 4; ++mm) { const size_t off = rbase + (size_t)(ai * 128 + wr * 64 + mm * 16 + fr) * D + col0;
#pragma unroll
                for (int bj = 0; bj < 2; ++bj)
#pragma unroll
                    for (int n = 0; n < 2; ++n) { const pg8::f32x4 a = acc[ai][bj][mm][n]; const f32x4 gq = gv[bj][n], x4 = xi[mm][bj][n]; f32x4 o;
                        o.x = x4.x + gq.x * a[0]; o.y = x4.y + gq.y * a[1]; o.z = x4.z + gq.z * a[2]; o.w = x4.w + gq.w * a[3];
                        st4res(xout, off + bj * 128 + n * 16, o); } }
            asm volatile("" ::: "memory");
        }
    }
};

template <int EPI>
__device__ __forceinline__ void ph_gemm_simple(const bf16* A, const bf16* Bt, int M, int N, int K, bf16* Cb, int ldc, int ncols,
                                               const float* xin_lat, const float* xin_ctx, float* xout_lat, float* xout_ctx, const float* modl, int off_g, bf16* sm  ) { const int tidx = otid();
    bf16 (*sA)[40] = (bf16 (*)[40])sm; bf16 (*sB)[40] = (bf16 (*)[40])(sm + 128 * 40);
    const int tid = tidx, w = tid >> 6, lane = tid & 63, fr = lane & 15, fq = lane >> 4;
    const int lr = tid >> 2, lc = (tid & 3) * 8;
    const int nbn = N / 64, nvb = (M / 128) * nbn;
    for (int vb = blockIdx.x; vb < nvb; vb += gridDim.x) {
        const int m0 = (vb / nbn) * 128, n0 = (vb % nbn) * 64;
        f32x4 acc[4];
#pragma unroll
        for (int j = 0; j < 4; ++j) acc[j] = (f32x4){0.f, 0.f, 0.f, 0.f};
        for (int k0 = 0; k0 < K; k0 += 32) {
            *(bf16x8*)&sA[lr][lc] = *(const bf16x8*)(A + (size_t)(m0 + lr) * K + k0 + lc);
            if (tid < 256) *(bf16x8*)&sB[lr][lc] = *(const bf16x8*)(Bt + (size_t)(n0 + lr) * K + k0 + lc);
            __syncthreads();
            const bf16x8 a = *(const bf16x8*)&sA[w * 16 + fr][fq * 8];
#pragma unroll
            for (int j = 0; j < 4; ++j) { const bf16x8 b = *(const bf16x8*)&sB[j * 16 + fr][fq * 8]; acc[j] = __builtin_amdgcn_mfma_f32_16x16x32_bf16(a, b, acc[j], 0, 0, 0); }
            __syncthreads();
        }
#pragma unroll
        for (int j = 0; j < 4; ++j)
#pragma unroll
            for (int i = 0; i < 4; ++i) {
                const int row = m0 + w * 16 + fq * 4 + i, col = n0 + j * 16 + fr;
                if (EPI == 0) { if (col < ncols) Cb[(size_t)row * ldc + col] = f2bf(acc[j][i]); }
                else { const int mi = row < M_LAT ? row / S : 4; const float g = modl[(size_t)mi * 6 * D + off_g + col];
                    if (row < M_LAT) xout_lat[(size_t)row * D + col] = xin_lat[(size_t)row * D + col] + g * acc[j][i];
                    else { const size_t o = (size_t)(row - M_LAT) * D + col; xout_ctx[o] = xin_ctx[o] + g * acc[j][i]; } }
            }
    }
}

__device__ __forceinline__ void ph_na(const bf16* px, const float* rpb  , bf16* act, int nrows) { const int tidx = otid();
    for (int gid = blockIdx.x * NT + tidx; gid < nrows * NAH; gid += gridDim.x * NT) {
        const int row = gid / NAH, h = gid % NAH;
        float q[64], o[64];
        const bf16* qp = px + (size_t)row * DPROJ + O_NA_Q + h * 64;
#pragma unroll
        for (int d = 0; d < 64; ++d) { q[d] = bf2f(qp[d]) * 0.125f; o[d] = 0.f; }
        float mx = -1e30f, den = 0.f;
        int b, nwin = 0, rr = 0, cq = 0, r_start = 0, c_start = 0;
        if (row < M_LAT) { b = row / S; const int t = row % S; rr = t / GW; cq = t % GW; r_start = min(max(rr - 4, 0), 128 - 8); c_start = min(max(cq - 8, 0), GW - 16); nwin = 128; }
        else b = (row - M_LAT) / CTX;
        for (int i = 0; i < nwin + CTX; ++i) {
            int krow; float bias = 0.f;
            if (i < nwin) { const int j = i / 16, kc = c_start + (i % 16), kr = r_start + j; krow = b * S + kr * GW + kc;
                bias = rpb[(h * 15 + (kr - rr + 7)) * 31 + (kc - cq + 15)]; }
            else krow = M_LAT + b * CTX + (i - nwin);
            const bf16* kp = px + (size_t)krow * DPROJ + O_NA_K + h * 64;
            float s = 0.f;
#pragma unroll
            for (int d = 0; d < 64; ++d) s += q[d] * bf2f(kp[d]);
            s += bias;
            const float nm = fmaxf(mx, s), corr = __expf(mx - nm), p = __expf(s - nm);
            den = den * corr + p; mx = nm;
            const bf16* vp = px + (size_t)krow * DPROJ + O_NA_V + h * 64;
#pragma unroll
            for (int d = 0; d < 64; ++d) o[d] = o[d] * corr + p * bf2f(vp[d]);
        }
        const float inv = 1.f / den;
        bf16* op = act + (size_t)row * D + h * 64;
#pragma unroll
        for (int d = 0; d < 64; ++d) op[d] = f2bf(o[d] * inv);
    }
}

typedef short s16x4 __attribute__((ext_vector_type(4)));
typedef __attribute__((address_space(3))) const unsigned char* lds_cp;
__device__ __forceinline__ s16x4 vtr(lds_cp p) { return __builtin_bit_cast(s16x4, __builtin_amdgcn_ds_read_tr16_b64_v4i16((__attribute__((address_space(3))) s16x4*)p)); }
__device__ __forceinline__ float xq_max(float x) {
    auto s = __builtin_amdgcn_permlane16_swap(__float_as_uint(x), __float_as_uint(x), false, false);
    x = fmaxf(__uint_as_float(s[0]), __uint_as_float(s[1]));
    auto t = __builtin_amdgcn_permlane32_swap(__float_as_uint(x), __float_as_uint(x), false, false);
    return fmaxf(__uint_as_float(t[0]), __uint_as_float(t[1]));
}
__device__ __forceinline__ float xq_sum(float x) {
    auto s = __builtin_amdgcn_permlane16_swap(__float_as_uint(x), __float_as_uint(x), false, false);
    x = __uint_as_float(s[0]) + __uint_as_float(s[1]);
    auto t = __builtin_amdgcn_permlane32_swap(__float_as_uint(x), __float_as_uint(x), false, false);
    return __uint_as_float(t[0]) + __uint_as_float(t[1]);
}
__device__ __forceinline__ void lds_barrier() { __builtin_amdgcn_s_waitcnt(0xC07F); __builtin_amdgcn_s_barrier(); }
constexpr int NA_ROWB = 160;
constexpr int NA_KOFF = 0, NA_VOFF = 2 * 64 * NA_ROWB, NA_BOFF = 4 * 64 * NA_ROWB;
__device__ __forceinline__ void ph_na_mfma(const bf16* px, const float* rpb  , bf16* act, int nunits, unsigned char* ldsg) { const int tidx = otid();
    const int lane = tidx & 63, w = __builtin_amdgcn_readfirstlane(tidx >> 6), fr = lane & 15, quad = lane >> 4;
    const lds_cp lds = (lds_cp)ldsg;
    float* sbias = (float*)(ldsg + NA_BOFF);
    constexpr float LOG2E = 1.4426950408889634f;
    const int skey = tidx >> 3, spiece = tidx & 7;
    const int G_ = gridDim.x, vcu = (G_ % 8 == 0) ? ((int)blockIdx.x % 8) * (G_ / 8) + (int)blockIdx.x / 8 : (int)blockIdx.x;
    for (int u = vcu; u < nunits; u += G_) {
        int b, h, wr0 = 0, nwin = 0, rq = 0, g = 0, rs_q = 0, qrow;
        const bool latent = u < 1536;
        if (latent) { b = u / 384; h = (u / 64) % 6; const int rp = u % 64;
            wr0 = min(max(2 * rp - 4, 0), 120); const int rs1 = min(max(2 * rp - 3, 0), 120); nwin = rs1 + 8 - wr0;
            rq = 2 * rp + (w >> 2); g = w & 3; rs_q = min(max(rq - 4, 0), 120); qrow = b * S + rq * GW + 16 * g + fr; }
        else { const int cu = u - 1536; b = cu / 12; h = (cu >> 1) % 6; qrow = M_LAT + b * CTX + (cu & 1) * 128 + 16 * w + fr; }
        const int nchunks = 4 + nwin;
        const int cq = 16 * g + fr, c_start = min(max(cq - 8, 0), 48);
        lds_barrier();
        for (int i = tidx; i < 480; i += NT) sbias[i] = (i & 31) < 31 ? rpb[h * 465 + (i >> 5) * 31 + (i & 31)] * LOG2E : -1e30f;
        bf16x8 qf[2];
        qf[0] = *(const bf16x8*)(px + (size_t)qrow * DPROJ + O_NA_Q + h * 64 + 8 * quad);
        qf[1] = *(const bf16x8*)(px + (size_t)qrow * DPROJ + O_NA_Q + h * 64 + 32 + 8 * quad);
        u32x4 kreg, vreg;
        { const size_t r = (size_t)(M_LAT + b * CTX + skey);
          kreg = *(const u32x4*)(px + r * DPROJ + O_NA_K + h * 64 + spiece * 8); vreg = *(const u32x4*)(px + r * DPROJ + O_NA_V + h * 64 + spiece * 8); }
        *(u32x4*)(ldsg + NA_KOFF + skey * NA_ROWB + spiece * 16) = kreg; *(u32x4*)(ldsg + NA_VOFF + skey * NA_ROWB + spiece * 16) = vreg;
        lds_barrier();
        f32x4 O[4];
#pragma unroll
        for (int dt = 0; dt < 4; ++dt) O[dt] = (f32x4){0.f, 0.f, 0.f, 0.f};
        float m = -1e30f, lsum = 0.f;
        const int cbase = 4 * quad - cq + 15;
        const int vbase = 4 * quad - c_start;
        const int c0 = min(max(16 * g - 8, 0), 32);
        int boff[8];
#pragma unroll
        for (int e = 0; e < 8; ++e) { const int ce = c0 + 16 * (e >> 2) + (e & 3); boff[e] = ((unsigned)(vbase + ce) < 16u) ? 4 * min(max(cbase + ce, 0), 30) : 4 * 31; }
        for (int c = 0; c < nchunks; ++c) {
            const int buf = c & 1;
            if (c + 1 < nchunks) { const int c1 = c + 1; const size_t r = c1 < 4 ? (size_t)(M_LAT + b * CTX + 64 * c1 + skey) : (size_t)(b * S + (wr0 + c1 - 4) * GW + skey);
                kreg = *(const u32x4*)(px + r * DPROJ + O_NA_K + h * 64 + spiece * 8); vreg = *(const u32x4*)(px + r * DPROJ + O_NA_V + h * 64 + spiece * 8); }
            const bool isctx = c < 4; const int kr = wr0 + c - 4;
            const bool use = isctx || (kr >= rs_q && kr < rs_q + 8);
            if (use) {
                const lds_cp kb = lds + NA_KOFF + buf * 64 * NA_ROWB, vb = lds + NA_VOFF + buf * 64 * NA_ROWB;
                const char* brow = (const char*)(sbias + (kr - rq + 7) * 32);
#pragma unroll
                for (int pair = 0; pair < 2; ++pair) {
                    if (!isctx && pair == 1) continue;
                    const int kofs = isctx ? 32 * pair : c0;
                    f32x4 a0 = (f32x4){0.f, 0.f, 0.f, 0.f}, a1 = a0;
#pragma unroll
                    for (int s = 0; s < 2; ++s) {
                        const bf16x8 k0 = *(const __attribute__((address_space(3))) bf16x8*)(kb + (kofs + fr) * NA_ROWB + 64 * s + 16 * quad);
                        const bf16x8 k1 = *(const __attribute__((address_space(3))) bf16x8*)(kb + (kofs + 16 + fr) * NA_ROWB + 64 * s + 16 * quad);
                        a0 = __builtin_amdgcn_mfma_f32_16x16x32_bf16(k0, qf[s], a0, 0, 0, 0);
                        a1 = __builtin_amdgcn_mfma_f32_16x16x32_bf16(k1, qf[s], a1, 0, 0, 0);
                    }
                    typedef float f32x2 __attribute__((ext_vector_type(2)));
                    f32x2 s2[4];
                    { float sc[8];
                      if (isctx) {
#pragma unroll
                          for (int i = 0; i < 4; ++i) { sc[i] = a0[i] * (0.125f * LOG2E); sc[4 + i] = a1[i] * (0.125f * LOG2E); }
                      } else {
#pragma unroll
                          for (int e = 0; e < 8; ++e) { const float bm = *(const float*)(brow + boff[e]);
                              sc[e] = __builtin_fmaf(e < 4 ? a0[e & 3] : a1[e & 3], 0.125f * LOG2E, bm); }
                      }
#pragma unroll
                      for (int k = 0; k < 4; ++k) s2[k] = (f32x2){sc[2 * k], sc[2 * k + 1]}; }
                    float mx = __builtin_fmaxf(__builtin_fmaxf(__builtin_fmaxf(s2[0].x, s2[0].y), __builtin_fmaxf(s2[1].x, s2[1].y)), __builtin_fmaxf(__builtin_fmaxf(s2[2].x, s2[2].y), __builtin_fmaxf(s2[3].x, s2[3].y)));
                    mx = xq_max(mx);
                    if (__any(mx > m + 6.f)) {
                        const float mn = fmaxf(m, mx), corr = __builtin_amdgcn_exp2f(m - mn); m = mn;
                        lsum *= corr;
#pragma unroll
                        for (int dt = 0; dt < 4; ++dt) O[dt] = O[dt] * corr;
                    }
                    float p[8];
                    { const f32x2 m2 = (f32x2){m, m}; f32x2 p2[4];
#pragma unroll
                      for (int k = 0; k < 4; ++k) { const f32x2 t = s2[k] - m2; p2[k] = (f32x2){__builtin_amdgcn_exp2f(t.x), __builtin_amdgcn_exp2f(t.y)}; p[2 * k] = p2[k].x; p[2 * k + 1] = p2[k].y; }
                      const f32x2 q2 = (p2[0] + p2[1]) + (p2[2] + p2[3]); lsum += q2.x + q2.y; }
                    u32x4 pk; pk.x = pg8::cvt_pk_bf16_n(p[0], p[1]); pk.y = pg8::cvt_pk_bf16_n(p[2], p[3]); pk.z = pg8::cvt_pk_bf16_n(p[4], p[5]); pk.w = pg8::cvt_pk_bf16_n(p[6], p[7]);
                    const bf16x8 pb = __builtin_bit_cast(bf16x8, pk);
#pragma unroll
                    for (int dt = 0; dt < 4; ++dt) {
                        const lds_cp va = vb + (kofs + 4 * quad + (fr >> 2)) * NA_ROWB + (16 * dt + 4 * (fr & 3)) * 2;
                        const s16x4 v0 = vtr(va), v1 = vtr(va + 16 * NA_ROWB);
                        bf16x8 A; A[0] = v0[0]; A[1] = v0[1]; A[2] = v0[2]; A[3] = v0[3]; A[4] = v1[0]; A[5] = v1[1]; A[6] = v1[2]; A[7] = v1[3];
                        O[dt] = __builtin_amdgcn_mfma_f32_16x16x32_bf16(A, pb, O[dt], 0, 0, 0);
                    }
                }
            }
            if (c + 1 < nchunks) { const int nb = (c + 1) & 1;
                *(u32x4*)(ldsg + NA_KOFF + nb * 64 * NA_ROWB + skey * NA_ROWB + spiece * 16) = kreg; *(u32x4*)(ldsg + NA_VOFF + nb * 64 * NA_ROWB + skey * NA_ROWB + spiece * 16) = vreg; }
            lds_barrier();
        }
        const float inv = 1.f / xq_sum(lsum);
        bf16* op = act + (size_t)qrow * D + h * 64 + 4 * quad;
#pragma unroll
        for (int dt = 0; dt < 4; ++dt) { pg8::u32x2 o; o.x = pg8::cvt_pk_bf16(O[dt][0] * inv, O[dt][1] * inv); o.y = pg8::cvt_pk_bf16(O[dt][2] * inv, O[dt][3] * inv); *(pg8::u32x2*)(op + 16 * dt) = o; }
    }
}
template <int W>
__device__ __forceinline__ void pool_item(const bf16* px, bf16* act, int row, int oc) {
    int t, T, base;
    if (row < M_LAT) { t = row % S; T = S; base = row - t; } else { t = (row - M_LAT) % CTX; T = CTX; base = row - t; }
    const int lo = max(t - W / 2, 0), hi = min(t + W / 2, T);
    bf16x8 tv[W];
#pragma unroll
    for (int i = 0; i < W; ++i) { const int tt = min(lo + i, hi - 1); tv[i] = *(const bf16x8*)(px + (size_t)(base + tt) * DPROJ + O_POOL + oc * 8); }
    const bf16x8 xv = *(const bf16x8*)(px + (size_t)row * DPROJ + O_POOL + oc * 8);
    float s[8];
#pragma unroll
    for (int j = 0; j < 8; ++j) s[j] = 0.f;
#pragma unroll
    for (int i = 0; i < W; ++i) { const float wgt = (lo + i < hi) ? 1.f : 0.f;
#pragma unroll
        for (int j = 0; j < 8; ++j) s[j] += wgt * bf2f((bf16)tv[i][j]); }
    const float inv = 1.f / (float)(hi - lo);
    u32x4 o; o.x = pg8::cvt_pk_bf16(s[0] * inv - bf2f((bf16)xv[0]), s[1] * inv - bf2f((bf16)xv[1])); o.y = pg8::cvt_pk_bf16(s[2] * inv - bf2f((bf16)xv[2]), s[3] * inv - bf2f((bf16)xv[3]));
    o.z = pg8::cvt_pk_bf16(s[4] * inv - bf2f((bf16)xv[4]), s[5] * inv - bf2f((bf16)xv[5])); o.w = pg8::cvt_pk_bf16(s[6] * inv - bf2f((bf16)xv[6]), s[7] * inv - bf2f((bf16)xv[7]));
    *(u32x4*)(act + (size_t)row * D + 768 + oc * 8) = o;
}
__device__ __forceinline__ void ph_pool(const bf16* px, bf16* act, int nrows) { const int tidx = otid();
    const int per = nrows * 8;
    for (int gid = blockIdx.x * NT + tidx; gid < 4 * per; gid += gridDim.x * NT) {
        const int g = gid / per, r = gid - g * per, row = r >> 3, oc = g * 8 + (r & 7);
        if (g == 0) pool_item<2>(px, act, row, oc); else if (g == 1) pool_item<4>(px, act, row, oc); else if (g == 2) pool_item<8>(px, act, row, oc); else pool_item<16>(px, act, row, oc);
    }
}
__device__ __forceinline__ float rope_elem(const bf16* p, int d, const float* cs, const float* sn, bool rope) {
    const float x = bf2f(p[d]);
    if (!rope) return x;
    const int half = d >> 5, dd = d & 31, j = dd & 15;
    const float c = cs[half * 16 + j], s = sn[half * 16 + j];
    if (dd < 16) { const float x2 = bf2f(p[d + 16]); return x * c - x2 * s; }
    else { const float x1 = bf2f(p[d - 16]); return x1 * s + x * c; }
}
__device__ __forceinline__ int chunk_row0(int b, int ci) { return ci < 64 ? b * S + ci * 128 : M_LAT + b * CTX + (ci - 64) * 128; }
__device__ __forceinline__ void load_kv_chunk(const bf16* px, const float* cosT, const float* sinT, int b, int h, int ci, float* sk, float* sv) { const int tidx = otid();
    const int row0 = chunk_row0(b, ci); const bool rope = ci < 64;
    for (int i = tidx; i < 128 * 64; i += NT) { const int m = i / 64, d = i % 64, row = row0 + m; const int t = rope ? (ci * 128 + m) : 0;
        sk[i] = rope_elem(px + (size_t)row * DPROJ + O_RET_K + h * 64, d, cosT + t * 32, sinT + t * 32, rope) * 0.125f;
        sv[i] = bf2f(px[(size_t)row * DPROJ + O_RET_V + h * 64 + d]); }
}
__device__ __forceinline__ void ph_ret_state(const bf16* px, const float* cosT, const float* sinT, const float* dec_f, const float* dec_b, float* ST, float* sm) { const int tidx = otid();
    float* sk = sm; float* sv = sm + 128 * 64;
    for (int vb = blockIdx.x; vb < NB * RH * NCH; vb += gridDim.x) {
        const int ci = vb % NCH, h = (vb / NCH) % RH, b = vb / (NCH * RH);
        load_kv_chunk(px, cosT, sinT, b, h, ci, sk, sv);
        __syncthreads();
        const float lgf = -log1pf(expf(-dec_f[h])), lgb = -log1pf(expf(-dec_b[h]));
        for (int i = tidx; i < 4096; i += NT) { const int d = i / 64, e = i % 64;
            float af = 0.f, ab = 0.f;
            for (int m = 0; m < 128; ++m) { const float kv = sk[m * 64 + d] * sv[m * 64 + e]; af += expf((127.f - m) * lgf) * kv; ab += expf((float)m * lgb) * kv; }
            ST[((((size_t)(b * RH + h) * 2 + 0) * NCH + ci) * 4096) + i] = af; ST[((((size_t)(b * RH + h) * 2 + 1) * NCH + ci) * 4096) + i] = ab; }
        __syncthreads();
    }
}
__device__ __forceinline__ void ph_ret_scan(const float* dec_f, const float* dec_b, float* ST) { const int tidx = otid();
    for (int gid = blockIdx.x * NT + tidx; gid < NB * RH * 2 * 4096; gid += gridDim.x * NT) {
        const int e = gid % 4096, dir = (gid / 4096) & 1, bh = gid / 8192, h = bh % RH;
        const float lg = -log1pf(expf(-(dir ? dec_b[h] : dec_f[h]))), gg = expf(128.f * lg);
        float* P = ST + ((size_t)bh * 2 + dir) * NCH * 4096 + e;
        float t[64];
#pragma unroll
        for (int c = 0; c < 64; ++c) t[c] = P[(size_t)c * 4096];
        const float k0 = P[(size_t)64 * 4096], k1 = P[(size_t)65 * 4096];
        if (dir == 0) { P[(size_t)64 * 4096] = 0.f; P[(size_t)65 * 4096] = k0; float R = gg * k0 + k1;
#pragma unroll
            for (int c = 0; c < 64; ++c) { const float v = t[c]; t[c] = R; R = gg * R + v; } }
        else { P[(size_t)65 * 4096] = 0.f; P[(size_t)64 * 4096] = k1; float R = k0 + gg * k1;
#pragma unroll
            for (int c = 63; c >= 0; --c) { const float v = t[c]; t[c] = R; R = gg * R + v; } }
#pragma unroll
        for (int c = 0; c < 64; ++c) P[(size_t)c * 4096] = t[c];
    }
}
__device__ __forceinline__ void ph_ret_scan_bf(const float* dec_f, const float* dec_b, bf16* ST) { const int tidx = otid();
    for (int gid = blockIdx.x * NT + tidx; gid < NB * RH * 2 * 2048; gid += gridDim.x * NT) {
        const int e2 = gid % 2048, dir = (gid / 2048) & 1, bh = gid / 4096, h = bh % RH;
        const float lg = -log1pf(expf(-(dir ? dec_b[h] : dec_f[h]))), gg = expf(128.f * lg);
        unsigned* P = (unsigned*)(ST + ((size_t)bh * 2 + dir) * NCH * 4096) + e2;
        unsigned t[64];
#pragma unroll
        for (int c = 0; c < 64; ++c) t[c] = P[(size_t)c * 2048];
        const unsigned k0 = P[(size_t)64 * 2048], k1 = P[(size_t)65 * 2048];
        const float k0x = __uint_as_float(k0 << 16), k0y = __uint_as_float(k0 & 0xffff0000u), k1x = __uint_as_float(k1 << 16), k1y = __uint_as_float(k1 & 0xffff0000u);
        if (dir == 0) { P[(size_t)64 * 2048] = 0u; P[(size_t)65 * 2048] = k0; float Rx = gg * k0x + k1x, Ry = gg * k0y + k1y;
#pragma unroll
            for (int c = 0; c < 64; ++c) { const unsigned v = t[c]; t[c] = pg8::cvt_pk_bf16(Rx, Ry); Rx = gg * Rx + __uint_as_float(v << 16); Ry = gg * Ry + __uint_as_float(v & 0xffff0000u); } }
        else { P[(size_t)65 * 2048] = 0u; P[(size_t)64 * 2048] = k1; float Rx = k0x + gg * k1x, Ry = k0y + gg * k1y;
#pragma unroll
            for (int c = 63; c >= 0; --c) { const unsigned v = t[c]; t[c] = pg8::cvt_pk_bf16(Rx, Ry); Rx = gg * Rx + __uint_as_float(v << 16); Ry = gg * Ry + __uint_as_float(v & 0xffff0000u); } }
#pragma unroll
        for (int c = 0; c < 64; ++c) P[(size_t)c * 2048] = t[c];
    }
}
__device__ __forceinline__ void ph_ret_out(const bf16* px, const float* cosT, const float* sinT, const float* dec_f, const float* dec_b, const float* ST, const float* gn_w, bf16* act, int nci, float* sm) { const int tidx = otid();
    float* sk = sm; float* sv = sm + 128 * 64; float* sy = sm + 2 * 128 * 64; float* sq = sy + 128 * 65;
    const int n = tidx & 127, eq = tidx >> 7;
    for (int vb = blockIdx.x; vb < NB * RH * nci; vb += gridDim.x) {
        const int ci = vb % nci, h = (vb / nci) % RH, b = vb / (nci * RH);
        const int row0 = chunk_row0(b, ci); const bool rope = ci < 64;
        load_kv_chunk(px, cosT, sinT, b, h, ci, sk, sv);
        __syncthreads();
        const int row = row0 + n; const int t = rope ? (ci * 128 + n) : 0;
        const float lgf = -log1pf(expf(-dec_f[h])), lgb = -log1pf(expf(-dec_b[h]));
        float q[64], y[16];
#pragma unroll
        for (int d = 0; d < 64; ++d) { q[d] = rope_elem(px + (size_t)row * DPROJ + O_RET_Q + h * 64, d, cosT + t * 32, sinT + t * 32, rope); if (eq == 0) sq[n * 65 + d] = q[d]; }
        __syncthreads();
#pragma unroll
        for (int e = 0; e < 16; ++e) y[e] = 0.f;
        for (int m = 0; m < 128; ++m) {
            float s = 0.f;
#pragma unroll
            for (int d = 0; d < 64; ++d) s += q[d] * sk[m * 64 + d];
            const float dm = m < n ? expf((float)(n - m) * lgf) : (m > n ? expf((float)(m - n) * lgb) : 2.f);
            s *= dm;
#pragma unroll
            for (int e = 0; e < 16; ++e) y[e] += s * sv[m * 64 + eq * 16 + e];
        }
        const float* Sf = ST + (((size_t)(b * RH + h) * 2 + 0) * NCH + ci) * 4096 + eq * 16; const float* Sb = ST + (((size_t)(b * RH + h) * 2 + 1) * NCH + ci) * 4096 + eq * 16;
        const float xf = expf((float)(n + 1) * lgf), xb = expf((float)(128 - n) * lgb);
#pragma unroll 1
        for (int d = 0; d < 64; ++d) { const float qd = sq[n * 65 + d]; const float qf = qd * xf, qb = qd * xb;
#pragma unroll
            for (int e = 0; e < 16; ++e) y[e] += qf * Sf[d * 64 + e] + qb * Sb[d * 64 + e]; }
#pragma unroll
        for (int e = 0; e < 16; ++e) sy[n * 65 + eq * 16 + e] = y[e];
        __syncthreads();
        float mu = 0.f;
        for (int e = 0; e < 64; ++e) mu += sy[n * 65 + e];
        mu *= (1.f / 64.f); float var = 0.f;
        for (int e = 0; e < 64; ++e) { const float dd = sy[n * 65 + e] - mu; var += dd * dd; }
        const float rs = rsqrtf(var * (1.f / 64.f) + EPS);
        const bf16* gp = px + (size_t)row * DPROJ + O_RET_G + h * 64 + eq * 16; bf16* op = act + (size_t)row * D + NAW + h * 64 + eq * 16;
#pragma unroll
        for (int e = 0; e < 16; ++e) { const float g = bf2f(gp[e]); op[e] = f2bf((y[e] - mu) * rs * gn_w[h * 64 + eq * 16 + e] * silu(g)); }
        __syncthreads();
    }
}


__device__ __forceinline__ void rope8(const bf16* hp, int piece, const float* cs, const float* sn, bool rope, float (&o)[8]) {
    const bf16x8 own = *(const bf16x8*)(hp + piece * 8);
    if (!rope) {
#pragma unroll
        for (int j = 0; j < 8; ++j) o[j] = bf2f((bf16)own[j]);
        return; }
    const bf16x8 par = *(const bf16x8*)(hp + (piece ^ 2) * 8);
    const int half = piece >> 2, pp = piece & 3, tb = half * 16 + 8 * (pp & 1);
    const f32x4 c0 = *(const f32x4*)(cs + tb), c1 = *(const f32x4*)(cs + tb + 4), s0 = *(const f32x4*)(sn + tb), s1 = *(const f32x4*)(sn + tb + 4);
    const float c[8] = {c0.x, c0.y, c0.z, c0.w, c1.x, c1.y, c1.z, c1.w}, s[8] = {s0.x, s0.y, s0.z, s0.w, s1.x, s1.y, s1.z, s1.w};
#pragma unroll
    for (int j = 0; j < 8; ++j) { const float a = bf2f((bf16)own[j]), b = bf2f((bf16)par[j]); o[j] = pp < 2 ? a * c[j] - b * s[j] : b * s[j] + a * c[j]; }
}
__device__ __forceinline__ u32x4 pack8(const float (&o)[8], float sc) {
    u32x4 r; r.x = pg8::cvt_pk_bf16(o[0] * sc, o[1] * sc); r.y = pg8::cvt_pk_bf16(o[2] * sc, o[3] * sc); r.z = pg8::cvt_pk_bf16(o[4] * sc, o[5] * sc); r.w = pg8::cvt_pk_bf16(o[6] * sc, o[7] * sc); return r;
}
__device__ __forceinline__ bf16x8 tr2(lds_cp a, int second_off) {
    const s16x4 v0 = vtr(a), v1 = vtr(a + second_off);
    bf16x8 A; A[0] = v0[0]; A[1] = v0[1]; A[2] = v0[2]; A[3] = v0[3]; A[4] = v1[0]; A[5] = v1[1]; A[6] = v1[2]; A[7] = v1[3]; return A;
}
constexpr int RT_P = 160;
__device__ __forceinline__ void rope_inv8(int odd, float (&inv8)[8]) {
#pragma unroll
    for (int k = 0; k < 8; ++k) inv8[k] = __builtin_amdgcn_exp2f(-(float)(8 * odd + k) * (13.287712379549449f / 16.f)) * 0.15915494309189535f;
}
__device__ __forceinline__ void rope8c(const bf16x8 own, const bf16x8 par, int piece, int t, const float (&inv8)[8], bool rope, float (&o)[8]) {
    if (!rope) {
#pragma unroll
        for (int j = 0; j < 8; ++j) o[j] = bf2f((bf16)own[j]);
        return; }
    const int half = piece >> 2, pp = piece & 3;
    const float pos = (float)(half ? (t % GW) : (t / GW));
#pragma unroll
    for (int j = 0; j < 8; ++j) { const float rev = pos * inv8[j], c = __builtin_amdgcn_cosf(rev), s = __builtin_amdgcn_sinf(rev);
        const float a = bf2f((bf16)own[j]), b = bf2f((bf16)par[j]); o[j] = pp < 2 ? a * c - b * s : b * s + a * c; }
}
__device__ __forceinline__ void rope8r(const bf16x8 own, const bf16x8 par, int piece, const float* cs, const float* sn, bool rope, float (&o)[8]) {
    if (!rope) {
#pragma unroll
        for (int j = 0; j < 8; ++j) o[j] = bf2f((bf16)own[j]);
        return; }
    const int half = piece >> 2, pp = piece & 3, tb = half * 16 + 8 * (pp & 1);
    const f32x4 c0 = *(const f32x4*)(cs + tb), c1 = *(const f32x4*)(cs + tb + 4), s0 = *(const f32x4*)(sn + tb), s1 = *(const f32x4*)(sn + tb + 4);
    const float c[8] = {c0.x, c0.y, c0.z, c0.w, c1.x, c1.y, c1.z, c1.w}, s[8] = {s0.x, s0.y, s0.z, s0.w, s1.x, s1.y, s1.z, s1.w};
#pragma unroll
    for (int j = 0; j < 8; ++j) { const float a = bf2f((bf16)own[j]), b = bf2f((bf16)par[j]); o[j] = pp < 2 ? a * c[j] - b * s[j] : b * s[j] + a * c[j]; }
}
__device__ __forceinline__ void ph_ret_state_mfma(const bf16* px, const float* cosT, const float* sinT, const float* dec_f, const float* dec_b, bf16* ST, unsigned char* ldsg) { const int tidx = otid();
    const int lane = tidx & 63, w = __builtin_amdgcn_readfirstlane(tidx >> 6), fr = lane & 15, quad = lane >> 4;
    const lds_cp lds = (lds_cp)ldsg;
    constexpr int KF = 0, KB = 128 * RT_P, VS = 2 * 128 * RT_P;
    constexpr int NU = NB * RH * NCH;
    bf16x8 kown[2], kpar[2]; u32x4 vv[2];
#define R1_ISSUE(vbx) do { const int ci_ = (vbx) % NCH, h_ = ((vbx) / NCH) % RH, b_ = (vbx) / (NCH * RH); const int row0_ = chunk_row0(b_, ci_); \
        _Pragma("unroll") for (int it = 0; it < 2; ++it) { const int item = tidx + NT * it, m = item >> 3, piece = item & 7; const bf16* rp = px + (size_t)(row0_ + m) * DPROJ; \
            kown[it] = *(const bf16x8*)(rp + O_RET_K + h_ * 64 + piece * 8); kpar[it] = *(const bf16x8*)(rp + O_RET_K + h_ * 64 + (piece ^ 2) * 8); vv[it] = *(const u32x4*)(rp + O_RET_V + h_ * 64 + piece * 8); } } while (0)
    float invk[8]; rope_inv8(tidx & 1, invk);
    int vb = blockIdx.x;
    if (vb < NU) R1_ISSUE(vb);
    for (; vb < NU; vb += gridDim.x) {
        const int ci = vb % NCH, h = (vb / NCH) % RH, b = vb / (NCH * RH);
        const bool rope = ci < 64;
        const float lgf = -log1pf(expf(-dec_f[h])), lgb = -log1pf(expf(-dec_b[h]));
        lds_barrier();
#pragma unroll
        for (int it = 0; it < 2; ++it) { const int item = tidx + NT * it, m = item >> 3, piece = item & 7; const int t = rope ? (ci * 128 + m) : 0;
            float o[8]; rope8c(kown[it], kpar[it], piece, t, invk, rope, o);
            *(u32x4*)(ldsg + KF + m * RT_P + piece * 16) = pack8(o, 0.125f * expf((127.f - (float)m) * lgf));
            *(u32x4*)(ldsg + KB + m * RT_P + piece * 16) = pack8(o, 0.125f * expf((float)m * lgb));
            *(u32x4*)(ldsg + VS + m * RT_P + piece * 16) = vv[it]; }
        R1_ISSUE(min(vb + (int)gridDim.x, NU - 1));
        lds_barrier();
        const int dir = w >> 2, dt = w & 3;
        const lds_cp kb = lds + (dir ? KB : KF);
        bf16x8 A[4];
#pragma unroll
        for (int ks = 0; ks < 4; ++ks) A[ks] = tr2(kb + (32 * ks + 8 * quad + (fr >> 2)) * RT_P + (16 * dt + 4 * (fr & 3)) * 2, 4 * RT_P);
        bf16* outp = ST + ((((size_t)(b * RH + h) * 2 + dir) * NCH + ci) * 4096);
#pragma unroll
        for (int et = 0; et < 4; ++et) {
            f32x4 acc = (f32x4){0.f, 0.f, 0.f, 0.f};
#pragma unroll
            for (int ks = 0; ks < 4; ++ks) { const bf16x8 Bv = tr2(lds + VS + (32 * ks + 8 * quad + (fr >> 2)) * RT_P + (16 * et + 4 * (fr & 3)) * 2, 4 * RT_P);
                acc = __builtin_amdgcn_mfma_f32_16x16x32_bf16(A[ks], Bv, acc, 0, 0, 0); }
#pragma unroll
            for (int i = 0; i < 4; ++i) outp[(16 * dt + 4 * quad + i) * 64 + 16 * et + fr] = f2bf(acc[i]);
        }
    }
#undef R1_ISSUE
}
__device__ __forceinline__ void ph_ret_out_mfma(const bf16* px, const float* cosT, const float* sinT, const float* dec_f, const float* dec_b, const bf16* ST, const float* gn_w, bf16* act, int nci, unsigned char* ldsg) { const int tidx = otid();
    const int lane = tidx & 63, w = __builtin_amdgcn_readfirstlane(tidx >> 6), fr = lane & 15, quad = lane >> 4;
    const lds_cp lds = (lds_cp)ldsg;
    constexpr int KS = 0, VS = 128 * RT_P, SF = 2 * 128 * RT_P, SB = SF + 64 * RT_P;
    constexpr float LOG2E = 1.4426950408889634f;
    const int NU = NB * RH * nci;
    bf16x8 kown[2], kpar[2], qown[2], qpar[2]; u32x4 vv[2]; u32x4 sfu, sbu;
#define R3_ISSUE(vbx) do { const int ci_ = (vbx) % nci, h_ = ((vbx) / nci) % RH, b_ = (vbx) / (nci * RH); const int row0_ = chunk_row0(b_, ci_); \
        _Pragma("unroll") for (int it = 0; it < 2; ++it) { const int item = tidx + NT * it, m = item >> 3, piece = item & 7; const bf16* rp = px + (size_t)(row0_ + m) * DPROJ; \
            kown[it] = *(const bf16x8*)(rp + O_RET_K + h_ * 64 + piece * 8); kpar[it] = *(const bf16x8*)(rp + O_RET_K + h_ * 64 + (piece ^ 2) * 8); vv[it] = *(const u32x4*)(rp + O_RET_V + h_ * 64 + piece * 8); } \
        { const bf16* Sf_ = ST + (((size_t)(b_ * RH + h_) * 2 + 0) * NCH + ci_) * 4096; const bf16* Sb_ = ST + (((size_t)(b_ * RH + h_) * 2 + 1) * NCH + ci_) * 4096; const int d_ = tidx >> 3, e0_ = (tidx & 7) * 8; \
          sfu = *(const u32x4*)(Sf_ + d_ * 64 + e0_); sbu = *(const u32x4*)(Sb_ + d_ * 64 + e0_); } \
        { const bf16* qp = px + (size_t)(row0_ + 16 * w + fr) * DPROJ + O_RET_Q + h_ * 64; \
          _Pragma("unroll") for (int s = 0; s < 2; ++s) { qown[s] = *(const bf16x8*)(qp + (4 * s + quad) * 8); qpar[s] = *(const bf16x8*)(qp + ((4 * s + quad) ^ 2) * 8); } } } while (0)
    float invk[8], invq[8]; rope_inv8(tidx & 1, invk); rope_inv8(quad & 1, invq);
    int vb = blockIdx.x;
    if (vb < NU) R3_ISSUE(vb);
    for (; vb < NU; vb += gridDim.x) {
        const int ci = vb % nci, h = (vb / nci) % RH, b = vb / (nci * RH);
        const int row0 = chunk_row0(b, ci); const bool rope = ci < 64;
        const float lgf2 = -log1pf(expf(-dec_f[h])) * LOG2E, lgb2 = -log1pf(expf(-dec_b[h])) * LOG2E;
        lds_barrier();
#pragma unroll
        for (int it = 0; it < 2; ++it) { const int item = tidx + NT * it, m = item >> 3, piece = item & 7; const int t = rope ? (ci * 128 + m) : 0;
            float o[8]; rope8c(kown[it], kpar[it], piece, t, invk, rope, o);
            *(u32x4*)(ldsg + KS + m * RT_P + piece * 16) = pack8(o, 0.125f);
            *(u32x4*)(ldsg + VS + m * RT_P + piece * 16) = vv[it]; }
        { const int d = tidx >> 3, e0 = (tidx & 7) * 8;
          *(u32x4*)(ldsg + SF + d * RT_P + e0 * 2) = sfu; *(u32x4*)(ldsg + SB + d * RT_P + e0 * 2) = sbu; }
        const int nloc = 16 * w + fr, row = row0 + nloc; const int tq = rope ? (ci * 128 + nloc) : 0;
        bf16x8 qf[2];
#pragma unroll
        for (int s = 0; s < 2; ++s) { float o[8]; rope8c(qown[s], qpar[s], 4 * s + quad, tq, invq, rope, o); qf[s] = __builtin_bit_cast(bf16x8, pack8(o, 1.f)); }
        ushort4 gvp[4]; f32x4 wvp[4];
        { const bf16* gp = px + (size_t)row * DPROJ + O_RET_G + h * 64 + 4 * quad; const float* gw = gn_w + h * 64 + 4 * quad;
#pragma unroll
          for (int et = 0; et < 4; ++et) { gvp[et] = *(const ushort4*)(gp + 16 * et); wvp[et] = *(const f32x4*)(gw + 16 * et); } }
        R3_ISSUE(min(vb + (int)gridDim.x, NU - 1));
        lds_barrier();
        f32x4 Y[4];
#pragma unroll
        for (int et = 0; et < 4; ++et) Y[et] = (f32x4){0.f, 0.f, 0.f, 0.f};
        float lf[4], lb[4];
#pragma unroll
        for (int i = 0; i < 4; ++i) { const float dl = (float)(fr - 4 * quad - i); lf[i] = __builtin_amdgcn_exp2f(dl * lgf2); lb[i] = __builtin_amdgcn_exp2f(-dl * lgb2); }
#pragma unroll
        for (int mp = 0; mp < 4; ++mp) {
            float p[8];
#pragma unroll
            for (int t2 = 0; t2 < 2; ++t2) { const int mt = 2 * mp + t2;
                f32x4 acc = (f32x4){0.f, 0.f, 0.f, 0.f};
#pragma unroll
                for (int s = 0; s < 2; ++s) { const bf16x8 kf = *(const __attribute__((address_space(3))) bf16x8*)(lds + KS + (16 * mt + fr) * RT_P + 64 * s + 16 * quad);
                    acc = __builtin_amdgcn_mfma_f32_16x16x32_bf16(kf, qf[s], acc, 0, 0, 0); }
                if (mt == w) {
#pragma unroll
                    for (int i = 0; i < 4; ++i) { const int df = fr - 4 * quad - i;
                        const float dm = df > 0 ? lf[i] : (df < 0 ? lb[i] : 2.f);
                        p[4 * t2 + i] = acc[i] * dm; }
                } else {
                    const float tf = mt < w ? __builtin_amdgcn_exp2f((float)(16 * (w - mt)) * lgf2) : __builtin_amdgcn_exp2f((float)(16 * (mt - w)) * lgb2);
#pragma unroll
                    for (int i = 0; i < 4; ++i) p[4 * t2 + i] = acc[i] * ((mt < w ? lf[i] : lb[i]) * tf);
                } }
            u32x4 pk; pk.x = pg8::cvt_pk_bf16(p[0], p[1]); pk.y = pg8::cvt_pk_bf16(p[2], p[3]); pk.z = pg8::cvt_pk_bf16(p[4], p[5]); pk.w = pg8::cvt_pk_bf16(p[6], p[7]);
            const bf16x8 pb = __builtin_bit_cast(bf16x8, pk);
#pragma unroll
            for (int et = 0; et < 4; ++et) { const bf16x8 A = tr2(lds + VS + (32 * mp + 4 * quad + (fr >> 2)) * RT_P + (16 * et + 4 * (fr & 3)) * 2, 16 * RT_P);
                Y[et] = __builtin_amdgcn_mfma_f32_16x16x32_bf16(A, pb, Y[et], 0, 0, 0); }
        }
        const float xf = __builtin_amdgcn_exp2f((float)(nloc + 1) * lgf2), xb = __builtin_amdgcn_exp2f((float)(128 - nloc) * lgb2);
#pragma unroll
        for (int et = 0; et < 4; ++et) {
            f32x4 cf = (f32x4){0.f, 0.f, 0.f, 0.f}, cb = cf;
#pragma unroll
            for (int ks = 0; ks < 2; ++ks) { const int ro = (32 * ks + 8 * quad + (fr >> 2)) * RT_P + (16 * et + 4 * (fr & 3)) * 2;
                cf = __builtin_amdgcn_mfma_f32_16x16x32_bf16(tr2(lds + SF + ro, 4 * RT_P), qf[ks], cf, 0, 0, 0);
                cb = __builtin_amdgcn_mfma_f32_16x16x32_bf16(tr2(lds + SB + ro, 4 * RT_P), qf[ks], cb, 0, 0, 0); }
            Y[et] = Y[et] + cf * xf + cb * xb;
        }
        float s1 = 0.f;
#pragma unroll
        for (int et = 0; et < 4; ++et) s1 += (Y[et][0] + Y[et][1]) + (Y[et][2] + Y[et][3]);
        const float mu = xq_sum(s1) * (1.f / 64.f);
        float s2 = 0.f;
#pragma unroll
        for (int et = 0; et < 4; ++et)
#pragma unroll
            for (int i = 0; i < 4; ++i) { const float dd = Y[et][i] - mu; s2 += dd * dd; }
        const float rs = rsqrtf(xq_sum(s2) * (1.f / 64.f) + EPS);
        bf16* op = act + (size_t)row * D + NAW + h * 64 + 4 * quad;
#pragma unroll
        for (int et = 0; et < 4; ++et) { const ushort4 gv = gvp[et]; const f32x4 wv = wvp[et];
            const float o0 = (Y[et][0] - mu) * rs * wv.x * silu(bf2f(gv.x)), o1 = (Y[et][1] - mu) * rs * wv.y * silu(bf2f(gv.y)), o2 = (Y[et][2] - mu) * rs * wv.z * silu(bf2f(gv.z)), o3 = (Y[et][3] - mu) * rs * wv.w * silu(bf2f(gv.w));
            pg8::u32x2 o; o.x = pg8::cvt_pk_bf16(o0, o1); o.y = pg8::cvt_pk_bf16(o2, o3); *(pg8::u32x2*)(op + 16 * et) = o; }
    }
#undef R3_ISSUE
}
__device__ __forceinline__ void ph_topk1(const bf16* Q, const bf16* keysl, float* topv, int* topi, int nrows, bf16* sm) { const int tidx = otid();
    bf16 (*sk)[136] = (bf16 (*)[136])sm;
    const int nrt = nrows / NT;
    for (int vb = blockIdx.x; vb < nrt * 16; vb += gridDim.x) {
        const int hs = vb % 16, side = hs & 1, h = hs >> 1, row = (vb / 16) * NT + tidx;
        const bf16* kp = keysl + ((size_t)(side * PH + h) * PNK) * PKD;
        for (int i = tidx; i < 128 * 128; i += NT) sk[i / 128][i % 128] = kp[i];
        __syncthreads();
        float q[128];
        const bf16* qp = Q + (size_t)row * DQ + h * 256 + side * 128;
#pragma unroll
        for (int d = 0; d < 128; ++d) q[d] = bf2f(qp[d]);
        float tv[16]; int ti[16];
#pragma unroll
        for (int j = 0; j < 16; ++j) { tv[j] = -3e38f; ti[j] = 0; }
        for (int kk = 0; kk < 128; ++kk) {
            float s = 0.f;
#pragma unroll
            for (int d = 0; d < 128; ++d) s += q[d] * bf2f(sk[kk][d]);
            int si = kk;
#pragma unroll
            for (int j = 0; j < 16; ++j) { if (s > tv[j]) { const float tvv = tv[j]; const int tii = ti[j]; tv[j] = s; ti[j] = si; s = tvv; si = tii; } }
        }
        const size_t o = (((size_t)row * PH + h) * 2 + side) * 16;
#pragma unroll
        for (int j = 0; j < 16; ++j) { topv[o + j] = tv[j]; topi[o + j] = ti[j]; }
        __syncthreads();
    }
}
__device__ __forceinline__ void ph_topk2(const float* topv, const int* topi, int* idx, float* gate, int nrows) { const int tidx = otid();
    for (int gid = blockIdx.x * NT + tidx; gid < nrows * PH; gid += gridDim.x * NT) {
        const size_t o = (size_t)gid * 32;
        float vb[16];
#pragma unroll
        for (int j = 0; j < 16; ++j) vb[j] = topv[o + 16 + j];
        float tv[16]; int ti[16];
#pragma unroll
        for (int j = 0; j < 16; ++j) { tv[j] = -3e38f; ti[j] = 0; }
#pragma unroll 1
        for (int i = 0; i < 16; ++i) { const float vai = topv[o + i];
#pragma unroll
            for (int jb = 0; jb < 16; ++jb) { float s = vai + vb[jb]; int si = i * 16 + jb;
#pragma unroll
                for (int j = 0; j < 16; ++j) { if (s > tv[j]) { const float tvv = tv[j]; const int tii = ti[j]; tv[j] = s; ti[j] = si; s = tvv; si = tii; } } } }
        const float mx = tv[0]; float den = 0.f, p[16];
#pragma unroll
        for (int j = 0; j < 16; ++j) { p[j] = __expf(tv[j] - mx); den += p[j]; }
        const float inv = 1.f / den;
        const size_t oo = (size_t)gid * 16;
#pragma unroll
        for (int j = 0; j < 16; ++j) { const int ia = topi[o + (ti[j] >> 4)], ib = topi[o + 16 + (ti[j] & 15)]; idx[oo + j] = ia * PNK + ib; gate[oo + j] = p[j] * inv; }
    }
}


__device__ __forceinline__ void ins16(float (&L)[16], float v) {
#pragma unroll
    for (int j = 15; j >= 1; --j) L[j] = __builtin_amdgcn_fmed3f(L[j - 1], v, L[j]);
    L[0] = fmaxf(L[0], v);
}
__device__ __forceinline__ void bitonic_merge16(float (&L)[16], const float (&A)[16], const float (&B)[16]) {
#pragma unroll
    for (int j = 0; j < 16; ++j) L[j] = fmaxf(A[j], B[15 - j]);
#pragma unroll
    for (int st = 8; st >= 1; st >>= 1)
#pragma unroll
        for (int j = 0; j < 16; ++j) if ((j & st) == 0) { const float hi = fmaxf(L[j], L[j + st]), lo = fminf(L[j], L[j + st]); L[j] = hi; L[j + st] = lo; }
}
__device__ __forceinline__ void top16of32(float (&v)[32]) {
#define CE(i, j) { const float hi_ = fmaxf(v[i], v[j]), lo_ = fminf(v[i], v[j]); v[i] = hi_; v[j] = lo_; }
#define CMAX(i, j) { v[i] = fmaxf(v[i], v[j]); }
#define CMIN(i, j) { v[j] = fminf(v[i], v[j]); }
    CE(0,1) CE(2,3) CE(0,2) CE(1,3) CE(1,2) CE(4,5) CE(6,7) CE(4,6) CE(5,7) CE(5,6) CE(0,4) CE(2,6) CE(2,4) CE(1,5) CE(3,7) CE(3,5) CE(1,2) CE(3,4) CE(5,6) CE(8,9) CE(10,11) CE(8,10) CE(9,11) CE(9,10) CE(12,13) CE(14,15) CE(12,14) CE(13,15) CE(13,14) CE(8,12) CE(10,14) CE(10,12) CE(9,13) CE(11,15) CE(11,13) CE(9,10) CE(11,12) CE(13,14) CE(0,8) CE(4,12) CE(4,8) CE(2,10) CE(6,14) CE(6,10) CE(2,4) CE(6,8) CE(10,12) CE(1,9) CE(5,13) CE(5,9) CE(3,11) CE(7,15) CE(7,11) CE(3,5) CE(7,9) CE(11,13) CE(1,2) CE(3,4) CE(5,6) CE(7,8) CE(9,10) CE(11,12) CE(13,14) CE(16,17) CE(18,19) CE(16,18) CE(17,19) CE(17,18) CE(20,21) CE(22,23) CE(20,22) CE(21,23) CE(21,22) CE(16,20) CE(18,22) CE(18,20) CE(17,21) CE(19,23) CE(19,21) CE(17,18) CE(19,20) CE(21,22) CE(24,25) CE(26,27) CE(24,26) CE(25,27) CE(25,26) CE(28,29) CE(30,31) CE(28,30) CE(29,31) CE(29,30) CE(24,28) CE(26,30) CE(26,28) CE(25,29) CE(27,31) CE(27,29) CE(25,26) CE(27,28) CE(29,30) CE(16,24) CE(20,28) CE(20,24) CE(18,26) CE(22,30) CE(22,26) CE(18,20) CE(22,24) CE(26,28) CE(17,25) CE(21,29) CE(21,25) CE(19,27) CE(23,31) CE(23,27) CE(19,21) CE(23,25) CE(27,29) CE(17,18) CE(19,20) CE(21,22) CE(23,24) CE(25,26) CE(27,28) CE(29,30) CE(0,16) CMAX(8,24) CE(8,16) CE(4,20) CMAX(12,28) CMAX(12,20) CE(4,8) CE(12,16) CE(2,18) CMAX(10,26) CE(10,18) CE(6,22) CMAX(14,30) CMAX(14,22) CE(6,10) CMAX(14,18) CE(2,4) CE(6,8) CE(10,12) CE(14,16) CE(1,17) CMAX(9,25) CE(9,17) CE(5,21) CMAX(13,29) CMAX(13,21) CE(5,9) CE(13,17) CE(3,19) CMAX(11,27) CE(11,19) CE(7,23) CMAX(15,31) CMAX(15,23) CE(7,11) CMAX(15,19) CE(3,5) CE(7,9) CE(11,13) CMAX(15,17) CE(1,2) CE(3,4) CE(5,6) CE(7,8) CE(9,10) CE(11,12) CE(13,14) CMAX(15,16)
#undef CE
#undef CMAX
#undef CMIN
}
constexpr int TK_KROW = 272;
constexpr int TK_LIST = 2 * 128 * TK_KROW;
__device__ __forceinline__ void ph_tk_mfma(const bf16* Q, const bf16* keysl, int* idx, float* gate, int nrows, unsigned char* ldsg) { const int tidx = otid();
    const int lane = tidx & 63, w = __builtin_amdgcn_readfirstlane(tidx >> 6), fr = lane & 15, quad = lane >> 4;
    const lds_cp lds = (lds_cp)ldsg;
    unsigned* lists = (unsigned*)(ldsg + TK_LIST) + (w * 16 + fr) * 32;
    const int nunits = (nrows / 128) * PH;
    int hcur = -1;
    for (int u = blockIdx.x; u < nunits; u += gridDim.x) {
        const int h = u % PH, tile = u / PH;
        __syncthreads();
        if (h != hcur) {
            for (int i = tidx; i < 2 * 128 * 16; i += NT) { const int side = i >> 11, r = (i >> 4) & 127, pc = i & 15;
                *(u32x4*)(ldsg + (side * 128 + r) * TK_KROW + pc * 16) = *(const u32x4*)(keysl + ((size_t)(side * PH + h) * PNK + r) * PKD + pc * 8); }
            hcur = h;
        }
        __syncthreads();
        const int row = tile * 128 + 16 * w + fr;
        float Lb[16];
#pragma unroll
        for (int side = 0; side < 2; ++side) {
            bf16x8 qf[4];
#pragma unroll
            for (int s = 0; s < 4; ++s) qf[s] = *(const bf16x8*)(Q + (size_t)row * DQ + h * 256 + side * 128 + 32 * s + 8 * quad);
            float L[16];
            { float pv[32];
#pragma unroll
              for (int t = 0; t < 8; ++t) {
                f32x4 acc = (f32x4){0.f, 0.f, 0.f, 0.f};
#pragma unroll
                for (int s = 0; s < 4; ++s) { const bf16x8 kf = *(const __attribute__((address_space(3))) bf16x8*)(lds + (side * 128 + 16 * t + fr) * TK_KROW + 64 * s + 16 * quad);
                    acc = __builtin_amdgcn_mfma_f32_16x16x32_bf16(kf, qf[s], acc, 0, 0, 0); }
#pragma unroll
                for (int i = 0; i < 4; ++i) { const unsigned key = 16 * t + 4 * quad + i; pv[4 * t + i] = __uint_as_float((__float_as_uint(acc[i]) & ~0x7fu) | key); }
              }
              top16of32(pv);
#pragma unroll
              for (int j = 0; j < 16; ++j) L[j] = pv[j]; }
            { float A[16], B[16];
#pragma unroll
              for (int j = 0; j < 16; ++j) { auto s = __builtin_amdgcn_permlane16_swap(__float_as_uint(L[j]), __float_as_uint(L[j]), false, false); A[j] = __uint_as_float(s[0]); B[j] = __uint_as_float(s[1]); }
              bitonic_merge16(L, A, B);
#pragma unroll
              for (int j = 0; j < 16; ++j) { auto s = __builtin_amdgcn_permlane32_swap(__float_as_uint(L[j]), __float_as_uint(L[j]), false, false); A[j] = __uint_as_float(s[0]); B[j] = __uint_as_float(s[1]); }
              bitonic_merge16(L, A, B); }
            if (side == 0) {
                if (quad == 0) {
#pragma unroll
                    for (int j = 0; j < 16; ++j) lists[j] = __float_as_uint(L[j]); }
            } else {
#pragma unroll
                for (int j = 0; j < 16; ++j) Lb[j] = L[j];
                if (quad == 0) {
#pragma unroll
                    for (int j = 0; j < 16; ++j) lists[16 + j] = __float_as_uint(L[j]); }
            }
        }

        float C[16];
#pragma unroll
        for (int j = 0; j < 16; ++j) C[j] = -3.0e38f;
#pragma unroll
        for (int r = 0; r < 4; ++r) {
            const float vai = __uint_as_float(lists[4 * r + quad] & ~0x7fu);
            const int irow = 4 * r + quad, len = 16 / (irow + 1);
            constexpr int maxlen[4] = {16, 3, 1, 1};
#pragma unroll
            for (int j = 0; j < maxlen[r]; ++j) { const float s = vai + __uint_as_float(__float_as_uint(Lb[j]) & ~0x7fu);
                const float pkv = __uint_as_float((__float_as_uint(s) & ~0xffu) | (unsigned)(irow * 16 + j));
                ins16(C, j < len ? pkv : -3.0e38f); }
        }
        { float A[16], B[16];
#pragma unroll
          for (int j = 0; j < 16; ++j) { auto s = __builtin_amdgcn_permlane16_swap(__float_as_uint(C[j]), __float_as_uint(C[j]), false, false); A[j] = __uint_as_float(s[0]); B[j] = __uint_as_float(s[1]); }
          bitonic_merge16(C, A, B);
#pragma unroll
          for (int j = 0; j < 16; ++j) { auto s = __builtin_amdgcn_permlane32_swap(__float_as_uint(C[j]), __float_as_uint(C[j]), false, false); A[j] = __uint_as_float(s[0]); B[j] = __uint_as_float(s[1]); }
          bitonic_merge16(C, A, B); }
        const float mx = __uint_as_float(__float_as_uint(C[0]) & ~0xffu);
        float p[16], den = 0.f; int ex[16];
#pragma unroll
        for (int k = 0; k < 16; ++k) { const unsigned cb = __float_as_uint(C[k]); const float sv = __uint_as_float(cb & ~0xffu); p[k] = __expf(sv - mx); den += p[k];
            const unsigned ka = lists[(cb >> 4) & 15] & 0x7fu, kb = lists[16 + (cb & 15)] & 0x7fu; ex[k] = (int)(ka * PNK + kb); }
        const float inv = 1.f / den;
        if (quad == 0) {
            int* ip = idx + (size_t)row * 128 + h * 16; float* gp = gate + (size_t)row * 128 + h * 16;
#pragma unroll
            for (int k = 0; k < 16; k += 4) { *(int4*)(ip + k) = make_int4(ex[k], ex[k + 1], ex[k + 2], ex[k + 3]); *(f32x4*)(gp + k) = (f32x4){p[k] * inv, p[k + 1] * inv, p[k + 2] * inv, p[k + 3] * inv}; }
        }
    }
}
template <int B>
__device__ __forceinline__ void sort16at(float (&v)[64]) {
#define CE(i, j) { const float hi_ = fmaxf(v[B + i], v[B + j]), lo_ = fminf(v[B + i], v[B + j]); v[B + i] = hi_; v[B + j] = lo_; }
    CE(0,1) CE(2,3) CE(0,2) CE(1,3) CE(1,2) CE(4,5) CE(6,7) CE(4,6) CE(5,7) CE(5,6) CE(0,4) CE(2,6) CE(2,4) CE(1,5) CE(3,7) CE(3,5) CE(1,2) CE(3,4) CE(5,6) CE(8,9) CE(10,11) CE(8,10) CE(9,11) CE(9,10) CE(12,13) CE(14,15) CE(12,14) CE(13,15) CE(13,14) CE(8,12) CE(10,14) CE(10,12) CE(9,13) CE(11,15) CE(11,13) CE(9,10) CE(11,12) CE(13,14) CE(0,8) CE(4,12) CE(4,8) CE(2,10) CE(6,14) CE(6,10) CE(2,4) CE(6,8) CE(10,12) CE(1,9) CE(5,13) CE(5,9) CE(3,11) CE(7,15) CE(7,11) CE(3,5) CE(7,9) CE(11,13) CE(1,2) CE(3,4) CE(5,6) CE(7,8) CE(9,10) CE(11,12) CE(13,14)
#undef CE
}
__device__ __forceinline__ void top16of64(float (&v)[64], float (&L)[16]) {
    sort16at<0>(v); sort16at<16>(v); sort16at<32>(v); sort16at<48>(v);
    float A[16], Bv[16], M0[16], M1[16];
#pragma unroll
    for (int j = 0; j < 16; ++j) { A[j] = v[j]; Bv[j] = v[16 + j]; }
    bitonic_merge16(M0, A, Bv);
#pragma unroll
    for (int j = 0; j < 16; ++j) { A[j] = v[32 + j]; Bv[j] = v[48 + j]; }
    bitonic_merge16(M1, A, Bv);
    bitonic_merge16(L, M0, M1);
}
typedef float f32x16 __attribute__((ext_vector_type(16)));
template <bool HEADORD>
__device__ __forceinline__ void ph_tk32(const bf16* Q, const bf16* keysl, int* idx, float* gate, int nrows, unsigned char* ldsg) { const int tidx = otid();
    const int lane = tidx & 63, w = __builtin_amdgcn_readfirstlane(tidx >> 6), r32 = lane & 31, hh = lane >> 5;
    const lds_cp lds = (lds_cp)ldsg;
    unsigned* lists = (unsigned*)(ldsg + TK_LIST) + (w * 32 + r32) * 32;
    const int nunits = (nrows / 256) * PH;
    int hcur = -1;
    for (int ui = 0;; ++ui) {
        int h, tile;
        if (HEADORD) { const int c = (int)blockIdx.x, k = c >> 3; h = k & 7; tile = 4 * (c & 7) + (k >> 3) + 32 * ui; if (tile >= nrows / 256) break; }
        else { const int u = (int)blockIdx.x + ui * (int)gridDim.x; if (u >= nunits) break; h = u % PH; tile = u / PH; }
        __syncthreads();
        if (h != hcur) {
            for (int i = tidx; i < 2 * 128 * 16; i += NT) { const int side = i >> 11, r = (i >> 4) & 127, pc = i & 15;
                *(u32x4*)(ldsg + (side * 128 + r) * TK_KROW + pc * 16) = *(const u32x4*)(keysl + ((size_t)(side * PH + h) * PNK + r) * PKD + pc * 8); }
            hcur = h;
        }
        __syncthreads();
        const int row = tile * 256 + 32 * w + r32;
        float Lb[16];
#pragma unroll
        for (int side = 0; side < 2; ++side) {
            bf16x8 qf[8];
#pragma unroll
            for (int s = 0; s < 8; ++s) qf[s] = *(const bf16x8*)(Q + ((size_t)(((tile * 8 + w) * PH + h) * 2 + side)) * 4096 + s * 512 + hh * 256 + r32 * 8);
            float pv[64];
#pragma unroll
            for (int t = 0; t < 4; ++t) {
                f32x16 acc;
#pragma unroll
                for (int i = 0; i < 16; ++i) acc[i] = 0.f;
#pragma unroll
                for (int s = 0; s < 8; ++s) { const bf16x8 kf = *(const __attribute__((address_space(3))) bf16x8*)(lds + (side * 128 + 32 * t + r32) * TK_KROW + 32 * s + 16 * hh);
                    acc = __builtin_amdgcn_mfma_f32_32x32x16_bf16(kf, qf[s], acc, 0, 0, 0); }
#pragma unroll
                for (int i = 0; i < 16; ++i) { const unsigned key = 32 * t + (i & 3) + 8 * (i >> 2) + 4 * hh; pv[16 * t + i] = __uint_as_float((__float_as_uint(acc[i]) & ~0x7fu) | key); }
            }
            float L[16];
            top16of64(pv, L);
            { float A[16], B[16];
#pragma unroll
              for (int j = 0; j < 16; ++j) { auto s = __builtin_amdgcn_permlane32_swap(__float_as_uint(L[j]), __float_as_uint(L[j]), false, false); A[j] = __uint_as_float(s[0]); B[j] = __uint_as_float(s[1]); }
              bitonic_merge16(L, A, B); }
            if (side == 0) { if (hh == 0) {
#pragma unroll
                    for (int j = 0; j < 16; ++j) lists[j] = __float_as_uint(L[j]); } }
            else {
#pragma unroll
                for (int j = 0; j < 16; ++j) Lb[j] = L[j];
                if (hh == 0) {
#pragma unroll
                    for (int j = 0; j < 16; ++j) lists[16 + j] = __float_as_uint(L[j]); } }
        }
        float C[16];
#pragma unroll
        for (int j = 0; j < 16; ++j) C[j] = -3.0e38f;
#pragma unroll
        for (int r = 0; r < 8; ++r) {
            const float vai = __uint_as_float(lists[2 * r + hh] & ~0x7fu);
            const int irow = 2 * r + hh, len = 16 / (irow + 1);
            constexpr int maxlen[8] = {16, 5, 3, 2, 1, 1, 1, 1};
#pragma unroll
            for (int j = 0; j < maxlen[r]; ++j) { const float s = vai + __uint_as_float(__float_as_uint(Lb[j]) & ~0x7fu);
                const float pkv = __uint_as_float((__float_as_uint(s) & ~0xffu) | (unsigned)(irow * 16 + j));
                ins16(C, j < len ? pkv : -3.0e38f); }
        }
        { float A[16], B[16];
#pragma unroll
          for (int j = 0; j < 16; ++j) { auto s = __builtin_amdgcn_permlane32_swap(__float_as_uint(C[j]), __float_as_uint(C[j]), false, false); A[j] = __uint_as_float(s[0]); B[j] = __uint_as_float(s[1]); }
          bitonic_merge16(C, A, B); }
        const float mx = __uint_as_float(__float_as_uint(C[0]) & ~0xffu);
        float p[16], den = 0.f; int ex[16];
#pragma unroll
        for (int k = 0; k < 16; ++k) { const unsigned cb = __float_as_uint(C[k]); const float sv = __uint_as_float(cb & ~0xffu); p[k] = __expf(sv - mx); den += p[k];
            const unsigned ka = lists[(cb >> 4) & 15] & 0x7fu, kb = lists[16 + (cb & 15)] & 0x7fu; ex[k] = (int)(ka * PNK + kb); }
        const float inv = 1.f / den;
        if (hh == 0) {
            int* ip = idx + (size_t)row * 128 + h * 16; float* gp = gate + (size_t)row * 128 + h * 16;
#pragma unroll
            for (int k = 0; k < 16; k += 4) { *(int4*)(ip + k) = make_int4(ex[k], ex[k + 1], ex[k + 2], ex[k + 3]); *(f32x4*)(gp + k) = (f32x4){p[k] * inv, p[k + 1] * inv, p[k + 2] * inv, p[k + 3] * inv}; }
        }
    }
}
__device__ __forceinline__ float dot16(const float (&hx)[16], const bf16x8 a, const bf16x8 b) {
    float s = 0.f;
#pragma unroll
    for (int j = 0; j < 8; ++j) s += hx[j] * bf2f((bf16)a[j]) + hx[8 + j] * bf2f((bf16)b[j]);
    return s;
}
template <bool FINAL>
__device__ __forceinline__ void ph_peer(const bf16* act, const int* idx, const float* gate, const bf16* U, const bf16* V, const float* modl, int off_g,
                                        float* xlat, float* xctx, const float* fw, int nrows) { const int tidx = otid();
    const int lane = tidx & 63, wave = tidx >> 6;
    for (int row = blockIdx.x * 8 + wave; row < nrows; row += gridDim.x * 8) {
        float hx[16];
        { const bf16x8 a = *(const bf16x8*)(act + (size_t)row * D + lane * 8), b = *(const bf16x8*)(act + (size_t)row * D + 512 + lane * 8);
#pragma unroll
          for (int j = 0; j < 8; ++j) { hx[j] = bf2f((bf16)a[j]); hx[8 + j] = bf2f((bf16)b[j]); } }
        const int myi0 = idx[(size_t)row * 128 + lane], myi1 = idx[(size_t)row * 128 + 64 + lane];
        const float myg0 = gate[(size_t)row * 128 + lane], myg1 = gate[(size_t)row * 128 + 64 + lane];
        float a0 = 0.f, a1 = 0.f;
        for (int base = 0; base < 128; base += 8) {
            bf16x8 ua[8], ub[8];
#pragma unroll
            for (int j = 0; j < 8; ++j) { const int e = rl_i(base < 64 ? myi0 : myi1, (base + j) & 63); const bf16* up = U + (size_t)e * D; ua[j] = *(const bf16x8*)(up + lane * 8); ub[j] = *(const bf16x8*)(up + 512 + lane * 8); }
#pragma unroll
            for (int j = 0; j < 8; ++j) { const float s = wave_sum(dot16(hx, ua[j], ub[j])); if (lane == ((base + j) & 63)) { if (base < 64) a0 = s; else a1 = s; } }
        }
        const float w0 = myg0 * 0.5f * a0 * (1.f + erff(a0 * 0.70710678f)), w1 = myg1 * 0.5f * a1 * (1.f + erff(a1 * 0.70710678f));
        float out[16];
#pragma unroll
        for (int j = 0; j < 16; ++j) out[j] = 0.f;
        for (int base = 0; base < 128; base += 8) {
            bf16x8 va[8], vb[8];
#pragma unroll
            for (int j = 0; j < 8; ++j) { const int e = rl_i(base < 64 ? myi0 : myi1, (base + j) & 63); const bf16* vp = V + (size_t)e * D; va[j] = *(const bf16x8*)(vp + lane * 8); vb[j] = *(const bf16x8*)(vp + 512 + lane * 8); }
#pragma unroll
            for (int j = 0; j < 8; ++j) { const float w = rl_f(base < 64 ? w0 : w1, (base + j) & 63);
#pragma unroll
                for (int q = 0; q < 8; ++q) { out[q] += w * bf2f((bf16)va[j][q]); out[8 + q] += w * bf2f((bf16)vb[j][q]); } }
        }
        const int mi = row < M_LAT ? row / S : 4;
        float* xr = row < M_LAT ? xlat + (size_t)row * D : xctx + (size_t)(row - M_LAT) * D;
        const float* g2 = modl + (size_t)mi * 6 * D + off_g;
        float xn[16]; float ss = 0.f;
#pragma unroll
        for (int hlf = 0; hlf < 2; ++hlf) { const int k = hlf * 512 + lane * 8;
            const f32x4 x0 = *(const f32x4*)(xr + k), x1 = *(const f32x4*)(xr + k + 4), g0 = *(const f32x4*)(g2 + k), g1 = *(const f32x4*)(g2 + k + 4);
            xn[hlf * 8 + 0] = x0.x + g0.x * out[hlf * 8 + 0]; xn[hlf * 8 + 1] = x0.y + g0.y * out[hlf * 8 + 1]; xn[hlf * 8 + 2] = x0.z + g0.z * out[hlf * 8 + 2]; xn[hlf * 8 + 3] = x0.w + g0.w * out[hlf * 8 + 3];
            xn[hlf * 8 + 4] = x1.x + g1.x * out[hlf * 8 + 4]; xn[hlf * 8 + 5] = x1.y + g1.y * out[hlf * 8 + 5]; xn[hlf * 8 + 6] = x1.z + g1.z * out[hlf * 8 + 6]; xn[hlf * 8 + 7] = x1.w + g1.w * out[hlf * 8 + 7]; }
#pragma unroll
        for (int j = 0; j < 16; ++j) ss += xn[j] * xn[j];
        float rs = 1.f;
        if (FINAL) { ss = wave_sum(ss); rs = rsqrtf(ss * (1.f / D) + EPS); }
#pragma unroll
        for (int hlf = 0; hlf < 2; ++hlf) { const int k = hlf * 512 + lane * 8;
            f32x4 o0, o1;
            if (FINAL) { const f32x4 f0 = *(const f32x4*)(fw + k), f1 = *(const f32x4*)(fw + k + 4);
                o0 = (f32x4){xn[hlf * 8 + 0] * rs * f0.x, xn[hlf * 8 + 1] * rs * f0.y, xn[hlf * 8 + 2] * rs * f0.z, xn[hlf * 8 + 3] * rs * f0.w};
                o1 = (f32x4){xn[hlf * 8 + 4] * rs * f1.x, xn[hlf * 8 + 5] * rs * f1.y, xn[hlf * 8 + 6] * rs * f1.z, xn[hlf * 8 + 7] * rs * f1.w}; }
            else { o0 = (f32x4){xn[hlf * 8 + 0], xn[hlf * 8 + 1], xn[hlf * 8 + 2], xn[hlf * 8 + 3]}; o1 = (f32x4){xn[hlf * 8 + 4], xn[hlf * 8 + 5], xn[hlf * 8 + 6], xn[hlf * 8 + 7]}; }
            *(f32x4*)(xr + k) = o0; *(f32x4*)(xr + k + 4) = o1; }
    }
}


__device__ __forceinline__ void ph_quant(const float* src, unsigned char* dst, float* scl, int nrows, int offs  ) { const int tidx = otid();
    const int lane = tidx & 63, wave = tidx >> 6;
    for (int row0 = (blockIdx.x * 8 + wave) * 4; row0 < nrows; row0 += gridDim.x * 8 * 4) {
        f32x4 v[4][4];
#pragma unroll
        for (int r = 0; r < 4; ++r)
#pragma unroll
            for (int j = 0; j < 4; ++j) v[r][j] = *(const f32x4*)(src + (size_t)(row0 + r) * D + lane * 16 + 4 * j);
#pragma unroll
        for (int r = 0; r < 4; ++r) {
            float am = 0.f;
#pragma unroll
            for (int j = 0; j < 4; ++j) am = fmaxf(am, fmaxf(fmaxf(fabsf(v[r][j].x), fabsf(v[r][j].y)), fmaxf(fabsf(v[r][j].z), fabsf(v[r][j].w))));
            am = wave_max(am);
            const float sc = am > 0.f ? am * (1.f / 127.f) : 1.f, inv = 1.f / sc;
            u32x4 o;
#pragma unroll
            for (int j = 0; j < 4; ++j) { const int q0 = (int)rintf(v[r][j].x * inv) + offs, q1 = (int)rintf(v[r][j].y * inv) + offs, q2 = (int)rintf(v[r][j].z * inv) + offs, q3 = (int)rintf(v[r][j].w * inv) + offs;
                o[j] = (unsigned)(q0 & 0xff) | ((unsigned)(q1 & 0xff) << 8) | ((unsigned)(q2 & 0xff) << 16) | ((unsigned)(q3 & 0xff) << 24); }
            *(u32x4*)(dst + (size_t)(row0 + r) * D + lane * 16) = o;
            if (lane == 0) scl[row0 + r] = sc;
        }
    }
}
__device__ __forceinline__ void ph_quant_w(const bf16* src, unsigned char* dst, float* scl, int nrows) { const int tidx = otid();
    const int lane = tidx & 63, wave = tidx >> 6;
    for (int row0 = (blockIdx.x * 8 + wave) * 2; row0 < nrows; row0 += gridDim.x * 16) {
        bf16x8 a[2][2];
#pragma unroll
        for (int r = 0; r < 2; ++r) { a[r][0] = *(const bf16x8*)(src + (size_t)(row0 + r) * D + lane * 16); a[r][1] = *(const bf16x8*)(src + (size_t)(row0 + r) * D + lane * 16 + 8); }
#pragma unroll
        for (int r = 0; r < 2; ++r) { float f[16]; float am = 0.f;
#pragma unroll
            for (int j = 0; j < 8; ++j) { f[j] = bf2f((bf16)a[r][0][j]); f[8 + j] = bf2f((bf16)a[r][1][j]); am = fmaxf(am, fmaxf(fabsf(f[j]), fabsf(f[8 + j]))); }
            am = wave_max(am); const float sc = am > 0.f ? am * (1.f / 127.f) : 1.f, inv = 1.f / sc;
            u32x4 o;
#pragma unroll
            for (int j = 0; j < 4; ++j) { const int q0 = (int)rintf(f[4 * j] * inv), q1 = (int)rintf(f[4 * j + 1] * inv), q2 = (int)rintf(f[4 * j + 2] * inv), q3 = (int)rintf(f[4 * j + 3] * inv);
                o[j] = (unsigned)(q0 & 0xff) | ((unsigned)(q1 & 0xff) << 8) | ((unsigned)(q2 & 0xff) << 16) | ((unsigned)(q3 & 0xff) << 24); }
            *(u32x4*)(dst + (size_t)(row0 + r) * D + lane * 16) = o;
            if (lane == 0) scl[row0 + r] = sc; }
    }
}
__device__ __forceinline__ int xreduce64(int (&p)[64], int lane) {
#pragma unroll
    for (int k = 0; k < 32; ++k) { auto r = __builtin_amdgcn_permlane32_swap((unsigned)p[k], (unsigned)p[k + 32], false, false); p[k] = (int)(r[0] + r[1]); }
#pragma unroll
    for (int k = 0; k < 16; ++k) { auto r = __builtin_amdgcn_permlane16_swap((unsigned)p[k], (unsigned)p[k + 16], false, false); p[k] = (int)(r[0] + r[1]); }
#define XR_STEP(n, M) _Pragma("unroll") for (int k = 0; k < (n) / 2; ++k) { const bool up = (lane & (M)) != 0; const int send = up ? p[k] : p[k + (n) / 2], keep = up ? p[k + (n) / 2] : p[k]; \
        p[k] = keep + __builtin_amdgcn_ds_swizzle(send, ((M) << 10) | 0x1f); }
    XR_STEP(16, 8) XR_STEP(8, 4) XR_STEP(4, 2) XR_STEP(2, 1)
#undef XR_STEP
    return p[0];
}
template <int MODE  >
__device__ __forceinline__ void ph_peer8(bf16* act, const int* idx, const float* gate, const unsigned char* U8, const unsigned char* V8, const float* SU, const float* SV,
                                         const float* modl, int off_g, bf16* xlat, bf16* xctx, float* outf, const float* fw, const float* modn, int nrows) { const int tidx = otid();
    constexpr bool FINAL = (MODE == 2);
    const int lane = tidx & 63, wave = tidx >> 6;
    for (int row = blockIdx.x * 8 + wave; row < nrows; row += gridDim.x * 8) {
        int xq[4]; float sx;
        { const bf16x8 a = *(const bf16x8*)(act + (size_t)row * D + lane * 16), b = *(const bf16x8*)(act + (size_t)row * D + lane * 16 + 8);
          float hx[16]; float am = 0.f;
#pragma unroll
          for (int j = 0; j < 8; ++j) { hx[j] = bf2f((bf16)a[j]); hx[8 + j] = bf2f((bf16)b[j]); am = fmaxf(am, fmaxf(fabsf(hx[j]), fabsf(hx[8 + j]))); }
          am = wave_max(am); sx = am > 0.f ? am * (1.f / 127.f) : 1.f; const float inv = 1.f / sx;
#pragma unroll
          for (int j = 0; j < 4; ++j) { const int q0 = (int)rintf(hx[4 * j] * inv), q1 = (int)rintf(hx[4 * j + 1] * inv), q2 = (int)rintf(hx[4 * j + 2] * inv), q3 = (int)rintf(hx[4 * j + 3] * inv);
              xq[j] = (int)((unsigned)(q0 & 0xff) | ((unsigned)(q1 & 0xff) << 8) | ((unsigned)(q2 & 0xff) << 16) | ((unsigned)(q3 & 0xff) << 24)); } }
        const int myi0 = idx[(size_t)row * 128 + lane], myi1 = idx[(size_t)row * 128 + 64 + lane];
        const float myg0 = gate[(size_t)row * 128 + lane], myg1 = gate[(size_t)row * 128 + 64 + lane];
        const float su0 = SU[myi0], su1 = SU[myi1], sv0 = SV[myi0], sv1 = SV[myi1];
        float wgt[2];
#pragma unroll
        for (int hf = 0; hf < 2; ++hf) {
            int p[64];
#pragma unroll
            for (int base = 0; base < 64; base += 16) {
                u32x4 ub[16];
#pragma unroll
                for (int j = 0; j < 16; ++j) { const int e = rl_i(hf ? myi1 : myi0, base + j); ub[j] = *(const u32x4*)(U8 + (size_t)e * D + lane * 16); }
#pragma unroll
                for (int j = 0; j < 16; ++j) { int s = __builtin_amdgcn_sdot4((int)ub[j].x, xq[0], 0, false); s = __builtin_amdgcn_sdot4((int)ub[j].y, xq[1], s, false);
                    s = __builtin_amdgcn_sdot4((int)ub[j].z, xq[2], s, false); p[base + j] = __builtin_amdgcn_sdot4((int)ub[j].w, xq[3], s, false); }
            }
            const float a = (float)xreduce64(p, lane) * sx * (hf ? su1 : su0);
            wgt[hf] = (hf ? myg1 * sv1 : myg0 * sv0) * 0.5f * a * (1.f + erff(a * 0.70710678f));
        }
        float out[16];
#pragma unroll
        for (int j = 0; j < 16; ++j) out[j] = 0.f;
#pragma unroll 1
        for (int base = 0; base < 128; base += 16) {
            u32x4 vb[16];
#pragma unroll
            for (int j = 0; j < 16; ++j) { const int e = rl_i(base < 64 ? myi0 : myi1, (base + j) & 63); vb[j] = *(const u32x4*)(V8 + (size_t)e * D + lane * 16); }
#pragma unroll
            for (int j = 0; j < 16; ++j) { const float wv = rl_f(base < 64 ? wgt[0] : wgt[1], (base + j) & 63);
#pragma unroll
                for (int q = 0; q < 4; ++q) { const unsigned dw = vb[j][q];
                    out[4 * q + 0] += wv * (float)((int)(dw << 24) >> 24); out[4 * q + 1] += wv * (float)((int)(dw << 16) >> 24); out[4 * q + 2] += wv * (float)((int)(dw << 8) >> 24); out[4 * q + 3] += wv * (float)((int)dw >> 24); } }
        }
        const int mi = row < M_LAT ? row / S : 4;
        bf16* xr = (row < M_LAT ? xlat + (size_t)row * D : xctx + (size_t)(row - M_LAT) * D) + lane * 16;
        const float* g2 = modl + (size_t)mi * 6 * D + off_g + lane * 16;
        float xn[16]; float ss = 0.f;
#pragma unroll
        for (int q = 0; q < 4; ++q) { const f32x4 x0 = ld4res<true>(xr, 4 * q), g0 = *(const f32x4*)(g2 + 4 * q);
            xn[4 * q + 0] = bf2f(f2bf(x0.x + g0.x * out[4 * q + 0])); xn[4 * q + 1] = bf2f(f2bf(x0.y + g0.y * out[4 * q + 1]));
            xn[4 * q + 2] = bf2f(f2bf(x0.z + g0.z * out[4 * q + 2])); xn[4 * q + 3] = bf2f(f2bf(x0.w + g0.w * out[4 * q + 3])); }
#pragma unroll
        for (int j = 0; j < 16; ++j) ss += xn[j] * xn[j];
        float rs = 1.f;
        if (MODE != 0) { ss = wave_sum(ss); rs = rsqrtf(ss * (1.f / D) + EPS); }
#pragma unroll
        for (int q = 0; q < 4; ++q) {
            if (FINAL) { const f32x4 f0 = *(const f32x4*)(fw + lane * 16 + 4 * q); *(f32x4*)(outf + (size_t)row * D + lane * 16 + 4 * q) = (f32x4){xn[4 * q] * rs * f0.x, xn[4 * q + 1] * rs * f0.y, xn[4 * q + 2] * rs * f0.z, xn[4 * q + 3] * rs * f0.w}; }
            else st4res(xr, 4 * q, (f32x4){xn[4 * q], xn[4 * q + 1], xn[4 * q + 2], xn[4 * q + 3]}); }
        if (MODE == 1) {
            const float* sh = modn + (size_t)mi * 6 * D + lane * 16; const float* sc = sh + D; const float* nw = fw + lane * 16;
            u32x4 o0, o1; unsigned pk[8];
#pragma unroll
            for (int q = 0; q < 4; ++q) { const f32x4 w4 = *(const f32x4*)(nw + 4 * q), a4 = *(const f32x4*)(sc + 4 * q), b4 = *(const f32x4*)(sh + 4 * q);
                pk[2 * q] = pg8::cvt_pk_bf16(xn[4 * q] * rs * w4.x * (1.f + a4.x) + b4.x, xn[4 * q + 1] * rs * w4.y * (1.f + a4.y) + b4.y);
                pk[2 * q + 1] = pg8::cvt_pk_bf16(xn[4 * q + 2] * rs * w4.z * (1.f + a4.z) + b4.z, xn[4 * q + 3] * rs * w4.w * (1.f + a4.w) + b4.w); }
            o0 = (u32x4){pk[0], pk[1], pk[2], pk[3]}; o1 = (u32x4){pk[4], pk[5], pk[6], pk[7]};
            *(u32x4*)(act + (size_t)row * D + lane * 16) = o0; *(u32x4*)(act + (size_t)row * D + lane * 16 + 8) = o1;
        }
    }
}

constexpr int PSA_ENT_MAX = 512;
constexpr int PSA_XQ = 0, PSA_ENT = 135168, PSA_ENT_BYTES = 2048, PSA_SX = PSA_ENT + 8 * PSA_ENT_BYTES;
constexpr int PSA_HIST = 152576, PSA_WTOT = PSA_HIST + 8192, PSA_SORT_MAX = 4096;
static_assert(PSA_SX + 132 * 4 <= PSA_HIST && PSA_WTOT + 64 <= LDS_BYTES - 64, "sweep A LDS map");
constexpr int PSB_IDX = 0, PSB_WQ = 33792, PSB_SW = PSB_WQ + 132 * 128, PSB_SS = PSB_SW + 1024;
#ifndef PEER_NSLAB
#define PEER_NSLAB 8
#endif
#ifndef PEER_PSH
static_assert(true, "");
#define PEER_SORTA 1
#define PEER_PSH 11
#endif
__device__ __forceinline__ int reduce32i(int (&p)[32], int lane) {
#pragma unroll
    for (int k = 0; k < 16; ++k) { auto r = __builtin_amdgcn_permlane32_swap((unsigned)p[k], (unsigned)p[k + 16], false, false); p[k] = (int)(r[0] + r[1]); }
#pragma unroll
    for (int k = 0; k < 8; ++k) { auto r = __builtin_amdgcn_permlane16_swap((unsigned)p[k], (unsigned)p[k + 8], false, false); p[k] = (int)(r[0] + r[1]); }
    { const bool up = (lane & 8) != 0;
#pragma unroll
      for (int k = 0; k < 4; ++k) { const int send = up ? p[k] : p[k + 4], keep = up ? p[k + 4] : p[k]; p[k] = keep + __builtin_amdgcn_ds_swizzle(send, (8 << 10) | 0x1f); } }
    { const bool up = (lane & 4) != 0;
#pragma unroll
      for (int k = 0; k < 2; ++k) { const int send = up ? p[k] : p[k + 2], keep = up ? p[k + 2] : p[k]; p[k] = keep + __builtin_amdgcn_ds_swizzle(send, (4 << 10) | 0x1f); } }
    { const bool up = (lane & 2) != 0; const int send = up ? p[0] : p[1], keep = up ? p[1] : p[0]; p[0] = keep + __builtin_amdgcn_ds_swizzle(send, (2 << 10) | 0x1f); }
    p[0] += __builtin_amdgcn_ds_swizzle(p[0], (1 << 10) | 0x1f);
    return p[0];
}
template <int LPS>
__device__ __forceinline__ void reduce16r(int (&p)[16], int lane) {
#pragma unroll
    for (int k = 0; k < 8; ++k) { auto r = __builtin_amdgcn_permlane32_swap((unsigned)p[k], (unsigned)p[k + 8], false, false); p[k] = (int)(r[0] + r[1]); }
#pragma unroll
    for (int k = 0; k < 4; ++k) { auto r = __builtin_amdgcn_permlane16_swap((unsigned)p[k], (unsigned)p[k + 4], false, false); p[k] = (int)(r[0] + r[1]); }
    { const bool up = (lane & 8) != 0;
#pragma unroll
      for (int k = 0; k < 2; ++k) { const int send = up ? p[k] : p[k + 2], keep = up ? p[k + 2] : p[k]; p[k] = keep + __builtin_amdgcn_ds_swizzle(send, (8 << 10) | 0x1f); } }
    if (LPS == 4) { const bool up = (lane & 4) != 0; const int send = up ? p[0] : p[1], keep = up ? p[1] : p[0]; p[0] = keep + __builtin_amdgcn_ds_swizzle(send, (4 << 10) | 0x1f); }
}
template <int MODE  >
__device__ __forceinline__ void ph_peer_sweep(const int* idx, const float* gate, const unsigned char* U8, const unsigned char* V8, const float* SU, const float* SV, const unsigned char* XQ, const float* XS,
                                              float* AW  , const float* modl, int off_g, bf16* xlat, bf16* xctx, float* outf  , const float* nw, const float* modn, unsigned char* xqo, float* xso, int nrows, unsigned char* ldsg) { const int tidx = otid();
    const int lane = tidx & 63, wave = __builtin_amdgcn_readfirstlane(tidx >> 6);
    const int TPW = nrows / (int)gridDim.x, row0 = (int)blockIdx.x * TPW;
    const int J = (TPW - wave + 7) / 8;
    __syncthreads();
    unsigned* ent = (unsigned*)(ldsg + PSA_ENT + wave * PSA_ENT_BYTES); float* sxs = (float*)(ldsg + PSA_SX);
    for (int j = 0; j < J; ++j) { const int tl = wave + 8 * j; *(u32x4*)(ldsg + PSA_XQ + tl * 1024 + lane * 16) = *(const u32x4*)(XQ + (size_t)(row0 + tl) * D + lane * 16); if (lane == 0) sxs[tl] = XS[row0 + tl]; }
    unsigned iab[17];
#pragma unroll
    for (int j = 0; j < 17; ++j) { if (j < J) { const size_t r = (size_t)(row0 + wave + 8 * j) * 128; iab[j] = (unsigned)idx[r + lane] | ((unsigned)idx[r + 64 + lane] << 16); } else iab[j] = 0xffffffffu; }
#if PEER_SORTA
    unsigned* hist = (unsigned*)(ldsg + PSA_HIST); unsigned* srt = (unsigned*)(ldsg + PSA_ENT); unsigned* wtot = (unsigned*)(ldsg + PSA_WTOT);
    ((u32x4*)hist)[tidx] = (u32x4){0u, 0u, 0u, 0u};
    __syncthreads();
#endif
#define IA(j) ((int)(iab[j] & 0xffffu))
#define IB(j) ((int)(iab[j] >> 16))
#pragma unroll 1
    for (int p = 0; p < (NEXP >> PEER_PSH); ++p) {
        const unsigned* lst = ent; int n = 0, cstart = 0, cstride = 32, nov = 0;
#pragma unroll
        for (int j = 0; j < 17; ++j) asm volatile("" : "+v"(iab[j]));
        unsigned lane_o = (unsigned)lane; asm volatile("" : "+v"(lane_o));
#if PEER_SORTA
#pragma unroll
        for (int j = 0; j < 17; ++j) {
            if ((IA(j) >> PEER_PSH) == p) atomicAdd(&hist[IA(j) & 2047], 1u);
            if ((IB(j) >> PEER_PSH) == p) atomicAdd(&hist[IB(j) & 2047], 1u);
        }
        __syncthreads();
        const u32x4 hh4 = ((const u32x4*)hist)[tidx];
        const unsigned hs = hh4.x + hh4.y + hh4.z + hh4.w; unsigned inc = hs;
#pragma unroll
        for (int d = 1; d < 64; d <<= 1) { const unsigned t = (unsigned)__shfl_up((int)inc, d); if (lane >= d) inc += t; }
        if (lane == 63) wtot[wave] = inc;
        __syncthreads();
        unsigned wbase = 0, NS = 0;
#pragma unroll
        for (int w2 = 0; w2 < 8; ++w2) { const unsigned t = wtot[w2]; NS += t; if (w2 < wave) wbase += t; }
        NS = (unsigned)__builtin_amdgcn_readfirstlane((int)NS); wbase = (unsigned)__builtin_amdgcn_readfirstlane((int)wbase);
        { const unsigned ex = wbase + inc - hs; u32x4 o; o.x = ex; o.y = ex + hh4.x; o.z = o.y + hh4.y; o.w = o.z + hh4.z; ((u32x4*)hist)[tidx] = o; }
        __syncthreads();
        if (NS <= (unsigned)PSA_SORT_MAX) {
#pragma unroll
            for (int j = 0; j < 17; ++j) {
                if ((IA(j) >> PEER_PSH) == p) { const unsigned pos = atomicAdd(&hist[IA(j) & 2047], 1u); srt[pos] = (unsigned)IA(j) | (lane_o << 14) | ((unsigned)(wave + 8 * j) << 21); }
                if ((IB(j) >> PEER_PSH) == p) { const unsigned pos = atomicAdd(&hist[IB(j) & 2047], 1u); srt[pos] = (unsigned)IB(j) | ((64u + lane_o) << 14) | ((unsigned)(wave + 8 * j) << 21); }
            }
            __syncthreads();
            ((u32x4*)hist)[tidx] = (u32x4){0u, 0u, 0u, 0u};
            lst = srt; n = (int)NS; cstart = wave * 32; cstride = 256;
        } else {
        ((u32x4*)hist)[tidx] = (u32x4){0u, 0u, 0u, 0u};
#endif
#pragma unroll
        for (int j = 0; j < 17; ++j) {
            const bool in0 = (IA(j) >> PEER_PSH) == p, in1 = (IB(j) >> PEER_PSH) == p;
            const unsigned long long m0 = __ballot(in0), m1 = __ballot(in1);
            const int c0 = __popcll(m0), c1 = __popcll(m1);
            const int r0 = n + (int)__builtin_amdgcn_mbcnt_hi((unsigned)(m0 >> 32), __builtin_amdgcn_mbcnt_lo((unsigned)m0, 0u));
            const int r1 = n + c0 + (int)__builtin_amdgcn_mbcnt_hi((unsigned)(m1 >> 32), __builtin_amdgcn_mbcnt_lo((unsigned)m1, 0u));
            if (in0 && r0 < PSA_ENT_MAX) ent[r0] = (unsigned)IA(j) | (lane_o << 14) | ((unsigned)(wave + 8 * j) << 21);
            if (in1 && r1 < PSA_ENT_MAX) ent[r1] = (unsigned)IB(j) | ((64u + lane_o) << 14) | ((unsigned)(wave + 8 * j) << 21);
            n += c0 + c1;
        }
        nov = n;
        n = min(n, PSA_ENT_MAX);
#if PEER_SORTA
        }
#endif
        {
#pragma unroll 1
            for (int base = cstart; base < n; base += cstride) {
                const unsigned myent = lst[min(base + (lane & 31), n - 1)];
                u32x4 ub[32];
#pragma unroll
                for (int q = 0; q < 32; ++q) { const unsigned ej = (unsigned)rl_i((int)myent, q); ub[q] = *(const u32x4*)(U8 + (size_t)(ej & 0x3fffu) * D + lane * 16); }
                int ps[32];
#pragma unroll
                for (int q = 0; q < 32; ++q) { const int tq = (int)((unsigned)rl_i((int)myent, q) >> 21); const u32x4 xv = *(const u32x4*)(ldsg + PSA_XQ + tq * 1024 + lane * 16);
                    int s = __builtin_amdgcn_sdot4((int)ub[q].x, (int)xv.x, 0, false); s = __builtin_amdgcn_sdot4((int)ub[q].y, (int)xv.y, s, false);
                    s = __builtin_amdgcn_sdot4((int)ub[q].z, (int)xv.z, s, false); ps[q] = __builtin_amdgcn_sdot4((int)ub[q].w, (int)xv.w, s, false); }
                const int tot = reduce32i(ps, lane);
                const int slot = lane >> 1;
                if ((lane & 1) == 0 && base + slot < n) { const unsigned en = lst[base + slot]; const int tl = (int)(en >> 21), pos = (int)((en >> 14) & 127u);
                    AW[(size_t)(row0 + tl) * 128 + pos] = (float)tot * sxs[tl]; }
            }
        }
        if (nov > PSA_ENT_MAX) {
            int cnt = 0;
#pragma unroll 1
            for (int j = 0; j < J; ++j) { const size_t r = (size_t)(row0 + wave + 8 * j) * 128;
#pragma unroll 1
                for (int pos = 0; pos < 128; ++pos) { const int e = idx[r + pos];
                    if ((e >> PEER_PSH) == p) { if (cnt >= PSA_ENT_MAX) { const u32x4 uv = *(const u32x4*)(U8 + (size_t)e * D + lane * 16), xv = *(const u32x4*)(ldsg + PSA_XQ + (wave + 8 * j) * 1024 + lane * 16);
                            int s = __builtin_amdgcn_sdot4((int)uv.x, (int)xv.x, 0, false); s = __builtin_amdgcn_sdot4((int)uv.y, (int)xv.y, s, false); s = __builtin_amdgcn_sdot4((int)uv.z, (int)xv.z, s, false); s = __builtin_amdgcn_sdot4((int)uv.w, (int)xv.w, s, false);
                            const float a = wave_sum((float)s); if (lane == 0) AW[r + pos] = a * sxs[wave + 8 * j]; }
                        ++cnt; } } }
        }
        __syncthreads();
    }
    unsigned short* idxs = (unsigned short*)(ldsg + PSB_IDX); unsigned char* wqb = ldsg + PSB_WQ; float* sws = (float*)(ldsg + PSB_SW); float* ssl = (float*)(ldsg + PSB_SS);
    constexpr int LPS = 64 / PEER_NSLAB, RR = 64 / LPS, NK = 128 / RR, NG = NK / 4;
#pragma unroll
    for (int jb = 0; jb < 18; jb += 3) {
        float aw0[3], aw1[3], g0[3], g1[3], su0[3], su1[3], sv0[3], sv1[3];
#pragma unroll
        for (int q = 0; q < 3; ++q) { const int j = jb + q; if (j < 17 && j < J) { const size_t r = (size_t)(row0 + wave + 8 * j) * 128;
            aw0[q] = AW[r + lane]; aw1[q] = AW[r + 64 + lane]; g0[q] = gate[r + lane]; g1[q] = gate[r + 64 + lane];
            su0[q] = SU[IA(j)]; su1[q] = SU[IB(j)]; sv0[q] = SV[IA(j)]; sv1[q] = SV[IB(j)]; } }
#pragma unroll
        for (int q = 0; q < 3; ++q) { const int j = jb + q; if (j < 17 && j < J) { const int tl = wave + 8 * j;
            const float a0 = aw0[q] * su0[q], a1 = aw1[q] * su1[q];
            const float w0 = g0[q] * sv0[q] * 0.5f * a0 * (1.f + erff(a0 * 0.70710678f)), w1 = g1[q] * sv1[q] * 0.5f * a1 * (1.f + erff(a1 * 0.70710678f));
            const float wm = wave_max(fmaxf(fabsf(w0), fabsf(w1))); const float sw = wm > 0.f ? wm * (1.f / 127.f) : 1.f, inv = 1.f / sw;
            const int q0 = (int)rintf(w0 * inv), q1 = (int)rintf(w1 * inv);
            { const int pos = lane, k = pos / RR, rr = pos % RR; wqb[tl * 128 + ((k >> 2) * RR + rr) * 4 + (k & 3)] = (unsigned char)(q0 & 0xff); }
            { const int pos = 64 + lane, k = pos / RR, rr = pos % RR; wqb[tl * 128 + ((k >> 2) * RR + rr) * 4 + (k & 3)] = (unsigned char)(q1 & 0xff); }
            idxs[tl * 128 + lane] = (unsigned short)IA(j); idxs[tl * 128 + 64 + lane] = (unsigned short)IB(j);
            if (lane == 0) sws[tl] = sw; ssl[tl * 64 + lane] = 0.f; } }
    }
    __syncthreads();
    const int rr = lane / LPS, cc = lane % LPS;
    constexpr int NREPB = ((DUP_MASK >> 10) & 1) ? 2 : 1; constexpr float WSC = 1.f / NREPB;
    constexpr int TB = (NK == 8) ? 4 : 2;
    for (int repB = 0; repB < NREPB; ++repB)
#pragma unroll 1
    for (int s = 0; s < PEER_NSLAB; ++s) {
#pragma unroll 1
        for (int jg = 0; jg < J; jg += TB) {
            u32x4 vb[TB][NK];
#pragma unroll
            for (int q = 0; q < TB; ++q) if (jg + q < J) { const int tl = wave + 8 * (jg + q);
#pragma unroll
                for (int k = 0; k < NK; ++k) { const int e = idxs[tl * 128 + RR * k + rr]; vb[q][k] = *(const u32x4*)(V8 + (size_t)e * D + s * (LPS * 16) + cc * 16); } }
#pragma unroll
            for (int q = 0; q < TB; ++q) if (jg + q < J) { const int tl = wave + 8 * (jg + q), row = row0 + tl;
                int acc[16];
#pragma unroll
                for (int c = 0; c < 16; ++c) acc[c] = 0;
#pragma unroll
                for (int gq = 0; gq < NG; ++gq) { const int wq = *(const int*)(wqb + tl * 128 + (gq * RR + rr) * 4);
#pragma unroll
                    for (int d4 = 0; d4 < 4; ++d4) { const unsigned a = vb[q][4 * gq][d4], b = vb[q][4 * gq + 1][d4], c = vb[q][4 * gq + 2][d4], d = vb[q][4 * gq + 3][d4];
                        const unsigned x0 = __builtin_amdgcn_perm(b, a, 0x05010400u), x1 = __builtin_amdgcn_perm(b, a, 0x07030602u), y0 = __builtin_amdgcn_perm(d, c, 0x05010400u), y1 = __builtin_amdgcn_perm(d, c, 0x07030602u);
                        acc[4 * d4 + 0] = __builtin_amdgcn_sdot4((int)__builtin_amdgcn_perm(y0, x0, 0x05040100u), wq, acc[4 * d4 + 0], false);
                        acc[4 * d4 + 1] = __builtin_amdgcn_sdot4((int)__builtin_amdgcn_perm(y0, x0, 0x07060302u), wq, acc[4 * d4 + 1], false);
                        acc[4 * d4 + 2] = __builtin_amdgcn_sdot4((int)__builtin_amdgcn_perm(y1, x1, 0x05040100u), wq, acc[4 * d4 + 2], false);
                        acc[4 * d4 + 3] = __builtin_amdgcn_sdot4((int)__builtin_amdgcn_perm(y1, x1, 0x07060302u), wq, acc[4 * d4 + 3], false); } }
                reduce16r<LPS>(acc, lane);
                const float sc = sws[tl] * WSC;
                const int mi = row < M_LAT ? row / S : 4;
                bf16* xrow = row < M_LAT ? xlat + (size_t)row * D : xctx + (size_t)(row - M_LAT) * D;
                const float* g2 = modl + (size_t)mi * 6 * D + off_g;
                if (LPS == 4) { const int col = s * 64 + cc * 16 + rr; const bf16 vb = f2bf(bf2f(xrow[col]) + g2[col] * ((float)acc[0] * sc)); xrow[col] = vb; const float v0 = bf2f(vb); if (repB == NREPB - 1) ssl[tl * 64 + lane] += v0 * v0; }
                else { const int col = s * 128 + cc * 16 + 2 * rr; const unsigned xb = *(const unsigned*)(xrow + col); const float2 gg = *(const float2*)(g2 + col);
                    const unsigned ob = pg8::cvt_pk_bf16(__uint_as_float(xb << 16) + gg.x * ((float)acc[0] * sc), __uint_as_float(xb & 0xffff0000u) + gg.y * ((float)acc[1] * sc));
                    *(unsigned*)(xrow + col) = ob; const float v0 = __uint_as_float(ob << 16), v1 = __uint_as_float(ob & 0xffff0000u);
                    if (repB == NREPB - 1) ssl[tl * 64 + lane] += v0 * v0 + v1 * v1; }
            }
        }
        __syncthreads();
    }
    asm volatile("s_waitcnt vmcnt(0)" ::: "memory");
    __builtin_amdgcn_fence(__ATOMIC_ACQUIRE, "agent");
    asm volatile("s_waitcnt vmcnt(0)" ::: "memory");
#pragma unroll 1
    for (int j0 = 0; j0 < J; j0 += 2) {
        f32x4 v[2][4];
#pragma unroll
        for (int t = 0; t < 2; ++t) if (j0 + t < J) { const int row = row0 + wave + 8 * (j0 + t); const bf16* xrow = row < M_LAT ? xlat + (size_t)row * D : xctx + (size_t)(row - M_LAT) * D;
#pragma unroll
            for (int q = 0; q < 4; ++q) v[t][q] = ld4res<true>(xrow, (size_t)(lane + 64 * q) * 4); }
#pragma unroll
        for (int t = 0; t < 2; ++t) if (j0 + t < J) { const int tl = wave + 8 * (j0 + t), row = row0 + tl; const int mi = row < M_LAT ? row / S : 4;
            float* xrow = outf + (size_t)row * D;
            const float rs = rsqrtf(wave_sum(ssl[tl * 64 + lane]) * (1.f / D) + EPS);
            float am = 0.f;
#pragma unroll
            for (int q = 0; q < 4; ++q) { const int k = (lane + 64 * q) * 4; const f32x4 w = *(const f32x4*)(nw + k);
                if (MODE == 2) { f32x4 o; o.x = v[t][q].x * rs * w.x; o.y = v[t][q].y * rs * w.y; o.z = v[t][q].z * rs * w.z; o.w = v[t][q].w * rs * w.w; ((f32x4*)xrow)[lane + 64 * q] = o; }
                else { const f32x4 b = *(const f32x4*)(modn + (size_t)mi * 6 * D + k), a = *(const f32x4*)(modn + (size_t)mi * 6 * D + D + k);
                    v[t][q].x = v[t][q].x * rs * w.x * (1.f + a.x) + b.x; v[t][q].y = v[t][q].y * rs * w.y * (1.f + a.y) + b.y; v[t][q].z = v[t][q].z * rs * w.z * (1.f + a.z) + b.z; v[t][q].w = v[t][q].w * rs * w.w * (1.f + a.w) + b.w;
                    am = fmaxf(am, fmaxf(fmaxf(fabsf(v[t][q].x), fabsf(v[t][q].y)), fmaxf(fabsf(v[t][q].z), fabsf(v[t][q].w)))); } }
            if (MODE == 1) {
                am = wave_max(am); const float sx = am > 0.f ? am * (1.f / 127.f) : 1.f, inv = 1.f / sx;
#pragma unroll
                for (int q = 0; q < 4; ++q) { const int q0 = (int)rintf(v[t][q].x * inv), q1 = (int)rintf(v[t][q].y * inv), q2 = (int)rintf(v[t][q].z * inv), q3 = (int)rintf(v[t][q].w * inv);
                    *(unsigned*)(xqo + (size_t)row * D + (lane + 64 * q) * 4) = (unsigned)(q0 & 0xff) | ((unsigned)(q1 & 0xff) << 8) | ((unsigned)(q2 & 0xff) << 16) | ((unsigned)(q3 & 0xff) << 24); }
                if (lane == 0) xso[row] = sx; }
        }
    }
}
__device__ __forceinline__ void ph_final_norm(float* x, const float* fw, int nrows) { const int tidx = otid();
    const int lane = tidx & 63, wave = tidx >> 6;
    for (int row0 = (blockIdx.x * 8 + wave) * 2; row0 < nrows; row0 += gridDim.x * 16) {
        f32x4 v[2][4];
#pragma unroll
        for (int r = 0; r < 2; ++r)
#pragma unroll
            for (int j = 0; j < 4; ++j) v[r][j] = ((const f32x4*)(x + (size_t)(row0 + r) * D))[lane + 64 * j];
#pragma unroll
        for (int r = 0; r < 2; ++r) { float ss = 0.f;
#pragma unroll
            for (int j = 0; j < 4; ++j) ss += v[r][j].x * v[r][j].x + v[r][j].y * v[r][j].y + v[r][j].z * v[r][j].z + v[r][j].w * v[r][j].w;
            ss = wave_sum(ss); const float rs = rsqrtf(ss * (1.f / D) + EPS);
#pragma unroll
            for (int j = 0; j < 4; ++j) { const f32x4 w = *(const f32x4*)(fw + (lane + 64 * j) * 4); f32x4 o = v[r][j] * rs; o.x *= w.x; o.y *= w.y; o.z *= w.z; o.w *= w.w; ((f32x4*)(x + (size_t)(row0 + r) * D))[lane + 64 * j] = o; } }
    }
}
#define DEFINE_PTRS \
    const float* x = p.in[0]; const float* c = p.in[1]; const float* ctx = p.in[2]; const float* c_ctx = p.in[3]; \
    const float* norm1_w = p.in[4]; const float* norm2_w = p.in[5]; const float* w_ada = p.in[6]; const float* b_ada = p.in[7]; \
    const float* w_in = p.in[8]; const float* w_out = p.in[9]; const float* na_rpb = p.in[10]; \
    const float* dec_f = p.in[11]; const float* dec_b = p.in[12]; const float* gn_w = p.in[13]; \
    const float* pool_w = p.in[14]; const float* pool_scale = p.in[15]; const float* peer_wq = p.in[16]; \
    const float* peer_keys = p.in[17]; const float* peer_u = p.in[18]; const float* peer_v = p.in[19]; const float* final_w = p.in[20]; \
    unsigned char* ws = p.ws; float* out = p.out; \
    float* MOD = (float*)(ws + WS_MOD); float* cosT = (float*)(ws + WS_ROPE); float* sinT = cosT + S * 32; \
    bf16* WI = (bf16*)(ws + WS_WI); bf16* WO = (bf16*)(ws + WS_WO); bf16* WQ = (bf16*)(ws + WS_WQ); bf16* KEYS = (bf16*)(ws + WS_KEYS); \
    bf16* XR = (bf16*)(ws + WS_XR); bf16* XRC = (bf16*)(ws + WS_XRC); bf16* U = (bf16*)(ws + WS_U); bf16* V = (bf16*)(ws + WS_V); bf16* ACT = (bf16*)(ws + WS_ACT); \
    bf16* PX = (bf16*)(ws + WS_PX); bf16* Q = PX; float* ST = (float*)(ws + WS_ST); bf16* STB = (bf16*)(ws + WS_ST); int* IDX = (int*)(ws + WS_IDX); float* GATE = (float*)(ws + WS_GATE); \
    float* TOPV = (float*)(ws + WS_TOPV); int* TOPI = (int*)(ws + WS_TOPI); \
    float* AW = (float*)(ws + WS_AW); (void)AW; \
    unsigned char* WI8 = ws + WS_WI8; unsigned char* WQ8 = ws + WS_WQ8; float* SWI = (float*)(ws + WS_SWI); float* SWQ = (float*)(ws + WS_SWQ); (void)WI8; (void)WQ8; (void)SWI; (void)SWQ; \
    unsigned char* XQ = ws + WS_XQ; float* XS = (float*)(ws + WS_XS); (void)XQ; (void)XS; \
    unsigned char* U8 = ws + WS_U; unsigned char* V8 = ws + WS_V; float* SU = (float*)(ws + WS_SU); float* SV = (float*)(ws + WS_SV); (void)U8; (void)V8; (void)SU; (void)SV; \
    (void)x; (void)c; (void)ctx; (void)c_ctx; (void)norm1_w; (void)norm2_w; (void)w_ada; (void)b_ada; (void)w_in; (void)w_out; (void)na_rpb; (void)dec_f; (void)dec_b; (void)gn_w; \
    (void)pool_w; (void)pool_scale; (void)peer_wq; (void)peer_keys; (void)peer_u; (void)peer_v; (void)final_w; (void)out; (void)MOD; (void)cosT; (void)sinT; (void)WI; (void)WO; (void)WQ; \
    (void)KEYS; (void)XR; (void)XRC; (void)U; (void)V; (void)ACT; (void)PX; (void)Q; (void)ST; (void)IDX; (void)GATE; (void)TOPV; (void)TOPI;
#define GRID_SYNC() xcd_barrier(bar)

template <int l>
__device__ __forceinline__ void layer(const Params& p, unsigned char* lds, const XcdBarrier& bar) {
    DEFINE_PTRS
    constexpr bool last = (l == DEPTH - 1);
    const float* modl = MOD + (size_t)l * 5 * 6 * D;
    constexpr int mrows = last ? M_LAT : M_ALL;
    if (l == 0) { ph_quant_w(WI, WI8, SWI, DEPTH * DPROJ_PAD); ph_quant_w(WQ, WQ8, SWQ, DEPTH * DQ); }
    if (l == 0) { DUP(1) ph_norm<true, false>(x, ctx, norm1_w + l * D, modl, 0, D, nullptr, XQ, XS, M_ALL);
    GRID_SYNC(); }
    else if (gridDim.x != 256) { ph_norm<true, true>(XR, XRC, norm1_w + l * D, modl, 0, D, nullptr, XQ, XS, M_ALL);
    GRID_SYNC(); }
#if USE_PG8
    DUP(2) { pg8::Gemm g{(const pg8::bf16_t*)XQ, (const pg8::bf16_t*)(WI8 + (size_t)l * DPROJ_PAD * D), M_ALL, DPROJ_PAD, D / 2}; pg8::StaticOrder So; So.init(M_ALL, DPROJ_PAD, (int)gridDim.x, (int)blockIdx.x);
      EpiI8Bf16Out E{PX, DPROJ, DPROJ, XS, SWI + l * DPROJ_PAD}; pg8::gemm_phase_i8<EpiI8Bf16Out, pg8::StaticOrder>((PG8_LAS unsigned char*)lds, g, So, E, nullptr); }
#else
    ph_gemm_simple<0>(ACT, WI + (size_t)l * DPROJ_PAD * D, M_ALL, DPROJ_PAD, D, PX, DPROJ, DPROJ, nullptr, nullptr, nullptr, nullptr, nullptr, 0, (bf16*)lds);
#endif
    GRID_SYNC();
#if NA_NAIVE
    ph_na(PX, na_rpb + (size_t)l * NAH * 15 * 31, ACT, mrows);
#else
    DUP(4) { ph_na_mfma(PX, na_rpb + (size_t)l * NAH * 15 * 31, ACT, last ? 1536 : 1584, lds);
    __syncthreads(); }
#endif
    DUP(5) ph_pool(PX, ACT, mrows);
#if RET_NAIVE
    ph_ret_state(PX, cosT, sinT, dec_f + l * RH, dec_b + l * RH, ST, (float*)lds);
#else
    DUP(6) ph_ret_state_mfma(PX, cosT, sinT, dec_f + l * RH, dec_b + l * RH, STB, lds);
#endif
    GRID_SYNC();
#if RET_NAIVE
    ph_ret_scan(dec_f + l * RH, dec_b + l * RH, ST);
#else
    ph_ret_scan_bf(dec_f + l * RH, dec_b + l * RH, STB);
#endif
    GRID_SYNC();
#if RET_NAIVE
    ph_ret_out(PX, cosT, sinT, dec_f + l * RH, dec_b + l * RH, ST, gn_w + l * RW, ACT, last ? 64 : NCH, (float*)lds);
#else
    DUP(7) ph_ret_out_mfma(PX, cosT, sinT, dec_f + l * RH, dec_b + l * RH, STB, gn_w + l * RW, ACT, last ? 64 : NCH, lds);
#endif
    GRID_SYNC();
#if USE_PG8
    DUP(l == 0 ? 11 : 31) { pg8::Gemm g{ACT, WO + (size_t)l * D * D, mrows, D, D}; pg8::StaticOrder So; So.init(mrows, D, (int)gridDim.x, (int)blockIdx.x);
      if (l == 0) { EpiRes<false> E{x, ctx, XR, XRC, modl, 2 * D}; pg8::gemm_phase<EpiRes<false>, pg8::StaticOrder>((PG8_LAS unsigned char*)lds, g, So, E, nullptr); }
      else { EpiRes<true> E{XR, XRC, XR, XRC, modl, 2 * D}; pg8::gemm_phase<EpiRes<true>, pg8::StaticOrder>((PG8_LAS unsigned char*)lds, g, So, E, nullptr); } }
#else
    ph_gemm_simple<1>(ACT, WO + (size_t)l * D * D, mrows, D, D, nullptr, 0, 0, xl, xc, out, XCTX, modl, 2 * D, (bf16*)lds);
#endif
    GRID_SYNC();
    DUP(1) ph_norm<true, true>(XR, XRC, norm2_w + l * D, modl, 3 * D, 4 * D, gridDim.x != 256 ? ACT : nullptr, XQ, XS, mrows);
    GRID_SYNC();
#if USE_PG8
    DUP(3) { pg8::Gemm g{(const pg8::bf16_t*)XQ, (const pg8::bf16_t*)(WQ8 + (size_t)l * DQ * D), mrows, DQ, D / 2}; pg8::StaticOrder So; So.init(mrows, DQ, (int)gridDim.x, (int)blockIdx.x);
#if TK32
      EpiI8QT E{Q, XS, SWQ + l * DQ};
      if (gridDim.x == 256) { pg8::HeadOrder Ho; Ho.init(mrows, (int)blockIdx.x); pg8::gemm_phase_i8<EpiI8QT, pg8::HeadOrder>((PG8_LAS unsigned char*)lds, g, Ho, E, nullptr); }
      else pg8::gemm_phase_i8<EpiI8QT, pg8::StaticOrder>((PG8_LAS unsigned char*)lds, g, So, E, nullptr); }
#else
      EpiI8Bf16Out E{Q, DQ, DQ, XS, SWQ + l * DQ}; pg8::gemm_phase_i8<EpiI8Bf16Out, pg8::StaticOrder>((PG8_LAS unsigned char*)lds, g, So, E, nullptr); }
#endif
#else
    ph_gemm_simple<0>(ACT, WQ + (size_t)l * DQ * D, mrows, DQ, D, Q, DQ, DQ, nullptr, nullptr, nullptr, nullptr, nullptr, 0, (bf16*)lds);
#endif
#if TK32
    if (gridDim.x == 256) { __syncthreads(); DUP(8) ph_tk32<true>(Q, KEYS + (size_t)l * 2 * PH * PNK * PKD, IDX, GATE, mrows, lds); }
    else { GRID_SYNC(); DUP(8) ph_tk32<false>(Q, KEYS + (size_t)l * 2 * PH * PNK * PKD, IDX, GATE, mrows, lds); }
#else
    GRID_SYNC();
#endif
#if 1
#if TK32
#else
    DUP(8) ph_tk_mfma(Q, KEYS + (size_t)l * 2 * PH * PNK * PKD, IDX, GATE, mrows, lds);
#endif
#endif
    GRID_SYNC();
#if PEER_BF16
    ph_peer<last>(ACT, IDX, GATE, U + (size_t)l * NEXP * D, V + (size_t)l * NEXP * D, modl, 5 * D, out, XCTX, final_w, mrows);
#else
    if (gridDim.x == 256) {
        ph_peer_sweep<last ? 2 : 1>(IDX, GATE, U8 + (size_t)l * NEXP * D, V8 + (size_t)l * NEXP * D, SU + l * NEXP, SV + l * NEXP, XQ, XS, AW, modl, 5 * D, XR, XRC, out,
                                    last ? final_w : norm1_w + (l + 1) * D, MOD + (size_t)(l + 1 < DEPTH ? l + 1 : l) * 5 * 6 * D, XQ, XS, mrows, lds);
        if (!last) GRID_SYNC();
    } else {
        ph_peer8<last ? 2 : 0>(ACT, IDX, GATE, U8 + (size_t)l * NEXP * D, V8 + (size_t)l * NEXP * D, SU + l * NEXP, SV + l * NEXP, modl, 5 * D, XR, XRC, out, final_w, nullptr, mrows);
        if (!last) GRID_SYNC();
    }
    return;
#endif
    if (!last) GRID_SYNC();
}

__global__ void __launch_bounds__(NT, 2) mega(Params p) {
    extern __shared__ __attribute__((aligned(16))) unsigned char lds[];
    volatile LAS unsigned* bst = (volatile LAS unsigned*)((LAS unsigned char*)lds + LDS_BYTES - 64);
    if (threadIdx.x < 16) bst[threadIdx.x] = 0u;
    __syncthreads();
    const XcdBarrier bar = xcd_barrier_post((unsigned*)(p.ws + WS_CTL), bst);
    DUP(0) {
        DEFINE_PTRS
        DUP(20) { ph_mods(c, c_ctx, w_ada, b_ada, MOD, (float*)lds);
        __syncthreads();
#if RET_NAIVE
        ph_rope(cosT, sinT);
#endif
        }
        DUP(21)
        { ph_transpose_all(w_in, peer_wq, w_out, WI, WQ, WO, (float*)lds);
          ph_wo_pool(w_out, pool_w, pool_scale, WO, (float*)lds); }
        ph_cvt(peer_keys, KEYS, (size_t)DEPTH * 2 * PH * PNK * PKD / 4);
#if PEER_BF16
        ph_cvt(peer_u, U, (size_t)DEPTH * NEXP * D / 4);
        ph_cvt(peer_v, V, (size_t)DEPTH * NEXP * D / 4);
#else
        DUP(22) { ph_quant(peer_u, U8, SU, DEPTH * NEXP, 0);
        ph_quant(peer_v, V8, SV, DEPTH * NEXP, 0); }
#endif
    }
    GRID_SYNC();
    layer<0>(p, lds, bar);
    layer<1>(p, lds, bar);
}
}

extern "C" void kernel_launch(void* const* d_in, const int* in_sizes, int n_in, void* d_out, int out_size, void* d_ws, size_t ws_size, hipStream_t stream) {
    static int grid = 0;
    if (grid == 0) {
        if (n_in != 21 || out_size != M_LAT * D || ws_size < WS_END) { fprintf(stderr, "kernel_launch: unexpected sizes n_in %d out %d ws %zu (need %zu)\n", n_in, out_size, ws_size, (size_t)WS_END); grid = -1; return; }
        int dev = 0, cus = 0, per_cu = 0;
        if (hipGetDevice(&dev) != hipSuccess || hipDeviceGetAttribute(&cus, hipDeviceAttributeMultiprocessorCount, dev) != hipSuccess) { fprintf(stderr, "kernel_launch: device query failed\n"); grid = -1; return; }
        if (hipFuncSetAttribute((const void*)mega, hipFuncAttributeMaxDynamicSharedMemorySize, LDS_BYTES) != hipSuccess) { fprintf(stderr, "kernel_launch: hipFuncSetAttribute failed\n"); grid = -1; return; }
        if (hipOccupancyMaxActiveBlocksPerMultiprocessor(&per_cu, (const void*)mega, NT, LDS_BYTES) != hipSuccess || per_cu < 1) { fprintf(stderr, "kernel_launch: occupancy query says %d\n", per_cu); grid = -1; (void)hipGetLastError(); return; }
        grid = cus;
    }
    if (grid < 0) return;
    Params p{};
    for (int i = 0; i < 21; ++i) p.in[i] = (const float*)d_in[i];
    p.out = (float*)d_out; p.ws = (unsigned char*)d_ws;
    if (hipMemsetAsync((char*)d_ws + WS_CTL, 0, 65536, stream) != hipSuccess) { fprintf(stderr, "kernel_launch: memset failed\n"); return; }
    hipLaunchKernelGGL(mega, dim3(grid), dim3(NT), LDS_BYTES, stream, p);
    hipError_t e = hipPeekAtLastError();
    if (e != hipSuccess) fprintf(stderr, "kernel_launch: launch failed: %s (grid %d)\n", hipGetErrorString(e), grid);
}
```

```cpp
#include <hip/hip_runtime.h>
#include <cstdio>
#include <cstdint>

#ifndef DUP_MASK
#define DUP_MASK 0
#endif
#ifndef USE_PG8
#define USE_PG8 1
#endif
#ifndef NA_NAIVE
#define NA_NAIVE 0
#endif
#ifndef TK_NAIVE
#define TK_NAIVE 0
#endif
#ifndef RET_NAIVE
#define RET_NAIVE 0
#endif
#ifndef TK32
#define TK32 1
#endif
#ifndef PEER_BF16
#define PEER_BF16 0
#endif
#define DUP(bit) for (int _r = 0; _r < ((((unsigned)DUP_MASK >> (bit)) & 1u) ? 2 : 1); ++_r)

__device__ __forceinline__ int otid() { int t = threadIdx.x; asm volatile("" : "+v"(t)); return t; }

namespace pg8 {

#define PG8_LAS __attribute__((address_space(3)))
typedef unsigned short bf16_t;
typedef short bf16x8 __attribute__((ext_vector_type(8)));
typedef float f32x4 __attribute__((ext_vector_type(4)));
typedef unsigned u32x4 __attribute__((ext_vector_type(4)));
constexpr int BM = 256, BK = 64, HALF = 128, HTB = HALF * BK * 2  , STAGE_BYTES = 8 * HTB, NXCD = 8, WGM = 8;

__host__ __device__ __forceinline__ int lds_byte(int r, int c) { const int st = (r >> 4) * 2 + (c >> 5), rr = r & 15, cc = c & 31, ob = rr * 64 + cc * 2; return st * 1024 + (ob ^ (((ob >> 9) & 1) << 5)); }
__host__ __device__ __forceinline__ void stage_rc(int b, int& R, int& C) { const int st = b / 1024, sb = b % 1024, swz = sb ^ (((sb >> 9) & 1) << 5); R = (st >> 1) * 16 + swz / 64; C = (st & 1) * 32 + (swz % 64) / 2; }
__host__ __device__ __forceinline__ int perm32(int rho) { const int n = rho >> 4, i = rho & 15; return 8 * (i >> 2) + 4 * n + (i & 3); }

struct Unit { int pm, pn; };
struct Gemm { const bf16_t* A; const bf16_t* Bt; int M, N, K; };

struct StaticOrder {
    int nM, nN, nwg, G, c;
    __host__ __device__ __forceinline__ void init(int M, int N, int G_, int c_) { nM = M / BM; nN = N / BM; nwg = nM * nN; G = G_; c = c_; }
    __host__ __device__ __forceinline__ bool next(int i, Unit& u) const {
        const long L = (long)i * G + c; if (L >= nwg) return false;
        int wgid = (int)L; { const int q = nwg / NXCD, r = nwg % NXCD, xcd = wgid % NXCD, off = wgid / NXCD; wgid = (xcd < r ? xcd * (q + 1) : r * (q + 1) + (xcd - r) * q) + off; }
        const int nig = WGM * nN, gid = wgid / nig, fm = gid * WGM, gsz = (nM - fm) < WGM ? (nM - fm) : WGM;
        u.pm = fm + ((wgid % nig) % gsz); u.pn = (wgid % nig) / gsz; return true;
    }
    __device__ __forceinline__ void a_ready(const Unit&) const {}
    __device__ __forceinline__ void done(const Unit&) const {}
};
struct HeadOrder {
    int nM, c;
    __device__ __forceinline__ void init(int M, int c_) { nM = M / BM; c = c_; }
    __device__ __forceinline__ bool next(int i, Unit& u) const { const int k = c >> 3, pm = 4 * (c & 7) + (k >> 3) + 32 * i; if (pm >= nM) return false; u.pm = pm; u.pn = k & 7; return true; }
    __device__ __forceinline__ void a_ready(const Unit&) const {} __device__ __forceinline__ void done(const Unit&) const {}
};
struct OneUnit { Unit u; __device__ __forceinline__ bool next(int i, Unit& o) const { if (i != 0) return false; o = u; return true; }
    __device__ __forceinline__ void a_ready(const Unit&) const {} __device__ __forceinline__ void done(const Unit&) const {} };

typedef unsigned u32x2 __attribute__((ext_vector_type(2)));
__device__ __forceinline__ unsigned cvt_pk_bf16(float lo, float hi) { unsigned r; asm volatile("v_cvt_pk_bf16_f32 %0, %1, %2" : "=v"(r) : "v"(lo), "v"(hi)); return r; }
typedef __bf16 bf16x2v_t __attribute__((ext_vector_type(2)));
typedef float f32x2v_t __attribute__((ext_vector_type(2)));
__device__ __forceinline__ unsigned cvt_pk_bf16_n(float lo, float hi) { const bf16x2v_t r = __builtin_convertvector((f32x2v_t){lo, hi}, bf16x2v_t); return __builtin_bit_cast(unsigned, r); }
template <class Epi, class Sched, bool STAMP = false>
__device__ __forceinline__ void gemm_phase(PG8_LAS unsigned char* lds, const Gemm g, const Sched& S, const Epi& E, unsigned long long* stamps) {
    const int tid = otid(), wid = __builtin_amdgcn_readfirstlane(tid >> 6), lane = tid & 63, wr = wid >> 2, wc = wid & 3, fr = lane & 15, fq = lane >> 4;
    const int K = g.K, nt = K / BK;
    int ts_lo = 0, ts_hi = 0, nts = 0; const unsigned long long rt_entry = STAMP ? (unsigned long long)wall_clock64() : 0ull;
#define PG8_STAMP() do { if (STAMP && wid == 0 && nts < 64) { const unsigned long long _c = (unsigned long long)clock64(); \
        ts_lo = (lane == nts) ? (int)(unsigned)_c : ts_lo; ts_hi = (lane == nts) ? (int)(unsigned)(_c >> 32) : ts_hi; ++nts; } } while (0)
    PG8_STAMP();
    unsigned voffA[2], voffB[2];
#pragma unroll
    for (int i = 0; i < 2; ++i) { int R, C; stage_rc(tid * 16 + i * 8192, R, C); const int Rb = Epi::PERM ? ((R & ~31) + perm32(R & 31)) : R;
        voffA[i] = (unsigned)(R * K + C) * 2u; voffB[i] = (unsigned)(Rb * K + C) * 2u; }
    const size_t kstep = (size_t)(BK * 2);
    const size_t hstep = (size_t)HALF * K * 2;
    const size_t tstep = 2 * hstep;
    const unsigned ldsw = (unsigned)wid * 1024u;
    const int aoff = lds_byte(wr * 64 + fr, fq * 8), boff = lds_byte(wc * 32 + fr, fq * 8);
#define PG8_SA(b, h) (((b) * 2 + (h)) * HTB)
#define PG8_SB(b, h) ((4 + (b) * 2 + (h)) * HTB)
#define PG8_STAGE(bufoff, gbase, voff) do { _Pragma("unroll") for (int _i = 0; _i < 2; ++_i) \
        __builtin_amdgcn_global_load_lds((const unsigned*)((const char*)(gbase) + (voff)[_i]), (PG8_LAS unsigned*)(lds + (bufoff) + ldsw + _i * 8192), 16, 0, 0); } while (0)
#define PG8_LDA(dst, b, h) do { _Pragma("unroll") for (int m = 0; m < 4; ++m) _Pragma("unroll") for (int k = 0; k < 2; ++k) dst[m][k] = *(const PG8_LAS bf16x8*)(lds + PG8_SA(b, h) + aoff + m * 2048 + k * 1024); } while (0)
#define PG8_LDB(dst, b, h) do { _Pragma("unroll") for (int n = 0; n < 2; ++n) _Pragma("unroll") for (int k = 0; k < 2; ++k) dst[n][k] = *(const PG8_LAS bf16x8*)(lds + PG8_SB(b, h) + boff + n * 2048 + k * 1024); } while (0)
#define PG8_MMA(ai, bj, At, Bt) do { __builtin_amdgcn_s_setprio(1); _Pragma("unroll") for (int m = 0; m < 4; ++m) _Pragma("unroll") for (int n = 0; n < 2; ++n) _Pragma("unroll") for (int k = 0; k < 2; ++k) \
        acc[ai][bj][m][n] = __builtin_amdgcn_mfma_f32_16x16x32_bf16(Bt[n][k], At[m][k], acc[ai][bj][m][n], 0, 0, 0); __builtin_amdgcn_s_setprio(0); } while (0)
#define PG8_WAIT_V(n) asm volatile("s_waitcnt vmcnt(" #n ")" ::: "memory")
#define PG8_WAIT_L(n) asm volatile("s_waitcnt lgkmcnt(" #n ")" ::: "memory")
#define PG8_BAR __builtin_amdgcn_s_barrier()
#define PG8_SCHED __builtin_amdgcn_sched_barrier(0)
    Unit cur, nxt; int ui = 0;
    if (!S.next(0, cur)) return;
    f32x4 acc[2][2][4][2];
#pragma unroll
    for (int a = 0; a < 2; ++a)
#pragma unroll
        for (int b = 0; b < 2; ++b)
#pragma unroll
            for (int m = 0; m < 4; ++m)
#pragma unroll
                for (int n = 0; n < 2; ++n) acc[a][b][m][n] = (f32x4){0.f, 0.f, 0.f, 0.f};
    bf16x8 At[4][2], B0[2][2], B1[2][2];
    const char* cA = (const char*)g.A + (size_t)cur.pm * tstep; const char* cB = (const char*)g.Bt + (size_t)cur.pn * tstep;
    S.a_ready(cur);
    PG8_STAGE(PG8_SB(0, 0), cB, voffB); PG8_STAGE(PG8_SA(0, 0), cA, voffA); PG8_STAGE(PG8_SB(0, 1), cB + hstep, voffB); PG8_STAGE(PG8_SA(0, 1), cA + hstep, voffA);
    if (wr == 1) PG8_BAR;
    PG8_WAIT_V(4); PG8_BAR;
    PG8_STAGE(PG8_SB(1, 0), cB + kstep, voffB); PG8_STAGE(PG8_SA(1, 0), cA + kstep, voffA); PG8_STAGE(PG8_SB(1, 1), cB + hstep + kstep, voffB);
    PG8_WAIT_V(6); PG8_BAR;
    PG8_STAMP();
    for (;;) {
        const bool has_next = S.next(ui + 1, nxt);
        const char* nA = has_next ? (const char*)g.A + (size_t)nxt.pm * tstep : cA; const char* nB = has_next ? (const char*)g.Bt + (size_t)nxt.pn * tstep : cB;
        for (int t = 0; t < nt; t += 2) {
            const bool last = (t == nt - 2);
            const char* a1 = cA + (size_t)(t + 1) * kstep;
            const char* a2 = last ? nA : cA + (size_t)(t + 2) * kstep; const char* b2 = last ? nB : cB + (size_t)(t + 2) * kstep;
            const char* a3 = a2 + kstep; const char* b3 = b2 + kstep;
            if (last && has_next) S.a_ready(nxt);
            PG8_LDB(B0, 0, 0); PG8_SCHED; PG8_LDA(At, 0, 0); PG8_STAGE(PG8_SA(1, 1), a1 + hstep, voffA);
            PG8_WAIT_L(8); PG8_BAR; PG8_WAIT_L(0); PG8_MMA(0, 0, At, B0); PG8_BAR; PG8_SCHED;
            PG8_LDB(B1, 0, 1); PG8_STAGE(PG8_SB(0, 0), b2, voffB);
            PG8_BAR; PG8_WAIT_L(0); PG8_MMA(0, 1, At, B1); PG8_BAR;
            PG8_LDA(At, 0, 1); PG8_STAGE(PG8_SA(0, 0), a2, voffA);
            PG8_BAR; PG8_WAIT_L(0); PG8_MMA(1, 0, At, B0); PG8_BAR; PG8_SCHED;
            PG8_STAGE(PG8_SB(0, 1), b2 + hstep, voffB);
            PG8_WAIT_V(6); PG8_BAR; PG8_MMA(1, 1, At, B1); PG8_BAR;
            PG8_LDB(B0, 1, 0); PG8_SCHED; PG8_LDA(At, 1, 0); PG8_STAGE(PG8_SA(0, 1), a2 + hstep, voffA);
            PG8_WAIT_L(8); PG8_BAR; PG8_WAIT_L(0); PG8_MMA(0, 0, At, B0); PG8_BAR; PG8_SCHED;
            PG8_LDB(B1, 1, 1); PG8_STAGE(PG8_SB(1, 0), b3, voffB);
            PG8_BAR; PG8_WAIT_L(0); PG8_MMA(0, 1, At, B1); PG8_BAR;
            PG8_LDA(At, 1, 1); PG8_STAGE(PG8_SA(1, 0), a3, voffA);
            PG8_BAR; PG8_WAIT_L(0); PG8_MMA(1, 0, At, B0); PG8_BAR; PG8_SCHED;
            PG8_STAGE(PG8_SB(1, 1), b3 + hstep, voffB);
            PG8_WAIT_V(6); PG8_BAR; PG8_MMA(1, 1, At, B1); PG8_BAR;
        }
        PG8_STAMP();
        if constexpr (!Epi::AFTER_DRAIN) { E(acc, cur, wr, wc, fr, fq); S.done(cur); }
        PG8_STAMP();
        if (!has_next) break;
#pragma unroll
        for (int a = 0; a < 2; ++a)
#pragma unroll
            for (int b = 0; b < 2; ++b)
#pragma unroll
                for (int m = 0; m < 4; ++m)
#pragma unroll
                    for (int n = 0; n < 2; ++n) acc[a][b][m][n] = (f32x4){0.f, 0.f, 0.f, 0.f};
        cur = nxt; cA = nA; cB = nB; ++ui;
    }
    PG8_WAIT_V(0);
    if (wr == 0) PG8_BAR;
    PG8_BAR;
    if constexpr (Epi::AFTER_DRAIN) { E.fused(acc, cur, wr, wc, fr, fq, lds, wid, lane); S.done(cur); }
    PG8_STAMP();
    if (STAMP && wid == 0) { stamps[lane] = lane < nts ? (((unsigned long long)(unsigned)ts_hi << 32) | (unsigned)ts_lo) : 0ull;
        if (lane == 62) stamps[62] = rt_entry; if (lane == 63) stamps[63] = (unsigned long long)wall_clock64(); }
#undef PG8_STAMP
#undef PG8_SA
#undef PG8_SB
#undef PG8_STAGE
#undef PG8_LDA
#undef PG8_LDB
#undef PG8_MMA
#undef PG8_WAIT_V
#undef PG8_WAIT_L
#undef PG8_BAR
#undef PG8_SCHED
}

typedef int i32x4 __attribute__((ext_vector_type(4)));
template <class Epi, class Sched, bool STAMP = false>
__device__ __forceinline__ void gemm_phase_i8(PG8_LAS unsigned char* lds, const Gemm g, const Sched& S, const Epi& E, unsigned long long* stamps) {
    const int tid = otid(), wid = __builtin_amdgcn_readfirstlane(tid >> 6), lane = tid & 63, wr = wid >> 2, wc = wid & 3, fr = lane & 15, fq = lane >> 4;
    const int K = g.K, nt = K / BK;
    int ts_lo = 0, ts_hi = 0, nts = 0; const unsigned long long rt_entry = STAMP ? (unsigned long long)wall_clock64() : 0ull;
#define PG8_STAMP() do { if (STAMP && wid == 0 && nts < 64) { const unsigned long long _c = (unsigned long long)clock64(); \
        ts_lo = (lane == nts) ? (int)(unsigned)_c : ts_lo; ts_hi = (lane == nts) ? (int)(unsigned)(_c >> 32) : ts_hi; ++nts; } } while (0)
    PG8_STAMP();
    unsigned voffA[2], voffB[2];
#pragma unroll
    for (int i = 0; i < 2; ++i) { int R, C; stage_rc(tid * 16 + i * 8192, R, C); const int Rb = Epi::PERM ? ((R & ~31) + perm32(R & 31)) : R;
        voffA[i] = (unsigned)(R * K + C) * 2u; voffB[i] = (unsigned)(Rb * K + C) * 2u; }
    const size_t kstep = (size_t)(BK * 2);
    const size_t hstep = (size_t)HALF * K * 2;
    const size_t tstep = 2 * hstep;
    const unsigned ldsw = (unsigned)wid * 1024u;
    const int aoff = lds_byte(wr * 64 + fr, fq * 8), boff = lds_byte(wc * 32 + fr, fq * 8);
#define PG8_SA(b, h) (((b) * 2 + (h)) * HTB)
#define PG8_SB(b, h) ((4 + (b) * 2 + (h)) * HTB)
#define PG8_STAGE(bufoff, gbase, voff) do { _Pragma("unroll") for (int _i = 0; _i < 2; ++_i) \
        __builtin_amdgcn_global_load_lds((const unsigned*)((const char*)(gbase) + (voff)[_i]), (PG8_LAS unsigned*)(lds + (bufoff) + ldsw + _i * 8192), 16, 0, 0); } while (0)
#define PG8_LDA(dst, b, h) do { _Pragma("unroll") for (int m = 0; m < 4; ++m) _Pragma("unroll") for (int k = 0; k < 2; ++k) dst[m][k] = *(const PG8_LAS i32x4*)(lds + PG8_SA(b, h) + aoff + m * 2048 + k * 1024); } while (0)
#define PG8_LDB(dst, b, h) do { _Pragma("unroll") for (int n = 0; n < 2; ++n) _Pragma("unroll") for (int k = 0; k < 2; ++k) dst[n][k] = *(const PG8_LAS i32x4*)(lds + PG8_SB(b, h) + boff + n * 2048 + k * 1024); } while (0)
#define PG8_MMA(ai, bj, At, Bt) do { __builtin_amdgcn_s_setprio(1); _Pragma("unroll") for (int m = 0; m < 4; ++m) _Pragma("unroll") for (int n = 0; n < 2; ++n) _Pragma("unroll") for (int k = 0; k < 2; ++k) \
        acc[ai][bj][m][n] = __builtin_amdgcn_mfma_i32_16x16x64_i8(Bt[n][k], At[m][k], acc[ai][bj][m][n], 0, 0, 0); __builtin_amdgcn_s_setprio(0); } while (0)
#define PG8_WAIT_V(n) asm volatile("s_waitcnt vmcnt(" #n ")" ::: "memory")
#define PG8_WAIT_L(n) asm volatile("s_waitcnt lgkmcnt(" #n ")" ::: "memory")
#define PG8_BAR __builtin_amdgcn_s_barrier()
#define PG8_SCHED __builtin_amdgcn_sched_barrier(0)
    Unit cur, nxt; int ui = 0;
    if (!S.next(0, cur)) return;
    i32x4 acc[2][2][4][2];
#pragma unroll
    for (int a = 0; a < 2; ++a)
#pragma unroll
        for (int b = 0; b < 2; ++b)
#pragma unroll
            for (int m = 0; m < 4; ++m)
#pragma unroll
                for (int n = 0; n < 2; ++n) acc[a][b][m][n] = (i32x4){0, 0, 0, 0};
    i32x4 At[4][2], B0[2][2], B1[2][2];
    const char* cA = (const char*)g.A + (size_t)cur.pm * tstep; const char* cB = (const char*)g.Bt + (size_t)cur.pn * tstep;
    S.a_ready(cur);
    PG8_STAGE(PG8_SB(0, 0), cB, voffB); PG8_STAGE(PG8_SA(0, 0), cA, voffA); PG8_STAGE(PG8_SB(0, 1), cB + hstep, voffB); PG8_STAGE(PG8_SA(0, 1), cA + hstep, voffA);
    if (wr == 1) PG8_BAR;
    PG8_WAIT_V(4); PG8_BAR;
    PG8_STAGE(PG8_SB(1, 0), cB + kstep, voffB); PG8_STAGE(PG8_SA(1, 0), cA + kstep, voffA); PG8_STAGE(PG8_SB(1, 1), cB + hstep + kstep, voffB);
    PG8_WAIT_V(6); PG8_BAR;
    PG8_STAMP();
    for (;;) {
        const bool has_next = S.next(ui + 1, nxt);
        const char* nA = has_next ? (const char*)g.A + (size_t)nxt.pm * tstep : cA; const char* nB = has_next ? (const char*)g.Bt + (size_t)nxt.pn * tstep : cB;
        for (int t = 0; t < nt; t += 2) {
            const bool last = (t == nt - 2);
            const char* a1 = cA + (size_t)(t + 1) * kstep;
            const char* a2 = last ? nA : cA + (size_t)(t + 2) * kstep; const char* b2 = last ? nB : cB + (size_t)(t + 2) * kstep;
            const char* a3 = a2 + kstep; const char* b3 = b2 + kstep;
            if (last && has_next) S.a_ready(nxt);
            PG8_LDB(B0, 0, 0); PG8_SCHED; PG8_LDA(At, 0, 0); PG8_STAGE(PG8_SA(1, 1), a1 + hstep, voffA);
            PG8_WAIT_L(8); PG8_BAR; PG8_WAIT_L(0); PG8_MMA(0, 0, At, B0); PG8_BAR; PG8_SCHED;
            PG8_LDB(B1, 0, 1); PG8_STAGE(PG8_SB(0, 0), b2, voffB);
            PG8_BAR; PG8_WAIT_L(0); PG8_MMA(0, 1, At, B1); PG8_BAR;
            PG8_LDA(At, 0, 1); PG8_STAGE(PG8_SA(0, 0), a2, voffA);
            PG8_BAR; PG8_WAIT_L(0); PG8_MMA(1, 0, At, B0); PG8_BAR; PG8_SCHED;
            PG8_STAGE(PG8_SB(0, 1), b2 + hstep, voffB);
            PG8_WAIT_V(6); PG8_BAR; PG8_MMA(1, 1, At, B1); PG8_BAR;
            PG8_LDB(B0, 1, 0); PG8_SCHED; PG8_LDA(At, 1, 0); PG8_STAGE(PG8_SA(0, 1), a2 + hstep, voffA);
            PG8_WAIT_L(8); PG8_BAR; PG8_WAIT_L(0); PG8_MMA(0, 0, At, B0); PG8_BAR; PG8_SCHED;
            PG8_LDB(B1, 1, 1); PG8_STAGE(PG8_SB(1, 0), b3, voffB);
            PG8_BAR; PG8_WAIT_L(0); PG8_MMA(0, 1, At, B1); PG8_BAR;
            PG8_LDA(At, 1, 1); PG8_STAGE(PG8_SA(1, 0), a3, voffA);
            PG8_BAR; PG8_WAIT_L(0); PG8_MMA(1, 0, At, B0); PG8_BAR; PG8_SCHED;
            PG8_STAGE(PG8_SB(1, 1), b3 + hstep, voffB);
            PG8_WAIT_V(6); PG8_BAR; PG8_MMA(1, 1, At, B1); PG8_BAR;
        }
        PG8_STAMP();
        if constexpr (!Epi::AFTER_DRAIN) { for (int _e = 0; _e < ((((unsigned)DUP_MASK >> 14) & 1u) ? 2 : 1); ++_e) E(acc, cur, wr, wc, fr, fq); S.done(cur); }
        PG8_STAMP();
        if (!has_next) break;
#pragma unroll
        for (int a = 0; a < 2; ++a)
#pragma unroll
            for (int b = 0; b < 2; ++b)
#pragma unroll
                for (int m = 0; m < 4; ++m)
#pragma unroll
                    for (int n = 0; n < 2; ++n) acc[a][b][m][n] = (i32x4){0, 0, 0, 0};
        cur = nxt; cA = nA; cB = nB; ++ui;
    }
    PG8_WAIT_V(0);
    if (wr == 0) PG8_BAR;
    PG8_BAR;
    if constexpr (Epi::AFTER_DRAIN) { E.fused(acc, cur, wr, wc, fr, fq, lds, wid, lane); S.done(cur); }
    PG8_STAMP();
    if (STAMP && wid == 0) { stamps[lane] = lane < nts ? (((unsigned long long)(unsigned)ts_hi << 32) | (unsigned)ts_lo) : 0ull;
        if (lane == 62) stamps[62] = rt_entry; if (lane == 63) stamps[63] = (unsigned long long)wall_clock64(); }
#undef PG8_STAMP
#undef PG8_SA
#undef PG8_SB
#undef PG8_STAGE
#undef PG8_LDA
#undef PG8_LDB
#undef PG8_MMA
#undef PG8_WAIT_V
#undef PG8_WAIT_L
#undef PG8_BAR
#undef PG8_SCHED
}
}

#define XB_TMO      128
#define XB_XCNT(j)  (256  + 64 * (j))
#define XB_XSUB(j)  (1280 + 64 * (j))
#define XB_XGEN(j)  (2304 + 64 * (j))
#define XB_TOP      3328
#define XB_TOPGEN   3392
#define XCD_BAR_WORDS 3456
#define XB_SPIN_CAP (1u << 18)
#define LAS __attribute__((address_space(3)))

__device__ __forceinline__ unsigned xb_ld(unsigned* p)              { return __hip_atomic_load(p, __ATOMIC_RELAXED, __HIP_MEMORY_SCOPE_AGENT); }
__device__ __forceinline__ unsigned xb_add(unsigned* p, unsigned v) { return __hip_atomic_fetch_add(p, v, __ATOMIC_RELAXED, __HIP_MEMORY_SCOPE_AGENT); }
__device__ __forceinline__ unsigned xb_xcc_id() { return (unsigned)__builtin_amdgcn_s_getreg((3 << 11) | 20) & 0xFu; }
#define XB_SPIN(cond, bar) do { unsigned _sp = 0; while (cond) { __builtin_amdgcn_s_sleep(1); \
    if ((++_sp & 255u) == 0u) { if (xb_ld(&(bar)[XB_TMO])) break; if (_sp > XB_SPIN_CAP) { atomicAdd(&(bar)[XB_TMO], 1u); break; } } } } while (0)

struct XcdBarrier {
    unsigned* bar; unsigned x;
    volatile LAS unsigned* st;
};

__device__ __forceinline__ XcdBarrier xcd_barrier_post(unsigned* bar, volatile LAS unsigned* st) {
    XcdBarrier b; b.bar = bar; b.x = xb_xcc_id(); b.st = st;
    if (threadIdx.x == 0) (void)xb_add(&bar[XB_XCNT(b.x)], 1u);
    return b;
}
__device__ __forceinline__ void xcd_barrier_complete(unsigned* bar, unsigned x, unsigned& nloc, unsigned& nx) {
    const unsigned G = gridDim.x * gridDim.y * gridDim.z;
    unsigned sum, cnt, mine, sp = 0u;
    for (;;) {
        sum = 0u; cnt = 0u; mine = 0u;
#pragma unroll
        for (unsigned j = 0; j < 16; ++j) { const unsigned c = xb_ld(&bar[XB_XCNT(j)]); sum += c; cnt += (c > 0u) ? 1u : 0u; mine = (j == x) ? c : mine; }
        if (sum == G) break;
        __builtin_amdgcn_s_sleep(1);
        if ((++sp & 255u) == 0u) { if (xb_ld(&bar[XB_TMO])) break; if (sp > XB_SPIN_CAP) { atomicAdd(&bar[XB_TMO], 1u); break; } }
    }
    nloc = mine > 0u ? mine : 1u; nx = cnt > 0u ? cnt : 1u;
}

__device__ __forceinline__ void xcd_barrier(const XcdBarrier& b) {
    asm volatile("s_waitcnt vmcnt(0)" ::: "memory");
    __syncthreads();
    if (threadIdx.x == 0) {
        unsigned* bar = b.bar;
        __builtin_amdgcn_s_waitcnt(0);
        unsigned nloc = b.st[0], nx = b.st[1];
        if (nloc == 0u) { xcd_barrier_complete(bar, b.x, nloc, nx); b.st[0] = nloc; b.st[1] = nx; }
        const unsigned old = xb_add(&bar[XB_XSUB(b.x)], 1u);
        const unsigned gen = old / nloc;
        if (old + 1u == (gen + 1u) * nloc) {
            __builtin_amdgcn_fence(__ATOMIC_RELEASE, "agent");
            asm volatile("s_waitcnt vmcnt(0)" ::: "memory");
            const unsigned og = xb_add(&bar[XB_TOP], 1u);
            const unsigned tg = og / nx;
            if (og + 1u == (tg + 1u) * nx) xb_add(&bar[XB_TOPGEN], 1u);
            else XB_SPIN(xb_ld(&bar[XB_TOPGEN]) == tg, bar);
            __builtin_amdgcn_fence(__ATOMIC_ACQUIRE, "agent");
            xb_add(&bar[XB_XGEN(b.x)], 1u);
            asm volatile("s_waitcnt vmcnt(0)" ::: "memory");
        } else {
            XB_SPIN(xb_ld(&bar[XB_XGEN(b.x)]) == gen, bar);
            __builtin_amdgcn_fence(__ATOMIC_ACQUIRE, "agent");
            asm volatile("s_waitcnt vmcnt(0)" ::: "memory");
        }
    }
    __syncthreads();
}


namespace {
constexpr int D = 1024, NB = 4, S = 8192, DEPTH = 2, GW = 64, CTX = 256, HD = 64;
constexpr int NAH = 6, RH = 6, NAW = 384, RW = 384, PW = 256;
constexpr int M_LAT = NB * S, M_CTX = NB * CTX, M_ALL = M_LAT + M_CTX;
constexpr int O_NA_Q = 0, O_NA_K = 384, O_NA_V = 768, O_RET_Q = 1152, O_RET_K = 1536, O_RET_V = 1920, O_RET_G = 2304, O_POOL = 2688;
constexpr int DPROJ = 2944, DPROJ_PAD = 3072;
constexpr int PH = 8, PNK = 128, PKD = 128, PTOP = 16, NEXP = 16384, DQ = 2048;
constexpr float EPS = 1e-6f;
constexpr int NCH = S / 128 + 2;
constexpr int NT = 512;
constexpr int LDS_BYTES = 163840;

typedef unsigned short bf16;
typedef short bf16x8 __attribute__((ext_vector_type(8)));
typedef float f32x4 __attribute__((ext_vector_type(4)));
typedef unsigned u32x4 __attribute__((ext_vector_type(4)));

__device__ __forceinline__ float bf2f(bf16 v) { return __uint_as_float(((unsigned)v) << 16); }
__device__ __forceinline__ bf16 f2bf(float f) { unsigned u = __float_as_uint(f); return (bf16)((u + 0x7fffu + ((u >> 16) & 1u)) >> 16); }
__device__ __forceinline__ float silu(float x) { return x / (1.f + __expf(-x)); }
#define SWZ_XOR(v, m) __int_as_float(__builtin_amdgcn_ds_swizzle(__float_as_int(v), ((m) << 10) | 0x1f))
__device__ __forceinline__ float wave_sum(float v) {
    v += SWZ_XOR(v, 1); v += SWZ_XOR(v, 2); v += SWZ_XOR(v, 4); v += SWZ_XOR(v, 8); v += SWZ_XOR(v, 16);
    return __int_as_float(__builtin_amdgcn_readlane(__float_as_int(v), 0)) + __int_as_float(__builtin_amdgcn_readlane(__float_as_int(v), 32));
}
__device__ __forceinline__ float wave_max(float v) {
    v = fmaxf(v, SWZ_XOR(v, 1)); v = fmaxf(v, SWZ_XOR(v, 2)); v = fmaxf(v, SWZ_XOR(v, 4)); v = fmaxf(v, SWZ_XOR(v, 8)); v = fmaxf(v, SWZ_XOR(v, 16));
    return fmaxf(__int_as_float(__builtin_amdgcn_readlane(__float_as_int(v), 0)), __int_as_float(__builtin_amdgcn_readlane(__float_as_int(v), 32)));
}
__device__ __forceinline__ int rl_i(int v, int lane) { return __builtin_amdgcn_readlane(v, lane); }
__device__ __forceinline__ float rl_f(float v, int lane) { return __int_as_float(__builtin_amdgcn_readlane(__float_as_int(v), lane)); }

constexpr size_t MiB = 1u << 20;
constexpr size_t WS_CTL = 0;
constexpr size_t WS_MOD = 1 * MiB;
constexpr size_t WS_ROPE = WS_MOD + 512 * 1024;
constexpr size_t WS_KEYS = 3 * MiB + 512 * 1024;
constexpr size_t WS_SU = 4 * MiB + 512 * 1024, WS_SV = WS_SU + 256 * 1024;
constexpr size_t WS_XS = 5 * MiB;
constexpr size_t WS_SWI = 5 * MiB + 512 * 1024, WS_SWQ = WS_SWI + 65536;
constexpr size_t WS_WO = 6 * MiB;
constexpr size_t WS_WI8 = 10 * MiB, WS_WQ8 = 16 * MiB;
constexpr size_t WS_WI = 20 * MiB;
constexpr size_t WS_WQ = 32 * MiB;
constexpr size_t WS_U = 40 * MiB;
constexpr size_t WS_V = 72 * MiB;
constexpr size_t WS_XQ = 104 * MiB;
constexpr size_t WS_ACT = 137 * MiB;
constexpr size_t WS_PX = 203 * MiB;
constexpr size_t WS_AW = WS_PX + 160 * MiB;
constexpr size_t WS_ST = 393 * MiB;
constexpr size_t WS_XR = 443 * MiB;
constexpr size_t WS_XRC = 507 * MiB;
constexpr size_t WS_END = 509 * MiB;
constexpr size_t WS_IDX = WS_ST, WS_GATE = WS_ST + 17 * MiB;
constexpr size_t WS_TOPV = WS_PX + 133 * MiB, WS_TOPI = WS_ACT;

struct Params { const float* in[21]; float* out; unsigned char* ws; };

__device__ __forceinline__ void ph_mods(const float* c, const float* c_ctx, const float* w_ada, const float* b_ada, float* mod, float* sm  ) { const int tidx = otid();
    const int tid = tidx, ks = tid >> 6, jj = tid & 63;
    float* act = sm; float* red = sm + 5 * D;
    if ((int)blockIdx.x >= DEPTH * 96) return;
    for (int i = tid; i < 5 * D; i += NT) { const float v = i < 4 * D ? c[i] : c_ctx[i - 4 * D]; act[i] = silu(v); }
    __syncthreads();
    for (int vb = blockIdx.x; vb < DEPTH * 96; vb += gridDim.x) {
        const int l = vb / 96, j = (vb % 96) * 64 + jj;
        const float* w = w_ada + (size_t)l * D * 6 * D + (size_t)(ks * 128) * 6 * D + j;
        const float* ap = act + ks * 128;
        float a0 = 0, a1 = 0, a2 = 0, a3 = 0, a4 = 0;
#pragma unroll 32
        for (int k = 0; k < 128; ++k) { const float wv = w[(size_t)k * 6 * D];
            a0 += ap[k] * wv; a1 += ap[D + k] * wv; a2 += ap[2 * D + k] * wv; a3 += ap[3 * D + k] * wv; a4 += ap[4 * D + k] * wv; }
        red[(ks * 5 + 0) * 64 + jj] = a0; red[(ks * 5 + 1) * 64 + jj] = a1; red[(ks * 5 + 2) * 64 + jj] = a2; red[(ks * 5 + 3) * 64 + jj] = a3; red[(ks * 5 + 4) * 64 + jj] = a4;
        __syncthreads();
        if (tid < 320) { const int r = tid >> 6; float s = 0.f;
#pragma unroll
            for (int q = 0; q < 8; ++q) s += red[(q * 5 + r) * 64 + jj];
            mod[((size_t)l * 5 + r) * 6 * D + j] = s + b_ada[l * 6 * D + j]; }
        __syncthreads();
    }
}
__device__ __forceinline__ void ph_rope(float* cosT, float* sinT) { const int tidx = otid();
    for (int gid = blockIdx.x * NT + tidx; gid < S * 32; gid += gridDim.x * NT) {
        const int t = gid / 32, j = gid % 32, jj = j & 15;
        const float inv = powf(10000.f, -(float)jj / 16.f);
        const float pos = j < 16 ? (float)(t / GW) : (float)(t % GW);
        const float ang = pos * inv;
        cosT[gid] = cosf(ang); sinT[gid] = sinf(ang);
    }
}
__device__ __forceinline__ void ph_transpose(const float* W, int K, int N, int Npad, int ldk, bf16* Wt, float* tile  ) { const int tidx = otid();
    const int tid = tidx, nbn = Npad / 64, nvb = nbn * (K / 64);
    for (int vb = blockIdx.x; vb < nvb; vb += gridDim.x) {
        const int n0 = (vb % nbn) * 64, k0 = (vb / nbn) * 64;
        { const int kk = tid >> 4, n4 = (tid & 15) * 4;
#pragma unroll
          for (int i = 0; i < 2; ++i) { const int k = kk + 32 * i; const int n = n0 + n4;
              const f32x4 v = (n < N) ? *(const f32x4*)(W + (size_t)(k0 + k) * N + n) : (f32x4){0.f, 0.f, 0.f, 0.f};
              tile[k * 65 + n4] = v.x; tile[k * 65 + n4 + 1] = v.y; tile[k * 65 + n4 + 2] = v.z; tile[k * 65 + n4 + 3] = v.w; } }
        __syncthreads();
        { const int n = tid >> 3, kc = (tid & 7) * 8;
          u32x4 o; o.x = pg8::cvt_pk_bf16(tile[(kc + 0) * 65 + n], tile[(kc + 1) * 65 + n]); o.y = pg8::cvt_pk_bf16(tile[(kc + 2) * 65 + n], tile[(kc + 3) * 65 + n]);
          o.z = pg8::cvt_pk_bf16(tile[(kc + 4) * 65 + n], tile[(kc + 5) * 65 + n]); o.w = pg8::cvt_pk_bf16(tile[(kc + 6) * 65 + n], tile[(kc + 7) * 65 + n]);
          *(u32x4*)(Wt + (size_t)(n0 + n) * ldk + k0 + kc) = o; }
        __syncthreads();
    }
}
__device__ __forceinline__ void ph_transpose_all(const float* w_in, const float* peer_wq, const float* w_out, bf16* WI, bf16* WQ, bf16* WO, float* tile) { const int tidx = otid();
    constexpr int T_IN = (DPROJ_PAD / 64) * (D / 64), T_Q = (DQ / 64) * (D / 64), T_O = (D / 64) * (768 / 64), T_L = T_IN + T_Q + T_O, T_ALL = DEPTH * T_L;
    const int tid = tidx, G = (int)gridDim.x, c = G - 1 - (int)blockIdx.x;
#define TR_DECODE(vb) const int l_ = (vb) / T_L, r0_ = (vb) % T_L; const int which_ = r0_ < T_IN ? 0 : (r0_ < T_IN + T_Q ? 1 : 2); const int r_ = r0_ - (which_ == 0 ? 0 : (which_ == 1 ? T_IN : T_IN + T_Q)); \
        const int N_ = which_ == 0 ? DPROJ : (which_ == 1 ? DQ : D), nbn_ = which_ == 0 ? DPROJ_PAD / 64 : (which_ == 1 ? DQ / 64 : D / 64); \
        const float* W_ = which_ == 0 ? w_in + (size_t)l_ * D * DPROJ : (which_ == 1 ? peer_wq + (size_t)l_ * D * DQ : w_out + (size_t)l_ * D * D); \
        bf16* Wt_ = which_ == 0 ? WI + (size_t)l_ * DPROJ_PAD * D : (which_ == 1 ? WQ + (size_t)l_ * DQ * D : WO + (size_t)l_ * D * D); \
        const int n0_ = (r_ % nbn_) * 64, k0_ = (r_ / nbn_) * 64;
    for (int vb0 = c; vb0 < T_ALL; vb0 += 4 * G) {
        f32x4 v[4][2];
#pragma unroll
        for (int i = 0; i < 4; ++i) { const int vb = vb0 + i * G;
            if (vb < T_ALL) { TR_DECODE(vb) (void)Wt_; const int kk = tid >> 4, n = n0_ + (tid & 15) * 4;
#pragma unroll
                for (int q = 0; q < 2; ++q) v[i][q] = (n < N_) ? *(const f32x4*)(W_ + (size_t)(k0_ + kk + 32 * q) * N_ + n) : (f32x4){0.f, 0.f, 0.f, 0.f}; } }
#pragma unroll
        for (int i = 0; i < 4; ++i) { const int vb = vb0 + i * G;
            if (vb < T_ALL) { float* tl = tile + i * (64 * 65); const int kk = tid >> 4, n4 = (tid & 15) * 4;
#pragma unroll
                for (int q = 0; q < 2; ++q) { const int k = kk + 32 * q; tl[k * 65 + n4] = v[i][q].x; tl[k * 65 + n4 + 1] = v[i][q].y; tl[k * 65 + n4 + 2] = v[i][q].z; tl[k * 65 + n4 + 3] = v[i][q].w; } } }
        __syncthreads();
#pragma unroll
        for (int i = 0; i < 4; ++i) { const int vb = vb0 + i * G;
            if (vb < T_ALL) { TR_DECODE(vb) (void)W_; (void)N_; const float* tl = tile + i * (64 * 65); const int n = tid >> 3, kc = (tid & 7) * 8;
                u32x4 o; o.x = pg8::cvt_pk_bf16(tl[(kc + 0) * 65 + n], tl[(kc + 1) * 65 + n]); o.y = pg8::cvt_pk_bf16(tl[(kc + 2) * 65 + n], tl[(kc + 3) * 65 + n]);
                o.z = pg8::cvt_pk_bf16(tl[(kc + 4) * 65 + n], tl[(kc + 5) * 65 + n]); o.w = pg8::cvt_pk_bf16(tl[(kc + 6) * 65 + n], tl[(kc + 7) * 65 + n]);
                *(u32x4*)(Wt_ + (size_t)(n0_ + n) * D + k0_ + kc) = o; } }
        __syncthreads();
    }
#undef TR_DECODE
}
__device__ __forceinline__ void ph_wo_pool(const float* w_out_all, const float* pool_w_all, const float* pool_scale_all, bf16* Wo_t_all, float* sm) { const int tidx = otid();
    const int tid = tidx; float* P = sm; float* Ws = sm + 64 * 65;
    for (int vb = (int)gridDim.x - 1 - (int)blockIdx.x; vb < DEPTH * 4 * 16; vb += gridDim.x) {
        const int l = vb >> 6, g = (vb >> 4) & 3, n0 = (vb & 15) * 64;
        const float* w_out = w_out_all + (size_t)l * D * D; const float* pool_w = pool_w_all + (size_t)l * 4 * 64 * 64; const float* pool_scale = pool_scale_all + (size_t)l * PW; bf16* Wo_t = Wo_t_all + (size_t)l * D * D;
        for (int i = tid; i < 4096; i += NT) { const int r = i >> 6, cc = i & 63; P[r * 65 + cc] = pool_w[(g * 64 + r) * 64 + cc] * pool_scale[g * 64 + cc]; Ws[r * 65 + cc] = w_out[(size_t)(768 + g * 64 + r) * D + n0 + cc]; }
        __syncthreads();
        { const int i = tid & 63, nq = tid >> 6;
#pragma unroll 1
          for (int nn = nq * 8; nn < nq * 8 + 8; ++nn) { float s = 0.f;
#pragma unroll 16
              for (int j = 0; j < 64; ++j) s += P[i * 65 + j] * Ws[j * 65 + nn];
              Wo_t[(size_t)(n0 + nn) * D + 768 + g * 64 + i] = f2bf(s); } }
        __syncthreads();
    }
}
__device__ __forceinline__ void ph_cvt(const float* src, bf16* dst, size_t n4) { const int tidx = otid();
    for (size_t i = (size_t)blockIdx.x * NT + tidx; i < n4; i += (size_t)gridDim.x * NT) {
        const f32x4 v = ((const f32x4*)src)[i]; ushort4 o; o.x = f2bf(v.x); o.y = f2bf(v.y); o.z = f2bf(v.z); o.w = f2bf(v.w); ((ushort4*)dst)[i] = o; }
}

template <bool BF> __device__ __forceinline__ f32x4 ld4res(const void* p, size_t idx) {
    if (BF) { const ushort4 v = *(const ushort4*)((const bf16*)p + idx); return (f32x4){bf2f(v.x), bf2f(v.y), bf2f(v.z), bf2f(v.w)}; }
    else return *(const f32x4*)((const float*)p + idx);
}
__device__ __forceinline__ void st4res(bf16* p, size_t idx, f32x4 v) { pg8::u32x2 o; o.x = pg8::cvt_pk_bf16(v.x, v.y); o.y = pg8::cvt_pk_bf16(v.z, v.w); *(pg8::u32x2*)(p + idx) = o; }

template <bool XQOUT, bool INBF>
__device__ __forceinline__ void ph_norm(const void* xlat, const void* xctx, const float* nw, const float* modl, int off_sh, int off_sc, bf16* act  , unsigned char* xq, float* xs, int nrows) { const int tidx = otid();
    const int lane = tidx & 63, wave = tidx >> 6;
    for (int row0 = (blockIdx.x * 8 + wave) * 2; row0 < nrows; row0 += gridDim.x * 16) {
        f32x4 v[2][4];
#pragma unroll
        for (int r = 0; r < 2; ++r) { const int row = row0 + r; const void* src = row < M_LAT ? xlat : xctx; const size_t rb = (size_t)(row < M_LAT ? row : row - M_LAT) * D;
#pragma unroll
            for (int j = 0; j < 4; ++j) v[r][j] = ld4res<INBF>(src, rb + (size_t)(lane + 64 * j) * 4); }
#pragma unroll
        for (int r = 0; r < 2; ++r) { const int row = row0 + r; const int mi = row < M_LAT ? row / S : 4;
            const float* sh = modl + (size_t)mi * 6 * D + off_sh; const float* sc = modl + (size_t)mi * 6 * D + off_sc;
            float ss = 0.f;
#pragma unroll
            for (int j = 0; j < 4; ++j) ss += v[r][j].x * v[r][j].x + v[r][j].y * v[r][j].y + v[r][j].z * v[r][j].z + v[r][j].w * v[r][j].w;
            ss = wave_sum(ss);
            const float rs = rsqrtf(ss * (1.f / D) + EPS);
            f32x4 hv[4]; float am = 0.f;
#pragma unroll
            for (int j = 0; j < 4; ++j) { const int k = (lane + 64 * j) * 4;
                const f32x4 w = *(const f32x4*)(nw + k), a = *(const f32x4*)(sc + k), b = *(const f32x4*)(sh + k);
                hv[j].x = v[r][j].x * rs * w.x * (1.f + a.x) + b.x; hv[j].y = v[r][j].y * rs * w.y * (1.f + a.y) + b.y; hv[j].z = v[r][j].z * rs * w.z * (1.f + a.z) + b.z; hv[j].w = v[r][j].w * rs * w.w * (1.f + a.w) + b.w;
                if (act) { ushort4 o; o.x = f2bf(hv[j].x); o.y = f2bf(hv[j].y); o.z = f2bf(hv[j].z); o.w = f2bf(hv[j].w);
                *(ushort4*)(act + (size_t)row * D + k) = o; }
                am = fmaxf(am, fmaxf(fmaxf(fabsf(hv[j].x), fabsf(hv[j].y)), fmaxf(fabsf(hv[j].z), fabsf(hv[j].w)))); }
            if (XQOUT) { am = wave_max(am); const float sx = am > 0.f ? am * (1.f / 127.f) : 1.f, inv = 1.f / sx;
#pragma unroll
                for (int j = 0; j < 4; ++j) { const int q0 = (int)rintf(hv[j].x * inv), q1 = (int)rintf(hv[j].y * inv), q2 = (int)rintf(hv[j].z * inv), q3 = (int)rintf(hv[j].w * inv);
                    *(unsigned*)(xq + (size_t)row * D + (lane + 64 * j) * 4) = (unsigned)(q0 & 0xff) | ((unsigned)(q1 & 0xff) << 8) | ((unsigned)(q2 & 0xff) << 16) | ((unsigned)(q3 & 0xff) << 24); }
                if (lane == 0) xs[row] = sx; }
        }
    }
}

struct EpiBf16Out {
    static constexpr bool PERM = true, AFTER_DRAIN = false;
    bf16* O; int ldc; int ncols;
    __device__ __forceinline__ void operator()(const pg8::f32x4 (&acc)[2][2][4][2], const pg8::Unit& u, int wr, int wc, int fr, int fq) const {
        const int row0 = u.pm * 256 + wr * 64 + fr, col0 = u.pn * 256 + wc * 32 + 8 * fq;
#pragma unroll
        for (int ai = 0; ai < 2; ++ai)
#pragma unroll
            for (int m = 0; m < 4; ++m) { bf16* rowp = O + (size_t)(row0 + ai * 128 + m * 16) * ldc + col0;
#pragma unroll
                for (int bj = 0; bj < 2; ++bj) { if (col0 + bj * 128 < ncols) { const pg8::f32x4 v0 = acc[ai][bj][m][0], v1 = acc[ai][bj][m][1];
                    u32x4 w; w.x = pg8::cvt_pk_bf16(v0[0], v0[1]); w.y = pg8::cvt_pk_bf16(v0[2], v0[3]); w.z = pg8::cvt_pk_bf16(v1[0], v1[1]); w.w = pg8::cvt_pk_bf16(v1[2], v1[3]);
                    *(u32x4*)(rowp + bj * 128) = w; } } }
    }
};
#ifndef NT_STORE
#define NT_STORE 0
#endif
struct EpiI8Bf16Out {
    static constexpr bool PERM = true, AFTER_DRAIN = false;
    bf16* O; int ldc; int ncols; const float* sa; const float* sb;
    __device__ __forceinline__ void operator()(const pg8::i32x4 (&acc)[2][2][4][2], const pg8::Unit& u, int wr, int wc, int fr, int fq) const {
        const int row0 = u.pm * 256 + wr * 64 + fr, col0 = u.pn * 256 + wc * 32 + 8 * fq;
        f32x4 sbv[2][2];
#pragma unroll
        for (int bj = 0; bj < 2; ++bj) { sbv[bj][0] = *(const f32x4*)(sb + col0 + bj * 128); sbv[bj][1] = *(const f32x4*)(sb + col0 + bj * 128 + 4); }
        float srv[2][4];
#pragma unroll
        for (int ai = 0; ai < 2; ++ai)
#pragma unroll
            for (int m = 0; m < 4; ++m) srv[ai][m] = sa[row0 + ai * 128 + m * 16];
#pragma unroll
        for (int ai = 0; ai < 2; ++ai)
#pragma unroll
            for (int m = 0; m < 4; ++m) { const int row = row0 + ai * 128 + m * 16; const float sr = srv[ai][m]; bf16* rowp = O + (size_t)row * ldc + col0;
#pragma unroll
                for (int bj = 0; bj < 2; ++bj) { if (col0 + bj * 128 < ncols) { const pg8::i32x4 v0 = acc[ai][bj][m][0], v1 = acc[ai][bj][m][1]; const f32x4 s0 = sbv[bj][0] * sr, s1 = sbv[bj][1] * sr;
                    u32x4 w; w.x = pg8::cvt_pk_bf16((float)v0[0] * s0.x, (float)v0[1] * s0.y); w.y = pg8::cvt_pk_bf16((float)v0[2] * s0.z, (float)v0[3] * s0.w);
                    w.z = pg8::cvt_pk_bf16((float)v1[0] * s1.x, (float)v1[1] * s1.y); w.w = pg8::cvt_pk_bf16((float)v1[2] * s1.z, (float)v1[3] * s1.w);
                    if (NT_STORE) __builtin_nontemporal_store(w, (u32x4*)(rowp + bj * 128)); else *(u32x4*)(rowp + bj * 128) = w; } } }
    }
};
struct EpiI8QT {
    static constexpr bool PERM = true, AFTER_DRAIN = false;
    bf16* O; const float* sa; const float* sb;
    __device__ __forceinline__ void operator()(const pg8::i32x4 (&acc)[2][2][4][2], const pg8::Unit& u, int wr, int wc, int fr, int fq) const {
        const int row0 = u.pm * 256 + wr * 64 + fr, col0 = u.pn * 256 + wc * 32 + 8 * fq;
        f32x4 sbv[2][2];
#pragma unroll
        for (int bj = 0; bj < 2; ++bj) { sbv[bj][0] = *(const f32x4*)(sb + col0 + bj * 128); sbv[bj][1] = *(const f32x4*)(sb + col0 + bj * 128 + 4); }
        float srv[2][4];
#pragma unroll
        for (int ai = 0; ai < 2; ++ai)
#pragma unroll
            for (int m = 0; m < 4; ++m) srv[ai][m] = sa[row0 + ai * 128 + m * 16];
        const int sfrag = (2 * wc + (fq >> 1)) * 512 + (fq & 1) * 256;
#pragma unroll
        for (int ai = 0; ai < 2; ++ai)
#pragma unroll
            for (int m = 0; m < 4; ++m) { const int row = row0 + ai * 128 + m * 16; const float sr = srv[ai][m];
#pragma unroll
                for (int bj = 0; bj < 2; ++bj) { const pg8::i32x4 v0 = acc[ai][bj][m][0], v1 = acc[ai][bj][m][1]; const f32x4 s0 = sbv[bj][0] * sr, s1 = sbv[bj][1] * sr;
                    u32x4 w; w.x = pg8::cvt_pk_bf16((float)v0[0] * s0.x, (float)v0[1] * s0.y); w.y = pg8::cvt_pk_bf16((float)v0[2] * s0.z, (float)v0[3] * s0.w);
                    w.z = pg8::cvt_pk_bf16((float)v1[0] * s1.x, (float)v1[1] * s1.y); w.w = pg8::cvt_pk_bf16((float)v1[2] * s1.z, (float)v1[3] * s1.w);
                    *(u32x4*)(O + ((size_t)(((row >> 5) * PH + u.pn) * 2 + bj)) * 4096 + sfrag + (row & 31) * 8) = w; } }
    }
};
template <bool INBF>
struct EpiRes {
    static constexpr bool PERM = false, AFTER_DRAIN = false;
    const void* xin_lat; const void* xin_ctx; bf16* xout_lat; bf16* xout_ctx; const float* modl; int off_g;
    __device__ __forceinline__ void operator()(const pg8::f32x4 (&acc)[2][2][4][2], const pg8::Unit& u, int wr, int wc, int fr, int fq) const {
        const int r0 = u.pm * 256; const bool lat = r0 < M_LAT; const int mi = lat ? r0 / S : 4;
        const void* xin = lat ? xin_lat : xin_ctx; bf16* xout = lat ? xout_lat : xout_ctx;
        const size_t rbase = (size_t)(lat ? r0 : r0 - M_LAT) * D;
        const int col0 = u.pn * 256 + wc * 32 + 4 * fq;
        const float* gp = modl + (size_t)mi * 6 * D + off_g + col0;
        f32x4 gv[2][2];
#pragma unroll
        for (int bj = 0; bj < 2; ++bj)
#pragma unroll
            for (int n = 0; n < 2; ++n) gv[bj][n] = *(const f32x4*)(gp + bj * 128 + n * 16);
#pragma unroll
        for (int ai = 0; ai < 2; ++ai) {
            f32x4 xi[4][2][2];
#pragma unroll
            for (int mm = 0; mm < 4; ++mm) { const size_t off = rbase + (size_t)(ai * 128 + wr * 64 + mm * 16 + fr) * D + col0;
#pragma unroll
                for (int bj = 0; bj < 2; ++bj)
#pragma unroll
                    for (int n = 0; n < 2; ++n) xi[mm][bj][n] = ld4res<INBF>(xin, off + bj * 128 + n * 16); }
#pragma unroll
            for (int mm = 0; mm < 4; ++mm) { const size_t off = rbase + (size_t)(ai * 128 + wr * 64 + mm * 16 + fr) * D + col0;
#pragma unroll
                for (int bj = 0; bj < 2; ++bj)
#pragma unroll
                    for (int n = 0; n < 2; ++n) { const pg8::f32x4 a = acc[ai][bj][mm][n]; const f32x4 gq = gv[bj][n], x4 = xi[mm][bj][n]; f32x4 o;
                        o.x = x4.x + gq.x * a[0]; o.y = x4.y + gq.y * a[1]; o.z = x4.z + gq.z * a[2]; o.w = x4.w + gq.w * a[3];
                        st4res(xout, off + bj * 128 + n * 16, o); } }
            asm volatile("" ::: "memory");
        }
    }
};

template <int EPI>
__device__ __forceinline__ void ph_gemm_simple(const bf16* A, const bf16* Bt, int M, int N, int K, bf16* Cb, int ldc, int ncols,
                                               const float* xin_lat, const float* xin_ctx, float* xout_lat, float* xout_ctx, const float* modl, int off_g, bf16* sm  ) { const int tidx = otid();
    bf16 (*sA)[40] = (bf16 (*)[40])sm; bf16 (*sB)[40] = (bf16 (*)[40])(sm + 128 * 40);
    const int tid = tidx, w = tid >> 6, lane = tid & 63, fr = lane & 15, fq = lane >> 4;
    const int lr = tid >> 2, lc = (tid & 3) * 8;
    const int nbn = N / 64, nvb = (M / 128) * nbn;
    for (int vb = blockIdx.x; vb < nvb; vb += gridDim.x) {
        const int m0 = (vb / nbn) * 128, n0 = (vb % nbn) * 64;
        f32x4 acc[4];
#pragma unroll
        for (int j = 0; j < 4; ++j) acc[j] = (f32x4){0.f, 0.f, 0.f, 0.f};
        for (int k0 = 0; k0 < K; k0 += 32) {
            *(bf16x8*)&sA[lr][lc] = *(const bf16x8*)(A + (size_t)(m0 + lr) * K + k0 + lc);
            if (tid < 256) *(bf16x8*)&sB[lr][lc] = *(const bf16x8*)(Bt + (size_t)(n0 + lr) * K + k0 + lc);
            __syncthreads();
            const bf16x8 a = *(const bf16x8*)&sA[w * 16 + fr][fq * 8];
#pragma unroll
            for (int j = 0; j < 4; ++j) { const bf16x8 b = *(const bf16x8*)&sB[j * 16 + fr][fq * 8]; acc[j] = __builtin_amdgcn_mfma_f32_16x16x32_bf16(a, b, acc[j], 0, 0, 0); }
            __syncthreads();
        }
#pragma unroll
        for (int j = 0; j < 4; ++j)
#pragma unroll
            for (int i = 0; i < 4; ++i) {
                const int row = m0 + w * 16 + fq * 4 + i, col = n0 + j * 16 + fr;
                if (EPI == 0) { if (col < ncols) Cb[(size_t)row * ldc + col] = f2bf(acc[j][i]); }
                else { const int mi = row < M_LAT ? row / S : 4; const float g = modl[(size_t)mi * 6 * D + off_g + col];
                    if (row < M_LAT) xout_lat[(size_t)row * D + col] = xin_lat[(size_t)row * D + col] + g * acc[j][i];
                    else { const size_t o = (size_t)(row - M_LAT) * D + col; xout_ctx[o] = xin_ctx[o] + g * acc[j][i]; } }
            }
    }
}

__device__ __forceinline__ void ph_na(const bf16* px, const float* rpb  , bf16* act, int nrows) { const int tidx = otid();
    for (int gid = blockIdx.x * NT + tidx; gid < nrows * NAH; gid += gridDim.x * NT) {
        const int row = gid / NAH, h = gid % NAH;
        float q[64], o[64];
        const bf16* qp = px + (size_t)row * DPROJ + O_NA_Q + h * 64;
#pragma unroll
        for (int d = 0; d < 64; ++d) { q[d] = bf2f(qp[d]) * 0.125f; o[d] = 0.f; }
        float mx = -1e30f, den = 0.f;
        int b, nwin = 0, rr = 0, cq = 0, r_start = 0, c_start = 0;
        if (row < M_LAT) { b = row / S; const int t = row % S; rr = t / GW; cq = t % GW; r_start = min(max(rr - 4, 0), 128 - 8); c_start = min(max(cq - 8, 0), GW - 16); nwin = 128; }
        else b = (row - M_LAT) / CTX;
        for (int i = 0; i < nwin + CTX; ++i) {
            int krow; float bias = 0.f;
            if (i < nwin) { const int j = i / 16, kc = c_start + (i % 16), kr = r_start + j; krow = b * S + kr * GW + kc;
                bias = rpb[(h * 15 + (kr - rr + 7)) * 31 + (kc - cq + 15)]; }
            else krow = M_LAT + b * CTX + (i - nwin);
            const bf16* kp = px + (size_t)krow * DPROJ + O_NA_K + h * 64;
            float s = 0.f;
#pragma unroll
            for (int d = 0; d < 64; ++d) s += q[d] * bf2f(kp[d]);
            s += bias;
            const float nm = fmaxf(mx, s), corr = __expf(mx - nm), p = __expf(s - nm);
            den = den * corr + p; mx = nm;
            const bf16* vp = px + (size_t)krow * DPROJ + O_NA_V + h * 64;
#pragma unroll
            for (int d = 0; d < 64; ++d) o[d] = o[d] * corr + p * bf2f(vp[d]);
        }
        const float inv = 1.f / den;
        bf16* op = act + (size_t)row * D + h * 64;
#pragma unroll
        for (int d = 0; d < 64; ++d) op[d] = f2bf(o[d] * inv);
    }
}

typedef short s16x4 __attribute__((ext_vector_type(4)));
typedef __attribute__((address_space(3))) const unsigned char* lds_cp;
__device__ __forceinline__ s16x4 vtr(lds_cp p) { return __builtin_bit_cast(s16x4, __builtin_amdgcn_ds_read_tr16_b64_v4i16((__attribute__((address_space(3))) s16x4*)p)); }
__device__ __forceinline__ float xq_max(float x) {
    auto s = __builtin_amdgcn_permlane16_swap(__float_as_uint(x), __float_as_uint(x), false, false);
    x = fmaxf(__uint_as_float(s[0]), __uint_as_float(s[1]));
    auto t = __builtin_amdgcn_permlane32_swap(__float_as_uint(x), __float_as_uint(x), false, false);
    return fmaxf(__uint_as_float(t[0]), __uint_as_float(t[1]));
}
__device__ __forceinline__ float xq_sum(float x) {
    auto s = __builtin_amdgcn_permlane16_swap(__float_as_uint(x), __float_as_uint(x), false, false);
    x = __uint_as_float(s[0]) + __uint_as_float(s[1]);
    auto t = __builtin_amdgcn_permlane32_swap(__float_as_uint(x), __float_as_uint(x), false, false);
    return __uint_as_float(t[0]) + __uint_as_float(t[1]);
}
__device__ __forceinline__ void lds_barrier() { __builtin_amdgcn_s_waitcnt(0xC07F); __builtin_amdgcn_s_barrier(); }
constexpr int NA_ROWB = 160;
constexpr int NA_KOFF = 0, NA_VOFF = 2 * 64 * NA_ROWB, NA_BOFF = 4 * 64 * NA_ROWB;
__device__ __forceinline__ void ph_na_mfma(const bf16* px, const float* rpb  , bf16* act, int nunits, unsigned char* ldsg) { const int tidx = otid();
    const int lane = tidx & 63, w = __builtin_amdgcn_readfirstlane(tidx >> 6), fr = lane & 15, quad = lane >> 4;
    const lds_cp lds = (lds_cp)ldsg;
    float* sbias = (float*)(ldsg + NA_BOFF);
    constexpr float LOG2E = 1.4426950408889634f;
    const int skey = tidx >> 3, spiece = tidx & 7;
    const int G_ = gridDim.x, vcu = (G_ % 8 == 0) ? ((int)blockIdx.x % 8) * (G_ / 8) + (int)blockIdx.x / 8 : (int)blockIdx.x;
    for (int u = vcu; u < nunits; u += G_) {
        int b, h, wr0 = 0, nwin = 0, rq = 0, g = 0, rs_q = 0, qrow;
        const bool latent = u < 1536;
        if (latent) { b = u / 384; h = (u / 64) % 6; const int rp = u % 64;
            wr0 = min(max(2 * rp - 4, 0), 120); const int rs1 = min(max(2 * rp - 3, 0), 120); nwin = rs1 + 8 - wr0;
            rq = 2 * rp + (w >> 2); g = w & 3; rs_q = min(max(rq - 4, 0), 120); qrow = b * S + rq * GW + 16 * g + fr; }
        else { const int cu = u - 1536; b = cu / 12; h = (cu >> 1) % 6; qrow = M_LAT + b * CTX + (cu & 1) * 128 + 16 * w + fr; }
        const int nchunks = 4 + nwin;
        const int cq = 16 * g + fr, c_start = min(max(cq - 8, 0), 48);
        lds_barrier();
        for (int i = tidx; i < 480; i += NT) sbias[i] = (i & 31) < 31 ? rpb[h * 465 + (i >> 5) * 31 + (i & 31)] * LOG2E : -1e30f;
        bf16x8 qf[2];
        qf[0] = *(const bf16x8*)(px + (size_t)qrow * DPROJ + O_NA_Q + h * 64 + 8 * quad);
        qf[1] = *(const bf16x8*)(px + (size_t)qrow * DPROJ + O_NA_Q + h * 64 + 32 + 8 * quad);
        u32x4 kreg, vreg;
        { const size_t r = (size_t)(M_LAT + b * CTX + skey);
          kreg = *(const u32x4*)(px + r * DPROJ + O_NA_K + h * 64 + spiece * 8); vreg = *(const u32x4*)(px + r * DPROJ + O_NA_V + h * 64 + spiece * 8); }
        *(u32x4*)(ldsg + NA_KOFF + skey * NA_ROWB + spiece * 16) = kreg; *(u32x4*)(ldsg + NA_VOFF + skey * NA_ROWB + spiece * 16) = vreg;
        lds_barrier();
        f32x4 O[4];
#pragma unroll
        for (int dt = 0; dt < 4; ++dt) O[dt] = (f32x4){0.f, 0.f, 0.f, 0.f};
        float m = -1e30f, lsum = 0.f;
        const int cbase = 4 * quad - cq + 15;
        const int vbase = 4 * quad - c_start;
        const int c0 = min(max(16 * g - 8, 0), 32);
        int boff[8];
#pragma unroll
        for (int e = 0; e < 8; ++e) { const int ce = c0 + 16 * (e >> 2) + (e & 3); boff[e] = ((unsigned)(vbase + ce) < 16u) ? 4 * min(max(cbase + ce, 0), 30) : 4 * 31; }
        for (int c = 0; c < nchunks; ++c) {
            const int buf = c & 1;
            if (c + 1 < nchunks) { const int c1 = c + 1; const size_t r = c1 < 4 ? (size_t)(M_LAT + b * CTX + 64 * c1 + skey) : (size_t)(b * S + (wr0 + c1 - 4) * GW + skey);
                kreg = *(const u32x4*)(px + r * DPROJ + O_NA_K + h * 64 + spiece * 8); vreg = *(const u32x4*)(px + r * DPROJ + O_NA_V + h * 64 + spiece * 8); }
            const bool isctx = c < 4; const int kr = wr0 + c - 4;
            const bool use = isctx || (kr >= rs_q && kr < rs_q + 8);
            if (use) {
                const lds_cp kb = lds + NA_KOFF + buf * 64 * NA_ROWB, vb = lds + NA_VOFF + buf * 64 * NA_ROWB;
                const char* brow = (const char*)(sbias + (kr - rq + 7) * 32);
#pragma unroll
                for (int pair = 0; pair < 2; ++pair) {
                    if (!isctx && pair == 1) continue;
                    const int kofs = isctx ? 32 * pair : c0;
                    f32x4 a0 = (f32x4){0.f, 0.f, 0.f, 0.f}, a1 = a0;
#pragma unroll
                    for (int s = 0; s < 2; ++s) {
                        const bf16x8 k0 = *(const __attribute__((address_space(3))) bf16x8*)(kb + (kofs + fr) * NA_ROWB + 64 * s + 16 * quad);
                        const bf16x8 k1 = *(const __attribute__((address_space(3))) bf16x8*)(kb + (kofs + 16 + fr) * NA_ROWB + 64 * s + 16 * quad);
                        a0 = __builtin_amdgcn_mfma_f32_16x16x32_bf16(k0, qf[s], a0, 0, 0, 0);
                        a1 = __builtin_amdgcn_mfma_f32_16x16x32_bf16(k1, qf[s], a1, 0, 0, 0);
                    }
                    typedef float f32x2 __attribute__((ext_vector_type(2)));
                    f32x2 s2[4];
                    { float sc[8];
                      if (isctx) {
#pragma unroll
                          for (int i = 0; i < 4; ++i) { sc[i] = a0[i] * (0.125f * LOG2E); sc[4 + i] = a1[i] * (0.125f * LOG2E); }
                      } else {
#pragma unroll
                          for (int e = 0; e < 8; ++e) { const float bm = *(const float*)(brow + boff[e]);
                              sc[e] = __builtin_fmaf(e < 4 ? a0[e & 3] : a1[e & 3], 0.125f * LOG2E, bm); }
                      }
#pragma unroll
                      for (int k = 0; k < 4; ++k) s2[k] = (f32x2){sc[2 * k], sc[2 * k + 1]}; }
                    float mx = __builtin_fmaxf(__builtin_fmaxf(__builtin_fmaxf(s2[0].x, s2[0].y), __builtin_fmaxf(s2[1].x, s2[1].y)), __builtin_fmaxf(__builtin_fmaxf(s2[2].x, s2[2].y), __builtin_fmaxf(s2[3].x, s2[3].y)));
                    mx = xq_max(mx);
                    if (__any(mx > m + 6.f)) {
                        const float mn = fmaxf(m, mx), corr = __builtin_amdgcn_exp2f(m - mn); m = mn;
                        lsum *= corr;
#pragma unroll
                        for (int dt = 0; dt < 4; ++dt) O[dt] = O[dt] * corr;
                    }
                    float p[8];
                    { const f32x2 m2 = (f32x2){m, m}; f32x2 p2[4];
#pragma unroll
                      for (int k = 0; k < 4; ++k) { const f32x2 t = s2[k] - m2; p2[k] = (f32x2){__builtin_amdgcn_exp2f(t.x), __builtin_amdgcn_exp2f(t.y)}; p[2 * k] = p2[k].x; p[2 * k + 1] = p2[k].y; }
                      const f32x2 q2 = (p2[0] + p2[1]) + (p2[2] + p2[3]); lsum += q2.x + q2.y; }
                    u32x4 pk; pk.x = pg8::cvt_pk_bf16_n(p[0], p[1]); pk.y = pg8::cvt_pk_bf16_n(p[2], p[3]); pk.z = pg8::cvt_pk_bf16_n(p[4], p[5]); pk.w = pg8::cvt_pk_bf16_n(p[6], p[7]);
                    const bf16x8 pb = __builtin_bit_cast(bf16x8, pk);
#pragma unroll
                    for (int dt = 0; dt < 4; ++dt) {
                        const lds_cp va = vb + (kofs + 4 * quad + (fr >> 2)) * NA_ROWB + (16 * dt + 4 * (fr & 3)) * 2;
                        const s16x4 v0 = vtr(va), v1 = vtr(va + 16 * NA_ROWB);
                        bf16x8 A; A[0] = v0[0]; A[1] = v0[1]; A[2] = v0[2]; A[3] = v0[3]; A[4] = v1[0]; A[5] = v1[1]; A[6] = v1[2]; A[7] = v1[3];
                        O[dt] = __builtin_amdgcn_mfma_f32_16x16x32_bf16(A, pb, O[dt], 0, 0, 0);
                    }
                }
            }
            if (c + 1 < nchunks) { const int nb = (c + 1) & 1;
                *(u32x4*)(ldsg + NA_KOFF + nb * 64 * NA_ROWB + skey * NA_ROWB + spiece * 16) = kreg; *(u32x4*)(ldsg + NA_VOFF + nb * 64 * NA_ROWB + skey * NA_ROWB + spiece * 16) = vreg; }
            lds_barrier();
        }
        const float inv = 1.f / xq_sum(lsum);
        bf16* op = act + (size_t)qrow * D + h * 64 + 4 * quad;
#pragma unroll
        for (int dt = 0; dt < 4; ++dt) { pg8::u32x2 o; o.x = pg8::cvt_pk_bf16(O[dt][0] * inv, O[dt][1] * inv); o.y = pg8::cvt_pk_bf16(O[dt][2] * inv, O[dt][3] * inv); *(pg8::u32x2*)(op + 16 * dt) = o; }
    }
}
__device__ __forceinline__ void ph_na_mfma2(const bf16* px, const float* rpb  , bf16* act, int nunits, unsigned char* ldsg) { const int tidx = otid();
    const int lane = tidx & 63, w = __builtin_amdgcn_readfirstlane(tidx >> 6), fr = lane & 15, quad = lane >> 4;
    const lds_cp lds = (lds_cp)ldsg;
    float* sbias = (float*)(ldsg + NA_BOFF);
    constexpr float LOG2E = 1.4426950408889634f;
    typedef float f32x2 __attribute__((ext_vector_type(2)));
    const int skey = tidx >> 3, spiece = tidx & 7;
    const int G_ = gridDim.x, vcu = (G_ % 8 == 0) ? ((int)blockIdx.x % 8) * (G_ / 8) + (int)blockIdx.x / 8 : (int)blockIdx.x;
    for (int u = vcu; u < nunits; u += G_) {
        int b, h, wr0 = 0, nwin = 0, g = 0, nt, rq[2] = {0, 0}, rs_q[2] = {0, 0}, qrow[2];
        const bool latent = u < 768;
        if (latent) { b = u / 192; h = (u / 32) % 6; const int rp = u % 32; nt = 2;
            wr0 = min(max(4 * rp - 4, 0), 120); nwin = min(max(4 * rp - 1, 0), 120) + 8 - wr0;
            g = w & 3;
#pragma unroll
            for (int t = 0; t < 2; ++t) { rq[t] = 4 * rp + 2 * (w >> 2) + t; rs_q[t] = min(max(rq[t] - 4, 0), 120); qrow[t] = b * S + rq[t] * GW + 16 * g + fr; } }
        else { const int cu = u - 768; b = cu / 12; h = (cu >> 1) % 6; nt = 1; qrow[0] = qrow[1] = M_LAT + b * CTX + (cu & 1) * 128 + 16 * w + fr; }
        const int nchunks = 4 + nwin;
        const int cq = 16 * g + fr, c_start = min(max(cq - 8, 0), 48);
        lds_barrier();
        for (int i = tidx; i < 480; i += NT) sbias[i] = (i & 31) < 31 ? rpb[h * 465 + (i >> 5) * 31 + (i & 31)] * LOG2E : -1e30f;
        bf16x8 qf[2][2];
#pragma unroll
        for (int t = 0; t < 2; ++t) { qf[t][0] = *(const bf16x8*)(px + (size_t)qrow[t] * DPROJ + O_NA_Q + h * 64 + 8 * quad); qf[t][1] = *(const bf16x8*)(px + (size_t)qrow[t] * DPROJ + O_NA_Q + h * 64 + 32 + 8 * quad); }
        u32x4 kreg, vreg;
        { const size_t r = (size_t)(M_LAT + b * CTX + skey);
          kreg = *(const u32x4*)(px + r * DPROJ + O_NA_K + h * 64 + spiece * 8); vreg = *(const u32x4*)(px + r * DPROJ + O_NA_V + h * 64 + spiece * 8); }
        *(u32x4*)(ldsg + NA_KOFF + skey * NA_ROWB + spiece * 16) = kreg; *(u32x4*)(ldsg + NA_VOFF + skey * NA_ROWB + spiece * 16) = vreg;
        lds_barrier();
        f32x4 O[2][4];
#pragma unroll
        for (int t = 0; t < 2; ++t)
#pragma unroll
            for (int dt = 0; dt < 4; ++dt) O[t][dt] = (f32x4){0.f, 0.f, 0.f, 0.f};
        float m[2] = {-1e30f, -1e30f}, lsum[2] = {0.f, 0.f};
        const int cbase = 4 * quad - cq + 15;
        const int vbase = 4 * quad - c_start;
        const int c0 = min(max(16 * g - 8, 0), 32);
        int boff[8];
#pragma unroll
        for (int e = 0; e < 8; ++e) { const int ce = c0 + 16 * (e >> 2) + (e & 3); boff[e] = ((unsigned)(vbase + ce) < 16u) ? 4 * min(max(cbase + ce, 0), 30) : 4 * 31; }
        for (int c = 0; c < nchunks; ++c) {
            const int buf = c & 1;
            if (c + 1 < nchunks) { const int c1 = c + 1; const size_t r = c1 < 4 ? (size_t)(M_LAT + b * CTX + 64 * c1 + skey) : (size_t)(b * S + (wr0 + c1 - 4) * GW + skey);
                kreg = *(const u32x4*)(px + r * DPROJ + O_NA_K + h * 64 + spiece * 8); vreg = *(const u32x4*)(px + r * DPROJ + O_NA_V + h * 64 + spiece * 8); }
            const bool isctx = c < 4; const int kr = wr0 + c - 4;
            bool use[2];
#pragma unroll
            for (int t = 0; t < 2; ++t) use[t] = t < nt && (isctx || (kr >= rs_q[t] && kr < rs_q[t] + 8));
            if (use[0] || use[1]) {
                const lds_cp kb = lds + NA_KOFF + buf * 64 * NA_ROWB, vb = lds + NA_VOFF + buf * 64 * NA_ROWB;
#pragma unroll
                for (int pair = 0; pair < 2; ++pair) {
                    if (!isctx && pair == 1) continue;
                    const int kofs = isctx ? 32 * pair : c0;
                    bf16x8 k0[2], k1[2];
#pragma unroll
                    for (int s = 0; s < 2; ++s) { k0[s] = *(const __attribute__((address_space(3))) bf16x8*)(kb + (kofs + fr) * NA_ROWB + 64 * s + 16 * quad);
                        k1[s] = *(const __attribute__((address_space(3))) bf16x8*)(kb + (kofs + 16 + fr) * NA_ROWB + 64 * s + 16 * quad); }
                    bf16x8 pb[2];
#pragma unroll
                    for (int t = 0; t < 2; ++t) {
                        if (!use[t]) continue;
                        f32x4 a0 = (f32x4){0.f, 0.f, 0.f, 0.f}, a1 = a0;
#pragma unroll
                        for (int s = 0; s < 2; ++s) { a0 = __builtin_amdgcn_mfma_f32_16x16x32_bf16(k0[s], qf[t][s], a0, 0, 0, 0); a1 = __builtin_amdgcn_mfma_f32_16x16x32_bf16(k1[s], qf[t][s], a1, 0, 0, 0); }
                        f32x2 s2[4];
                        { float sc[8];
                          if (isctx) {
#pragma unroll
                              for (int i = 0; i < 4; ++i) { sc[i] = a0[i] * (0.125f * LOG2E); sc[4 + i] = a1[i] * (0.125f * LOG2E); }
                          } else { const char* brow = (const char*)(sbias + (kr - rq[t] + 7) * 32);
#pragma unroll
                              for (int e = 0; e < 8; ++e) { const float bm = *(const float*)(brow + boff[e]);
                                  sc[e] = __builtin_fmaf(e < 4 ? a0[e & 3] : a1[e & 3], 0.125f * LOG2E, bm); }
                          }
#pragma unroll
                          for (int k = 0; k < 4; ++k) s2[k] = (f32x2){sc[2 * k], sc[2 * k + 1]}; }
                        float mx = __builtin_fmaxf(__builtin_fmaxf(__builtin_fmaxf(s2[0].x, s2[0].y), __builtin_fmaxf(s2[1].x, s2[1].y)), __builtin_fmaxf(__builtin_fmaxf(s2[2].x, s2[2].y), __builtin_fmaxf(s2[3].x, s2[3].y)));
                        mx = xq_max(mx);
                        if (__any(mx > m[t] + 6.f)) {
                            const float mn = fmaxf(m[t], mx), corr = __builtin_amdgcn_exp2f(m[t] - mn); m[t] = mn;
                            lsum[t] *= corr;
#pragma unroll
                            for (int dt = 0; dt < 4; ++dt) O[t][dt] = O[t][dt] * corr;
                        }
                        float p[8];
                        { const f32x2 m2 = (f32x2){m[t], m[t]}; f32x2 p2[4];
#pragma unroll
                          for (int k = 0; k < 4; ++k) { const f32x2 tt = s2[k] - m2; p2[k] = (f32x2){__builtin_amdgcn_exp2f(tt.x), __builtin_amdgcn_exp2f(tt.y)}; p[2 * k] = p2[k].x; p[2 * k + 1] = p2[k].y; }
                          const f32x2 q2 = (p2[0] + p2[1]) + (p2[2] + p2[3]); lsum[t] += q2.x + q2.y; }
                        u32x4 pk; pk.x = pg8::cvt_pk_bf16_n(p[0], p[1]); pk.y = pg8::cvt_pk_bf16_n(p[2], p[3]); pk.z = pg8::cvt_pk_bf16_n(p[4], p[5]); pk.w = pg8::cvt_pk_bf16_n(p[6], p[7]);
                        pb[t] = __builtin_bit_cast(bf16x8, pk);
                    }
#pragma unroll
                    for (int dt = 0; dt < 4; ++dt) {
                        const lds_cp va = vb + (kofs + 4 * quad + (fr >> 2)) * NA_ROWB + (16 * dt + 4 * (fr & 3)) * 2;
                        const s16x4 v0 = vtr(va), v1 = vtr(va + 16 * NA_ROWB);
                        bf16x8 A; A[0] = v0[0]; A[1] = v0[1]; A[2] = v0[2]; A[3] = v0[3]; A[4] = v1[0]; A[5] = v1[1]; A[6] = v1[2]; A[7] = v1[3];
#pragma unroll
                        for (int t = 0; t < 2; ++t) if (use[t]) O[t][dt] = __builtin_amdgcn_mfma_f32_16x16x32_bf16(A, pb[t], O[t][dt], 0, 0, 0);
                    }
                }
            }
            if (c + 1 < nchunks) { const int nb = (c + 1) & 1;
                *(u32x4*)(ldsg + NA_KOFF + nb * 64 * NA_ROWB + skey * NA_ROWB + spiece * 16) = kreg; *(u32x4*)(ldsg + NA_VOFF + nb * 64 * NA_ROWB + skey * NA_ROWB + spiece * 16) = vreg; }
            lds_barrier();
        }
#pragma unroll
        for (int t = 0; t < 2; ++t) {
            if (t >= nt) continue;
            const float inv = 1.f / xq_sum(lsum[t]);
            bf16* op = act + (size_t)qrow[t] * D + h * 64 + 4 * quad;
#pragma unroll
            for (int dt = 0; dt < 4; ++dt) { pg8::u32x2 o; o.x = pg8::cvt_pk_bf16(O[t][dt][0] * inv, O[t][dt][1] * inv); o.y = pg8::cvt_pk_bf16(O[t][dt][2] * inv, O[t][dt][3] * inv); *(pg8::u32x2*)(op + 16 * dt) = o; }
        }
    }
}
template <int W>
__device__ __forceinline__ void pool_item(const bf16* px, bf16* act, int row, int oc) {
    int t, T, base;
    if (row < M_LAT) { t = row % S; T = S; base = row - t; } else { t = (row - M_LAT) % CTX; T = CTX; base = row - t; }
    const int lo = max(t - W / 2, 0), hi = min(t + W / 2, T);
    bf16x8 tv[W];
#pragma unroll
    for (int i = 0; i < W; ++i) { const int tt = min(lo + i, hi - 1); tv[i] = *(const bf16x8*)(px + (size_t)(base + tt) * DPROJ + O_POOL + oc * 8); }
    const bf16x8 xv = *(const bf16x8*)(px + (size_t)row * DPROJ + O_POOL + oc * 8);
    float s[8];
#pragma unroll
    for (int j = 0; j < 8; ++j) s[j] = 0.f;
#pragma unroll
    for (int i = 0; i < W; ++i) { const float wgt = (lo + i < hi) ? 1.f : 0.f;
#pragma unroll
        for (int j = 0; j < 8; ++j) s[j] += wgt * bf2f((bf16)tv[i][j]); }
    const float inv = 1.f / (float)(hi - lo);
    u32x4 o; o.x = pg8::cvt_pk_bf16(s[0] * inv - bf2f((bf16)xv[0]), s[1] * inv - bf2f((bf16)xv[1])); o.y = pg8::cvt_pk_bf16(s[2] * inv - bf2f((bf16)xv[2]), s[3] * inv - bf2f((bf16)xv[3]));
    o.z = pg8::cvt_pk_bf16(s[4] * inv - bf2f((bf16)xv[4]), s[5] * inv - bf2f((bf16)xv[5])); o.w = pg8::cvt_pk_bf16(s[6] * inv - bf2f((bf16)xv[6]), s[7] * inv - bf2f((bf16)xv[7]));
    *(u32x4*)(act + (size_t)row * D + 768 + oc * 8) = o;
}
__device__ __forceinline__ void ph_pool(const bf16* px, bf16* act, int nrows) { const int tidx = otid();
    const int per = nrows * 8;
    for (int gid = blockIdx.x * NT + tidx; gid < 4 * per; gid += gridDim.x * NT) {
        const int g = gid / per, r = gid - g * per, row = r >> 3, oc = g * 8 + (r & 7);
        if (g == 0) pool_item<2>(px, act, row, oc); else if (g == 1) pool_item<4>(px, act, row, oc); else if (g == 2) pool_item<8>(px, act, row, oc); else pool_item<16>(px, act, row, oc);
    }
}
__device__ __forceinline__ float rope_elem(const bf16* p, int d, const float* cs, const float* sn, bool rope) {
    const float x = bf2f(p[d]);
    if (!rope) return x;
    const int half = d >> 5, dd = d & 31, j = dd & 15;
    const float c = cs[half * 16 + j], s = sn[half * 16 + j];
    if (dd < 16) { const float x2 = bf2f(p[d + 16]); return x * c - x2 * s; }
    else { const float x1 = bf2f(p[d - 16]); return x1 * s + x * c; }
}
__device__ __forceinline__ int chunk_row0(int b, int ci) { return ci < 64 ? b * S + ci * 128 : M_LAT + b * CTX + (ci - 64) * 128; }
__device__ __forceinline__ void load_kv_chunk(const bf16* px, const float* cosT, const float* sinT, int b, int h, int ci, float* sk, float* sv) { const int tidx = otid();
    const int row0 = chunk_row0(b, ci); const bool rope = ci < 64;
    for (int i = tidx; i < 128 * 64; i += NT) { const int m = i / 64, d = i % 64, row = row0 + m; const int t = rope ? (ci * 128 + m) : 0;
        sk[i] = rope_elem(px + (size_t)row * DPROJ + O_RET_K + h * 64, d, cosT + t * 32, sinT + t * 32, rope) * 0.125f;
        sv[i] = bf2f(px[(size_t)row * DPROJ + O_RET_V + h * 64 + d]); }
}
__device__ __forceinline__ void ph_ret_state(const bf16* px, const float* cosT, const float* sinT, const float* dec_f, const float* dec_b, float* ST, float* sm) { const int tidx = otid();
    float* sk = sm; float* sv = sm + 128 * 64;
    for (int vb = blockIdx.x; vb < NB * RH * NCH; vb += gridDim.x) {
        const int ci = vb % NCH, h = (vb / NCH) % RH, b = vb / (NCH * RH);
        load_kv_chunk(px, cosT, sinT, b, h, ci, sk, sv);
        __syncthreads();
        const float lgf = -log1pf(expf(-dec_f[h])), lgb = -log1pf(expf(-dec_b[h]));
        for (int i = tidx; i < 4096; i += NT) { const int d = i / 64, e = i % 64;
            float af = 0.f, ab = 0.f;
            for (int m = 0; m < 128; ++m) { const float kv = sk[m * 64 + d] * sv[m * 64 + e]; af += expf((127.f - m) * lgf) * kv; ab += expf((float)m * lgb) * kv; }
            ST[((((size_t)(b * RH + h) * 2 + 0) * NCH + ci) * 4096) + i] = af; ST[((((size_t)(b * RH + h) * 2 + 1) * NCH + ci) * 4096) + i] = ab; }
        __syncthreads();
    }
}
__device__ __forceinline__ void ph_ret_scan(const float* dec_f, const float* dec_b, float* ST) { const int tidx = otid();
    for (int gid = blockIdx.x * NT + tidx; gid < NB * RH * 2 * 4096; gid += gridDim.x * NT) {
        const int e = gid % 4096, dir = (gid / 4096) & 1, bh = gid / 8192, h = bh % RH;
        const float lg = -log1pf(expf(-(dir ? dec_b[h] : dec_f[h]))), gg = expf(128.f * lg);
        float* P = ST + ((size_t)bh * 2 + dir) * NCH * 4096 + e;
        float t[64];
#pragma unroll
        for (int c = 0; c < 64; ++c) t[c] = P[(size_t)c * 4096];
        const float k0 = P[(size_t)64 * 4096], k1 = P[(size_t)65 * 4096];
        if (dir == 0) { P[(size_t)64 * 4096] = 0.f; P[(size_t)65 * 4096] = k0; float R = gg * k0 + k1;
#pragma unroll
            for (int c = 0; c < 64; ++c) { const float v = t[c]; t[c] = R; R = gg * R + v; } }
        else { P[(size_t)65 * 4096] = 0.f; P[(size_t)64 * 4096] = k1; float R = k0 + gg * k1;
#pragma unroll
            for (int c = 63; c >= 0; --c) { const float v = t[c]; t[c] = R; R = gg * R + v; } }
#pragma unroll
        for (int c = 0; c < 64; ++c) P[(size_t)c * 4096] = t[c];
    }
}
__device__ __forceinline__ void ph_ret_scan_bf(const float* dec_f, const float* dec_b, bf16* ST) { const int tidx = otid();
    for (int gid = blockIdx.x * NT + tidx; gid < NB * RH * 2 * 2048; gid += gridDim.x * NT) {
        const int e2 = gid % 2048, dir = (gid / 2048) & 1, bh = gid / 4096, h = bh % RH;
        const float lg = -log1pf(expf(-(dir ? dec_b[h] : dec_f[h]))), gg = expf(128.f * lg);
        unsigned* P = (unsigned*)(ST + ((size_t)bh * 2 + dir) * NCH * 4096) + e2;
        unsigned t[64];
#pragma unroll
        for (int c = 0; c < 64; ++c) t[c] = P[(size_t)c * 2048];
        const unsigned k0 = P[(size_t)64 * 2048], k1 = P[(size_t)65 * 2048];
        const float k0x = __uint_as_float(k0 << 16), k0y = __uint_as_float(k0 & 0xffff0000u), k1x = __uint_as_float(k1 << 16), k1y = __uint_as_float(k1 & 0xffff0000u);
        if (dir == 0) { P[(size_t)64 * 2048] = 0u; P[(size_t)65 * 2048] = k0; float Rx = gg * k0x + k1x, Ry = gg * k0y + k1y;
#pragma unroll
            for (int c = 0; c < 64; ++c) { const unsigned v = t[c]; t[c] = pg8::cvt_pk_bf16(Rx, Ry); Rx = gg * Rx + __uint_as_float(v << 16); Ry = gg * Ry + __uint_as_float(v & 0xffff0000u); } }
        else { P[(size_t)65 * 2048] = 0u; P[(size_t)64 * 2048] = k1; float Rx = k0x + gg * k1x, Ry = k0y + gg * k1y;
#pragma unroll
            for (int c = 63; c >= 0; --c) { const unsigned v = t[c]; t[c] = pg8::cvt_pk_bf16(Rx, Ry); Rx = gg * Rx + __uint_as_float(v << 16); Ry = gg * Ry + __uint_as_float(v & 0xffff0000u); } }
#pragma unroll
        for (int c = 0; c < 64; ++c) P[(size_t)c * 2048] = t[c];
    }
}
__device__ __forceinline__ void ph_ret_out(const bf16* px, const float* cosT, const float* sinT, const float* dec_f, const float* dec_b, const float* ST, const float* gn_w, bf16* act, int nci, float* sm) { const int tidx = otid();
    float* sk = sm; float* sv = sm + 128 * 64; float* sy = sm + 2 * 128 * 64; float* sq = sy + 128 * 65;
    const int n = tidx & 127, eq = tidx >> 7;
    for (int vb = blockIdx.x; vb < NB * RH * nci; vb += gridDim.x) {
        const int ci = vb % nci, h = (vb / nci) % RH, b = vb / (nci * RH);
        const int row0 = chunk_row0(b, ci); const bool rope = ci < 64;
        load_kv_chunk(px, cosT, sinT, b, h, ci, sk, sv);
        __syncthreads();
        const int row = row0 + n; const int t = rope ? (ci * 128 + n) : 0;
        const float lgf = -log1pf(expf(-dec_f[h])), lgb = -log1pf(expf(-dec_b[h]));
        float q[64], y[16];
#pragma unroll
        for (int d = 0; d < 64; ++d) { q[d] = rope_elem(px + (size_t)row * DPROJ + O_RET_Q + h * 64, d, cosT + t * 32, sinT + t * 32, rope); if (eq == 0) sq[n * 65 + d] = q[d]; }
        __syncthreads();
#pragma unroll
        for (int e = 0; e < 16; ++e) y[e] = 0.f;
        for (int m = 0; m < 128; ++m) {
            float s = 0.f;
#pragma unroll
            for (int d = 0; d < 64; ++d) s += q[d] * sk[m * 64 + d];
            const float dm = m < n ? expf((float)(n - m) * lgf) : (m > n ? expf((float)(m - n) * lgb) : 2.f);
            s *= dm;
#pragma unroll
            for (int e = 0; e < 16; ++e) y[e] += s * sv[m * 64 + eq * 16 + e];
        }
        const float* Sf = ST + (((size_t)(b * RH + h) * 2 + 0) * NCH + ci) * 4096 + eq * 16; const float* Sb = ST + (((size_t)(b * RH + h) * 2 + 1) * NCH + ci) * 4096 + eq * 16;
        const float xf = expf((float)(n + 1) * lgf), xb = expf((float)(128 - n) * lgb);
#pragma unroll 1
        for (int d = 0; d < 64; ++d) { const float qd = sq[n * 65 + d]; const float qf = qd * xf, qb = qd * xb;
#pragma unroll
            for (int e = 0; e < 16; ++e) y[e] += qf * Sf[d * 64 + e] + qb * Sb[d * 64 + e]; }
#pragma unroll
        for (int e = 0; e < 16; ++e) sy[n * 65 + eq * 16 + e] = y[e];
        __syncthreads();
        float mu = 0.f;
        for (int e = 0; e < 64; ++e) mu += sy[n * 65 + e];
        mu *= (1.f / 64.f); float var = 0.f;
        for (int e = 0; e < 64; ++e) { const float dd = sy[n * 65 + e] - mu; var += dd * dd; }
        const float rs = rsqrtf(var * (1.f / 64.f) + EPS);
        const bf16* gp = px + (size_t)row * DPROJ + O_RET_G + h * 64 + eq * 16; bf16* op = act + (size_t)row * D + NAW + h * 64 + eq * 16;
#pragma unroll
        for (int e = 0; e < 16; ++e) { const float g = bf2f(gp[e]); op[e] = f2bf((y[e] - mu) * rs * gn_w[h * 64 + eq * 16 + e] * silu(g)); }
        __syncthreads();
    }
}


__device__ __forceinline__ void rope8(const bf16* hp, int piece, const float* cs, const float* sn, bool rope, float (&o)[8]) {
    const bf16x8 own = *(const bf16x8*)(hp + piece * 8);
    if (!rope) {
#pragma unroll
        for (int j = 0; j < 8; ++j) o[j] = bf2f((bf16)own[j]);
        return; }
    const bf16x8 par = *(const bf16x8*)(hp + (piece ^ 2) * 8);
    const int half = piece >> 2, pp = piece & 3, tb = half * 16 + 8 * (pp & 1);
    const f32x4 c0 = *(const f32x4*)(cs + tb), c1 = *(const f32x4*)(cs + tb + 4), s0 = *(const f32x4*)(sn + tb), s1 = *(const f32x4*)(sn + tb + 4);
    const float c[8] = {c0.x, c0.y, c0.z, c0.w, c1.x, c1.y, c1.z, c1.w}, s[8] = {s0.x, s0.y, s0.z, s0.w, s1.x, s1.y, s1.z, s1.w};
#pragma unroll
    for (int j = 0; j < 8; ++j) { const float a = bf2f((bf16)own[j]), b = bf2f((bf16)par[j]); o[j] = pp < 2 ? a * c[j] - b * s[j] : b * s[j] + a * c[j]; }
}
__device__ __forceinline__ u32x4 pack8(const float (&o)[8], float sc) {
    u32x4 r; r.x = pg8::cvt_pk_bf16(o[0] * sc, o[1] * sc); r.y = pg8::cvt_pk_bf16(o[2] * sc, o[3] * sc); r.z = pg8::cvt_pk_bf16(o[4] * sc, o[5] * sc); r.w = pg8::cvt_pk_bf16(o[6] * sc, o[7] * sc); return r;
}
__device__ __forceinline__ bf16x8 tr2(lds_cp a, int second_off) {
    const s16x4 v0 = vtr(a), v1 = vtr(a + second_off);
    bf16x8 A; A[0] = v0[0]; A[1] = v0[1]; A[2] = v0[2]; A[3] = v0[3]; A[4] = v1[0]; A[5] = v1[1]; A[6] = v1[2]; A[7] = v1[3]; return A;
}
constexpr int RT_P = 160;
__device__ __forceinline__ void rope_inv8(int odd, float (&inv8)[8]) {
#pragma unroll
    for (int k = 0; k < 8; ++k) inv8[k] = __builtin_amdgcn_exp2f(-(float)(8 * odd + k) * (13.287712379549449f / 16.f)) * 0.15915494309189535f;
}
__device__ __forceinline__ void rope8c(const bf16x8 own, const bf16x8 par, int piece, int t, const float (&inv8)[8], bool rope, float (&o)[8]) {
    if (!rope) {
#pragma unroll
        for (int j = 0; j < 8; ++j) o[j] = bf2f((bf16)own[j]);
        return; }
    const int half = piece >> 2, pp = piece & 3;
    const float pos = (float)(half ? (t % GW) : (t / GW));
#pragma unroll
    for (int j = 0; j < 8; ++j) { const float rev = pos * inv8[j], c = __builtin_amdgcn_cosf(rev), s = __builtin_amdgcn_sinf(rev);
        const float a = bf2f((bf16)own[j]), b = bf2f((bf16)par[j]); o[j] = pp < 2 ? a * c - b * s : b * s + a * c; }
}
__device__ __forceinline__ void rope8r(const bf16x8 own, const bf16x8 par, int piece, const float* cs, const float* sn, bool rope, float (&o)[8]) {
    if (!rope) {
#pragma unroll
        for (int j = 0; j < 8; ++j) o[j] = bf2f((bf16)own[j]);
        return; }
    const int half = piece >> 2, pp = piece & 3, tb = half * 16 + 8 * (pp & 1);
    const f32x4 c0 = *(const f32x4*)(cs + tb), c1 = *(const f32x4*)(cs + tb + 4), s0 = *(const f32x4*)(sn + tb), s1 = *(const f32x4*)(sn + tb + 4);
    const float c[8] = {c0.x, c0.y, c0.z, c0.w, c1.x, c1.y, c1.z, c1.w}, s[8] = {s0.x, s0.y, s0.z, s0.w, s1.x, s1.y, s1.z, s1.w};
#pragma unroll
    for (int j = 0; j < 8; ++j) { const float a = bf2f((bf16)own[j]), b = bf2f((bf16)par[j]); o[j] = pp < 2 ? a * c[j] - b * s[j] : b * s[j] + a * c[j]; }
}
__device__ __forceinline__ void ph_ret_state_mfma(const bf16* px, const float* cosT, const float* sinT, const float* dec_f, const float* dec_b, bf16* ST, unsigned char* ldsg) { const int tidx = otid();
    const int lane = tidx & 63, w = __builtin_amdgcn_readfirstlane(tidx >> 6), fr = lane & 15, quad = lane >> 4;
    const lds_cp lds = (lds_cp)ldsg;
    constexpr int KF = 0, KB = 128 * RT_P, VS = 2 * 128 * RT_P;
    constexpr int NU = NB * RH * NCH;
    bf16x8 kown[2], kpar[2]; u32x4 vv[2];
#define R1_ISSUE(vbx) do { const int ci_ = (vbx) % NCH, h_ = ((vbx) / NCH) % RH, b_ = (vbx) / (NCH * RH); const int row0_ = chunk_row0(b_, ci_); \
        _Pragma("unroll") for (int it = 0; it < 2; ++it) { const int item = tidx + NT * it, m = item >> 3, piece = item & 7; const bf16* rp = px + (size_t)(row0_ + m) * DPROJ; \
            kown[it] = *(const bf16x8*)(rp + O_RET_K + h_ * 64 + piece * 8); kpar[it] = *(const bf16x8*)(rp + O_RET_K + h_ * 64 + (piece ^ 2) * 8); vv[it] = *(const u32x4*)(rp + O_RET_V + h_ * 64 + piece * 8); } } while (0)
    float invk[8]; rope_inv8(tidx & 1, invk);
    int vb = blockIdx.x;
    if (vb < NU) R1_ISSUE(vb);
    for (; vb < NU; vb += gridDim.x) {
        const int ci = vb % NCH, h = (vb / NCH) % RH, b = vb / (NCH * RH);
        const bool rope = ci < 64;
        const float lgf = -log1pf(expf(-dec_f[h])), lgb = -log1pf(expf(-dec_b[h]));
        lds_barrier();
#pragma unroll
        for (int it = 0; it < 2; ++it) { const int item = tidx + NT * it, m = item >> 3, piece = item & 7; const int t = rope ? (ci * 128 + m) : 0;
            float o[8]; rope8c(kown[it], kpar[it], piece, t, invk, rope, o);
            *(u32x4*)(ldsg + KF + m * RT_P + piece * 16) = pack8(o, 0.125f * expf((127.f - (float)m) * lgf));
            *(u32x4*)(ldsg + KB + m * RT_P + piece * 16) = pack8(o, 0.125f * expf((float)m * lgb));
            *(u32x4*)(ldsg + VS + m * RT_P + piece * 16) = vv[it]; }
        R1_ISSUE(min(vb + (int)gridDim.x, NU - 1));
        lds_barrier();
        const int dir = w >> 2, dt = w & 3;
        const lds_cp kb = lds + (dir ? KB : KF);
        bf16x8 A[4];
#pragma unroll
        for (int ks = 0; ks < 4; ++ks) A[ks] = tr2(kb + (32 * ks + 8 * quad + (fr >> 2)) * RT_P + (16 * dt + 4 * (fr & 3)) * 2, 4 * RT_P);
        bf16* outp = ST + ((((size_t)(b * RH + h) * 2 + dir) * NCH + ci) * 4096);
#pragma unroll
        for (int et = 0; et < 4; ++et) {
            f32x4 acc = (f32x4){0.f, 0.f, 0.f, 0.f};
#pragma unroll
            for (int ks = 0; ks < 4; ++ks) { const bf16x8 Bv = tr2(lds + VS + (32 * ks + 8 * quad + (fr >> 2)) * RT_P + (16 * et + 4 * (fr & 3)) * 2, 4 * RT_P);
                acc = __builtin_amdgcn_mfma_f32_16x16x32_bf16(A[ks], Bv, acc, 0, 0, 0); }
#pragma unroll
            for (int i = 0; i < 4; ++i) outp[(16 * dt + 4 * quad + i) * 64 + 16 * et + fr] = f2bf(acc[i]);
        }
    }
#undef R1_ISSUE
}
__device__ __forceinline__ void ph_ret_out_mfma(const bf16* px, const float* cosT, const float* sinT, const float* dec_f, const float* dec_b, const bf16* ST, const float* gn_w, bf16* act, int nci, unsigned char* ldsg) { const int tidx = otid();
    const int lane = tidx & 63, w = __builtin_amdgcn_readfirstlane(tidx >> 6), fr = lane & 15, quad = lane >> 4;
    const lds_cp lds = (lds_cp)ldsg;
    constexpr int KS = 0, VS = 128 * RT_P, SF = 2 * 128 * RT_P, SB = SF + 64 * RT_P;
    constexpr float LOG2E = 1.4426950408889634f;
    const int NU = NB * RH * nci;
    bf16x8 kown[2], kpar[2], qown[2], qpar[2]; u32x4 vv[2]; u32x4 sfu, sbu;
#define R3_ISSUE(vbx) do { const int ci_ = (vbx) % nci, h_ = ((vbx) / nci) % RH, b_ = (vbx) / (nci * RH); const int row0_ = chunk_row0(b_, ci_); \
        _Pragma("unroll") for (int it = 0; it < 2; ++it) { const int item = tidx + NT * it, m = item >> 3, piece = item & 7; const bf16* rp = px + (size_t)(row0_ + m) * DPROJ; \
            kown[it] = *(const bf16x8*)(rp + O_RET_K + h_ * 64 + piece * 8); kpar[it] = *(const bf16x8*)(rp + O_RET_K + h_ * 64 + (piece ^ 2) * 8); vv[it] = *(const u32x4*)(rp + O_RET_V + h_ * 64 + piece * 8); } \
        { const bf16* Sf_ = ST + (((size_t)(b_ * RH + h_) * 2 + 0) * NCH + ci_) * 4096; const bf16* Sb_ = ST + (((size_t)(b_ * RH + h_) * 2 + 1) * NCH + ci_) * 4096; const int d_ = tidx >> 3, e0_ = (tidx & 7) * 8; \
          sfu = *(const u32x4*)(Sf_ + d_ * 64 + e0_); sbu = *(const u32x4*)(Sb_ + d_ * 64 + e0_); } \
        { const bf16* qp = px + (size_t)(row0_ + 16 * w + fr) * DPROJ + O_RET_Q + h_ * 64; \
          _Pragma("unroll") for (int s = 0; s < 2; ++s) { qown[s] = *(const bf16x8*)(qp + (4 * s + quad) * 8); qpar[s] = *(const bf16x8*)(qp + ((4 * s + quad) ^ 2) * 8); } } } while (0)
    float invk[8], invq[8]; rope_inv8(tidx & 1, invk); rope_inv8(quad & 1, invq);
    int vb = blockIdx.x;
    if (vb < NU) R3_ISSUE(vb);
    for (; vb < NU; vb += gridDim.x) {
        const int ci = vb % nci, h = (vb / nci) % RH, b = vb / (nci * RH);
        const int row0 = chunk_row0(b, ci); const bool rope = ci < 64;
        const float lgf2 = -log1pf(expf(-dec_f[h])) * LOG2E, lgb2 = -log1pf(expf(-dec_b[h])) * LOG2E;
        lds_barrier();
#pragma unroll
        for (int it = 0; it < 2; ++it) { const int item = tidx + NT * it, m = item >> 3, piece = item & 7; const int t = rope ? (ci * 128 + m) : 0;
            float o[8]; rope8c(kown[it], kpar[it], piece, t, invk, rope, o);
            *(u32x4*)(ldsg + KS + m * RT_P + piece * 16) = pack8(o, 0.125f);
            *(u32x4*)(ldsg + VS + m * RT_P + piece * 16) = vv[it]; }
        { const int d = tidx >> 3, e0 = (tidx & 7) * 8;
          *(u32x4*)(ldsg + SF + d * RT_P + e0 * 2) = sfu; *(u32x4*)(ldsg + SB + d * RT_P + e0 * 2) = sbu; }
        const int nloc = 16 * w + fr, row = row0 + nloc; const int tq = rope ? (ci * 128 + nloc) : 0;
        bf16x8 qf[2];
#pragma unroll
        for (int s = 0; s < 2; ++s) { float o[8]; rope8c(qown[s], qpar[s], 4 * s + quad, tq, invq, rope, o); qf[s] = __builtin_bit_cast(bf16x8, pack8(o, 1.f)); }
        ushort4 gvp[4]; f32x4 wvp[4];
        { const bf16* gp = px + (size_t)row * DPROJ + O_RET_G + h * 64 + 4 * quad; const float* gw = gn_w + h * 64 + 4 * quad;
#pragma unroll
          for (int et = 0; et < 4; ++et) { gvp[et] = *(const ushort4*)(gp + 16 * et); wvp[et] = *(const f32x4*)(gw + 16 * et); } }
        R3_ISSUE(min(vb + (int)gridDim.x, NU - 1));
        lds_barrier();
        f32x4 Y[4];
#pragma unroll
        for (int et = 0; et < 4; ++et) Y[et] = (f32x4){0.f, 0.f, 0.f, 0.f};
        float lf[4], lb[4];
#pragma unroll
        for (int i = 0; i < 4; ++i) { const float dl = (float)(fr - 4 * quad - i); lf[i] = __builtin_amdgcn_exp2f(dl * lgf2); lb[i] = __builtin_amdgcn_exp2f(-dl * lgb2); }
#pragma unroll
        for (int mp = 0; mp < 4; ++mp) {
            float p[8];
#pragma unroll
            for (int t2 = 0; t2 < 2; ++t2) { const int mt = 2 * mp + t2;
                f32x4 acc = (f32x4){0.f, 0.f, 0.f, 0.f};
#pragma unroll
                for (int s = 0; s < 2; ++s) { const bf16x8 kf = *(const __attribute__((address_space(3))) bf16x8*)(lds + KS + (16 * mt + fr) * RT_P + 64 * s + 16 * quad);
                    acc = __builtin_amdgcn_mfma_f32_16x16x32_bf16(kf, qf[s], acc, 0, 0, 0); }
                if (mt == w) {
#pragma unroll
                    for (int i = 0; i < 4; ++i) { const int df = fr - 4 * quad - i;
                        const float dm = df > 0 ? lf[i] : (df < 0 ? lb[i] : 2.f);
                        p[4 * t2 + i] = acc[i] * dm; }
                } else {
                    const float tf = mt < w ? __builtin_amdgcn_exp2f((float)(16 * (w - mt)) * lgf2) : __builtin_amdgcn_exp2f((float)(16 * (mt - w)) * lgb2);
#pragma unroll
                    for (int i = 0; i < 4; ++i) p[4 * t2 + i] = acc[i] * ((mt < w ? lf[i] : lb[i]) * tf);
                } }
            u32x4 pk; pk.x = pg8::cvt_pk_bf16(p[0], p[1]); pk.y = pg8::cvt_pk_bf16(p[2], p[3]); pk.z = pg8::cvt_pk_bf16(p[4], p[5]); pk.w = pg8::cvt_pk_bf16(p[6], p[7]);
            const bf16x8 pb = __builtin_bit_cast(bf16x8, pk);
#pragma unroll
            for (int et = 0; et < 4; ++et) { const bf16x8 A = tr2(lds + VS + (32 * mp + 4 * quad + (fr >> 2)) * RT_P + (16 * et + 4 * (fr & 3)) * 2, 16 * RT_P);
                Y[et] = __builtin_amdgcn_mfma_f32_16x16x32_bf16(A, pb, Y[et], 0, 0, 0); }
        }
        const float xf = __builtin_amdgcn_exp2f((float)(nloc + 1) * lgf2), xb = __builtin_amdgcn_exp2f((float)(128 - nloc) * lgb2);
#pragma unroll
        for (int et = 0; et < 4; ++et) {
            f32x4 cf = (f32x4){0.f, 0.f, 0.f, 0.f}, cb = cf;
#pragma unroll
            for (int ks = 0; ks < 2; ++ks) { const int ro = (32 * ks + 8 * quad + (fr >> 2)) * RT_P + (16 * et + 4 * (fr & 3)) * 2;
                cf = __builtin_amdgcn_mfma_f32_16x16x32_bf16(tr2(lds + SF + ro, 4 * RT_P), qf[ks], cf, 0, 0, 0);
                cb = __builtin_amdgcn_mfma_f32_16x16x32_bf16(tr2(lds + SB + ro, 4 * RT_P), qf[ks], cb, 0, 0, 0); }
            Y[et] = Y[et] + cf * xf + cb * xb;
        }
        float s1 = 0.f;
#pragma unroll
        for (int et = 0; et < 4; ++et) s1 += (Y[et][0] + Y[et][1]) + (Y[et][2] + Y[et][3]);
        const float mu = xq_sum(s1) * (1.f / 64.f);
        float s2 = 0.f;
#pragma unroll
        for (int et = 0; et < 4; ++et)
#pragma unroll
            for (int i = 0; i < 4; ++i) { const float dd = Y[et][i] - mu; s2 += dd * dd; }
        const float rs = rsqrtf(xq_sum(s2) * (1.f / 64.f) + EPS);
        bf16* op = act + (size_t)row * D + NAW + h * 64 + 4 * quad;
#pragma unroll
        for (int et = 0; et < 4; ++et) { const ushort4 gv = gvp[et]; const f32x4 wv = wvp[et];
            const float o0 = (Y[et][0] - mu) * rs * wv.x * silu(bf2f(gv.x)), o1 = (Y[et][1] - mu) * rs * wv.y * silu(bf2f(gv.y)), o2 = (Y[et][2] - mu) * rs * wv.z * silu(bf2f(gv.z)), o3 = (Y[et][3] - mu) * rs * wv.w * silu(bf2f(gv.w));
            pg8::u32x2 o; o.x = pg8::cvt_pk_bf16(o0, o1); o.y = pg8::cvt_pk_bf16(o2, o3); *(pg8::u32x2*)(op + 16 * et) = o; }
    }
#undef R3_ISSUE
}
__device__ __forceinline__ void ph_topk1(const bf16* Q, const bf16* keysl, float* topv, int* topi, int nrows, bf16* sm) { const int tidx = otid();
    bf16 (*sk)[136] = (bf16 (*)[136])sm;
    const int nrt = nrows / NT;
    for (int vb = blockIdx.x; vb < nrt * 16; vb += gridDim.x) {
        const int hs = vb % 16, side = hs & 1, h = hs >> 1, row = (vb / 16) * NT + tidx;
        const bf16* kp = keysl + ((size_t)(side * PH + h) * PNK) * PKD;
        for (int i = tidx; i < 128 * 128; i += NT) sk[i / 128][i % 128] = kp[i];
        __syncthreads();
        float q[128];
        const bf16* qp = Q + (size_t)row * DQ + h * 256 + side * 128;
#pragma unroll
        for (int d = 0; d < 128; ++d) q[d] = bf2f(qp[d]);
        float tv[16]; int ti[16];
#pragma unroll
        for (int j = 0; j < 16; ++j) { tv[j] = -3e38f; ti[j] = 0; }
        for (int kk = 0; kk < 128; ++kk) {
            float s = 0.f;
#pragma unroll
            for (int d = 0; d < 128; ++d) s += q[d] * bf2f(sk[kk][d]);
            int si = kk;
#pragma unroll
            for (int j = 0; j < 16; ++j) { if (s > tv[j]) { const float tvv = tv[j]; const int tii = ti[j]; tv[j] = s; ti[j] = si; s = tvv; si = tii; } }
        }
        const size_t o = (((size_t)row * PH + h) * 2 + side) * 16;
#pragma unroll
        for (int j = 0; j < 16; ++j) { topv[o + j] = tv[j]; topi[o + j] = ti[j]; }
        __syncthreads();
    }
}
__device__ __forceinline__ void ph_topk2(const float* topv, const int* topi, int* idx, float* gate, int nrows) { const int tidx = otid();
    for (int gid = blockIdx.x * NT + tidx; gid < nrows * PH; gid += gridDim.x * NT) {
        const size_t o = (size_t)gid * 32;
        float vb[16];
#pragma unroll
        for (int j = 0; j < 16; ++j) vb[j] = topv[o + 16 + j];
        float tv[16]; int ti[16];
#pragma unroll
        for (int j = 0; j < 16; ++j) { tv[j] = -3e38f; ti[j] = 0; }
#pragma unroll 1
        for (int i = 0; i < 16; ++i) { const float vai = topv[o + i];
#pragma unroll
            for (int jb = 0; jb < 16; ++jb) { float s = vai + vb[jb]; int si = i * 16 + jb;
#pragma unroll
                for (int j = 0; j < 16; ++j) { if (s > tv[j]) { const float tvv = tv[j]; const int tii = ti[j]; tv[j] = s; ti[j] = si; s = tvv; si = tii; } } } }
        const float mx = tv[0]; float den = 0.f, p[16];
#pragma unroll
        for (int j = 0; j < 16; ++j) { p[j] = __expf(tv[j] - mx); den += p[j]; }
        const float inv = 1.f / den;
        const size_t oo = (size_t)gid * 16;
#pragma unroll
        for (int j = 0; j < 16; ++j) { const int ia = topi[o + (ti[j] >> 4)], ib = topi[o + 16 + (ti[j] & 15)]; idx[oo + j] = ia * PNK + ib; gate[oo + j] = p[j] * inv; }
    }
}


__device__ __forceinline__ void ins16(float (&L)[16], float v) {
#pragma unroll
    for (int j = 15; j >= 1; --j) L[j] = __builtin_amdgcn_fmed3f(L[j - 1], v, L[j]);
    L[0] = fmaxf(L[0], v);
}
__device__ __forceinline__ void bitonic_merge16(float (&L)[16], const float (&A)[16], const float (&B)[16]) {
#pragma unroll
    for (int j = 0; j < 16; ++j) L[j] = fmaxf(A[j], B[15 - j]);
#pragma unroll
    for (int st = 8; st >= 1; st >>= 1)
#pragma unroll
        for (int j = 0; j < 16; ++j) if ((j & st) == 0) { const float hi = fmaxf(L[j], L[j + st]), lo = fminf(L[j], L[j + st]); L[j] = hi; L[j + st] = lo; }
}
__device__ __forceinline__ void top16of32(float (&v)[32]) {
#define CE(i, j) { const float hi_ = fmaxf(v[i], v[j]), lo_ = fminf(v[i], v[j]); v[i] = hi_; v[j] = lo_; }
#define CMAX(i, j) { v[i] = fmaxf(v[i], v[j]); }
#define CMIN(i, j) { v[j] = fminf(v[i], v[j]); }
    CE(0,1) CE(2,3) CE(0,2) CE(1,3) CE(1,2) CE(4,5) CE(6,7) CE(4,6) CE(5,7) CE(5,6) CE(0,4) CE(2,6) CE(2,4) CE(1,5) CE(3,7) CE(3,5) CE(1,2) CE(3,4) CE(5,6) CE(8,9) CE(10,11) CE(8,10) CE(9,11) CE(9,10) CE(12,13) CE(14,15) CE(12,14) CE(13,15) CE(13,14) CE(8,12) CE(10,14) CE(10,12) CE(9,13) CE(11,15) CE(11,13) CE(9,10) CE(11,12) CE(13,14) CE(0,8) CE(4,12) CE(4,8) CE(2,10) CE(6,14) CE(6,10) CE(2,4) CE(6,8) CE(10,12) CE(1,9) CE(5,13) CE(5,9) CE(3,11) CE(7,15) CE(7,11) CE(3,5) CE(7,9) CE(11,13) CE(1,2) CE(3,4) CE(5,6) CE(7,8) CE(9,10) CE(11,12) CE(13,14) CE(16,17) CE(18,19) CE(16,18) CE(17,19) CE(17,18) CE(20,21) CE(22,23) CE(20,22) CE(21,23) CE(21,22) CE(16,20) CE(18,22) CE(18,20) CE(17,21) CE(19,23) CE(19,21) CE(17,18) CE(19,20) CE(21,22) CE(24,25) CE(26,27) CE(24,26) CE(25,27) CE(25,26) CE(28,29) CE(30,31) CE(28,30) CE(29,31) CE(29,30) CE(24,28) CE(26,30) CE(26,28) CE(25,29) CE(27,31) CE(27,29) CE(25,26) CE(27,28) CE(29,30) CE(16,24) CE(20,28) CE(20,24) CE(18,26) CE(22,30) CE(22,26) CE(18,20) CE(22,24) CE(26,28) CE(17,25) CE(21,29) CE(21,25) CE(19,27) CE(23,31) CE(23,27) CE(19,21) CE(23,25) CE(27,29) CE(17,18) CE(19,20) CE(21,22) CE(23,24) CE(25,26) CE(27,28) CE(29,30) CE(0,16) CMAX(8,24) CE(8,16) CE(4,20) CMAX(12,28) CMAX(12,20) CE(4,8) CE(12,16) CE(2,18) CMAX(10,26) CE(10,18) CE(6,22) CMAX(14,30) CMAX(14,22) CE(6,10) CMAX(14,18) CE(2,4) CE(6,8) CE(10,12) CE(14,16) CE(1,17) CMAX(9,25) CE(9,17) CE(5,21) CMAX(13,29) CMAX(13,21) CE(5,9) CE(13,17) CE(3,19) CMAX(11,27) CE(11,19) CE(7,23) CMAX(15,31) CMAX(15,23) CE(7,11) CMAX(15,19) CE(3,5) CE(7,9) CE(11,13) CMAX(15,17) CE(1,2) CE(3,4) CE(5,6) CE(7,8) CE(9,10) CE(11,12) CE(13,14) CMAX(15,16)
#undef CE
#undef CMAX
#undef CMIN
}
constexpr int TK_KROW = 272;
constexpr int TK_LIST = 2 * 128 * TK_KROW;
__device__ __forceinline__ void ph_tk_mfma(const bf16* Q, const bf16* keysl, int* idx, float* gate, int nrows, unsigned char* ldsg) { const int tidx = otid();
    const int lane = tidx & 63, w = __builtin_amdgcn_readfirstlane(tidx >> 6), fr = lane & 15, quad = lane >> 4;
    const lds_cp lds = (lds_cp)ldsg;
    unsigned* lists = (unsigned*)(ldsg + TK_LIST) + (w * 16 + fr) * 32;
    const int nunits = (nrows / 128) * PH;
    int hcur = -1;
    for (int u = blockIdx.x; u < nunits; u += gridDim.x) {
        const int h = u % PH, tile = u / PH;
        __syncthreads();
        if (h != hcur) {
            for (int i = tidx; i < 2 * 128 * 16; i += NT) { const int side = i >> 11, r = (i >> 4) & 127, pc = i & 15;
                *(u32x4*)(ldsg + (side * 128 + r) * TK_KROW + pc * 16) = *(const u32x4*)(keysl + ((size_t)(side * PH + h) * PNK + r) * PKD + pc * 8); }
            hcur = h;
        }
        __syncthreads();
        const int row = tile * 128 + 16 * w + fr;
        float Lb[16];
#pragma unroll
        for (int side = 0; side < 2; ++side) {
            bf16x8 qf[4];
#pragma unroll
            for (int s = 0; s < 4; ++s) qf[s] = *(const bf16x8*)(Q + (size_t)row * DQ + h * 256 + side * 128 + 32 * s + 8 * quad);
            float L[16];
            { float pv[32];
#pragma unroll
              for (int t = 0; t < 8; ++t) {
                f32x4 acc = (f32x4){0.f, 0.f, 0.f, 0.f};
#pragma unroll
                for (int s = 0; s < 4; ++s) { const bf16x8 kf = *(const __attribute__((address_space(3))) bf16x8*)(lds + (side * 128 + 16 * t + fr) * TK_KROW + 64 * s + 16 * quad);
                    acc = __builtin_amdgcn_mfma_f32_16x16x32_bf16(kf, qf[s], acc, 0, 0, 0); }
#pragma unroll
                for (int i = 0; i < 4; ++i) { const unsigned key = 16 * t + 4 * quad + i; pv[4 * t + i] = __uint_as_float((__float_as_uint(acc[i]) & ~0x7fu) | key); }
              }
              top16of32(pv);
#pragma unroll
              for (int j = 0; j < 16; ++j) L[j] = pv[j]; }
            { float A[16], B[16];
#pragma unroll
              for (int j = 0; j < 16; ++j) { auto s = __builtin_amdgcn_permlane16_swap(__float_as_uint(L[j]), __float_as_uint(L[j]), false, false); A[j] = __uint_as_float(s[0]); B[j] = __uint_as_float(s[1]); }
              bitonic_merge16(L, A, B);
#pragma unroll
              for (int j = 0; j < 16; ++j) { auto s = __builtin_amdgcn_permlane32_swap(__float_as_uint(L[j]), __float_as_uint(L[j]), false, false); A[j] = __uint_as_float(s[0]); B[j] = __uint_as_float(s[1]); }
              bitonic_merge16(L, A, B); }
            if (side == 0) {
                if (quad == 0) {
#pragma unroll
                    for (int j = 0; j < 16; ++j) lists[j] = __float_as_uint(L[j]); }
            } else {
#pragma unroll
                for (int j = 0; j < 16; ++j) Lb[j] = L[j];
                if (quad == 0) {
#pragma unroll
                    for (int j = 0; j < 16; ++j) lists[16 + j] = __float_as_uint(L[j]); }
            }
        }

        float C[16];
#pragma unroll
        for (int j = 0; j < 16; ++j) C[j] = -3.0e38f;
#pragma unroll
        for (int r = 0; r < 4; ++r) {
            const float vai = __uint_as_float(lists[4 * r + quad] & ~0x7fu);
            const int irow = 4 * r + quad, len = 16 / (irow + 1);
            constexpr int maxlen[4] = {16, 3, 1, 1};
#pragma unroll
            for (int j = 0; j < maxlen[r]; ++j) { const float s = vai + __uint_as_float(__float_as_uint(Lb[j]) & ~0x7fu);
                const float pkv = __uint_as_float((__float_as_uint(s) & ~0xffu) | (unsigned)(irow * 16 + j));
                ins16(C, j < len ? pkv : -3.0e38f); }
        }
        { float A[16], B[16];
#pragma unroll
          for (int j = 0; j < 16; ++j) { auto s = __builtin_amdgcn_permlane16_swap(__float_as_uint(C[j]), __float_as_uint(C[j]), false, false); A[j] = __uint_as_float(s[0]); B[j] = __uint_as_float(s[1]); }
          bitonic_merge16(C, A, B);
#pragma unroll
          for (int j = 0; j < 16; ++j) { auto s = __builtin_amdgcn_permlane32_swap(__float_as_uint(C[j]), __float_as_uint(C[j]), false, false); A[j] = __uint_as_float(s[0]); B[j] = __uint_as_float(s[1]); }
          bitonic_merge16(C, A, B); }
        const float mx = __uint_as_float(__float_as_uint(C[0]) & ~0xffu);
        float p[16], den = 0.f; int ex[16];
#pragma unroll
        for (int k = 0; k < 16; ++k) { const unsigned cb = __float_as_uint(C[k]); const float sv = __uint_as_float(cb & ~0xffu); p[k] = __expf(sv - mx); den += p[k];
            const unsigned ka = lists[(cb >> 4) & 15] & 0x7fu, kb = lists[16 + (cb & 15)] & 0x7fu; ex[k] = (int)(ka * PNK + kb); }
        const float inv = 1.f / den;
        if (quad == 0) {
            int* ip = idx + (size_t)row * 128 + h * 16; float* gp = gate + (size_t)row * 128 + h * 16;
#pragma unroll
            for (int k = 0; k < 16; k += 4) { *(int4*)(ip + k) = make_int4(ex[k], ex[k + 1], ex[k + 2], ex[k + 3]); *(f32x4*)(gp + k) = (f32x4){p[k] * inv, p[k + 1] * inv, p[k + 2] * inv, p[k + 3] * inv}; }
        }
    }
}
template <int B>
__device__ __forceinline__ void sort16at(float (&v)[64]) {
#define CE(i, j) { const float hi_ = fmaxf(v[B + i], v[B + j]), lo_ = fminf(v[B + i], v[B + j]); v[B + i] = hi_; v[B + j] = lo_; }
    CE(0,1) CE(2,3) CE(0,2) CE(1,3) CE(1,2) CE(4,5) CE(6,7) CE(4,6) CE(5,7) CE(5,6) CE(0,4) CE(2,6) CE(2,4) CE(1,5) CE(3,7) CE(3,5) CE(1,2) CE(3,4) CE(5,6) CE(8,9) CE(10,11) CE(8,10) CE(9,11) CE(9,10) CE(12,13) CE(14,15) CE(12,14) CE(13,15) CE(13,14) CE(8,12) CE(10,14) CE(10,12) CE(9,13) CE(11,15) CE(11,13) CE(9,10) CE(11,12) CE(13,14) CE(0,8) CE(4,12) CE(4,8) CE(2,10) CE(6,14) CE(6,10) CE(2,4) CE(6,8) CE(10,12) CE(1,9) CE(5,13) CE(5,9) CE(3,11) CE(7,15) CE(7,11) CE(3,5) CE(7,9) CE(11,13) CE(1,2) CE(3,4) CE(5,6) CE(7,8) CE(9,10) CE(11,12) CE(13,14)
#undef CE
}
__device__ __forceinline__ void top16of64(float (&v)[64], float (&L)[16]) {
    sort16at<0>(v); sort16at<16>(v); sort16at<32>(v); sort16at<48>(v);
    float A[16], Bv[16], M0[16], M1[16];
#pragma unroll
    for (int j = 0; j < 16; ++j) { A[j] = v[j]; Bv[j] = v[16 + j]; }
    bitonic_merge16(M0, A, Bv);
#pragma unroll
    for (int j = 0; j < 16; ++j) { A[j] = v[32 + j]; Bv[j] = v[48 + j]; }
    bitonic_merge16(M1, A, Bv);
    bitonic_merge16(L, M0, M1);
}
typedef float f32x16 __attribute__((ext_vector_type(16)));
template <bool HEADORD>
__device__ __forceinline__ void ph_tk32(const bf16* Q, const bf16* keysl, int* idx, float* gate, int nrows, unsigned char* ldsg) { const int tidx = otid();
    const int lane = tidx & 63, w = __builtin_amdgcn_readfirstlane(tidx >> 6), r32 = lane & 31, hh = lane >> 5;
    const lds_cp lds = (lds_cp)ldsg;
    unsigned* lists = (unsigned*)(ldsg + TK_LIST) + (w * 32 + r32) * 32;
    const int nunits = (nrows / 256) * PH;
    int hcur = -1;
    for (int ui = 0;; ++ui) {
        int h, tile;
        if (HEADORD) { const int c = (int)blockIdx.x, k = c >> 3; h = k & 7; tile = 4 * (c & 7) + (k >> 3) + 32 * ui; if (tile >= nrows / 256) break; }
        else { const int u = (int)blockIdx.x + ui * (int)gridDim.x; if (u >= nunits) break; h = u % PH; tile = u / PH; }
        __syncthreads();
        if (h != hcur) {
            for (int i = tidx; i < 2 * 128 * 16; i += NT) { const int side = i >> 11, r = (i >> 4) & 127, pc = i & 15;
                *(u32x4*)(ldsg + (side * 128 + r) * TK_KROW + pc * 16) = *(const u32x4*)(keysl + ((size_t)(side * PH + h) * PNK + r) * PKD + pc * 8); }
            hcur = h;
        }
        __syncthreads();
        const int row = tile * 256 + 32 * w + r32;
        float Lb[16];
#pragma unroll
        for (int side = 0; side < 2; ++side) {
            bf16x8 qf[8];
#pragma unroll
            for (int s = 0; s < 8; ++s) qf[s] = *(const bf16x8*)(Q + ((size_t)(((tile * 8 + w) * PH + h) * 2 + side)) * 4096 + s * 512 + hh * 256 + r32 * 8);
            float pv[64];
#pragma unroll
            for (int t = 0; t < 4; ++t) {
                f32x16 acc;
#pragma unroll
                for (int i = 0; i < 16; ++i) acc[i] = 0.f;
#pragma unroll
                for (int s = 0; s < 8; ++s) { const bf16x8 kf = *(const __attribute__((address_space(3))) bf16x8*)(lds + (side * 128 + 32 * t + r32) * TK_KROW + 32 * s + 16 * hh);
                    acc = __builtin_amdgcn_mfma_f32_32x32x16_bf16(kf, qf[s], acc, 0, 0, 0); }
#pragma unroll
                for (int i = 0; i < 16; ++i) { const unsigned key = 32 * t + (i & 3) + 8 * (i >> 2) + 4 * hh; pv[16 * t + i] = __uint_as_float((__float_as_uint(acc[i]) & ~0x7fu) | key); }
            }
            float L[16];
            top16of64(pv, L);
            { float A[16], B[16];
#pragma unroll
              for (int j = 0; j < 16; ++j) { auto s = __builtin_amdgcn_permlane32_swap(__float_as_uint(L[j]), __float_as_uint(L[j]), false, false); A[j] = __uint_as_float(s[0]); B[j] = __uint_as_float(s[1]); }
              bitonic_merge16(L, A, B); }
            if (side == 0) { if (hh == 0) {
#pragma unroll
                    for (int j = 0; j < 16; ++j) lists[j] = __float_as_uint(L[j]); } }
            else {
#pragma unroll
                for (int j = 0; j < 16; ++j) Lb[j] = L[j];
                if (hh == 0) {
#pragma unroll
                    for (int j = 0; j < 16; ++j) lists[16 + j] = __float_as_uint(L[j]); } }
        }
        float C[16];
#pragma unroll
        for (int j = 0; j < 16; ++j) C[j] = -3.0e38f;
#pragma unroll
        for (int r = 0; r < 8; ++r) {
            const float vai = __uint_as_float(lists[2 * r + hh] & ~0x7fu);
            const int irow = 2 * r + hh, len = 16 / (irow + 1);
            constexpr int maxlen[8] = {16, 5, 3, 2, 1, 1, 1, 1};
#pragma unroll
            for (int j = 0; j < maxlen[r]; ++j) { const float s = vai + __uint_as_float(__float_as_uint(Lb[j]) & ~0x7fu);
                const float pkv = __uint_as_float((__float_as_uint(s) & ~0xffu) | (unsigned)(irow * 16 + j));
                ins16(C, j < len ? pkv : -3.0e38f); }
        }
        { float A[16], B[16];
#pragma unroll
          for (int j = 0; j < 16; ++j) { auto s = __builtin_amdgcn_permlane32_swap(__float_as_uint(C[j]), __float_as_uint(C[j]), false, false); A[j] = __uint_as_float(s[0]); B[j] = __uint_as_float(s[1]); }
          bitonic_merge16(C, A, B); }
        const float mx = __uint_as_float(__float_as_uint(C[0]) & ~0xffu);
        float p[16], den = 0.f; int ex[16];
#pragma unroll
        for (int k = 0; k < 16; ++k) { const unsigned cb = __float_as_uint(C[k]); const float sv = __uint_as_float(cb & ~0xffu); p[k] = __expf(sv - mx); den += p[k];
            const unsigned ka = lists[(cb >> 4) & 15] & 0x7fu, kb = lists[16 + (cb & 15)] & 0x7fu; ex[k] = (int)(ka * PNK + kb); }
        const float inv = 1.f / den;
        if (hh == 0) {
            int* ip = idx + (size_t)row * 128 + h * 16; float* gp = gate + (size_t)row * 128 + h * 16;
#pragma unroll
            for (int k = 0; k < 16; k += 4) { *(int4*)(ip + k) = make_int4(ex[k], ex[k + 1], ex[k + 2], ex[k + 3]); *(f32x4*)(gp + k) = (f32x4){p[k] * inv, p[k + 1] * inv, p[k + 2] * inv, p[k + 3] * inv}; }
        }
    }
}
__device__ __forceinline__ float dot16(const float (&hx)[16], const bf16x8 a, const bf16x8 b) {
    float s = 0.f;
#pragma unroll
    for (int j = 0; j < 8; ++j) s += hx[j] * bf2f((bf16)a[j]) + hx[8 + j] * bf2f((bf16)b[j]);
    return s;
}
template <bool FINAL>
__device__ __forceinline__ void ph_peer(const bf16* act, const int* idx, const float* gate, const bf16* U, const bf16* V, const float* modl, int off_g,
                                        float* xlat, float* xctx, const float* fw, int nrows) { const int tidx = otid();
    const int lane = tidx & 63, wave = tidx >> 6;
    for (int row = blockIdx.x * 8 + wave; row < nrows; row += gridDim.x * 8) {
        float hx[16];
        { const bf16x8 a = *(const bf16x8*)(act + (size_t)row * D + lane * 8), b = *(const bf16x8*)(act + (size_t)row * D + 512 + lane * 8);
#pragma unroll
          for (int j = 0; j < 8; ++j) { hx[j] = bf2f((bf16)a[j]); hx[8 + j] = bf2f((bf16)b[j]); } }
        const int myi0 = idx[(size_t)row * 128 + lane], myi1 = idx[(size_t)row * 128 + 64 + lane];
        const float myg0 = gate[(size_t)row * 128 + lane], myg1 = gate[(size_t)row * 128 + 64 + lane];
        float a0 = 0.f, a1 = 0.f;
        for (int base = 0; base < 128; base += 8) {
            bf16x8 ua[8], ub[8];
#pragma unroll
            for (int j = 0; j < 8; ++j) { const int e = rl_i(base < 64 ? myi0 : myi1, (base + j) & 63); const bf16* up = U + (size_t)e * D; ua[j] = *(const bf16x8*)(up + lane * 8); ub[j] = *(const bf16x8*)(up + 512 + lane * 8); }
#pragma unroll
            for (int j = 0; j < 8; ++j) { const float s = wave_sum(dot16(hx, ua[j], ub[j])); if (lane == ((base + j) & 63)) { if (base < 64) a0 = s; else a1 = s; } }
        }
        const float w0 = myg0 * 0.5f * a0 * (1.f + erff(a0 * 0.70710678f)), w1 = myg1 * 0.5f * a1 * (1.f + erff(a1 * 0.70710678f));
        float out[16];
#pragma unroll
        for (int j = 0; j < 16; ++j) out[j] = 0.f;
        for (int base = 0; base < 128; base += 8) {
            bf16x8 va[8], vb[8];
#pragma unroll
            for (int j = 0; j < 8; ++j) { const int e = rl_i(base < 64 ? myi0 : myi1, (base + j) & 63); const bf16* vp = V + (size_t)e * D; va[j] = *(const bf16x8*)(vp + lane * 8); vb[j] = *(const bf16x8*)(vp + 512 + lane * 8); }
#pragma unroll
            for (int j = 0; j < 8; ++j) { const float w = rl_f(base < 64 ? w0 : w1, (base + j) & 63);
#pragma unroll
                for (int q = 0; q < 8; ++q) { out[q] += w * bf2f((bf16)va[j][q]); out[8 + q] += w * bf2f((bf16)vb[j][q]); } }
        }
        const int mi = row < M_LAT ? row / S : 4;
        float* xr = row < M_LAT ? xlat + (size_t)row * D : xctx + (size_t)(row - M_LAT) * D;
        const float* g2 = modl + (size_t)mi * 6 * D + off_g;
        float xn[16]; float ss = 0.f;
#pragma unroll
        for (int hlf = 0; hlf < 2; ++hlf) { const int k = hlf * 512 + lane * 8;
            const f32x4 x0 = *(const f32x4*)(xr + k), x1 = *(const f32x4*)(xr + k + 4), g0 = *(const f32x4*)(g2 + k), g1 = *(const f32x4*)(g2 + k + 4);
            xn[hlf * 8 + 0] = x0.x + g0.x * out[hlf * 8 + 0]; xn[hlf * 8 + 1] = x0.y + g0.y * out[hlf * 8 + 1]; xn[hlf * 8 + 2] = x0.z + g0.z * out[hlf * 8 + 2]; xn[hlf * 8 + 3] = x0.w + g0.w * out[hlf * 8 + 3];
            xn[hlf * 8 + 4] = x1.x + g1.x * out[hlf * 8 + 4]; xn[hlf * 8 + 5] = x1.y + g1.y * out[hlf * 8 + 5]; xn[hlf * 8 + 6] = x1.z + g1.z * out[hlf * 8 + 6]; xn[hlf * 8 + 7] = x1.w + g1.w * out[hlf * 8 + 7]; }
#pragma unroll
        for (int j = 0; j < 16; ++j) ss += xn[j] * xn[j];
        float rs = 1.f;
        if (FINAL) { ss = wave_sum(ss); rs = rsqrtf(ss * (1.f / D) + EPS); }
#pragma unroll
        for (int hlf = 0; hlf < 2; ++hlf) { const int k = hlf * 512 + lane * 8;
            f32x4 o0, o1;
            if (FINAL) { const f32x4 f0 = *(const f32x4*)(fw + k), f1 = *(const f32x4*)(fw + k + 4);
                o0 = (f32x4){xn[hlf * 8 + 0] * rs * f0.x, xn[hlf * 8 + 1] * rs * f0.y, xn[hlf * 8 + 2] * rs * f0.z, xn[hlf * 8 + 3] * rs * f0.w};
                o1 = (f32x4){xn[hlf * 8 + 4] * rs * f1.x, xn[hlf * 8 + 5] * rs * f1.y, xn[hlf * 8 + 6] * rs * f1.z, xn[hlf * 8 + 7] * rs * f1.w}; }
            else { o0 = (f32x4){xn[hlf * 8 + 0], xn[hlf * 8 + 1], xn[hlf * 8 + 2], xn[hlf * 8 + 3]}; o1 = (f32x4){xn[hlf * 8 + 4], xn[hlf * 8 + 5], xn[hlf * 8 + 6], xn[hlf * 8 + 7]}; }
            *(f32x4*)(xr + k) = o0; *(f32x4*)(xr + k + 4) = o1; }
    }
}


__device__ __forceinline__ void ph_quant(const float* src, unsigned char* dst, float* scl, int nrows, int offs  ) { const int tidx = otid();
    const int lane = tidx & 63, wave = tidx >> 6;
    for (int row0 = (blockIdx.x * 8 + wave) * 4; row0 < nrows; row0 += gridDim.x * 8 * 4) {
        f32x4 v[4][4];
#pragma unroll
        for (int r = 0; r < 4; ++r)
#pragma unroll
            for (int j = 0; j < 4; ++j) v[r][j] = *(const f32x4*)(src + (size_t)(row0 + r) * D + lane * 16 + 4 * j);
#pragma unroll
        for (int r = 0; r < 4; ++r) {
            float am = 0.f;
#pragma unroll
            for (int j = 0; j < 4; ++j) am = fmaxf(am, fmaxf(fmaxf(fabsf(v[r][j].x), fabsf(v[r][j].y)), fmaxf(fabsf(v[r][j].z), fabsf(v[r][j].w))));
            am = wave_max(am);
            const float sc = am > 0.f ? am * (1.f / 127.f) : 1.f, inv = 1.f / sc;
            u32x4 o;
#pragma unroll
            for (int j = 0; j < 4; ++j) { const int q0 = (int)rintf(v[r][j].x * inv) + offs, q1 = (int)rintf(v[r][j].y * inv) + offs, q2 = (int)rintf(v[r][j].z * inv) + offs, q3 = (int)rintf(v[r][j].w * inv) + offs;
                o[j] = (unsigned)(q0 & 0xff) | ((unsigned)(q1 & 0xff) << 8) | ((unsigned)(q2 & 0xff) << 16) | ((unsigned)(q3 & 0xff) << 24); }
            *(u32x4*)(dst + (size_t)(row0 + r) * D + lane * 16) = o;
            if (lane == 0) scl[row0 + r] = sc;
        }
    }
}
__device__ __forceinline__ void ph_quant_w(const bf16* src, unsigned char* dst, float* scl, int nrows) { const int tidx = otid();
    const int lane = tidx & 63, wave = tidx >> 6;
    for (int row0 = (blockIdx.x * 8 + wave) * 2; row0 < nrows; row0 += gridDim.x * 16) {
        bf16x8 a[2][2];
#pragma unroll
        for (int r = 0; r < 2; ++r) { a[r][0] = *(const bf16x8*)(src + (size_t)(row0 + r) * D + lane * 16); a[r][1] = *(const bf16x8*)(src + (size_t)(row0 + r) * D + lane * 16 + 8); }
#pragma unroll
        for (int r = 0; r < 2; ++r) { float f[16]; float am = 0.f;
#pragma unroll
            for (int j = 0; j < 8; ++j) { f[j] = bf2f((bf16)a[r][0][j]); f[8 + j] = bf2f((bf16)a[r][1][j]); am = fmaxf(am, fmaxf(fabsf(f[j]), fabsf(f[8 + j]))); }
            am = wave_max(am); const float sc = am > 0.f ? am * (1.f / 127.f) : 1.f, inv = 1.f / sc;
            u32x4 o;
#pragma unroll
            for (int j = 0; j < 4; ++j) { const int q0 = (int)rintf(f[4 * j] * inv), q1 = (int)rintf(f[4 * j + 1] * inv), q2 = (int)rintf(f[4 * j + 2] * inv), q3 = (int)rintf(f[4 * j + 3] * inv);
                o[j] = (unsigned)(q0 & 0xff) | ((unsigned)(q1 & 0xff) << 8) | ((unsigned)(q2 & 0xff) << 16) | ((unsigned)(q3 & 0xff) << 24); }
            *(u32x4*)(dst + (size_t)(row0 + r) * D + lane * 16) = o;
            if (lane == 0) scl[row0 + r] = sc; }
    }
}
__device__ __forceinline__ int xreduce64(int (&p)[64], int lane) {
#pragma unroll
    for (int k = 0; k < 32; ++k) { auto r = __builtin_amdgcn_permlane32_swap((unsigned)p[k], (unsigned)p[k + 32], false, false); p[k] = (int)(r[0] + r[1]); }
#pragma unroll
    for (int k = 0; k < 16; ++k) { auto r = __builtin_amdgcn_permlane16_swap((unsigned)p[k], (unsigned)p[k + 16], false, false); p[k] = (int)(r[0] + r[1]); }
#define XR_STEP(n, M) _Pragma("unroll") for (int k = 0; k < (n) / 2; ++k) { const bool up = (lane & (M)) != 0; const int send = up ? p[k] : p[k + (n) / 2], keep = up ? p[k + (n) / 2] : p[k]; \
        p[k] = keep + __builtin_amdgcn_ds_swizzle(send, ((M) << 10) | 0x1f); }
    XR_STEP(16, 8) XR_STEP(8, 4) XR_STEP(4, 2) XR_STEP(2, 1)
#undef XR_STEP
    return p[0];
}
template <int MODE  >
__device__ __forceinline__ void ph_peer8(bf16* act, const int* idx, const float* gate, const unsigned char* U8, const unsigned char* V8, const float* SU, const float* SV,
                                         const float* modl, int off_g, bf16* xlat, bf16* xctx, float* outf, const float* fw, const float* modn, int nrows) { const int tidx = otid();
    constexpr bool FINAL = (MODE == 2);
    const int lane = tidx & 63, wave = tidx >> 6;
    for (int row = blockIdx.x * 8 + wave; row < nrows; row += gridDim.x * 8) {
        int xq[4]; float sx;
        { const bf16x8 a = *(const bf16x8*)(act + (size_t)row * D + lane * 16), b = *(const bf16x8*)(act + (size_t)row * D + lane * 16 + 8);
          float hx[16]; float am = 0.f;
#pragma unroll
          for (int j = 0; j < 8; ++j) { hx[j] = bf2f((bf16)a[j]); hx[8 + j] = bf2f((bf16)b[j]); am = fmaxf(am, fmaxf(fabsf(hx[j]), fabsf(hx[8 + j]))); }
          am = wave_max(am); sx = am > 0.f ? am * (1.f / 127.f) : 1.f; const float inv = 1.f / sx;
#pragma unroll
          for (int j = 0; j < 4; ++j) { const int q0 = (int)rintf(hx[4 * j] * inv), q1 = (int)rintf(hx[4 * j + 1] * inv), q2 = (int)rintf(hx[4 * j + 2] * inv), q3 = (int)rintf(hx[4 * j + 3] * inv);
              xq[j] = (int)((unsigned)(q0 & 0xff) | ((unsigned)(q1 & 0xff) << 8) | ((unsigned)(q2 & 0xff) << 16) | ((unsigned)(q3 & 0xff) << 24)); } }
        const int myi0 = idx[(size_t)row * 128 + lane], myi1 = idx[(size_t)row * 128 + 64 + lane];
        const float myg0 = gate[(size_t)row * 128 + lane], myg1 = gate[(size_t)row * 128 + 64 + lane];
        const float su0 = SU[myi0], su1 = SU[myi1], sv0 = SV[myi0], sv1 = SV[myi1];
        float wgt[2];
#pragma unroll
        for (int hf = 0; hf < 2; ++hf) {
            int p[64];
#pragma unroll
            for (int base = 0; base < 64; base += 16) {
                u32x4 ub[16];
#pragma unroll
                for (int j = 0; j < 16; ++j) { const int e = rl_i(hf ? myi1 : myi0, base + j); ub[j] = *(const u32x4*)(U8 + (size_t)e * D + lane * 16); }
#pragma unroll
                for (int j = 0; j < 16; ++j) { int s = __builtin_amdgcn_sdot4((int)ub[j].x, xq[0], 0, false); s = __builtin_amdgcn_sdot4((int)ub[j].y, xq[1], s, false);
                    s = __builtin_amdgcn_sdot4((int)ub[j].z, xq[2], s, false); p[base + j] = __builtin_amdgcn_sdot4((int)ub[j].w, xq[3], s, false); }
            }
            const float a = (float)xreduce64(p, lane) * sx * (hf ? su1 : su0);
            wgt[hf] = (hf ? myg1 * sv1 : myg0 * sv0) * 0.5f * a * (1.f + erff(a * 0.70710678f));
        }
        float out[16];
#pragma unroll
        for (int j = 0; j < 16; ++j) out[j] = 0.f;
#pragma unroll 1
        for (int base = 0; base < 128; base += 16) {
            u32x4 vb[16];
#pragma unroll
            for (int j = 0; j < 16; ++j) { const int e = rl_i(base < 64 ? myi0 : myi1, (base + j) & 63); vb[j] = *(const u32x4*)(V8 + (size_t)e * D + lane * 16); }
#pragma unroll
            for (int j = 0; j < 16; ++j) { const float wv = rl_f(base < 64 ? wgt[0] : wgt[1], (base + j) & 63);
#pragma unroll
                for (int q = 0; q < 4; ++q) { const unsigned dw = vb[j][q];
                    out[4 * q + 0] += wv * (float)((int)(dw << 24) >> 24); out[4 * q + 1] += wv * (float)((int)(dw << 16) >> 24); out[4 * q + 2] += wv * (float)((int)(dw << 8) >> 24); out[4 * q + 3] += wv * (float)((int)dw >> 24); } }
        }
        const int mi = row < M_LAT ? row / S : 4;
        bf16* xr = (row < M_LAT ? xlat + (size_t)row * D : xctx + (size_t)(row - M_LAT) * D) + lane * 16;
        const float* g2 = modl + (size_t)mi * 6 * D + off_g + lane * 16;
        float xn[16]; float ss = 0.f;
#pragma unroll
        for (int q = 0; q < 4; ++q) { const f32x4 x0 = ld4res<true>(xr, 4 * q), g0 = *(const f32x4*)(g2 + 4 * q);
            xn[4 * q + 0] = bf2f(f2bf(x0.x + g0.x * out[4 * q + 0])); xn[4 * q + 1] = bf2f(f2bf(x0.y + g0.y * out[4 * q + 1]));
            xn[4 * q + 2] = bf2f(f2bf(x0.z + g0.z * out[4 * q + 2])); xn[4 * q + 3] = bf2f(f2bf(x0.w + g0.w * out[4 * q + 3])); }
#pragma unroll
        for (int j = 0; j < 16; ++j) ss += xn[j] * xn[j];
        float rs = 1.f;
        if (MODE != 0) { ss = wave_sum(ss); rs = rsqrtf(ss * (1.f / D) + EPS); }
#pragma unroll
        for (int q = 0; q < 4; ++q) {
            if (FINAL) { const f32x4 f0 = *(const f32x4*)(fw + lane * 16 + 4 * q); *(f32x4*)(outf + (size_t)row * D + lane * 16 + 4 * q) = (f32x4){xn[4 * q] * rs * f0.x, xn[4 * q + 1] * rs * f0.y, xn[4 * q + 2] * rs * f0.z, xn[4 * q + 3] * rs * f0.w}; }
            else st4res(xr, 4 * q, (f32x4){xn[4 * q], xn[4 * q + 1], xn[4 * q + 2], xn[4 * q + 3]}); }
        if (MODE == 1) {
            const float* sh = modn + (size_t)mi * 6 * D + lane * 16; const float* sc = sh + D; const float* nw = fw + lane * 16;
            u32x4 o0, o1; unsigned pk[8];
#pragma unroll
            for (int q = 0; q < 4; ++q) { const f32x4 w4 = *(const f32x4*)(nw + 4 * q), a4 = *(const f32x4*)(sc + 4 * q), b4 = *(const f32x4*)(sh + 4 * q);
                pk[2 * q] = pg8::cvt_pk_bf16(xn[4 * q] * rs * w4.x * (1.f + a4.x) + b4.x, xn[4 * q + 1] * rs * w4.y * (1.f + a4.y) + b4.y);
                pk[2 * q + 1] = pg8::cvt_pk_bf16(xn[4 * q + 2] * rs * w4.z * (1.f + a4.z) + b4.z, xn[4 * q + 3] * rs * w4.w * (1.f + a4.w) + b4.w); }
            o0 = (u32x4){pk[0], pk[1], pk[2], pk[3]}; o1 = (u32x4){pk[4], pk[5], pk[6], pk[7]};
            *(u32x4*)(act + (size_t)row * D + lane * 16) = o0; *(u32x4*)(act + (size_t)row * D + lane * 16 + 8) = o1;
        }
    }
}

constexpr int PSA_ENT_MAX = 512;
constexpr int PSA_XQ = 0, PSA_ENT = 135168, PSA_ENT_BYTES = 2048, PSA_SX = PSA_ENT + 8 * PSA_ENT_BYTES;
constexpr int PSA_HIST = 152576, PSA_WTOT = PSA_HIST + 8192, PSA_SORT_MAX = 4096;
static_assert(PSA_SX + 132 * 4 <= PSA_HIST && PSA_WTOT + 64 <= LDS_BYTES - 64, "sweep A LDS map");
constexpr int PSB_IDX = 0, PSB_WQ = 33792, PSB_SW = PSB_WQ + 132 * 128, PSB_SS = PSB_SW + 1024;
#ifndef PEER_NSLAB
#define PEER_NSLAB 8
#endif
#ifndef PEER_PSH
static_assert(true, "");
#define PEER_SORTA 1
#define PEER_PSH 11
#endif
__device__ __forceinline__ int reduce32i(int (&p)[32], int lane) {
#pragma unroll
    for (int k = 0; k < 16; ++k) { auto r = __builtin_amdgcn_permlane32_swap((unsigned)p[k], (unsigned)p[k + 16], false, false); p[k] = (int)(r[0] + r[1]); }
#pragma unroll
    for (int k = 0; k < 8; ++k) { auto r = __builtin_amdgcn_permlane16_swap((unsigned)p[k], (unsigned)p[k + 8], false, false); p[k] = (int)(r[0] + r[1]); }
    { const bool up = (lane & 8) != 0;
#pragma unroll
      for (int k = 0; k < 4; ++k) { const int send = up ? p[k] : p[k + 4], keep = up ? p[k + 4] : p[k]; p[k] = keep + __builtin_amdgcn_ds_swizzle(send, (8 << 10) | 0x1f); } }
    { const bool up = (lane & 4) != 0;
#pragma unroll
      for (int k = 0; k < 2; ++k) { const int send = up ? p[k] : p[k + 2], keep = up ? p[k + 2] : p[k]; p[k] = keep + __builtin_amdgcn_ds_swizzle(send, (4 << 10) | 0x1f); } }
    { const bool up = (lane & 2) != 0; const int send = up ? p[0] : p[1], keep = up ? p[1] : p[0]; p[0] = keep + __builtin_amdgcn_ds_swizzle(send, (2 << 10) | 0x1f); }
    p[0] += __builtin_amdgcn_ds_swizzle(p[0], (1 << 10) | 0x1f);
    return p[0];
}
template <int LPS>
__device__ __forceinline__ void reduce16r(int (&p)[16], int lane) {
#pragma unroll
    for (int k = 0; k < 8; ++k) { auto r = __builtin_amdgcn_permlane32_swap((unsigned)p[k], (unsigned)p[k + 8], false, false); p[k] = (int)(r[0] + r[1]); }
#pragma unroll
    for (int k = 0; k < 4; ++k) { auto r = __builtin_amdgcn_permlane16_swap((unsigned)p[k], (unsigned)p[k + 4], false, false); p[k] = (int)(r[0] + r[1]); }
    { const bool up = (lane & 8) != 0;
#pragma unroll
      for (int k = 0; k < 2; ++k) { const int send = up ? p[k] : p[k + 2], keep = up ? p[k + 2] : p[k]; p[k] = keep + __builtin_amdgcn_ds_swizzle(send, (8 << 10) | 0x1f); } }
    if (LPS == 4) { const bool up = (lane & 4) != 0; const int send = up ? p[0] : p[1], keep = up ? p[1] : p[0]; p[0] = keep + __builtin_amdgcn_ds_swizzle(send, (4 << 10) | 0x1f); }
}
template <int MODE  >
__device__ __forceinline__ void ph_peer_sweep(const int* idx, const float* gate, const unsigned char* U8, const unsigned char* V8, const float* SU, const float* SV, const unsigned char* XQ, const float* XS,
                                              float* AW  , const float* modl, int off_g, bf16* xlat, bf16* xctx, float* outf  , const float* nw, const float* modn, unsigned char* xqo, float* xso, int nrows, unsigned char* ldsg) { const int tidx = otid();
    const int lane = tidx & 63, wave = __builtin_amdgcn_readfirstlane(tidx >> 6);
    const int TPW = nrows / (int)gridDim.x, row0 = (int)blockIdx.x * TPW;
    const int J = (TPW - wave + 7) / 8;
    __syncthreads();
    unsigned* ent = (unsigned*)(ldsg + PSA_ENT + wave * PSA_ENT_BYTES); float* sxs = (float*)(ldsg + PSA_SX);
    for (int j = 0; j < J; ++j) { const int tl = wave + 8 * j; *(u32x4*)(ldsg + PSA_XQ + tl * 1024 + lane * 16) = *(const u32x4*)(XQ + (size_t)(row0 + tl) * D + lane * 16); if (lane == 0) sxs[tl] = XS[row0 + tl]; }
    unsigned iab[17];
#pragma unroll
    for (int j = 0; j < 17; ++j) { if (j < J) { const size_t r = (size_t)(row0 + wave + 8 * j) * 128; iab[j] = (unsigned)idx[r + lane] | ((unsigned)idx[r + 64 + lane] << 16); } else iab[j] = 0xffffffffu; }
#if PEER_SORTA
    unsigned* hist = (unsigned*)(ldsg + PSA_HIST); unsigned* srt = (unsigned*)(ldsg + PSA_ENT); unsigned* wtot = (unsigned*)(ldsg + PSA_WTOT);
    ((u32x4*)hist)[tidx] = (u32x4){0u, 0u, 0u, 0u};
    __syncthreads();
#endif
#define IA(j) ((int)(iab[j] & 0xffffu))
#define IB(j) ((int)(iab[j] >> 16))
#pragma unroll 1
    for (int p = 0; p < (NEXP >> PEER_PSH); ++p) {
        const unsigned* lst = ent; int n = 0, cstart = 0, cstride = 32, nov = 0;
#pragma unroll
        for (int j = 0; j < 17; ++j) asm volatile("" : "+v"(iab[j]));
        unsigned lane_o = (unsigned)lane; asm volatile("" : "+v"(lane_o));
#if PEER_SORTA
#pragma unroll
        for (int j = 0; j < 17; ++j) {
            if ((IA(j) >> PEER_PSH) == p) atomicAdd(&hist[IA(j) & 2047], 1u);
            if ((IB(j) >> PEER_PSH) == p) atomicAdd(&hist[IB(j) & 2047], 1u);
        }
        __syncthreads();
        const u32x4 hh4 = ((const u32x4*)hist)[tidx];
        const unsigned hs = hh4.x + hh4.y + hh4.z + hh4.w; unsigned inc = hs;
#pragma unroll
        for (int d = 1; d < 64; d <<= 1) { const unsigned t = (unsigned)__shfl_up((int)inc, d); if (lane >= d) inc += t; }
        if (lane == 63) wtot[wave] = inc;
        __syncthreads();
        unsigned wbase = 0, NS = 0;
#pragma unroll
        for (int w2 = 0; w2 < 8; ++w2) { const unsigned t = wtot[w2]; NS += t; if (w2 < wave) wbase += t; }
        NS = (unsigned)__builtin_amdgcn_readfirstlane((int)NS); wbase = (unsigned)__builtin_amdgcn_readfirstlane((int)wbase);
        { const unsigned ex = wbase + inc - hs; u32x4 o; o.x = ex; o.y = ex + hh4.x; o.z = o.y + hh4.y; o.w = o.z + hh4.z; ((u32x4*)hist)[tidx] = o; }
        __syncthreads();
        if (NS <= (unsigned)PSA_SORT_MAX) {
#pragma unroll
            for (int j = 0; j < 17; ++j) {
                if ((IA(j) >> PEER_PSH) == p) { const unsigned pos = atomicAdd(&hist[IA(j) & 2047], 1u); srt[pos] = (unsigned)IA(j) | (lane_o << 14) | ((unsigned)(wave + 8 * j) << 21); }
                if ((IB(j) >> PEER_PSH) == p) { const unsigned pos = atomicAdd(&hist[IB(j) & 2047], 1u); srt[pos] = (unsigned)IB(j) | ((64u + lane_o) << 14) | ((unsigned)(wave + 8 * j) << 21); }
            }
            __syncthreads();
            ((u32x4*)hist)[tidx] = (u32x4){0u, 0u, 0u, 0u};
            lst = srt; n = (int)NS; cstart = wave * 32; cstride = 256;
        } else {
        ((u32x4*)hist)[tidx] = (u32x4){0u, 0u, 0u, 0u};
#endif
#pragma unroll
        for (int j = 0; j < 17; ++j) {
            const bool in0 = (IA(j) >> PEER_PSH) == p, in1 = (IB(j) >> PEER_PSH) == p;
            const unsigned long long m0 = __ballot(in0), m1 = __ballot(in1);
            const int c0 = __popcll(m0), c1 = __popcll(m1);
            const int r0 = n + (int)__builtin_amdgcn_mbcnt_hi((unsigned)(m0 >> 32), __builtin_amdgcn_mbcnt_lo((unsigned)m0, 0u));
            const int r1 = n + c0 + (int)__builtin_amdgcn_mbcnt_hi((unsigned)(m1 >> 32), __builtin_amdgcn_mbcnt_lo((unsigned)m1, 0u));
            if (in0 && r0 < PSA_ENT_MAX) ent[r0] = (unsigned)IA(j) | (lane_o << 14) | ((unsigned)(wave + 8 * j) << 21);
            if (in1 && r1 < PSA_ENT_MAX) ent[r1] = (unsigned)IB(j) | ((64u + lane_o) << 14) | ((unsigned)(wave + 8 * j) << 21);
            n += c0 + c1;
        }
        nov = n;
        n = min(n, PSA_ENT_MAX);
#if PEER_SORTA
        }
#endif
        {
#pragma unroll 1
            for (int base = cstart; base < n; base += cstride) {
                const unsigned myent = lst[min(base + (lane & 31), n - 1)];
                u32x4 ub[32];
#pragma unroll
                for (int q = 0; q < 32; ++q) { const unsigned ej = (unsigned)rl_i((int)myent, q); ub[q] = *(const u32x4*)(U8 + (size_t)(ej & 0x3fffu) * D + lane * 16); }
                int ps[32];
#pragma unroll
                for (int q = 0; q < 32; ++q) { const int tq = (int)((unsigned)rl_i((int)myent, q) >> 21); const u32x4 xv = *(const u32x4*)(ldsg + PSA_XQ + tq * 1024 + lane * 16);
                    int s = __builtin_amdgcn_sdot4((int)ub[q].x, (int)xv.x, 0, false); s = __builtin_amdgcn_sdot4((int)ub[q].y, (int)xv.y, s, false);
                    s = __builtin_amdgcn_sdot4((int)ub[q].z, (int)xv.z, s, false); ps[q] = __builtin_amdgcn_sdot4((int)ub[q].w, (int)xv.w, s, false); }
                const int tot = reduce32i(ps, lane);
                const int slot = lane >> 1;
                if ((lane & 1) == 0 && base + slot < n) { const unsigned en = lst[base + slot]; const int tl = (int)(en >> 21), pos = (int)((en >> 14) & 127u);
                    AW[(size_t)(row0 + tl) * 128 + pos] = (float)tot * sxs[tl]; }
            }
        }
        if (nov > PSA_ENT_MAX) {
            int cnt = 0;
#pragma unroll 1
            for (int j = 0; j < J; ++j) { const size_t r = (size_t)(row0 + wave + 8 * j) * 128;
#pragma unroll 1
                for (int pos = 0; pos < 128; ++pos) { const int e = idx[r + pos];
                    if ((e >> PEER_PSH) == p) { if (cnt >= PSA_ENT_MAX) { const u32x4 uv = *(const u32x4*)(U8 + (size_t)e * D + lane * 16), xv = *(const u32x4*)(ldsg + PSA_XQ + (wave + 8 * j) * 1024 + lane * 16);
                            int s = __builtin_amdgcn_sdot4((int)uv.x, (int)xv.x, 0, false); s = __builtin_amdgcn_sdot4((int)uv.y, (int)xv.y, s, false); s = __builtin_amdgcn_sdot4((int)uv.z, (int)xv.z, s, false); s = __builtin_amdgcn_sdot4((int)uv.w, (int)xv.w, s, false);
                            const float a = wave_sum((float)s); if (lane == 0) AW[r + pos] = a * sxs[wave + 8 * j]; }
                        ++cnt; } } }
        }
        __syncthreads();
    }
    unsigned short* idxs = (unsigned short*)(ldsg + PSB_IDX); unsigned char* wqb = ldsg + PSB_WQ; float* sws = (float*)(ldsg + PSB_SW); float* ssl = (float*)(ldsg + PSB_SS);
    constexpr int LPS = 64 / PEER_NSLAB, RR = 64 / LPS, NK = 128 / RR, NG = NK / 4;
#pragma unroll
    for (int jb = 0; jb < 18; jb += 3) {
        float aw0[3], aw1[3], g0[3], g1[3], su0[3], su1[3], sv0[3], sv1[3];
#pragma unroll
        for (int q = 0; q < 3; ++q) { const int j = jb + q; if (j < 17 && j < J) { const size_t r = (size_t)(row0 + wave + 8 * j) * 128;
            aw0[q] = AW[r + lane]; aw1[q] = AW[r + 64 + lane]; g0[q] = gate[r + lane]; g1[q] = gate[r + 64 + lane];
            su0[q] = SU[IA(j)]; su1[q] = SU[IB(j)]; sv0[q] = SV[IA(j)]; sv1[q] = SV[IB(j)]; } }
#pragma unroll
        for (int q = 0; q < 3; ++q) { const int j = jb + q; if (j < 17 && j < J) { const int tl = wave + 8 * j;
            const float a0 = aw0[q] * su0[q], a1 = aw1[q] * su1[q];
            const float w0 = g0[q] * sv0[q] * 0.5f * a0 * (1.f + erff(a0 * 0.70710678f)), w1 = g1[q] * sv1[q] * 0.5f * a1 * (1.f + erff(a1 * 0.70710678f));
            const float wm = wave_max(fmaxf(fabsf(w0), fabsf(w1))); const float sw = wm > 0.f ? wm * (1.f / 127.f) : 1.f, inv = 1.f / sw;
            const int q0 = (int)rintf(w0 * inv), q1 = (int)rintf(w1 * inv);
            { const int pos = lane, k = pos / RR, rr = pos % RR; wqb[tl * 128 + ((k >> 2) * RR + rr) * 4 + (k & 3)] = (unsigned char)(q0 & 0xff); }
            { const int pos = 64 + lane, k = pos / RR, rr = pos % RR; wqb[tl * 128 + ((k >> 2) * RR + rr) * 4 + (k & 3)] = (unsigned char)(q1 & 0xff); }
            idxs[tl * 128 + lane] = (unsigned short)IA(j); idxs[tl * 128 + 64 + lane] = (unsigned short)IB(j);
            if (lane == 0) sws[tl] = sw; ssl[tl * 64 + lane] = 0.f; } }
    }
    __syncthreads();
    const int rr = lane / LPS, cc = lane % LPS;
    constexpr int NREPB = ((DUP_MASK >> 10) & 1) ? 2 : 1; constexpr float WSC = 1.f / NREPB;
    constexpr int TB = (NK == 8) ? 4 : 2;
    for (int repB = 0; repB < NREPB; ++repB)
#pragma unroll 1
    for (int s = 0; s < PEER_NSLAB; ++s) {
#pragma unroll 1
        for (int jg = 0; jg < J; jg += TB) {
            u32x4 vb[TB][NK];
#pragma unroll
            for (int q = 0; q < TB; ++q) if (jg + q < J) { const int tl = wave + 8 * (jg + q);
#pragma unroll
                for (int k = 0; k < NK; ++k) { const int e = idxs[tl * 128 + RR * k + rr]; vb[q][k] = *(const u32x4*)(V8 + (size_t)e * D + s * (LPS * 16) + cc * 16); } }
#pragma unroll
            for (int q = 0; q < TB; ++q) if (jg + q < J) { const int tl = wave + 8 * (jg + q), row = row0 + tl;
                int acc[16];
#pragma unroll
                for (int c = 0; c < 16; ++c) acc[c] = 0;
#pragma unroll
                for (int gq = 0; gq < NG; ++gq) { const int wq = *(const int*)(wqb + tl * 128 + (gq * RR + rr) * 4);
#pragma unroll
                    for (int d4 = 0; d4 < 4; ++d4) { const unsigned a = vb[q][4 * gq][d4], b = vb[q][4 * gq + 1][d4], c = vb[q][4 * gq + 2][d4], d = vb[q][4 * gq + 3][d4];
                        const unsigned x0 = __builtin_amdgcn_perm(b, a, 0x05010400u), x1 = __builtin_amdgcn_perm(b, a, 0x07030602u), y0 = __builtin_amdgcn_perm(d, c, 0x05010400u), y1 = __builtin_amdgcn_perm(d, c, 0x07030602u);
                        acc[4 * d4 + 0] = __builtin_amdgcn_sdot4((int)__builtin_amdgcn_perm(y0, x0, 0x05040100u), wq, acc[4 * d4 + 0], false);
                        acc[4 * d4 + 1] = __builtin_amdgcn_sdot4((int)__builtin_amdgcn_perm(y0, x0, 0x07060302u), wq, acc[4 * d4 + 1], false);
                        acc[4 * d4 + 2] = __builtin_amdgcn_sdot4((int)__builtin_amdgcn_perm(y1, x1, 0x05040100u), wq, acc[4 * d4 + 2], false);
                        acc[4 * d4 + 3] = __builtin_amdgcn_sdot4((int)__builtin_amdgcn_perm(y1, x1, 0x07060302u), wq, acc[4 * d4 + 3], false); } }
                reduce16r<LPS>(acc, lane);
                const float sc = sws[tl] * WSC;
                const int mi = row < M_LAT ? row / S : 4;
                bf16* xrow = row < M_LAT ? xlat + (size_t)row * D : xctx + (size_t)(row - M_LAT) * D;
                const float* g2 = modl + (size_t)mi * 6 * D + off_g;
                if (LPS == 4) { const int col = s * 64 + cc * 16 + rr; const bf16 vb = f2bf(bf2f(xrow[col]) + g2[col] * ((float)acc[0] * sc)); xrow[col] = vb; const float v0 = bf2f(vb); if (repB == NREPB - 1) ssl[tl * 64 + lane] += v0 * v0; }
                else { const int col = s * 128 + cc * 16 + 2 * rr; const unsigned xb = *(const unsigned*)(xrow + col); const float2 gg = *(const float2*)(g2 + col);
                    const unsigned ob = pg8::cvt_pk_bf16(__uint_as_float(xb << 16) + gg.x * ((float)acc[0] * sc), __uint_as_float(xb & 0xffff0000u) + gg.y * ((float)acc[1] * sc));
                    *(unsigned*)(xrow + col) = ob; const float v0 = __uint_as_float(ob << 16), v1 = __uint_as_float(ob & 0xffff0000u);
                    if (repB == NREPB - 1) ssl[tl * 64 + lane] += v0 * v0 + v1 * v1; }
            }
        }
        __syncthreads();
    }
    asm volatile("s_waitcnt vmcnt(0)" ::: "memory");
    __builtin_amdgcn_fence(__ATOMIC_ACQUIRE, "agent");
    asm volatile("s_waitcnt vmcnt(0)" ::: "memory");
#pragma unroll 1
    for (int j0 = 0; j0 < J; j0 += 2) {
        f32x4 v[2][4];
#pragma unroll
        for (int t = 0; t < 2; ++t) if (j0 + t < J) { const int row = row0 + wave + 8 * (j0 + t); const bf16* xrow = row < M_LAT ? xlat + (size_t)row * D : xctx + (size_t)(row - M_LAT) * D;
#pragma unroll
            for (int q = 0; q < 4; ++q) v[t][q] = ld4res<true>(xrow, (size_t)(lane + 64 * q) * 4); }
#pragma unroll
        for (int t = 0; t < 2; ++t) if (j0 + t < J) { const int tl = wave + 8 * (j0 + t), row = row0 + tl; const int mi = row < M_LAT ? row / S : 4;
            float* xrow = outf + (size_t)row * D;
            const float rs = rsqrtf(wave_sum(ssl[tl * 64 + lane]) * (1.f / D) + EPS);
            float am = 0.f;
#pragma unroll
            for (int q = 0; q < 4; ++q) { const int k = (lane + 64 * q) * 4; const f32x4 w = *(const f32x4*)(nw + k);
                if (MODE == 2) { f32x4 o; o.x = v[t][q].x * rs * w.x; o.y = v[t][q].y * rs * w.y; o.z = v[t][q].z * rs * w.z; o.w = v[t][q].w * rs * w.w; ((f32x4*)xrow)[lane + 64 * q] = o; }
                else { const f32x4 b = *(const f32x4*)(modn + (size_t)mi * 6 * D + k), a = *(const f32x4*)(modn + (size_t)mi * 6 * D + D + k);
                    v[t][q].x = v[t][q].x * rs * w.x * (1.f + a.x) + b.x; v[t][q].y = v[t][q].y * rs * w.y * (1.f + a.y) + b.y; v[t][q].z = v[t][q].z * rs * w.z * (1.f + a.z) + b.z; v[t][q].w = v[t][q].w * rs * w.w * (1.f + a.w) + b.w;
                    am = fmaxf(am, fmaxf(fmaxf(fabsf(v[t][q].x), fabsf(v[t][q].y)), fmaxf(fabsf(v[t][q].z), fabsf(v[t][q].w)))); } }
            if (MODE == 1) {
                am = wave_max(am); const float sx = am > 0.f ? am * (1.f / 127.f) : 1.f, inv = 1.f / sx;
#pragma unroll
                for (int q = 0; q < 4; ++q) { const int q0 = (int)rintf(v[t][q].x * inv), q1 = (int)rintf(v[t][q].y * inv), q2 = (int)rintf(v[t][q].z * inv), q3 = (int)rintf(v[t][q].w * inv);
                    *(unsigned*)(xqo + (size_t)row * D + (lane + 64 * q) * 4) = (unsigned)(q0 & 0xff) | ((unsigned)(q1 & 0xff) << 8) | ((unsigned)(q2 & 0xff) << 16) | ((unsigned)(q3 & 0xff) << 24); }
                if (lane == 0) xso[row] = sx; }
        }
    }
}
__device__ __forceinline__ void ph_final_norm(float* x, const float* fw, int nrows) { const int tidx = otid();
    const int lane = tidx & 63, wave = tidx >> 6;
    for (int row0 = (blockIdx.x * 8 + wave) * 2; row0 < nrows; row0 += gridDim.x * 16) {
        f32x4 v[2][4];
#pragma unroll
        for (int r = 0; r < 2; ++r)
#pragma unroll
            for (int j = 0; j < 4; ++j) v[r][j] = ((const f32x4*)(x + (size_t)(row0 + r) * D))[lane + 64 * j];
#pragma unroll
        for (int r = 0; r < 2; ++r) { float ss = 0.f;
#pragma unroll
            for (int j = 0; j < 4; ++j) ss += v[r][j].x * v[r][j].x + v[r][j].y * v[r][j].y + v[r][j].z * v[r][j].z + v[r][j].w * v[r][j].w;
            ss = wave_sum(ss); const float rs = rsqrtf(ss * (1.f / D) + EPS);
#pragma unroll
            for (int j = 0; j < 4; ++j) { const f32x4 w = *(const f32x4*)(fw + (lane + 64 * j) * 4); f32x4 o = v[r][j] * rs; o.x *= w.x; o.y *= w.y; o.z *= w.z; o.w *= w.w; ((f32x4*)(x + (size_t)(row0 + r) * D))[lane + 64 * j] = o; } }
    }
}
#define DEFINE_PTRS \
    const float* x = p.in[0]; const float* c = p.in[1]; const float* ctx = p.in[2]; const float* c_ctx = p.in[3]; \
    const float* norm1_w = p.in[4]; const float* norm2_w = p.in[5]; const float* w_ada = p.in[6]; const float* b_ada = p.in[7]; \
    const float* w_in = p.in[8]; const float* w_out = p.in[9]; const float* na_rpb = p.in[10]; \
    const float* dec_f = p.in[11]; const float* dec_b = p.in[12]; const float* gn_w = p.in[13]; \
    const float* pool_w = p.in[14]; const float* pool_scale = p.in[15]; const float* peer_wq = p.in[16]; \
    const float* peer_keys = p.in[17]; const float* peer_u = p.in[18]; const float* peer_v = p.in[19]; const float* final_w = p.in[20]; \
    unsigned char* ws = p.ws; float* out = p.out; \
    float* MOD = (float*)(ws + WS_MOD); float* cosT = (float*)(ws + WS_ROPE); float* sinT = cosT + S * 32; \
    bf16* WI = (bf16*)(ws + WS_WI); bf16* WO = (bf16*)(ws + WS_WO); bf16* WQ = (bf16*)(ws + WS_WQ); bf16* KEYS = (bf16*)(ws + WS_KEYS); \
    bf16* XR = (bf16*)(ws + WS_XR); bf16* XRC = (bf16*)(ws + WS_XRC); bf16* U = (bf16*)(ws + WS_U); bf16* V = (bf16*)(ws + WS_V); bf16* ACT = (bf16*)(ws + WS_ACT); \
    bf16* PX = (bf16*)(ws + WS_PX); bf16* Q = PX; float* ST = (float*)(ws + WS_ST); bf16* STB = (bf16*)(ws + WS_ST); int* IDX = (int*)(ws + WS_IDX); float* GATE = (float*)(ws + WS_GATE); \
    float* TOPV = (float*)(ws + WS_TOPV); int* TOPI = (int*)(ws + WS_TOPI); \
    float* AW = (float*)(ws + WS_AW); (void)AW; \
    unsigned char* WI8 = ws + WS_WI8; unsigned char* WQ8 = ws + WS_WQ8; float* SWI = (float*)(ws + WS_SWI); float* SWQ = (float*)(ws + WS_SWQ); (void)WI8; (void)WQ8; (void)SWI; (void)SWQ; \
    unsigned char* XQ = ws + WS_XQ; float* XS = (float*)(ws + WS_XS); (void)XQ; (void)XS; \
    unsigned char* U8 = ws + WS_U; unsigned char* V8 = ws + WS_V; float* SU = (float*)(ws + WS_SU); float* SV = (float*)(ws + WS_SV); (void)U8; (void)V8; (void)SU; (void)SV; \
    (void)x; (void)c; (void)ctx; (void)c_ctx; (void)norm1_w; (void)norm2_w; (void)w_ada; (void)b_ada; (void)w_in; (void)w_out; (void)na_rpb; (void)dec_f; (void)dec_b; (void)gn_w; \
    (void)pool_w; (void)pool_scale; (void)peer_wq; (void)peer_keys; (void)peer_u; (void)peer_v; (void)final_w; (void)out; (void)MOD; (void)cosT; (void)sinT; (void)WI; (void)WO; (void)WQ; \
    (void)KEYS; (void)XR; (void)XRC; (void)U; (void)V; (void)ACT; (void)PX; (void)Q; (void)ST; (void)IDX; (void)GATE; (void)TOPV; (void)TOPI;
#define GRID_SYNC() xcd_barrier(bar)

template <int l>
__device__ __forceinline__ void layer(const Params& p, unsigned char* lds, const XcdBarrier& bar) {
    DEFINE_PTRS
    constexpr bool last = (l == DEPTH - 1);
    const float* modl = MOD + (size_t)l * 5 * 6 * D;
    constexpr int mrows = last ? M_LAT : M_ALL;
    if (l == 0) { ph_quant_w(WI, WI8, SWI, DEPTH * DPROJ_PAD); ph_quant_w(WQ, WQ8, SWQ, DEPTH * DQ); }
    if (l == 0) { DUP(1) ph_norm<true, false>(x, ctx, norm1_w + l * D, modl, 0, D, nullptr, XQ, XS, M_ALL);
    GRID_SYNC(); }
    else if (gridDim.x != 256) { ph_norm<true, true>(XR, XRC, norm1_w + l * D, modl, 0, D, nullptr, XQ, XS, M_ALL);
    GRID_SYNC(); }
#if USE_PG8
    DUP(2) { pg8::Gemm g{(const pg8::bf16_t*)XQ, (const pg8::bf16_t*)(WI8 + (size_t)l * DPROJ_PAD * D), M_ALL, DPROJ_PAD, D / 2}; pg8::StaticOrder So; So.init(M_ALL, DPROJ_PAD, (int)gridDim.x, (int)blockIdx.x);
      EpiI8Bf16Out E{PX, DPROJ, DPROJ, XS, SWI + l * DPROJ_PAD}; pg8::gemm_phase_i8<EpiI8Bf16Out, pg8::StaticOrder>((PG8_LAS unsigned char*)lds, g, So, E, nullptr); }
#else
    ph_gemm_simple<0>(ACT, WI + (size_t)l * DPROJ_PAD * D, M_ALL, DPROJ_PAD, D, PX, DPROJ, DPROJ, nullptr, nullptr, nullptr, nullptr, nullptr, 0, (bf16*)lds);
#endif
    GRID_SYNC();
#if NA_NAIVE
    ph_na(PX, na_rpb + (size_t)l * NAH * 15 * 31, ACT, mrows);
#else
    DUP(4) { ph_na_mfma2(PX, na_rpb + (size_t)l * NAH * 15 * 31, ACT, last ? 768 : 816, lds);
    __syncthreads(); }
#endif
    DUP(5) ph_pool(PX, ACT, mrows);
#if RET_NAIVE
    ph_ret_state(PX, cosT, sinT, dec_f + l * RH, dec_b + l * RH, ST, (float*)lds);
#else
    DUP(6) ph_ret_state_mfma(PX, cosT, sinT, dec_f + l * RH, dec_b + l * RH, STB, lds);
#endif
    GRID_SYNC();
#if RET_NAIVE
    ph_ret_scan(dec_f + l * RH, dec_b + l * RH, ST);
#else
    ph_ret_scan_bf(dec_f + l * RH, dec_b + l * RH, STB);
#endif
    GRID_SYNC();
#if RET_NAIVE
    ph_ret_out(PX, cosT, sinT, dec_f + l * RH, dec_b + l * RH, ST, gn_w + l * RW, ACT, last ? 64 : NCH, (float*)lds);
#else
    DUP(7) ph_ret_out_mfma(PX, cosT, sinT, dec_f + l * RH, dec_b + l * RH, STB, gn_w + l * RW, ACT, last ? 64 : NCH, lds);
#endif
    GRID_SYNC();
#if USE_PG8
    DUP(l == 0 ? 11 : 31) { pg8::Gemm g{ACT, WO + (size_t)l * D * D, mrows, D, D}; pg8::StaticOrder So; So.init(mrows, D, (int)gridDim.x, (int)blockIdx.x);
      if (l == 0) { EpiRes<false> E{x, ctx, XR, XRC, modl, 2 * D}; pg8::gemm_phase<EpiRes<false>, pg8::StaticOrder>((PG8_LAS unsigned char*)lds, g, So, E, nullptr); }
      else { EpiRes<true> E{XR, XRC, XR, XRC, modl, 2 * D}; pg8::gemm_phase<EpiRes<true>, pg8::StaticOrder>((PG8_LAS unsigned char*)lds, g, So, E, nullptr); } }
#else
    ph_gemm_simple<1>(ACT, WO + (size_t)l * D * D, mrows, D, D, nullptr, 0, 0, xl, xc, out, XCTX, modl, 2 * D, (bf16*)lds);
#endif
    GRID_SYNC();
    DUP(1) ph_norm<true, true>(XR, XRC, norm2_w + l * D, modl, 3 * D, 4 * D, gridDim.x != 256 ? ACT : nullptr, XQ, XS, mrows);
    GRID_SYNC();
#if USE_PG8
    DUP(3) { pg8::Gemm g{(const pg8::bf16_t*)XQ, (const pg8::bf16_t*)(WQ8 + (size_t)l * DQ * D), mrows, DQ, D / 2}; pg8::StaticOrder So; So.init(mrows, DQ, (int)gridDim.x, (int)blockIdx.x);
#if TK32
      EpiI8QT E{Q, XS, SWQ + l * DQ};
      if (gridDim.x == 256) { pg8::HeadOrder Ho; Ho.init(mrows, (int)blockIdx.x); pg8::gemm_phase_i8<EpiI8QT, pg8::HeadOrder>((PG8_LAS unsigned char*)lds, g, Ho, E, nullptr); }
      else pg8::gemm_phase_i8<EpiI8QT, pg8::StaticOrder>((PG8_LAS unsigned char*)lds, g, So, E, nullptr); }
#else
      EpiI8Bf16Out E{Q, DQ, DQ, XS, SWQ + l * DQ}; pg8::gemm_phase_i8<EpiI8Bf16Out, pg8::StaticOrder>((PG8_LAS unsigned char*)lds, g, So, E, nullptr); }
#endif
#else
    ph_gemm_simple<0>(ACT, WQ + (size_t)l * DQ * D, mrows, DQ, D, Q, DQ, DQ, nullptr, nullptr, nullptr, nullptr, nullptr, 0, (bf16*)lds);
#endif
#if TK32
    if (gridDim.x == 256) { __syncthreads(); DUP(8) ph_tk32<true>(Q, KEYS + (size_t)l * 2 * PH * PNK * PKD, IDX, GATE, mrows, lds); }
    else { GRID_SYNC(); DUP(8) ph_tk32<false>(Q, KEYS + (size_t)l * 2 * PH * PNK * PKD, IDX, GATE, mrows, lds); }
#else
    GRID_SYNC();
#endif
#if 1
#if TK32
#else
    DUP(8) ph_tk_mfma(Q, KEYS + (size_t)l * 2 * PH * PNK * PKD, IDX, GATE, mrows, lds);
#endif
#endif
    GRID_SYNC();
#if PEER_BF16
    ph_peer<last>(ACT, IDX, GATE, U + (size_t)l * NEXP * D, V + (size_t)l * NEXP * D, modl, 5 * D, out, XCTX, final_w, mrows);
#else
    if (gridDim.x == 256) {
        ph_peer_sweep<last ? 2 : 1>(IDX, GATE, U8 + (size_t)l * NEXP * D, V8 + (size_t)l * NEXP * D, SU + l * NEXP, SV + l * NEXP, XQ, XS, AW, modl, 5 * D, XR, XRC, out,
                                    last ? final_w : norm1_w + (l + 1) * D, MOD + (size_t)(l + 1 < DEPTH ? l + 1 : l) * 5 * 6 * D, XQ, XS, mrows, lds);
        if (!last) GRID_SYNC();
    } else {
        ph_peer8<last ? 2 : 0>(ACT, IDX, GATE, U8 + (size_t)l * NEXP * D, V8 + (size_t)l * NEXP * D, SU + l * NEXP, SV + l * NEXP, modl, 5 * D, XR, XRC, out, final_w, nullptr, mrows);
        if (!last) GRID_SYNC();
    }
    return;
#endif
    if (!last) GRID_SYNC();
}

__global__ void __launch_bounds__(NT, 2) mega(Params p) {
    extern __shared__ __attribute__((aligned(16))) unsigned char lds[];
    volatile LAS unsigned* bst = (volatile LAS unsigned*)((LAS unsigned char*)lds + LDS_BYTES - 64);
    if (threadIdx.x < 16) bst[threadIdx.x] = 0u;
    __syncthreads();
    const XcdBarrier bar = xcd_barrier_post((unsigned*)(p.ws + WS_CTL), bst);
    DUP(0) {
        DEFINE_PTRS
        DUP(20) { ph_mods(c, c_ctx, w_ada, b_ada, MOD, (float*)lds);
        __syncthreads();
#if RET_NAIVE
        ph_rope(cosT, sinT);
#endif
        }
        DUP(21)
        { ph_transpose_all(w_in, peer_wq, w_out, WI, WQ, WO, (float*)lds);
          ph_wo_pool(w_out, pool_w, pool_scale, WO, (float*)lds); }
        ph_cvt(peer_keys, KEYS, (size_t)DEPTH * 2 * PH * PNK * PKD / 4);
#if PEER_BF16
        ph_cvt(peer_u, U, (size_t)DEPTH * NEXP * D / 4);
        ph_cvt(peer_v, V, (size_t)DEPTH * NEXP * D / 4);
#else
        DUP(22) { ph_quant(peer_u, U8, SU, DEPTH * NEXP, 0);
        ph_quant(peer_v, V8, SV, DEPTH * NEXP, 0); }
#endif
    }
    GRID_SYNC();
    layer<0>(p, lds, bar);
    layer<1>(p, lds, bar);
}
}

extern "C" void kernel_launch(void* const* d_in, const int* in_sizes, int n_in, void* d_out, int out_size, void* d_ws, size_t ws_size, hipStream_t stream) {
    static int grid = 0;
    if (grid == 0) {
        if (n_in != 21 || out_size != M_LAT * D || ws_size < WS_END) { fprintf(stderr, "kernel_launch: unexpected sizes n_in %d out %d ws %zu (need %zu)\n", n_in, out_size, ws_size, (size_t)WS_END); grid = -1; return; }
        int dev = 0, cus = 0, per_cu = 0;
        if (hipGetDevice(&dev) != hipSuccess || hipDeviceGetAttribute(&cus, hipDeviceAttributeMultiprocessorCount, dev) != hipSuccess) { fprintf(stderr, "kernel_launch: device query failed\n"); grid = -1; return; }
        if (hipFuncSetAttribute((const void*)mega, hipFuncAttributeMaxDynamicSharedMemorySize, LDS_BYTES) != hipSuccess) { fprintf(stderr, "kernel_launch: hipFuncSetAttribute failed\n"); grid = -1; return; }
        if (hipOccupancyMaxActiveBlocksPerMultiprocessor(&per_cu, (const void*)mega, NT, LDS_BYTES) != hipSuccess || per_cu < 1) { fprintf(stderr, "kernel_launch: occupancy query says %d\n", per_cu); grid = -1; (void)hipGetLastError(); return; }
        grid = cus;
    }
    if (grid < 0) return;
    Params p{};
    for (int i = 0; i < 21; ++i) p.in[i] = (const float*)d_in[i];
    p.out = (float*)d_out; p.ws = (unsigned char*)d_ws;
    if (hipMemsetAsync((char*)d_ws + WS_CTL, 0, 65536, stream) != hipSuccess) { fprintf(stderr, "kernel_launch: memset failed\n"); return; }
    hipLaunchKernelGGL(mega, dim3(grid), dim3(NT), LDS_BYTES, stream, p);
    hipError_t e = hipPeekAtLastError();
    if (e != hipSuccess) fprintf(stderr, "kernel_launch: launch failed: %s (grid %d)\n", hipGetErrorString(e), grid);
}
```
